# Optimizing an MI355X kernel written in HIP

```python
import jax, jax.numpy as jnp
from jax import lax
import numpy as np

D_MODEL = 1024
BATCH = 4
SEQ = 4096
DEPTH = 1

C_CONV = 512
CONV_WIDTH = 31
RW_HEADS = 8
RW_HEAD_DIM = 64
RW_WIDTH = RW_HEADS * RW_HEAD_DIM
LORA_W = 32
LORA_A = 32
LORA_G = 96
N_BRANCH = 2
PK_HEADS = 8
PK_DIM = 256
PK_HALF = PK_DIM // 2
N_KEYS = 128
N_EXPERTS = N_KEYS * N_KEYS
PK_TOPK = 16
EXPERT_BLOCK = 128
NORM_EPS = 1e-6
LN_EPS = 1e-5
GN_EPS = 64e-5
COL_CONV = 2 * C_CONV
COL_RKV = 3 * RW_WIDTH
COL_LORA = LORA_W + LORA_A + LORA_G
COL_GATE = N_BRANCH * D_MODEL
D_IN = COL_CONV + COL_RKV + COL_LORA + COL_GATE

kernel_name = 'hybrid_conv_rwkv7_peer_block'


def rmsnorm(x, g):
    xf = x.astype(jnp.float32)
    y = xf * lax.rsqrt(jnp.mean(xf * xf, axis=-1, keepdims=True) + NORM_EPS)
    return (y * g.astype(jnp.float32)).astype(x.dtype)


def token_shift_lerp(z, mu):
    prev = jnp.pad(z, ((0, 0), (1, 0), (0, 0)))[:, :-1]
    return z + (prev - z) * mu


def conv_branch(u, dw, dw_b, ln_g, ln_b, pw, pw_b):
    a, b = jnp.split(u, 2, axis=-1)
    glu = a * jax.nn.sigmoid(b)
    y = lax.conv_general_dilated(
        glu, dw.reshape(CONV_WIDTH, 1, C_CONV).astype(glu.dtype),
        window_strides=(1,), padding=[(CONV_WIDTH - 1, 0)],
        dimension_numbers=('NWC', 'WIO', 'NWC'),
        feature_group_count=C_CONV) + dw_b
    yf = y.astype(jnp.float32)
    mean = jnp.mean(yf, axis=-1, keepdims=True)
    var = jnp.mean(jnp.square(yf - mean), axis=-1, keepdims=True)
    yn = (yf - mean) * lax.rsqrt(var + LN_EPS) * ln_g.astype(jnp.float32) + ln_b.astype(jnp.float32)
    yn = jax.nn.silu(yn).astype(u.dtype)
    return yn @ pw + pw_b


def rwkv7_branch(u, mu, w0, w2, a0, a2, g2, k_k, k_a, r_k, gn_g, gn_b, w_o):
    bsz, s = u.shape[0], u.shape[1]
    u = token_shift_lerp(u, mu)
    r, k, v, lw, la, lg = jnp.split(
        u, [RW_WIDTH, 2 * RW_WIDTH, 3 * RW_WIDTH,
            3 * RW_WIDTH + LORA_W, 3 * RW_WIDTH + LORA_W + LORA_A], axis=-1)
    w = -jax.nn.softplus(-(w0 + jnp.tanh(lw) @ w2)) - 0.5
    decay = jnp.exp(-jnp.exp(w.astype(jnp.float32)))
    a = jax.nn.sigmoid(a0 + la @ a2)
    g = jax.nn.sigmoid(lg) @ g2
    kk = k * k_k
    k = k * (1 + (a - 1) * k_a)

    def heads(t):
        return t.reshape(bsz, s, RW_HEADS, RW_HEAD_DIM).astype(jnp.float32)

    r_h, k_h, v_h, a_h, w_h, kk_h = map(heads, (r, k, v, a, decay, kk))
    kk_h = kk_h / jnp.maximum(jnp.linalg.norm(kk_h, axis=-1, keepdims=True), 1e-12)

    def step(state, inp):
        r_t, w_t, k_t, v_t, kk_t, a_t = inp
        sa = jnp.einsum('bhvk,bhk->bhv', state, -kk_t)
        state = (state * w_t[:, :, None, :]
                 + sa[..., None] * (kk_t * a_t)[:, :, None, :]
                 + v_t[..., None] * k_t[:, :, None, :])
        return state, jnp.einsum('bhvk,bhk->bhv', state, r_t)

    def time_major(t):
        return jnp.moveaxis(t, 1, 0)

    s0 = jnp.zeros((bsz, RW_HEADS, RW_HEAD_DIM, RW_HEAD_DIM), jnp.float32)
    _, y = lax.scan(step, s0, (time_major(r_h), time_major(w_h), time_major(k_h),
                               time_major(v_h), time_major(kk_h), time_major(a_h)))
    y = jnp.moveaxis(y, 0, 1)
    mean = jnp.mean(y, axis=-1, keepdims=True)
    var = jnp.mean(jnp.square(y - mean), axis=-1, keepdims=True)
    yn = ((y - mean) * lax.rsqrt(var + GN_EPS)
          * gn_g.reshape(RW_HEADS, RW_HEAD_DIM).astype(jnp.float32)
          + gn_b.reshape(RW_HEADS, RW_HEAD_DIM).astype(jnp.float32))
    bonus = jnp.sum(r_h * k_h * r_k.astype(jnp.float32), axis=-1, keepdims=True) * v_h
    o = (yn + bonus).reshape(bsz, s, RW_WIDTH).astype(u.dtype) * g
    return o @ w_o


def peer_ffn(h, w_q, keys, u_tab, v_tab):
    bsz, s, d = h.shape
    q = (h @ w_q).reshape(bsz, s, PK_HEADS, PK_DIM).astype(jnp.float32)
    kf = keys.astype(jnp.float32)
    s1 = jnp.einsum('bshd,hnd->bshn', q[..., :PK_HALF], kf[:, 0])
    s2 = jnp.einsum('bshd,hnd->bshn', q[..., PK_HALF:], kf[:, 1])
    v1, i1 = lax.top_k(s1, PK_TOPK)
    v2, i2 = lax.top_k(s2, PK_TOPK)
    cand = (v1[..., :, None] + v2[..., None, :]).reshape(bsz, s, PK_HEADS, PK_TOPK * PK_TOPK)
    best, c = lax.top_k(cand, PK_TOPK)
    e1 = jnp.take_along_axis(i1, c // PK_TOPK, axis=-1)
    e2 = jnp.take_along_axis(i2, c % PK_TOPK, axis=-1)
    expert = e1 * N_KEYS + e2
    gate = jax.nn.softmax(best, axis=-1)
    n_tok = bsz * s
    nb = n_tok // EXPERT_BLOCK
    hk = PK_HEADS * PK_TOPK
    xb = h.reshape(nb, EXPERT_BLOCK, d)
    eb = expert.reshape(nb, EXPERT_BLOCK, hk)
    gb = gate.reshape(nb, EXPERT_BLOCK, hk).astype(h.dtype)

    def block(args):
        xt, et, gt = args
        u_sel = jnp.take(u_tab, et, axis=0)
        act = jax.nn.gelu(jnp.einsum('tkd,td->tk', u_sel, xt), approximate=False)
        v_sel = jnp.take(v_tab, et, axis=0)
        return jnp.einsum('tk,tkd->td', gt * act, v_sel)

    out = lax.map(block, (xb, eb, gb))
    return out.reshape(bsz, s, d)


def setup_inputs(seed: int = 0) -> dict:
    key = jax.random.key(seed)
    ks = jax.random.split(key, 40)
    f32 = jnp.float32
    L = DEPTH

    def nrm(k, shape, std):
        return jax.random.normal(k, shape, f32) * std

    def ones_noise(k, shape, base=1.0):
        return base + 0.05 * jax.random.normal(k, shape, f32)

    return {
        'x': jax.random.normal(ks[0], (BATCH, SEQ, D_MODEL), f32),
        'norm_mix_g': ones_noise(ks[1], (L, D_MODEL)),
        'w_in': nrm(ks[2], (L, D_MODEL, D_IN), D_MODEL ** -0.5),
        'conv_dw': nrm(ks[3], (L, CONV_WIDTH, C_CONV), CONV_WIDTH ** -0.5),
        'conv_dw_b': nrm(ks[4], (L, C_CONV), 0.02),
        'conv_ln_g': ones_noise(ks[5], (L, C_CONV)),
        'conv_ln_b': nrm(ks[6], (L, C_CONV), 0.02),
        'conv_pw': nrm(ks[7], (L, C_CONV, D_MODEL), C_CONV ** -0.5),
        'conv_pw_b': nrm(ks[8], (L, D_MODEL), 0.02),
        'rw_mu': jax.random.uniform(ks[9], (L, COL_RKV + COL_LORA), f32),
        'rw_w0': jax.random.uniform(ks[10], (L, RW_WIDTH), f32, -5.0, -1.0),
        'rw_w2': nrm(ks[11], (L, LORA_W, RW_WIDTH), 0.3 * LORA_W ** -0.5),
        'rw_a0': nrm(ks[12], (L, RW_WIDTH), 0.1),
        'rw_a2': nrm(ks[13], (L, LORA_A, RW_WIDTH), LORA_A ** -0.5),
        'rw_g2': nrm(ks[14], (L, LORA_G, RW_WIDTH), LORA_G ** -0.5),
        'rw_k_k': ones_noise(ks[15], (L, RW_WIDTH), 0.85),
        'rw_k_a': ones_noise(ks[16], (L, RW_WIDTH)),
        'rw_r_k': nrm(ks[17], (L, RW_HEADS, RW_HEAD_DIM), 0.1),
        'rw_gn_g': ones_noise(ks[18], (L, RW_WIDTH)),
        'rw_gn_b': nrm(ks[19], (L, RW_WIDTH), 0.02),
        'rw_w_o': nrm(ks[20], (L, RW_WIDTH, D_MODEL), RW_WIDTH ** -0.5),
        'w_out': nrm(ks[21], (L, D_MODEL, D_MODEL), D_MODEL ** -0.5),
        'norm_ffn_g': ones_noise(ks[22], (L, D_MODEL)),
        'peer_wq': nrm(ks[23], (L, D_MODEL, PK_HEADS * PK_DIM), D_MODEL ** -0.5),
        'peer_keys': nrm(ks[24], (L, PK_HEADS, 2, N_KEYS, PK_HALF), PK_HALF ** -0.5),
        'peer_u': nrm(ks[25], (L, N_EXPERTS, D_MODEL), D_MODEL ** -0.5),
        'peer_v': nrm(ks[26], (L, N_EXPERTS, D_MODEL), 0.25),
        'norm_f_g': ones_noise(ks[27], (D_MODEL,)),
    }


def reference(x, norm_mix_g, w_in, conv_dw, conv_dw_b, conv_ln_g, conv_ln_b, conv_pw, conv_pw_b,
              rw_mu, rw_w0, rw_w2, rw_a0, rw_a2, rw_g2, rw_k_k, rw_k_a, rw_r_k, rw_gn_g, rw_gn_b,
              rw_w_o, w_out, norm_ffn_g, peer_wq, peer_keys, peer_u, peer_v, norm_f_g):
    for l in range(DEPTH):
        h = rmsnorm(x, norm_mix_g[l])
        proj = h @ w_in[l]
        u_conv, u_rw, gate_logits = jnp.split(
            proj, [COL_CONV, COL_CONV + COL_RKV + COL_LORA], axis=-1)
        y_conv = conv_branch(u_conv, conv_dw[l], conv_dw_b[l], conv_ln_g[l], conv_ln_b[l],
                             conv_pw[l], conv_pw_b[l])
        y_rw = rwkv7_branch(u_rw, rw_mu[l], rw_w0[l], rw_w2[l], rw_a0[l], rw_a2[l], rw_g2[l],
                            rw_k_k[l], rw_k_a[l], rw_r_k[l], rw_gn_g[l], rw_gn_b[l], rw_w_o[l])
        g_conv, g_rw = jnp.split(jax.nn.sigmoid(gate_logits), 2, axis=-1)
        x = x + (g_conv * y_conv + g_rw * y_rw) @ w_out[l]
        h = rmsnorm(x, norm_ffn_g[l])
        x = x + peer_ffn(h, peer_wq[l], peer_keys[l], peer_u[l], peer_v[l])
    return rmsnorm(x, norm_f_g)
```

```cpp
#include <hip/hip_runtime.h>
#include <stdint.h>
#include <stdio.h>
namespace pg8 {
#define PG8_LAS __attribute__((address_space(3)))
typedef unsigned short bf16_t;
typedef short bf16x8 __attribute__((ext_vector_type(8)));
typedef float f32x4 __attribute__((ext_vector_type(4)));
typedef unsigned u32x4 __attribute__((ext_vector_type(4)));
constexpr int BM = 256, BK = 64, HALF = 128, HTB = HALF * BK * 2  , STAGE_BYTES = 8 * HTB, NXCD = 8, WGM = 8;

__host__ __device__ __forceinline__ int lds_byte(int r, int c) { const int st = (r >> 4) * 2 + (c >> 5), rr = r & 15, cc = c & 31, ob = rr * 64 + cc * 2; return st * 1024 + (ob ^ (((ob >> 9) & 1) << 5)); }
__host__ __device__ __forceinline__ void stage_rc(int b, int& R, int& C) { const int st = b / 1024, sb = b % 1024, swz = sb ^ (((sb >> 9) & 1) << 5); R = (st >> 1) * 16 + swz / 64; C = (st & 1) * 32 + (swz % 64) / 2; }
__host__ __device__ __forceinline__ int perm32(int rho) { const int n = rho >> 4, i = rho & 15; return 8 * (i >> 2) + 4 * n + (i & 3); }

struct Unit { int pm, pn; };
struct Gemm { const bf16_t* A; const bf16_t* Bt; int M, N, K; };

struct StaticOrder {
    int nM, nN, nwg, G, c;
    __host__ __device__ void init(int M, int N, int G_, int c_) { nM = M / BM; nN = N / BM; nwg = nM * nN; G = G_; c = c_; }
    __host__ __device__ bool next(int i, Unit& u) const {
        const long L = (long)i * G + c; if (L >= nwg) return false;
        int wgid = (int)L; { const int q = nwg / NXCD, r = nwg % NXCD, xcd = wgid % NXCD, off = wgid / NXCD; wgid = (xcd < r ? xcd * (q + 1) : r * (q + 1) + (xcd - r) * q) + off; }
        const int nig = WGM * nN, gid = wgid / nig, fm = gid * WGM, gsz = (nM - fm) < WGM ? (nM - fm) : WGM;
        u.pm = fm + ((wgid % nig) % gsz); u.pn = (wgid % nig) / gsz; return true;
    }
    __device__ __forceinline__ void a_ready(const Unit&) const {}
    __device__ __forceinline__ void done(const Unit&) const {}
};
__device__ __forceinline__ unsigned cvt_pk_bf16(float lo, float hi) { unsigned r; asm volatile("v_cvt_pk_bf16_f32 %0, %1, %2" : "=v"(r) : "v"(lo), "v"(hi)); return r; }
template <class Epi, class Sched, bool STAMP = false>
__device__ __forceinline__ void gemm_phase(PG8_LAS unsigned char* lds, const Gemm g, const Sched& S, const Epi& E, unsigned long long* stamps) {
    const int tid = threadIdx.x, wid = __builtin_amdgcn_readfirstlane(tid >> 6), lane = tid & 63, wr = wid >> 2, wc = wid & 3, fr = lane & 15, fq = lane >> 4;
    const int K = g.K, nt = K / BK;
    int ts_lo = 0, ts_hi = 0, nts = 0; const unsigned long long rt_entry = STAMP ? (unsigned long long)wall_clock64() : 0ull;
#define PG8_STAMP() do { if (STAMP && wid == 0 && nts < 64) { const unsigned long long _c = (unsigned long long)clock64(); \
        ts_lo = (lane == nts) ? (int)(unsigned)_c : ts_lo; ts_hi = (lane == nts) ? (int)(unsigned)(_c >> 32) : ts_hi; ++nts; } } while (0)
    PG8_STAMP();
    unsigned voffA[2], voffB[2];
#pragma unroll
    for (int i = 0; i < 2; ++i) { int R, C; stage_rc(tid * 16 + i * 8192, R, C); const int Rb = Epi::PERM ? ((R & ~31) + perm32(R & 31)) : R;
        voffA[i] = (unsigned)(R * K + C) * 2u; voffB[i] = (unsigned)(Rb * K + C) * 2u; }
    const size_t kstep = (size_t)(BK * 2);
    const size_t hstep = (size_t)HALF * K * 2;
    const size_t tstep = 2 * hstep;
    const unsigned ldsw = (unsigned)wid * 1024u;
    const int aoff = lds_byte(wr * 64 + fr, fq * 8), boff = lds_byte(wc * 32 + fr, fq * 8);
#define PG8_SA(b, h) (((b) * 2 + (h)) * HTB)
#define PG8_SB(b, h) ((4 + (b) * 2 + (h)) * HTB)
#define PG8_STAGE(bufoff, gbase, voff) do { _Pragma("unroll") for (int _i = 0; _i < 2; ++_i) \
        __builtin_amdgcn_global_load_lds((const unsigned*)((const char*)(gbase) + (voff)[_i]), (PG8_LAS unsigned*)(lds + (bufoff) + ldsw + _i * 8192), 16, 0, 0); } while (0)
#define PG8_LDA(dst, b, h) do { _Pragma("unroll") for (int m = 0; m < 4; ++m) _Pragma("unroll") for (int k = 0; k < 2; ++k) dst[m][k] = *(const PG8_LAS bf16x8*)(lds + PG8_SA(b, h) + aoff + m * 2048 + k * 1024); } while (0)
#define PG8_LDB(dst, b, h) do { _Pragma("unroll") for (int n = 0; n < 2; ++n) _Pragma("unroll") for (int k = 0; k < 2; ++k) dst[n][k] = *(const PG8_LAS bf16x8*)(lds + PG8_SB(b, h) + boff + n * 2048 + k * 1024); } while (0)
#define PG8_MMA(ai, bj, At, Bt) do { __builtin_amdgcn_s_setprio(1); _Pragma("unroll") for (int m = 0; m < 4; ++m) _Pragma("unroll") for (int n = 0; n < 2; ++n) _Pragma("unroll") for (int k = 0; k < 2; ++k) \
        acc[ai][bj][m][n] = __builtin_amdgcn_mfma_f32_16x16x32_bf16(Bt[n][k], At[m][k], acc[ai][bj][m][n], 0, 0, 0); __builtin_amdgcn_s_setprio(0); } while (0)
#define PG8_WAIT_V(n) asm volatile("s_waitcnt vmcnt(" #n ")" ::: "memory")
#define PG8_WAIT_L(n) asm volatile("s_waitcnt lgkmcnt(" #n ")" ::: "memory")
#define PG8_BAR __builtin_amdgcn_s_barrier()
#define PG8_SCHED __builtin_amdgcn_sched_barrier(0)
    Unit cur, nxt; int ui = 0;
    if (!S.next(0, cur)) return;
    f32x4 acc[2][2][4][2];
#pragma unroll
    for (int a = 0; a < 2; ++a)
#pragma unroll
        for (int b = 0; b < 2; ++b)
#pragma unroll
            for (int m = 0; m < 4; ++m)
#pragma unroll
                for (int n = 0; n < 2; ++n) acc[a][b][m][n] = (f32x4){0.f, 0.f, 0.f, 0.f};
    bf16x8 At[4][2], B0[2][2], B1[2][2];
    const char* cA = (const char*)g.A + (size_t)cur.pm * tstep; const char* cB = (const char*)g.Bt + (size_t)cur.pn * tstep;
    S.a_ready(cur);
    PG8_STAGE(PG8_SB(0, 0), cB, voffB); PG8_STAGE(PG8_SA(0, 0), cA, voffA); PG8_STAGE(PG8_SB(0, 1), cB + hstep, voffB); PG8_STAGE(PG8_SA(0, 1), cA + hstep, voffA);
    if (wr == 1) PG8_BAR;
    PG8_WAIT_V(4); PG8_BAR;
    PG8_STAGE(PG8_SB(1, 0), cB + kstep, voffB); PG8_STAGE(PG8_SA(1, 0), cA + kstep, voffA); PG8_STAGE(PG8_SB(1, 1), cB + hstep + kstep, voffB);
    PG8_WAIT_V(6); PG8_BAR;
    PG8_STAMP();
    for (;;) {
        const bool has_next = S.next(ui + 1, nxt);
        const char* nA = has_next ? (const char*)g.A + (size_t)nxt.pm * tstep : cA; const char* nB = has_next ? (const char*)g.Bt + (size_t)nxt.pn * tstep : cB;
        for (int t = 0; t < nt; t += 2) {
            const bool last = (t == nt - 2);
            const char* a1 = cA + (size_t)(t + 1) * kstep;
            const char* a2 = last ? nA : cA + (size_t)(t + 2) * kstep; const char* b2 = last ? nB : cB + (size_t)(t + 2) * kstep;
            const char* a3 = a2 + kstep; const char* b3 = b2 + kstep;
            if (last && has_next) S.a_ready(nxt);
            PG8_LDB(B0, 0, 0); PG8_SCHED; PG8_LDA(At, 0, 0); PG8_STAGE(PG8_SA(1, 1), a1 + hstep, voffA);
            PG8_WAIT_L(8); PG8_BAR; PG8_WAIT_L(0); PG8_MMA(0, 0, At, B0); PG8_BAR; PG8_SCHED;
            PG8_LDB(B1, 0, 1); PG8_STAGE(PG8_SB(0, 0), b2, voffB);
            PG8_BAR; PG8_WAIT_L(0); PG8_MMA(0, 1, At, B1); PG8_BAR;
            PG8_LDA(At, 0, 1); PG8_STAGE(PG8_SA(0, 0), a2, voffA);
            PG8_BAR; PG8_WAIT_L(0); PG8_MMA(1, 0, At, B0); PG8_BAR; PG8_SCHED;
            PG8_STAGE(PG8_SB(0, 1), b2 + hstep, voffB);
            PG8_WAIT_V(6); PG8_BAR; PG8_MMA(1, 1, At, B1); PG8_BAR;
            PG8_LDB(B0, 1, 0); PG8_SCHED; PG8_LDA(At, 1, 0); PG8_STAGE(PG8_SA(0, 1), a2 + hstep, voffA);
            PG8_WAIT_L(8); PG8_BAR; PG8_WAIT_L(0); PG8_MMA(0, 0, At, B0); PG8_BAR; PG8_SCHED;
            PG8_LDB(B1, 1, 1); PG8_STAGE(PG8_SB(1, 0), b3, voffB);
            PG8_BAR; PG8_WAIT_L(0); PG8_MMA(0, 1, At, B1); PG8_BAR;
            PG8_LDA(At, 1, 1); PG8_STAGE(PG8_SA(1, 0), a3, voffA);
            PG8_BAR; PG8_WAIT_L(0); PG8_MMA(1, 0, At, B0); PG8_BAR; PG8_SCHED;
            PG8_STAGE(PG8_SB(1, 1), b3 + hstep, voffB);
            PG8_WAIT_V(6); PG8_BAR; PG8_MMA(1, 1, At, B1); PG8_BAR;
        }
        PG8_STAMP();
        if constexpr (!Epi::AFTER_DRAIN) { E(acc, cur, wr, wc, fr, fq); S.done(cur); }
        PG8_STAMP();
        if (!has_next) break;
#pragma unroll
        for (int a = 0; a < 2; ++a)
#pragma unroll
            for (int b = 0; b < 2; ++b)
#pragma unroll
                for (int m = 0; m < 4; ++m)
#pragma unroll
                    for (int n = 0; n < 2; ++n) acc[a][b][m][n] = (f32x4){0.f, 0.f, 0.f, 0.f};
        cur = nxt; cA = nA; cB = nB; ++ui;
    }
    PG8_WAIT_V(0);
    if (wr == 0) PG8_BAR;
    PG8_BAR;
    if constexpr (Epi::AFTER_DRAIN) { E.fused(acc, cur, wr, wc, fr, fq, lds, wid, lane); S.done(cur); }
    PG8_STAMP();
    if (STAMP && wid == 0) { stamps[lane] = lane < nts ? (((unsigned long long)(unsigned)ts_hi << 32) | (unsigned)ts_lo) : 0ull;
        if (lane == 62) stamps[62] = rt_entry; if (lane == 63) stamps[63] = (unsigned long long)wall_clock64(); }
#undef PG8_STAMP
#undef PG8_SA
#undef PG8_SB
#undef PG8_STAGE
#undef PG8_LDA
#undef PG8_LDB
#undef PG8_MMA
#undef PG8_WAIT_V
#undef PG8_WAIT_L
#undef PG8_BAR
#undef PG8_SCHED
}
}

typedef unsigned short bf16;
using pg8::f32x4;
constexpr int T = 16384, SEQ = 4096, D = 1024, DIN = 4768, DINP = 4864;
constexpr int C_A = 0, C_B = 512, C_R = 1024, C_K = 1536, C_V = 2048, C_LW = 2560, C_LA = 2592, C_LG = 2624, C_GC = 2720, C_GR = 3744;
constexpr size_t MiB = 1u << 20;
constexpr size_t WS_WIN_T = 0, WS_PW_T = 10 * MiB, WS_WO_T = 11 * MiB, WS_WOUT_T = 12 * MiB, WS_WQ_T = 14 * MiB, WS_KEYS = 18 * MiB,
                 WS_BONUS = 18 * MiB + 512 * 1024, WS_XN = 20 * MiB, WS_PROJ = 52 * MiB, WS_LD = 204 * MiB, WS_YN = 236 * MiB, WS_END = 252 * MiB;
constexpr size_t WS_BETA = WS_XN, WS_G = WS_XN + 16 * MiB, WS_M = WS_LD;
constexpr size_t WS_Q = WS_PROJ, WS_UB = WS_PROJ + 64 * MiB, WS_VB = WS_PROJ + 96 * MiB, WS_EID = WS_PROJ + 128 * MiB, WS_GATE = WS_PROJ + 136 * MiB;

__device__ __forceinline__ bf16 f2bf(float f) { unsigned u = __float_as_uint(f); u += 0x7FFFu + ((u >> 16) & 1u); return (bf16)(u >> 16); }
__device__ __forceinline__ float bf2f(bf16 b) { return __uint_as_float(((unsigned)b) << 16); }
__device__ __forceinline__ float bflo(unsigned w) { return __uint_as_float(w << 16); }
__device__ __forceinline__ float bfhi(unsigned w) { return __uint_as_float(w & 0xFFFF0000u); }
__device__ __forceinline__ unsigned pack2(float lo, float hi) { return (unsigned)f2bf(lo) | ((unsigned)f2bf(hi) << 16); }
__device__ __forceinline__ float wave_sum(float v) {
#pragma unroll
    for (int o = 32; o > 0; o >>= 1) v += __shfl_xor(v, o, 64);
    return v;
}
__device__ __forceinline__ float sigmoidf_(float x) { return 1.f / (1.f + __expf(-x)); }
__device__ __forceinline__ void unpack8(const uint4 v, float (&f)[8]) {
    f[0] = bflo(v.x); f[1] = bfhi(v.x); f[2] = bflo(v.y); f[3] = bfhi(v.y); f[4] = bflo(v.z); f[5] = bfhi(v.z); f[6] = bflo(v.w); f[7] = bfhi(v.w);
}
__device__ __forceinline__ uint4 pack8(const float (&f)[8]) {
    uint4 v; v.x = pack2(f[0], f[1]); v.y = pack2(f[2], f[3]); v.z = pack2(f[4], f[5]); v.w = pack2(f[6], f[7]); return v;
}

__global__ __launch_bounds__(256) void k_transpose(const float* __restrict__ src, bf16* __restrict__ dst, int K, int N, int Npad) {
    __shared__ float tile[64][65];
    const int n0 = blockIdx.x * 64, k0 = blockIdx.y * 64;
    for (int i = threadIdx.x; i < 64 * 64; i += 256) { const int kk = i >> 6, nn = i & 63; float v = 0.f; if (n0 + nn < N) v = src[(size_t)(k0 + kk) * N + n0 + nn]; tile[kk][nn] = v; }
    __syncthreads();
    for (int i = threadIdx.x; i < 64 * 64; i += 256) { const int nn = i >> 6, kk = i & 63; if (n0 + nn < Npad) dst[(size_t)(n0 + nn) * K + k0 + kk] = f2bf(tile[kk][nn]); }
}
__global__ __launch_bounds__(256) void k_cvt(const float* __restrict__ src, bf16* __restrict__ dst, size_t n4) {
    for (size_t i = (size_t)blockIdx.x * 256 + threadIdx.x; i < n4; i += (size_t)gridDim.x * 256) {
        const float4 v = ((const float4*)src)[i]; uint2 o; o.x = pack2(v.x, v.y); o.y = pack2(v.z, v.w); ((uint2*)dst)[i] = o; }
}
__global__ __launch_bounds__(256) void k_rmsnorm(const float* __restrict__ x, const float* __restrict__ g, bf16* __restrict__ out, int rows) {
    const int wave = (blockIdx.x * 256 + threadIdx.x) >> 6, nw = (gridDim.x * 256) >> 6, lane = threadIdx.x & 63;
    for (int r = wave; r < rows; r += nw) {
        const float4* xr = (const float4*)(x + (size_t)r * D);
        float4 v[4]; float ss = 0.f;
#pragma unroll
        for (int i = 0; i < 4; ++i) { v[i] = xr[lane + 64 * i]; ss += v[i].x * v[i].x + v[i].y * v[i].y + v[i].z * v[i].z + v[i].w * v[i].w; }
        ss = wave_sum(ss);
        const float sc = rsqrtf(ss * (1.f / D) + 1e-6f);
#pragma unroll
        for (int i = 0; i < 4; ++i) { const float4 gg = ((const float4*)g)[lane + 64 * i]; uint2 o; o.x = pack2(v[i].x * sc * gg.x, v[i].y * sc * gg.y); o.y = pack2(v[i].z * sc * gg.z, v[i].w * sc * gg.w);
            ((uint2*)(out + (size_t)r * D))[lane + 64 * i] = o; }
    }
}

template <class F> struct EpiGen {
    static constexpr bool PERM = true, AFTER_DRAIN = false;
    F f;
    __device__ __forceinline__ void operator()(const f32x4 (&acc)[2][2][4][2], const pg8::Unit& u, int wr, int wc, int fr, int fq) const {
        const int row0 = u.pm * 256 + wr * 64 + fr, col0 = u.pn * 256 + wc * 32 + 8 * fq;
#pragma unroll
        for (int ai = 0; ai < 2; ++ai)
#pragma unroll
            for (int m = 0; m < 4; ++m)
#pragma unroll
                for (int bj = 0; bj < 2; ++bj) f(row0 + ai * 128 + m * 16, col0 + bj * 128, acc[ai][bj][m][0], acc[ai][bj][m][1]);
    }
};
struct FStoreBf16 { bf16* O; int ldc;
    __device__ __forceinline__ void operator()(int row, int col, f32x4 a, f32x4 b) const {
        uint4 o; o.x = pack2(a[0], a[1]); o.y = pack2(a[2], a[3]); o.z = pack2(b[0], b[1]); o.w = pack2(b[2], b[3]);
        *(uint4*)(O + (size_t)row * ldc + col) = o; } };
struct FConvM { bf16* M; const bf16* proj; const float* bias;
    __device__ __forceinline__ void operator()(int row, int col, f32x4 a, f32x4 b) const {
        float gl[8]; unpack8(*(const uint4*)(proj + (size_t)row * DINP + C_GC + col), gl);
        const float4 b0 = *(const float4*)(bias + col), b1 = *(const float4*)(bias + col + 4);
        float o[8] = {a[0] + b0.x, a[1] + b0.y, a[2] + b0.z, a[3] + b0.w, b[0] + b1.x, b[1] + b1.y, b[2] + b1.z, b[3] + b1.w};
#pragma unroll
        for (int i = 0; i < 8; ++i) o[i] *= sigmoidf_(gl[i]);
        *(uint4*)(M + (size_t)row * D + col) = pack8(o); } };
struct FRwM { bf16* M; const bf16* proj;
    __device__ __forceinline__ void operator()(int row, int col, f32x4 a, f32x4 b) const {
        float gl[8], mo[8]; unpack8(*(const uint4*)(proj + (size_t)row * DINP + C_GR + col), gl); unpack8(*(const uint4*)(M + (size_t)row * D + col), mo);
        float o[8] = {a[0], a[1], a[2], a[3], b[0], b[1], b[2], b[3]};
#pragma unroll
        for (int i = 0; i < 8; ++i) o[i] = mo[i] + o[i] * sigmoidf_(gl[i]);
        *(uint4*)(M + (size_t)row * D + col) = pack8(o); } };
struct FResX1 { const float* x; float* x1;
    __device__ __forceinline__ void operator()(int row, int col, f32x4 a, f32x4 b) const {
        const float4 x0 = *(const float4*)(x + (size_t)row * D + col), x1v = *(const float4*)(x + (size_t)row * D + col + 4);
        *(float4*)(x1 + (size_t)row * D + col) = make_float4(x0.x + a[0], x0.y + a[1], x0.z + a[2], x0.w + a[3]);
        *(float4*)(x1 + (size_t)row * D + col + 4) = make_float4(x1v.x + b[0], x1v.y + b[1], x1v.z + b[2], x1v.w + b[3]); } };

template <class Epi> __global__ __launch_bounds__(512, 2) void k_gemm(pg8::Gemm g, Epi E) {
    extern __shared__ __attribute__((aligned(16))) unsigned char shm[];
    pg8::StaticOrder S; S.init(g.M, g.N, (int)gridDim.x, (int)blockIdx.x);
    pg8::gemm_phase<Epi, pg8::StaticOrder, false>((PG8_LAS unsigned char*)shm, g, S, E, nullptr);
}

constexpr int CONV_LDS = 62 * 512 * 2;
__global__ __launch_bounds__(512) void k_conv(const bf16* __restrict__ proj, const float* __restrict__ dw, const float* __restrict__ dwb,
                                              const float* __restrict__ lng, const float* __restrict__ lnb, bf16* __restrict__ yn) {
    extern __shared__ __attribute__((aligned(16))) unsigned char shm[];
    bf16* glu = (bf16*)shm;
    const int tid = threadIdx.x, lane = tid & 63, wid = tid >> 6;
    for (int tile = blockIdx.x; tile < T / 32; tile += gridDim.x) {
        const int t0 = tile * 32, sq0 = t0 & ~(SEQ - 1);
        __syncthreads();
        for (int it = tid; it < 62 * 64; it += 512) {
            const int rr = it >> 6, cg = it & 63, t = t0 - 30 + rr;
            uint4 o = make_uint4(0, 0, 0, 0);
            if (t >= sq0) {
                float a[8], b[8]; unpack8(*(const uint4*)(proj + (size_t)t * DINP + C_A + cg * 8), a); unpack8(*(const uint4*)(proj + (size_t)t * DINP + C_B + cg * 8), b);
#pragma unroll
                for (int i = 0; i < 8; ++i) a[i] *= sigmoidf_(b[i]);
                o = pack8(a);
            }
            *(uint4*)(glu + rr * 512 + cg * 8) = o;
        }
        __syncthreads();
        float acc[4][8];
        { const float4 b0 = *(const float4*)(dwb + lane * 8), b1 = *(const float4*)(dwb + lane * 8 + 4);
#pragma unroll
          for (int i = 0; i < 4; ++i) { acc[i][0] = b0.x; acc[i][1] = b0.y; acc[i][2] = b0.z; acc[i][3] = b0.w; acc[i][4] = b1.x; acc[i][5] = b1.y; acc[i][6] = b1.z; acc[i][7] = b1.w; } }
        for (int j = 0; j < 31; ++j) {
            const float4 w0 = *(const float4*)(dw + j * 512 + lane * 8), w1 = *(const float4*)(dw + j * 512 + lane * 8 + 4);
            const float w[8] = {w0.x, w0.y, w0.z, w0.w, w1.x, w1.y, w1.z, w1.w};
#pragma unroll
            for (int i = 0; i < 4; ++i) { float gv[8]; unpack8(*(const uint4*)(glu + (wid * 4 + i + j) * 512 + lane * 8), gv);
#pragma unroll
                for (int c = 0; c < 8; ++c) acc[i][c] += gv[c] * w[c]; }
        }
        const float4 g0 = *(const float4*)(lng + lane * 8), g1 = *(const float4*)(lng + lane * 8 + 4), e0 = *(const float4*)(lnb + lane * 8), e1 = *(const float4*)(lnb + lane * 8 + 4);
        const float gg[8] = {g0.x, g0.y, g0.z, g0.w, g1.x, g1.y, g1.z, g1.w}, ee[8] = {e0.x, e0.y, e0.z, e0.w, e1.x, e1.y, e1.z, e1.w};
#pragma unroll
        for (int i = 0; i < 4; ++i) {
            float s = 0.f;
#pragma unroll
            for (int c = 0; c < 8; ++c) s += acc[i][c];
            const float mean = wave_sum(s) * (1.f / 512.f);
            float q = 0.f;
#pragma unroll
            for (int c = 0; c < 8; ++c) { acc[i][c] -= mean; q += acc[i][c] * acc[i][c]; }
            const float rstd = rsqrtf(wave_sum(q) * (1.f / 512.f) + 1e-5f);
            float o[8];
#pragma unroll
            for (int c = 0; c < 8; ++c) { const float z = acc[i][c] * rstd * gg[c] + ee[c]; o[c] = z * sigmoidf_(z); }
            *(uint4*)(yn + (size_t)(t0 + wid * 4 + i) * 512 + lane * 8) = pack8(o);
        }
    }
}

constexpr int RWP_W2 = 0, RWP_A2 = 32 * 64, RWP_G2 = 64 * 64, RWP_LW = 160 * 64, RWP_LA = RWP_LW + 64 * 32, RWP_LG = RWP_LA + 64 * 32, RWP_R = RWP_LG + 64 * 96,
              RWP_K = RWP_R + 64 * 64, RWP_V = RWP_K + 64 * 64, RWP_FLOATS = RWP_V + 64 * 64, RWP_LDS = RWP_FLOATS * 4;
struct RwParams { const bf16* proj; const float *mu, *w0, *w2, *a0, *a2, *g2, *k_k, *k_a, *r_k; bf16 *R, *KP, *V, *KK, *BETA, *G; float *LD, *BONUS; };
__global__ __launch_bounds__(512) void k_rwprep(RwParams p) {
    extern __shared__ __attribute__((aligned(16))) unsigned char shm[];
    float* L = (float*)shm;
    const int tid = threadIdx.x;
    for (int item = blockIdx.x; item < 2048; item += gridDim.x) {
        const int h = item & 7, chunk = item >> 3;
        const int t0 = chunk * 64, sq0 = t0 & ~(SEQ - 1);
        __syncthreads();
        for (int i = tid; i < 160 * 64; i += 512) { const int j = i >> 6, c = i & 63;
            float v; if (j < 32) v = p.w2[j * 512 + h * 64 + c]; else if (j < 64) v = p.a2[(j - 32) * 512 + h * 64 + c]; else v = p.g2[(j - 64) * 512 + h * 64 + c];
            L[i] = v; }
        for (int i = tid; i < 64 * 352; i += 512) {
            const int tt = i / 352, ci = i % 352, t = t0 + tt;
            int col; if (ci < 64) col = C_R + h * 64 + ci; else if (ci < 128) col = C_K + h * 64 + ci - 64; else if (ci < 192) col = C_V + h * 64 + ci - 128; else col = C_LW + ci - 192;
            const float cur = bf2f(p.proj[(size_t)t * DINP + col]);
            const float prev = (t > sq0) ? bf2f(p.proj[(size_t)(t - 1) * DINP + col]) : 0.f;
            const float u = cur + (prev - cur) * p.mu[col - C_R];
            if (ci < 64) L[RWP_R + tt * 64 + ci] = u; else if (ci < 128) L[RWP_K + tt * 64 + ci - 64] = u; else if (ci < 192) L[RWP_V + tt * 64 + ci - 128] = u;
            else if (ci < 224) L[RWP_LW + tt * 32 + ci - 192] = tanhf(u); else if (ci < 256) L[RWP_LA + tt * 32 + ci - 224] = u; else L[RWP_LG + tt * 96 + ci - 256] = sigmoidf_(u);
        }
        __syncthreads();
        const int c = tid & 63, tg = tid >> 6, hc = h * 64 + c;
        float wl[8], al[8], gl[8];
#pragma unroll
        for (int i = 0; i < 8; ++i) { wl[i] = p.w0[hc]; al[i] = p.a0[hc]; gl[i] = 0.f; }
        for (int j = 0; j < 32; ++j) { const float w2v = L[RWP_W2 + j * 64 + c], a2v = L[RWP_A2 + j * 64 + c];
#pragma unroll
            for (int i = 0; i < 8; ++i) { wl[i] += L[RWP_LW + (tg * 8 + i) * 32 + j] * w2v; al[i] += L[RWP_LA + (tg * 8 + i) * 32 + j] * a2v; } }
        for (int j = 0; j < 96; ++j) { const float g2v = L[RWP_G2 + j * 64 + c];
#pragma unroll
            for (int i = 0; i < 8; ++i) gl[i] += L[RWP_LG + (tg * 8 + i) * 96 + j] * g2v; }
        const float kkc = p.k_k[hc], kac = p.k_a[hc], rkc = p.r_k[hc];
#pragma unroll
        for (int i = 0; i < 8; ++i) {
            const int tt = tg * 8 + i; const size_t o = (size_t)(t0 + tt) * 512 + hc;
            const float xw = -wl[i];
            const float sp = fmaxf(xw, 0.f) + log1pf(__expf(-fabsf(xw)));
            const float w = -sp - 0.5f;
            const float ld = -__expf(w);
            const float a = sigmoidf_(al[i]);
            const float kraw = L[RWP_K + tt * 64 + c], r = L[RWP_R + tt * 64 + c], v = L[RWP_V + tt * 64 + c];
            const float kkr = kraw * kkc, kmod = kraw * (1.f + (a - 1.f) * kac);
            const float nrm = fmaxf(sqrtf(wave_sum(kkr * kkr)), 1e-12f);
            const float kkn = kkr / nrm;
            const float bon = wave_sum(r * kmod * rkc);
            p.R[o] = f2bf(r); p.KP[o] = f2bf(kmod); p.V[o] = f2bf(v); p.KK[o] = f2bf(kkn); p.BETA[o] = f2bf(kkn * a); p.G[o] = f2bf(gl[i]); p.LD[o] = ld;
            if (c == 0) p.BONUS[(size_t)(t0 + tt) * 8 + h] = bon;
        }
    }
}

constexpr int SCAN_LDS = 2 * 6 * 32 * 64 * 4;
__global__ __launch_bounds__(256) void k_scan(bf16* __restrict__ R, const bf16* __restrict__ KP, const bf16* __restrict__ V, const bf16* __restrict__ KK,
                                              const bf16* __restrict__ BETA, const float* __restrict__ LD) {
    extern __shared__ __attribute__((aligned(16))) unsigned char shm[];
    float* buf = (float*)shm;
    const int bh = blockIdx.x, b = bh >> 3, h = bh & 7, tid = threadIdx.x, row = tid >> 2, part = tid & 3;
    const size_t base = (size_t)b * SEQ * 512 + h * 64;
    float s[16];
#pragma unroll
    for (int i = 0; i < 16; ++i) s[i] = 0.f;
    float st[48];
    auto gload = [&](int ch) {
#pragma unroll
        for (int k = 0; k < 48; ++k) { const int idx = tid + 256 * k, a = idx >> 11, rem = idx & 2047, sidx = rem >> 6, c = rem & 63;
            const size_t o = base + (size_t)(ch * 32 + sidx) * 512 + c;
            float v;
            if (a == 0) v = bf2f(KK[o]); else if (a == 1) v = __expf(LD[o]); else if (a == 2) v = bf2f(BETA[o]); else if (a == 3) v = bf2f(KP[o]); else if (a == 4) v = bf2f(R[o]); else v = bf2f(V[o]);
            st[k] = v; } };
    auto lstore = [&](int bi) {
#pragma unroll
        for (int k = 0; k < 48; ++k) buf[bi * 12288 + tid + 256 * k] = st[k]; };
    gload(0); lstore(0); __syncthreads();
    for (int ch = 0; ch < 128; ++ch) {
        const int cur = ch & 1;
        if (ch + 1 < 128) gload(ch + 1);
        const float* B = buf + cur * 12288;
        for (int sidx = 0; sidx < 32; ++sidx) {
            const float4* kk4 = (const float4*)(B + 0 * 2048 + sidx * 64 + part * 16);
            const float4* de4 = (const float4*)(B + 1 * 2048 + sidx * 64 + part * 16);
            const float4* be4 = (const float4*)(B + 2 * 2048 + sidx * 64 + part * 16);
            const float4* kp4 = (const float4*)(B + 3 * 2048 + sidx * 64 + part * 16);
            const float4* r4 = (const float4*)(B + 4 * 2048 + sidx * 64 + part * 16);
            const float vv = B[5 * 2048 + sidx * 64 + row];
            float sa = 0.f;
#pragma unroll
            for (int q = 0; q < 4; ++q) { const float4 k = kk4[q]; sa += s[4 * q] * k.x + s[4 * q + 1] * k.y + s[4 * q + 2] * k.z + s[4 * q + 3] * k.w; }
            sa += __shfl_xor(sa, 1, 64); sa += __shfl_xor(sa, 2, 64); sa = -sa;
            float y = 0.f;
#pragma unroll
            for (int q = 0; q < 4; ++q) { const float4 de = de4[q], be = be4[q], kp = kp4[q], rr = r4[q];
                s[4 * q] = s[4 * q] * de.x + sa * be.x + vv * kp.x; s[4 * q + 1] = s[4 * q + 1] * de.y + sa * be.y + vv * kp.y;
                s[4 * q + 2] = s[4 * q + 2] * de.z + sa * be.z + vv * kp.z; s[4 * q + 3] = s[4 * q + 3] * de.w + sa * be.w + vv * kp.w;
                y += s[4 * q] * rr.x + s[4 * q + 1] * rr.y + s[4 * q + 2] * rr.z + s[4 * q + 3] * rr.w; }
            y += __shfl_xor(y, 1, 64); y += __shfl_xor(y, 2, 64);
            if (part == 0) R[base + (size_t)(ch * 32 + sidx) * 512 + row] = f2bf(y);
        }
        if (ch + 1 < 128) lstore(cur ^ 1);
        __syncthreads();
    }
}

__global__ __launch_bounds__(256) void k_post(bf16* __restrict__ Y, const bf16* __restrict__ V, const bf16* __restrict__ G, const float* __restrict__ BONUS,
                                              const float* __restrict__ gng, const float* __restrict__ gnb) {
    const int wave = (blockIdx.x * 256 + threadIdx.x) >> 6, nw = (gridDim.x * 256) >> 6, lane = threadIdx.x & 63;
    for (int it = wave; it < T * 8; it += nw) {
        const int t = it >> 3, h = it & 7; const size_t o = (size_t)t * 512 + h * 64 + lane;
        const float y = bf2f(Y[o]);
        const float mean = wave_sum(y) * (1.f / 64.f); const float d = y - mean;
        const float var = wave_sum(d * d) * (1.f / 64.f);
        const float ynv = d * rsqrtf(var + 64e-5f) * gng[h * 64 + lane] + gnb[h * 64 + lane];
        Y[o] = f2bf((ynv + BONUS[(size_t)t * 8 + h] * bf2f(V[o])) * bf2f(G[o]));
    }
}

#define CE_DESC(a, b) { const float _mx = fmaxf(a, b), _mn = fminf(a, b); a = _mx; b = _mn; }
__device__ __forceinline__ void sort16_desc(float (&a)[16]) {
#pragma unroll
    for (int k = 2; k <= 16; k <<= 1)
#pragma unroll
        for (int j = k >> 1; j > 0; j >>= 1)
#pragma unroll
            for (int i = 0; i < 16; ++i) { const int l = i ^ j; if (l > i) { if ((i & k) == 0) { CE_DESC(a[i], a[l]); } else { CE_DESC(a[l], a[i]); } } }
}
__device__ __forceinline__ void merge16_desc(float (&run)[16], const float (&grp)[16]) {
#pragma unroll
    for (int i = 0; i < 16; ++i) run[i] = fmaxf(run[i], grp[15 - i]);
#pragma unroll
    for (int j = 8; j > 0; j >>= 1)
#pragma unroll
        for (int i = 0; i < 16; ++i) { const int l = i ^ j; if (l > i) { CE_DESC(run[i], run[l]); } }
}
struct CandTab { int i[64], j[64]; };
constexpr CandTab make_cand_tab() { CandTab t{}; int n = 0; for (int i = 0; i < 16; ++i) for (int j = 0; j < 16; ++j) if ((i + 1) * (j + 1) <= 16) { t.i[n] = i; t.j[n] = j; ++n; }
    for (; n < 64; ++n) { t.i[n] = 0; t.j[n] = 0; } return t; }
constexpr CandTab CT = make_cand_tab();
constexpr int TOPK_LDS = 8 * (16 * 256 * 4 + 16 * 2 * 16 * 4);
__global__ __launch_bounds__(512) void k_topk(const bf16* __restrict__ Q, const bf16* __restrict__ keys, int* __restrict__ EID, float* __restrict__ GATE) {
    extern __shared__ __attribute__((aligned(16))) unsigned char shm[];
    const int tid = threadIdx.x, lane = tid & 63, h = tid >> 6, fr = lane & 15, fq = lane >> 4;
    float* sc = (float*)shm + h * (16 * 256 + 512);
    float* top = sc + 16 * 256;
    for (int item = blockIdx.x; item < T / 16; item += gridDim.x) {
        const int t0 = item * 16;
        int koff = 0; asm volatile("" : "+v"(koff));
#pragma unroll
        for (int p = 0; p < 2; ++p) {
            pg8::bf16x8 a[4];
#pragma unroll
            for (int ks = 0; ks < 4; ++ks) a[ks] = *(const pg8::bf16x8*)(Q + (size_t)(t0 + fr) * 2048 + h * 256 + p * 128 + ks * 32 + fq * 8);
#pragma unroll
            for (int nt = 0; nt < 8; ++nt) {
                f32x4 acc = {0.f, 0.f, 0.f, 0.f};
#pragma unroll
                for (int ks = 0; ks < 4; ++ks) { const pg8::bf16x8 bfr = *(const pg8::bf16x8*)(keys + koff + ((size_t)(h * 2 + p) * 128 + nt * 16 + fr) * 128 + ks * 32 + fq * 8);
                    acc = __builtin_amdgcn_mfma_f32_16x16x32_bf16(a[ks], bfr, acc, 0, 0, 0); }
#pragma unroll
                for (int r = 0; r < 4; ++r) sc[(4 * fq + r) * 256 + p * 128 + nt * 16 + fr] = acc[r];
            }
        }
        __builtin_amdgcn_s_waitcnt(0);
        __builtin_amdgcn_wave_barrier();
        if (lane < 32) {
            const int tok = lane & 15, half = lane >> 4;
            const float* s = sc + tok * 256 + half * 128;
            float run[16], grp[16];
#pragma unroll
            for (int i = 0; i < 16; ++i) run[i] = __uint_as_float((__float_as_uint(s[i]) & ~0x7Fu) | (unsigned)i);
            sort16_desc(run);
            for (int g = 1; g < 8; ++g) {
#pragma unroll
                for (int i = 0; i < 16; ++i) grp[i] = __uint_as_float((__float_as_uint(s[g * 16 + i]) & ~0x7Fu) | (unsigned)(g * 16 + i));
                sort16_desc(grp);
                merge16_desc(run, grp);
            }
#pragma unroll
            for (int i = 0; i < 16; ++i) top[(tok * 2 + half) * 16 + i] = run[i];
        }
        __builtin_amdgcn_s_waitcnt(0);
        __builtin_amdgcn_wave_barrier();
        if (lane < 16) {
            const float* t1 = top + (lane * 2) * 16; const float* t2 = t1 + 16;
            float v1[16], v2[16];
#pragma unroll
            for (int i = 0; i < 16; ++i) { v1[i] = __uint_as_float(__float_as_uint(t1[i]) & ~0x7Fu); v2[i] = __uint_as_float(__float_as_uint(t2[i]) & ~0x7Fu); }
            float run[16], grp[16];
#pragma unroll
            for (int i = 0; i < 16; ++i) run[i] = __uint_as_float((__float_as_uint(v1[CT.i[i]] + v2[CT.j[i]]) & ~0xFFu) | (unsigned)(CT.i[i] * 16 + CT.j[i]));
            sort16_desc(run);
#pragma unroll
            for (int g = 1; g < 4; ++g) {
#pragma unroll
                for (int i = 0; i < 16; ++i) { const int n = g * 16 + i; grp[i] = (n < 50) ? __uint_as_float((__float_as_uint(v1[CT.i[n]] + v2[CT.j[n]]) & ~0xFFu) | (unsigned)(CT.i[n] * 16 + CT.j[n])) : -3.0e38f; }
                sort16_desc(grp); merge16_desc(run, grp);
            }
            float e[16], sum = 0.f; const float mx = __uint_as_float(__float_as_uint(run[0]) & ~0xFFu);
#pragma unroll
            for (int i = 0; i < 16; ++i) { e[i] = __expf(__uint_as_float(__float_as_uint(run[i]) & ~0xFFu) - mx); sum += e[i]; }
            const float inv = 1.f / sum;
            const size_t ob = (size_t)(t0 + lane) * 128 + h * 16;
#pragma unroll
            for (int i = 0; i < 16; ++i) { const unsigned ij = __float_as_uint(run[i]) & 0xFFu; const unsigned e1 = __float_as_uint(t1[ij >> 4]) & 0x7Fu, e2 = __float_as_uint(t2[ij & 15]) & 0x7Fu;
                EID[ob + i] = (int)(e1 * 128 + e2); GATE[ob + i] = e[i] * inv; }
        }
        __builtin_amdgcn_wave_barrier();
    }
}

__global__ __launch_bounds__(256) void k_peer(const bf16* __restrict__ XN2, float* __restrict__ X1  , const bf16* __restrict__ UB, const bf16* __restrict__ VB,
                                              const int* __restrict__ EID, const float* __restrict__ GATE, const float* __restrict__ gf) {
    __shared__ float cfs[4][128];
    __shared__ int eids[4][128];
    const int wv = threadIdx.x >> 6, lane = threadIdx.x & 63;
    const int wave = (blockIdx.x * 256 + threadIdx.x) >> 6, nw = (gridDim.x * 256) >> 6;
    for (int t = wave; t < T; t += nw) {
        float hv[16];
        { float a[8], b[8]; unpack8(*(const uint4*)(XN2 + (size_t)t * D + lane * 16), a); unpack8(*(const uint4*)(XN2 + (size_t)t * D + lane * 16 + 8), b);
#pragma unroll
          for (int i = 0; i < 8; ++i) { hv[i] = a[i]; hv[8 + i] = b[i]; } }
        eids[wv][lane] = EID[(size_t)t * 128 + lane]; eids[wv][lane + 64] = EID[(size_t)t * 128 + 64 + lane];
        __builtin_amdgcn_s_waitcnt(0); __builtin_amdgcn_wave_barrier();
        for (int k0 = 0; k0 < 128; k0 += 4) {
            float dp[4];
#pragma unroll
            for (int q = 0; q < 4; ++q) { const int e = eids[wv][k0 + q];
                float a[8], b[8]; unpack8(*(const uint4*)(UB + (size_t)e * D + lane * 16), a); unpack8(*(const uint4*)(UB + (size_t)e * D + lane * 16 + 8), b);
                float s = 0.f;
#pragma unroll
                for (int i = 0; i < 8; ++i) s += a[i] * hv[i] + b[i] * hv[8 + i];
                dp[q] = s; }
#pragma unroll
            for (int q = 0; q < 4; ++q) { const float z = wave_sum(dp[q]); const float act = 0.5f * z * (1.f + erff(z * 0.70710678118f));
                if (lane == 0) cfs[wv][k0 + q] = act * GATE[(size_t)t * 128 + k0 + q]; }
        }
        __builtin_amdgcn_s_waitcnt(0); __builtin_amdgcn_wave_barrier();
        float acc[16];
#pragma unroll
        for (int i = 0; i < 16; ++i) acc[i] = 0.f;
        for (int k0 = 0; k0 < 128; k0 += 4) {
#pragma unroll
            for (int q = 0; q < 4; ++q) { const int e = eids[wv][k0 + q]; const float cf = cfs[wv][k0 + q];
                float a[8], b[8]; unpack8(*(const uint4*)(VB + (size_t)e * D + lane * 16), a); unpack8(*(const uint4*)(VB + (size_t)e * D + lane * 16 + 8), b);
#pragma unroll
                for (int i = 0; i < 8; ++i) { acc[i] += cf * a[i]; acc[8 + i] += cf * b[i]; } }
        }
        float* xr = X1 + (size_t)t * D + lane * 16; float ss = 0.f;
#pragma unroll
        for (int i = 0; i < 4; ++i) { const float4 v = ((const float4*)xr)[i]; acc[4 * i] += v.x; acc[4 * i + 1] += v.y; acc[4 * i + 2] += v.z; acc[4 * i + 3] += v.w; }
#pragma unroll
        for (int i = 0; i < 16; ++i) ss += acc[i] * acc[i];
        const float sc = rsqrtf(wave_sum(ss) * (1.f / D) + 1e-6f);
#pragma unroll
        for (int i = 0; i < 4; ++i) { const float4 g = ((const float4*)(gf + lane * 16))[i];
            ((float4*)xr)[i] = make_float4(acc[4 * i] * sc * g.x, acc[4 * i + 1] * sc * g.y, acc[4 * i + 2] * sc * g.z, acc[4 * i + 3] * sc * g.w); }
        __builtin_amdgcn_wave_barrier();
    }
}

template <class Epi> static void launch_gemm(const bf16* A, const bf16* Bt, int M, int N, int K, const Epi& E, hipStream_t s) {
    static bool attr = false; if (!attr) { (void)hipFuncSetAttribute((const void*)k_gemm<Epi>, hipFuncAttributeMaxDynamicSharedMemorySize, pg8::STAGE_BYTES); attr = true; }
    pg8::Gemm g{A, Bt, M, N, K};
    hipLaunchKernelGGL((k_gemm<Epi>), dim3(256), dim3(512), pg8::STAGE_BYTES, s, g, E);
}

extern "C" void kernel_launch(void* const* d_in, const int* in_sizes, int n_in, void* d_out, int out_size, void* d_ws, size_t ws_size, hipStream_t stream) {
    if (n_in != 28 || ws_size < WS_END) { fprintf(stderr, "kernel_launch: unexpected n_in %d / ws_size %zu\n", n_in, ws_size); return; }
    static bool attr = false;
    if (!attr) {
        (void)hipFuncSetAttribute((const void*)k_rwprep, hipFuncAttributeMaxDynamicSharedMemorySize, RWP_LDS);
        (void)hipFuncSetAttribute((const void*)k_scan, hipFuncAttributeMaxDynamicSharedMemorySize, SCAN_LDS);
        (void)hipFuncSetAttribute((const void*)k_conv, hipFuncAttributeMaxDynamicSharedMemorySize, CONV_LDS);
        (void)hipFuncSetAttribute((const void*)k_topk, hipFuncAttributeMaxDynamicSharedMemorySize, TOPK_LDS);
        attr = true;
    }
    const float* x = (const float*)d_in[0];
    auto F = [&](int i) { return (const float*)d_in[i]; };
    unsigned char* ws = (unsigned char*)d_ws; unsigned char* ob = (unsigned char*)d_out;
    bf16 *WIN_T = (bf16*)(ws + WS_WIN_T), *PW_T = (bf16*)(ws + WS_PW_T), *WO_T = (bf16*)(ws + WS_WO_T), *WOUT_T = (bf16*)(ws + WS_WOUT_T), *WQ_T = (bf16*)(ws + WS_WQ_T), *KEYS = (bf16*)(ws + WS_KEYS);
    bf16 *XN = (bf16*)(ws + WS_XN), *PROJ = (bf16*)(ws + WS_PROJ), *YN = (bf16*)(ws + WS_YN), *BETA = (bf16*)(ws + WS_BETA), *G = (bf16*)(ws + WS_G), *M = (bf16*)(ws + WS_M);
    bf16 *Q = (bf16*)(ws + WS_Q), *UB = (bf16*)(ws + WS_UB), *VB = (bf16*)(ws + WS_VB);
    float *LD = (float*)(ws + WS_LD), *BONUS = (float*)(ws + WS_BONUS), *GATE = (float*)(ws + WS_GATE); int* EID = (int*)(ws + WS_EID);
    bf16 *R = (bf16*)(ob), *KP = (bf16*)(ob + 16 * MiB), *V = (bf16*)(ob + 32 * MiB), *KK = (bf16*)(ob + 48 * MiB);
    float* X1 = (float*)d_out;

    hipLaunchKernelGGL(k_transpose, dim3(DINP / 64, 1024 / 64), dim3(256), 0, stream, F(2), WIN_T, 1024, DIN, DINP);
    hipLaunchKernelGGL(k_transpose, dim3(1024 / 64, 512 / 64), dim3(256), 0, stream, F(7), PW_T, 512, 1024, 1024);
    hipLaunchKernelGGL(k_transpose, dim3(1024 / 64, 512 / 64), dim3(256), 0, stream, F(20), WO_T, 512, 1024, 1024);
    hipLaunchKernelGGL(k_transpose, dim3(1024 / 64, 1024 / 64), dim3(256), 0, stream, F(21), WOUT_T, 1024, 1024, 1024);
    hipLaunchKernelGGL(k_transpose, dim3(2048 / 64, 1024 / 64), dim3(256), 0, stream, F(23), WQ_T, 1024, 2048, 2048);
    hipLaunchKernelGGL(k_cvt, dim3(256), dim3(256), 0, stream, F(24), KEYS, (size_t)(8 * 2 * 128 * 128 / 4));
    hipLaunchKernelGGL(k_rmsnorm, dim3(1024), dim3(256), 0, stream, x, F(1), XN, T);
    launch_gemm(XN, WIN_T, T, DINP, 1024, EpiGen<FStoreBf16>{FStoreBf16{PROJ, DINP}}, stream);
    hipLaunchKernelGGL(k_conv, dim3(512), dim3(512), CONV_LDS, stream, PROJ, F(3), F(4), F(5), F(6), YN);
    RwParams rp{PROJ, F(9), F(10), F(11), F(12), F(13), F(14), F(15), F(16), F(17), R, KP, V, KK, BETA, G, LD, BONUS};
    hipLaunchKernelGGL(k_rwprep, dim3(512), dim3(512), RWP_LDS, stream, rp);
    hipLaunchKernelGGL(k_scan, dim3(32), dim3(256), SCAN_LDS, stream, R, KP, V, KK, BETA, LD);
    hipLaunchKernelGGL(k_post, dim3(1024), dim3(256), 0, stream, R, V, G, BONUS, F(18), F(19));
    launch_gemm(YN, PW_T, T, 1024, 512, EpiGen<FConvM>{FConvM{M, PROJ, F(8)}}, stream);
    launch_gemm(R, WO_T, T, 1024, 512, EpiGen<FRwM>{FRwM{M, PROJ}}, stream);
    launch_gemm(M, WOUT_T, T, 1024, 1024, EpiGen<FResX1>{FResX1{x, X1}}, stream);
    hipLaunchKernelGGL(k_rmsnorm, dim3(1024), dim3(256), 0, stream, X1, F(22), XN, T);
    launch_gemm(XN, WQ_T, T, 2048, 1024, EpiGen<FStoreBf16>{FStoreBf16{Q, 2048}}, stream);
    hipLaunchKernelGGL(k_cvt, dim3(1024), dim3(256), 0, stream, F(25), UB, (size_t)16384 * 1024 / 4);
    hipLaunchKernelGGL(k_cvt, dim3(1024), dim3(256), 0, stream, F(26), VB, (size_t)16384 * 1024 / 4);
    hipLaunchKernelGGL(k_topk, dim3(512), dim3(512), TOPK_LDS, stream, Q, KEYS, EID, GATE);
    hipLaunchKernelGGL(k_peer, dim3(2048), dim3(256), 0, stream, XN, X1, UB, VB, EID, GATE, F(27));
}
```

```cpp
#include <hip/hip_runtime.h>
#include <stdint.h>
#include <stdio.h>
namespace pg8 {
#define PG8_LAS __attribute__((address_space(3)))
typedef unsigned short bf16_t;
typedef short bf16x8 __attribute__((ext_vector_type(8)));
typedef float f32x4 __attribute__((ext_vector_type(4)));
typedef unsigned u32x4 __attribute__((ext_vector_type(4)));
constexpr int BM = 256, BK = 64, HALF = 128, HTB = HALF * BK * 2  , STAGE_BYTES = 8 * HTB, NXCD = 8, WGM = 8;

__host__ __device__ __forceinline__ int lds_byte(int r, int c) { const int st = (r >> 4) * 2 + (c >> 5), rr = r & 15, cc = c & 31, ob = rr * 64 + cc * 2; return st * 1024 + (ob ^ (((ob >> 9) & 1) << 5)); }
__host__ __device__ __forceinline__ void stage_rc(int b, int& R, int& C) { const int st = b / 1024, sb = b % 1024, swz = sb ^ (((sb >> 9) & 1) << 5); R = (st >> 1) * 16 + swz / 64; C = (st & 1) * 32 + (swz % 64) / 2; }
__host__ __device__ __forceinline__ int perm32(int rho) { const int n = rho >> 4, i = rho & 15; return 8 * (i >> 2) + 4 * n + (i & 3); }

struct Unit { int pm, pn; };
struct Gemm { const bf16_t* A; const bf16_t* Bt; int M, N, K; };

struct StaticOrder {
    int nM, nN, nwg, G, c;
    __host__ __device__ void init(int M, int N, int G_, int c_) { nM = M / BM; nN = N / BM; nwg = nM * nN; G = G_; c = c_; }
    __host__ __device__ bool next(int i, Unit& u) const {
        const long L = (long)i * G + c; if (L >= nwg) return false;
        int wgid = (int)L; { const int q = nwg / NXCD, r = nwg % NXCD, xcd = wgid % NXCD, off = wgid / NXCD; wgid = (xcd < r ? xcd * (q + 1) : r * (q + 1) + (xcd - r) * q) + off; }
        const int nig = WGM * nN, gid = wgid / nig, fm = gid * WGM, gsz = (nM - fm) < WGM ? (nM - fm) : WGM;
        u.pm = fm + ((wgid % nig) % gsz); u.pn = (wgid % nig) / gsz; return true;
    }
    __device__ __forceinline__ void a_ready(const Unit&) const {}
    __device__ __forceinline__ void done(const Unit&) const {}
};
__device__ __forceinline__ unsigned cvt_pk_bf16(float lo, float hi) { unsigned r; asm volatile("v_cvt_pk_bf16_f32 %0, %1, %2" : "=v"(r) : "v"(lo), "v"(hi)); return r; }
struct Gemm2 { const bf16_t* A; const bf16_t* Bt; const bf16_t* A2; const bf16_t* Bt2; int M, N, K, nt1, nt; };
template <class Epi, class Sched, bool STAMP = false>
__device__ __forceinline__ void gemm_phase(PG8_LAS unsigned char* lds, const Gemm g, const Sched& S, const Epi& E, unsigned long long* stamps) {
    const int tid = threadIdx.x, wid = __builtin_amdgcn_readfirstlane(tid >> 6), lane = tid & 63, wr = wid >> 2, wc = wid & 3, fr = lane & 15, fq = lane >> 4;
    const int K = g.K, nt = K / BK;
    int ts_lo = 0, ts_hi = 0, nts = 0; const unsigned long long rt_entry = STAMP ? (unsigned long long)wall_clock64() : 0ull;
#define PG8_STAMP() do { if (STAMP && wid == 0 && nts < 64) { const unsigned long long _c = (unsigned long long)clock64(); \
        ts_lo = (lane == nts) ? (int)(unsigned)_c : ts_lo; ts_hi = (lane == nts) ? (int)(unsigned)(_c >> 32) : ts_hi; ++nts; } } while (0)
    PG8_STAMP();
    unsigned voffA[2], voffB[2];
#pragma unroll
    for (int i = 0; i < 2; ++i) { int R, C; stage_rc(tid * 16 + i * 8192, R, C); const int Rb = Epi::PERM ? ((R & ~31) + perm32(R & 31)) : R;
        voffA[i] = (unsigned)(R * K + C) * 2u; voffB[i] = (unsigned)(Rb * K + C) * 2u; }
    const size_t kstep = (size_t)(BK * 2);
    const size_t hstep = (size_t)HALF * K * 2;
    const size_t tstep = 2 * hstep;
    const unsigned ldsw = (unsigned)wid * 1024u;
    const int aoff = lds_byte(wr * 64 + fr, fq * 8), boff = lds_byte(wc * 32 + fr, fq * 8);
#define PG8_SA(b, h) (((b) * 2 + (h)) * HTB)
#define PG8_SB(b, h) ((4 + (b) * 2 + (h)) * HTB)
#define PG8_STAGE(bufoff, gbase, voff) do { _Pragma("unroll") for (int _i = 0; _i < 2; ++_i) \
        __builtin_amdgcn_global_load_lds((const unsigned*)((const char*)(gbase) + (voff)[_i]), (PG8_LAS unsigned*)(lds + (bufoff) + ldsw + _i * 8192), 16, 0, 0); } while (0)
#define PG8_LDA(dst, b, h) do { _Pragma("unroll") for (int m = 0; m < 4; ++m) _Pragma("unroll") for (int k = 0; k < 2; ++k) dst[m][k] = *(const PG8_LAS bf16x8*)(lds + PG8_SA(b, h) + aoff + m * 2048 + k * 1024); } while (0)
#define PG8_LDB(dst, b, h) do { _Pragma("unroll") for (int n = 0; n < 2; ++n) _Pragma("unroll") for (int k = 0; k < 2; ++k) dst[n][k] = *(const PG8_LAS bf16x8*)(lds + PG8_SB(b, h) + boff + n * 2048 + k * 1024); } while (0)
#define PG8_MMA(ai, bj, At, Bt) do { __builtin_amdgcn_s_setprio(1); _Pragma("unroll") for (int m = 0; m < 4; ++m) _Pragma("unroll") for (int n = 0; n < 2; ++n) _Pragma("unroll") for (int k = 0; k < 2; ++k) \
        acc[ai][bj][m][n] = __builtin_amdgcn_mfma_f32_16x16x32_bf16(Bt[n][k], At[m][k], acc[ai][bj][m][n], 0, 0, 0); __builtin_amdgcn_s_setprio(0); } while (0)
#define PG8_WAIT_V(n) asm volatile("s_waitcnt vmcnt(" #n ")" ::: "memory")
#define PG8_WAIT_L(n) asm volatile("s_waitcnt lgkmcnt(" #n ")" ::: "memory")
#define PG8_BAR __builtin_amdgcn_s_barrier()
#define PG8_SCHED __builtin_amdgcn_sched_barrier(0)
    Unit cur, nxt; int ui = 0;
    if (!S.next(0, cur)) return;
    f32x4 acc[2][2][4][2];
#pragma unroll
    for (int a = 0; a < 2; ++a)
#pragma unroll
        for (int b = 0; b < 2; ++b)
#pragma unroll
            for (int m = 0; m < 4; ++m)
#pragma unroll
                for (int n = 0; n < 2; ++n) acc[a][b][m][n] = (f32x4){0.f, 0.f, 0.f, 0.f};
    bf16x8 At[4][2], B0[2][2], B1[2][2];
    const char* cA = (const char*)g.A + (size_t)cur.pm * tstep; const char* cB = (const char*)g.Bt + (size_t)cur.pn * tstep;
    S.a_ready(cur);
    PG8_STAGE(PG8_SB(0, 0), cB, voffB); PG8_STAGE(PG8_SA(0, 0), cA, voffA); PG8_STAGE(PG8_SB(0, 1), cB + hstep, voffB); PG8_STAGE(PG8_SA(0, 1), cA + hstep, voffA);
    if (wr == 1) PG8_BAR;
    PG8_WAIT_V(4); PG8_BAR;
    PG8_STAGE(PG8_SB(1, 0), cB + kstep, voffB); PG8_STAGE(PG8_SA(1, 0), cA + kstep, voffA); PG8_STAGE(PG8_SB(1, 1), cB + hstep + kstep, voffB);
    PG8_WAIT_V(6); PG8_BAR;
    PG8_STAMP();
    for (;;) {
        const bool has_next = S.next(ui + 1, nxt);
        const char* nA = has_next ? (const char*)g.A + (size_t)nxt.pm * tstep : cA; const char* nB = has_next ? (const char*)g.Bt + (size_t)nxt.pn * tstep : cB;
        for (int t = 0; t < nt; t += 2) {
            const bool last = (t == nt - 2);
            const char* a1 = cA + (size_t)(t + 1) * kstep;
            const char* a2 = last ? nA : cA + (size_t)(t + 2) * kstep; const char* b2 = last ? nB : cB + (size_t)(t + 2) * kstep;
            const char* a3 = a2 + kstep; const char* b3 = b2 + kstep;
            if (last && has_next) S.a_ready(nxt);
            PG8_LDB(B0, 0, 0); PG8_SCHED; PG8_LDA(At, 0, 0); PG8_STAGE(PG8_SA(1, 1), a1 + hstep, voffA);
            PG8_WAIT_L(8); PG8_BAR; PG8_WAIT_L(0); PG8_MMA(0, 0, At, B0); PG8_BAR; PG8_SCHED;
            PG8_LDB(B1, 0, 1); PG8_STAGE(PG8_SB(0, 0), b2, voffB);
            PG8_BAR; PG8_WAIT_L(0); PG8_MMA(0, 1, At, B1); PG8_BAR;
            PG8_LDA(At, 0, 1); PG8_STAGE(PG8_SA(0, 0), a2, voffA);
            PG8_BAR; PG8_WAIT_L(0); PG8_MMA(1, 0, At, B0); PG8_BAR; PG8_SCHED;
            PG8_STAGE(PG8_SB(0, 1), b2 + hstep, voffB);
            PG8_WAIT_V(6); PG8_BAR; PG8_MMA(1, 1, At, B1); PG8_BAR;
            PG8_LDB(B0, 1, 0); PG8_SCHED; PG8_LDA(At, 1, 0); PG8_STAGE(PG8_SA(0, 1), a2 + hstep, voffA);
            PG8_WAIT_L(8); PG8_BAR; PG8_WAIT_L(0); PG8_MMA(0, 0, At, B0); PG8_BAR; PG8_SCHED;
            PG8_LDB(B1, 1, 1); PG8_STAGE(PG8_SB(1, 0), b3, voffB);
            PG8_BAR; PG8_WAIT_L(0); PG8_MMA(0, 1, At, B1); PG8_BAR;
            PG8_LDA(At, 1, 1); PG8_STAGE(PG8_SA(1, 0), a3, voffA);
            PG8_BAR; PG8_WAIT_L(0); PG8_MMA(1, 0, At, B0); PG8_BAR; PG8_SCHED;
            PG8_STAGE(PG8_SB(1, 1), b3 + hstep, voffB);
            PG8_WAIT_V(6); PG8_BAR; PG8_MMA(1, 1, At, B1); PG8_BAR;
        }
        PG8_STAMP();
        if constexpr (!Epi::AFTER_DRAIN) { E(acc, cur, wr, wc, fr, fq); S.done(cur); }
        PG8_STAMP();
        if (!has_next) break;
#pragma unroll
        for (int a = 0; a < 2; ++a)
#pragma unroll
            for (int b = 0; b < 2; ++b)
#pragma unroll
                for (int m = 0; m < 4; ++m)
#pragma unroll
                    for (int n = 0; n < 2; ++n) acc[a][b][m][n] = (f32x4){0.f, 0.f, 0.f, 0.f};
        cur = nxt; cA = nA; cB = nB; ++ui;
    }
    PG8_WAIT_V(0);
    if (wr == 0) PG8_BAR;
    PG8_BAR;
    if constexpr (Epi::AFTER_DRAIN) { E.fused(acc, cur, wr, wc, fr, fq, lds, wid, lane); S.done(cur); }
    PG8_STAMP();
    if (STAMP && wid == 0) { stamps[lane] = lane < nts ? (((unsigned long long)(unsigned)ts_hi << 32) | (unsigned)ts_lo) : 0ull;
        if (lane == 62) stamps[62] = rt_entry; if (lane == 63) stamps[63] = (unsigned long long)wall_clock64(); }
#undef PG8_STAMP
#undef PG8_SA
#undef PG8_SB
#undef PG8_STAGE
#undef PG8_LDA
#undef PG8_LDB
#undef PG8_MMA
#undef PG8_WAIT_V
#undef PG8_WAIT_L
#undef PG8_BAR
#undef PG8_SCHED
}

typedef int i32x8 __attribute__((ext_vector_type(8)));
typedef int i32x4 __attribute__((ext_vector_type(4)));
__device__ __forceinline__ i32x8 cat8(bf16x8 lo, bf16x8 hi) { const i32x4 a = __builtin_bit_cast(i32x4, lo), b = __builtin_bit_cast(i32x4, hi); return __builtin_shufflevector(a, b, 0, 1, 2, 3, 4, 5, 6, 7); }
template <class Epi, class Sched, bool STAMP = false>
__device__ __forceinline__ void gemm_phase_f8(PG8_LAS unsigned char* lds, const Gemm g, const Sched& S, const Epi& E, unsigned long long* stamps) {
    const int tid = threadIdx.x, wid = __builtin_amdgcn_readfirstlane(tid >> 6), lane = tid & 63, wr = wid >> 2, wc = wid & 3, fr = lane & 15, fq = lane >> 4;
    const int K = g.K, nt = K / BK;
    int ts_lo = 0, ts_hi = 0, nts = 0; const unsigned long long rt_entry = STAMP ? (unsigned long long)wall_clock64() : 0ull;
#define PG8_STAMP() do { if (STAMP && wid == 0 && nts < 64) { const unsigned long long _c = (unsigned long long)clock64(); \
        ts_lo = (lane == nts) ? (int)(unsigned)_c : ts_lo; ts_hi = (lane == nts) ? (int)(unsigned)(_c >> 32) : ts_hi; ++nts; } } while (0)
    PG8_STAMP();
    unsigned voffA[2], voffB[2];
#pragma unroll
    for (int i = 0; i < 2; ++i) { int R, C; stage_rc(tid * 16 + i * 8192, R, C); const int Rb = Epi::PERM ? ((R & ~31) + perm32(R & 31)) : R;
        voffA[i] = (unsigned)(R * K + C) * 2u; voffB[i] = (unsigned)(Rb * K + C) * 2u; }
    const size_t kstep = (size_t)(BK * 2);
    const size_t hstep = (size_t)HALF * K * 2;
    const size_t tstep = 2 * hstep;
    const unsigned ldsw = (unsigned)wid * 1024u;
    const int aoff = lds_byte(wr * 64 + fr, fq * 8), boff = lds_byte(wc * 32 + fr, fq * 8);
#define PG8_SA(b, h) (((b) * 2 + (h)) * HTB)
#define PG8_SB(b, h) ((4 + (b) * 2 + (h)) * HTB)
#define PG8_STAGE(bufoff, gbase, voff) do { _Pragma("unroll") for (int _i = 0; _i < 2; ++_i) \
        __builtin_amdgcn_global_load_lds((const unsigned*)((const char*)(gbase) + (voff)[_i]), (PG8_LAS unsigned*)(lds + (bufoff) + ldsw + _i * 8192), 16, 0, 0); } while (0)
#define PG8_LDA(dst, b, h) do { _Pragma("unroll") for (int m = 0; m < 4; ++m) _Pragma("unroll") for (int k = 0; k < 2; ++k) dst[m][k] = *(const PG8_LAS bf16x8*)(lds + PG8_SA(b, h) + aoff + m * 2048 + k * 1024); } while (0)
#define PG8_LDB(dst, b, h) do { _Pragma("unroll") for (int n = 0; n < 2; ++n) _Pragma("unroll") for (int k = 0; k < 2; ++k) dst[n][k] = *(const PG8_LAS bf16x8*)(lds + PG8_SB(b, h) + boff + n * 2048 + k * 1024); } while (0)
#define PG8_MMA(ai, bj, At, Bt) do { __builtin_amdgcn_s_setprio(1); _Pragma("unroll") for (int m = 0; m < 4; ++m) _Pragma("unroll") for (int n = 0; n < 2; ++n) \
        acc[ai][bj][m][n] = __builtin_amdgcn_mfma_scale_f32_16x16x128_f8f6f4(cat8(Bt[n][0], Bt[n][1]), cat8(At[m][0], At[m][1]), acc[ai][bj][m][n], 0, 0, 0, 0, 0, 0); __builtin_amdgcn_s_setprio(0); } while (0)
#define PG8_WAIT_V(n) asm volatile("s_waitcnt vmcnt(" #n ")" ::: "memory")
#define PG8_WAIT_L(n) asm volatile("s_waitcnt lgkmcnt(" #n ")" ::: "memory")
#define PG8_BAR __builtin_amdgcn_s_barrier()
#define PG8_SCHED __builtin_amdgcn_sched_barrier(0)
    Unit cur, nxt; int ui = 0;
    if (!S.next(0, cur)) return;
    f32x4 acc[2][2][4][2];
#pragma unroll
    for (int a = 0; a < 2; ++a)
#pragma unroll
        for (int b = 0; b < 2; ++b)
#pragma unroll
            for (int m = 0; m < 4; ++m)
#pragma unroll
                for (int n = 0; n < 2; ++n) acc[a][b][m][n] = (f32x4){0.f, 0.f, 0.f, 0.f};
    bf16x8 At[4][2], B0[2][2], B1[2][2];
    const char* cA = (const char*)g.A + (size_t)cur.pm * tstep; const char* cB = (const char*)g.Bt + (size_t)cur.pn * tstep;
    S.a_ready(cur);
    PG8_STAGE(PG8_SB(0, 0), cB, voffB); PG8_STAGE(PG8_SA(0, 0), cA, voffA); PG8_STAGE(PG8_SB(0, 1), cB + hstep, voffB); PG8_STAGE(PG8_SA(0, 1), cA + hstep, voffA);
    if (wr == 1) PG8_BAR;
    PG8_WAIT_V(4); PG8_BAR;
    PG8_STAGE(PG8_SB(1, 0), cB + kstep, voffB); PG8_STAGE(PG8_SA(1, 0), cA + kstep, voffA); PG8_STAGE(PG8_SB(1, 1), cB + hstep + kstep, voffB);
    PG8_WAIT_V(6); PG8_BAR;
    PG8_STAMP();
    for (;;) {
        const bool has_next = S.next(ui + 1, nxt);
        const char* nA = has_next ? (const char*)g.A + (size_t)nxt.pm * tstep : cA; const char* nB = has_next ? (const char*)g.Bt + (size_t)nxt.pn * tstep : cB;
        for (int t = 0; t < nt; t += 2) {
            const bool last = (t == nt - 2);
            const char* a1 = cA + (size_t)(t + 1) * kstep;
            const char* a2 = last ? nA : cA + (size_t)(t + 2) * kstep; const char* b2 = last ? nB : cB + (size_t)(t + 2) * kstep;
            const char* a3 = a2 + kstep; const char* b3 = b2 + kstep;
            if (last && has_next) S.a_ready(nxt);
            PG8_LDB(B0, 0, 0); PG8_SCHED; PG8_LDA(At, 0, 0); PG8_STAGE(PG8_SA(1, 1), a1 + hstep, voffA);
            PG8_WAIT_L(8); PG8_BAR; PG8_WAIT_L(0); PG8_MMA(0, 0, At, B0); PG8_BAR; PG8_SCHED;
            PG8_LDB(B1, 0, 1); PG8_STAGE(PG8_SB(0, 0), b2, voffB);
            PG8_BAR; PG8_WAIT_L(0); PG8_MMA(0, 1, At, B1); PG8_BAR;
            PG8_LDA(At, 0, 1); PG8_STAGE(PG8_SA(0, 0), a2, voffA);
            PG8_BAR; PG8_WAIT_L(0); PG8_MMA(1, 0, At, B0); PG8_BAR; PG8_SCHED;
            PG8_STAGE(PG8_SB(0, 1), b2 + hstep, voffB);
            PG8_WAIT_V(6); PG8_BAR; PG8_MMA(1, 1, At, B1); PG8_BAR;
            PG8_LDB(B0, 1, 0); PG8_SCHED; PG8_LDA(At, 1, 0); PG8_STAGE(PG8_SA(0, 1), a2 + hstep, voffA);
            PG8_WAIT_L(8); PG8_BAR; PG8_WAIT_L(0); PG8_MMA(0, 0, At, B0); PG8_BAR; PG8_SCHED;
            PG8_LDB(B1, 1, 1); PG8_STAGE(PG8_SB(1, 0), b3, voffB);
            PG8_BAR; PG8_WAIT_L(0); PG8_MMA(0, 1, At, B1); PG8_BAR;
            PG8_LDA(At, 1, 1); PG8_STAGE(PG8_SA(1, 0), a3, voffA);
            PG8_BAR; PG8_WAIT_L(0); PG8_MMA(1, 0, At, B0); PG8_BAR; PG8_SCHED;
            PG8_STAGE(PG8_SB(1, 1), b3 + hstep, voffB);
            PG8_WAIT_V(6); PG8_BAR; PG8_MMA(1, 1, At, B1); PG8_BAR;
        }
        PG8_STAMP();
        if constexpr (!Epi::AFTER_DRAIN) { E(acc, cur, wr, wc, fr, fq); S.done(cur); }
        PG8_STAMP();
        if (!has_next) break;
#pragma unroll
        for (int a = 0; a < 2; ++a)
#pragma unroll
            for (int b = 0; b < 2; ++b)
#pragma unroll
                for (int m = 0; m < 4; ++m)
#pragma unroll
                    for (int n = 0; n < 2; ++n) acc[a][b][m][n] = (f32x4){0.f, 0.f, 0.f, 0.f};
        cur = nxt; cA = nA; cB = nB; ++ui;
    }
    PG8_WAIT_V(0);
    if (wr == 0) PG8_BAR;
    PG8_BAR;
    if constexpr (Epi::AFTER_DRAIN) { E.fused(acc, cur, wr, wc, fr, fq, lds, wid, lane); S.done(cur); }
    PG8_STAMP();
    if (STAMP && wid == 0) { stamps[lane] = lane < nts ? (((unsigned long long)(unsigned)ts_hi << 32) | (unsigned)ts_lo) : 0ull;
        if (lane == 62) stamps[62] = rt_entry; if (lane == 63) stamps[63] = (unsigned long long)wall_clock64(); }
#undef PG8_STAMP
#undef PG8_SA
#undef PG8_SB
#undef PG8_STAGE
#undef PG8_LDA
#undef PG8_LDB
#undef PG8_MMA
#undef PG8_WAIT_V
#undef PG8_WAIT_L
#undef PG8_BAR
#undef PG8_SCHED
}

template <class Epi, class Sched, bool STAMP = false>
__device__ __forceinline__ void gemm_phase2(PG8_LAS unsigned char* lds, const Gemm2 g, const Sched& S, const Epi& E, unsigned long long* stamps) {
    const int tid = threadIdx.x, wid = __builtin_amdgcn_readfirstlane(tid >> 6), lane = tid & 63, wr = wid >> 2, wc = wid & 3, fr = lane & 15, fq = lane >> 4;
    const int K = g.K, nt1 = g.nt1, nt = g.nt;
    int ts_lo = 0, ts_hi = 0, nts = 0; const unsigned long long rt_entry = STAMP ? (unsigned long long)wall_clock64() : 0ull;
#define PG8_STAMP() do { if (STAMP && wid == 0 && nts < 64) { const unsigned long long _c = (unsigned long long)clock64(); \
        ts_lo = (lane == nts) ? (int)(unsigned)_c : ts_lo; ts_hi = (lane == nts) ? (int)(unsigned)(_c >> 32) : ts_hi; ++nts; } } while (0)
    PG8_STAMP();
    unsigned voffA[2], voffB[2];
#pragma unroll
    for (int i = 0; i < 2; ++i) { int R, C; stage_rc(tid * 16 + i * 8192, R, C); const int Rb = Epi::PERM ? ((R & ~31) + perm32(R & 31)) : R;
        voffA[i] = (unsigned)(R * K + C) * 2u; voffB[i] = (unsigned)(Rb * K + C) * 2u; }
    const size_t kstep = (size_t)(BK * 2);
    const size_t hstep = (size_t)HALF * K * 2;
    const size_t tstep = 2 * hstep;
    const unsigned ldsw = (unsigned)wid * 1024u;
    const int aoff = lds_byte(wr * 64 + fr, fq * 8), boff = lds_byte(wc * 32 + fr, fq * 8);
#define PG8_SA(b, h) (((b) * 2 + (h)) * HTB)
#define PG8_SB(b, h) ((4 + (b) * 2 + (h)) * HTB)
#define PG8_STAGE(bufoff, gbase, voff) do { _Pragma("unroll") for (int _i = 0; _i < 2; ++_i) \
        __builtin_amdgcn_global_load_lds((const unsigned*)((const char*)(gbase) + (voff)[_i]), (PG8_LAS unsigned*)(lds + (bufoff) + ldsw + _i * 8192), 16, 0, 0); } while (0)
#define PG8_LDA(dst, b, h) do { _Pragma("unroll") for (int m = 0; m < 4; ++m) _Pragma("unroll") for (int k = 0; k < 2; ++k) dst[m][k] = *(const PG8_LAS bf16x8*)(lds + PG8_SA(b, h) + aoff + m * 2048 + k * 1024); } while (0)
#define PG8_LDB(dst, b, h) do { _Pragma("unroll") for (int n = 0; n < 2; ++n) _Pragma("unroll") for (int k = 0; k < 2; ++k) dst[n][k] = *(const PG8_LAS bf16x8*)(lds + PG8_SB(b, h) + boff + n * 2048 + k * 1024); } while (0)
#define PG8_MMA(ai, bj, At, Bt) do { __builtin_amdgcn_s_setprio(1); _Pragma("unroll") for (int m = 0; m < 4; ++m) _Pragma("unroll") for (int n = 0; n < 2; ++n) _Pragma("unroll") for (int k = 0; k < 2; ++k) \
        acc[ai][bj][m][n] = __builtin_amdgcn_mfma_f32_16x16x32_bf16(Bt[n][k], At[m][k], acc[ai][bj][m][n], 0, 0, 0); __builtin_amdgcn_s_setprio(0); } while (0)
#define PG8_WAIT_V(n) asm volatile("s_waitcnt vmcnt(" #n ")" ::: "memory")
#define PG8_WAIT_L(n) asm volatile("s_waitcnt lgkmcnt(" #n ")" ::: "memory")
#define PG8_BAR __builtin_amdgcn_s_barrier()
#define PG8_SCHED __builtin_amdgcn_sched_barrier(0)
    Unit cur, nxt; int ui = 0;
    if (!S.next(0, cur)) return;
    f32x4 acc[2][2][4][2];
#pragma unroll
    for (int a = 0; a < 2; ++a)
#pragma unroll
        for (int b = 0; b < 2; ++b)
#pragma unroll
            for (int m = 0; m < 4; ++m)
#pragma unroll
                for (int n = 0; n < 2; ++n) acc[a][b][m][n] = (f32x4){0.f, 0.f, 0.f, 0.f};
    bf16x8 At[4][2], B0[2][2], B1[2][2];
    const char* cA = (const char*)g.A + (size_t)cur.pm * tstep; const char* cB = (const char*)g.Bt + (size_t)cur.pn * tstep;
    const char* dA = (const char*)g.A2 + (size_t)cur.pm * tstep - (size_t)nt1 * kstep; const char* dB = (const char*)g.Bt2 + (size_t)cur.pn * tstep - (size_t)nt1 * kstep;
#define PG8_TA(t_) ((((t_) < nt1) ? cA : dA) + (size_t)(t_) * kstep)
#define PG8_TB(t_) ((((t_) < nt1) ? cB : dB) + (size_t)(t_) * kstep)
    S.a_ready(cur);
    PG8_STAGE(PG8_SB(0, 0), cB, voffB); PG8_STAGE(PG8_SA(0, 0), cA, voffA); PG8_STAGE(PG8_SB(0, 1), cB + hstep, voffB); PG8_STAGE(PG8_SA(0, 1), cA + hstep, voffA);
    if (wr == 1) PG8_BAR;
    PG8_WAIT_V(4); PG8_BAR;
    PG8_STAGE(PG8_SB(1, 0), cB + kstep, voffB); PG8_STAGE(PG8_SA(1, 0), cA + kstep, voffA); PG8_STAGE(PG8_SB(1, 1), cB + hstep + kstep, voffB);
    PG8_WAIT_V(6); PG8_BAR;
    PG8_STAMP();
    for (;;) {
        const bool has_next = S.next(ui + 1, nxt);
        const char* nA = has_next ? (const char*)g.A + (size_t)nxt.pm * tstep : cA; const char* nB = has_next ? (const char*)g.Bt + (size_t)nxt.pn * tstep : cB;
        const char* ndA = has_next ? (const char*)g.A2 + (size_t)nxt.pm * tstep - (size_t)nt1 * kstep : dA; const char* ndB = has_next ? (const char*)g.Bt2 + (size_t)nxt.pn * tstep - (size_t)nt1 * kstep : dB;
        for (int t = 0; t < nt; t += 2) {
            const bool last = (t == nt - 2);
            if (t == nt1) E.mid(acc, cur, wr, wc, fr, fq);
            const char* a1 = PG8_TA(t + 1);
            const char* a2 = last ? nA : PG8_TA(t + 2); const char* b2 = last ? nB : PG8_TB(t + 2);
            const char* a3 = a2 + kstep; const char* b3 = b2 + kstep;
            if (last && has_next) S.a_ready(nxt);
            PG8_LDB(B0, 0, 0); PG8_SCHED; PG8_LDA(At, 0, 0); PG8_STAGE(PG8_SA(1, 1), a1 + hstep, voffA);
            PG8_WAIT_L(8); PG8_BAR; PG8_WAIT_L(0); PG8_MMA(0, 0, At, B0); PG8_BAR; PG8_SCHED;
            PG8_LDB(B1, 0, 1); PG8_STAGE(PG8_SB(0, 0), b2, voffB);
            PG8_BAR; PG8_WAIT_L(0); PG8_MMA(0, 1, At, B1); PG8_BAR;
            PG8_LDA(At, 0, 1); PG8_STAGE(PG8_SA(0, 0), a2, voffA);
            PG8_BAR; PG8_WAIT_L(0); PG8_MMA(1, 0, At, B0); PG8_BAR; PG8_SCHED;
            PG8_STAGE(PG8_SB(0, 1), b2 + hstep, voffB);
            PG8_WAIT_V(6); PG8_BAR; PG8_MMA(1, 1, At, B1); PG8_BAR;
            PG8_LDB(B0, 1, 0); PG8_SCHED; PG8_LDA(At, 1, 0); PG8_STAGE(PG8_SA(0, 1), a2 + hstep, voffA);
            PG8_WAIT_L(8); PG8_BAR; PG8_WAIT_L(0); PG8_MMA(0, 0, At, B0); PG8_BAR; PG8_SCHED;
            PG8_LDB(B1, 1, 1); PG8_STAGE(PG8_SB(1, 0), b3, voffB);
            PG8_BAR; PG8_WAIT_L(0); PG8_MMA(0, 1, At, B1); PG8_BAR;
            PG8_LDA(At, 1, 1); PG8_STAGE(PG8_SA(1, 0), a3, voffA);
            PG8_BAR; PG8_WAIT_L(0); PG8_MMA(1, 0, At, B0); PG8_BAR; PG8_SCHED;
            PG8_STAGE(PG8_SB(1, 1), b3 + hstep, voffB);
            PG8_WAIT_V(6); PG8_BAR; PG8_MMA(1, 1, At, B1); PG8_BAR;
        }
        PG8_STAMP();
        if constexpr (!Epi::AFTER_DRAIN) { E(acc, cur, wr, wc, fr, fq); S.done(cur); }
        PG8_STAMP();
        if (!has_next) break;
#pragma unroll
        for (int a = 0; a < 2; ++a)
#pragma unroll
            for (int b = 0; b < 2; ++b)
#pragma unroll
                for (int m = 0; m < 4; ++m)
#pragma unroll
                    for (int n = 0; n < 2; ++n) acc[a][b][m][n] = (f32x4){0.f, 0.f, 0.f, 0.f};
        cur = nxt; cA = nA; cB = nB; dA = ndA; dB = ndB; ++ui;
    }
    PG8_WAIT_V(0);
    if (wr == 0) PG8_BAR;
    PG8_BAR;
    if constexpr (Epi::AFTER_DRAIN) { E.fused(acc, cur, wr, wc, fr, fq, lds, wid, lane); S.done(cur); }
    PG8_STAMP();
    if (STAMP && wid == 0) { stamps[lane] = lane < nts ? (((unsigned long long)(unsigned)ts_hi << 32) | (unsigned)ts_lo) : 0ull;
        if (lane == 62) stamps[62] = rt_entry; if (lane == 63) stamps[63] = (unsigned long long)wall_clock64(); }
#undef PG8_STAMP
#undef PG8_TA
#undef PG8_TB
#undef PG8_SA
#undef PG8_SB
#undef PG8_STAGE
#undef PG8_LDA
#undef PG8_LDB
#undef PG8_MMA
#undef PG8_WAIT_V
#undef PG8_WAIT_L
#undef PG8_BAR
#undef PG8_SCHED
}
}
#define XB_TMO      128
#define XB_XCNT(j)  (256  + 64 * (j))
#define XB_XSUB(j)  (1280 + 64 * (j))
#define XB_XGEN(j)  (2304 + 64 * (j))
#define XB_TOP      3328
#define XB_TOPGEN   3392
#define XCD_BAR_WORDS 3456
#define XB_SPIN_CAP (1u << 18)
#define LAS __attribute__((address_space(3)))

__device__ __forceinline__ unsigned xb_ld(unsigned* p)              { return __hip_atomic_load(p, __ATOMIC_RELAXED, __HIP_MEMORY_SCOPE_AGENT); }
__device__ __forceinline__ unsigned xb_add(unsigned* p, unsigned v) { return __hip_atomic_fetch_add(p, v, __ATOMIC_RELAXED, __HIP_MEMORY_SCOPE_AGENT); }
__device__ __forceinline__ unsigned xb_xcc_id() { return (unsigned)__builtin_amdgcn_s_getreg((3 << 11) | 20) & 0xFu; }
#define XB_SPIN(cond, bar) do { unsigned _sp = 0; while (cond) { __builtin_amdgcn_s_sleep(1); \
    if ((++_sp & 255u) == 0u) { if (xb_ld(&(bar)[XB_TMO])) break; if (_sp > XB_SPIN_CAP) { atomicAdd(&(bar)[XB_TMO], 1u); break; } } } } while (0)

struct XcdBarrier {
    unsigned* bar; unsigned x;
    volatile LAS unsigned* st;
};

__device__ __forceinline__ XcdBarrier xcd_barrier_post(unsigned* bar, volatile LAS unsigned* st) {
    XcdBarrier b; b.bar = bar; b.x = xb_xcc_id(); b.st = st;
    if (threadIdx.x == 0) (void)xb_add(&bar[XB_XCNT(b.x)], 1u);
    return b;
}
__device__ __forceinline__ void xcd_barrier_complete(unsigned* bar, unsigned x, unsigned& nloc, unsigned& nx) {
    const unsigned G = gridDim.x * gridDim.y * gridDim.z;
    unsigned sum, cnt, mine, sp = 0u;
    for (;;) {
        sum = 0u; cnt = 0u; mine = 0u;
#pragma unroll
        for (unsigned j = 0; j < 16; ++j) { const unsigned c = xb_ld(&bar[XB_XCNT(j)]); sum += c; cnt += (c > 0u) ? 1u : 0u; mine = (j == x) ? c : mine; }
        if (sum == G) break;
        __builtin_amdgcn_s_sleep(1);
        if ((++sp & 255u) == 0u) { if (xb_ld(&bar[XB_TMO])) break; if (sp > XB_SPIN_CAP) { atomicAdd(&bar[XB_TMO], 1u); break; } }
    }
    nloc = mine > 0u ? mine : 1u; nx = cnt > 0u ? cnt : 1u;
}

__device__ __forceinline__ void xcd_barrier(const XcdBarrier& b) {
    asm volatile("s_waitcnt vmcnt(0)" ::: "memory");
    __syncthreads();
    if (threadIdx.x == 0) {
        unsigned* bar = b.bar;
        __builtin_amdgcn_s_waitcnt(0);
        unsigned nloc = b.st[0], nx = b.st[1];
        if (nloc == 0u) { xcd_barrier_complete(bar, b.x, nloc, nx); b.st[0] = nloc; b.st[1] = nx; }
        const unsigned old = xb_add(&bar[XB_XSUB(b.x)], 1u);
        const unsigned gen = old / nloc;
        if (old + 1u == (gen + 1u) * nloc) {
            __builtin_amdgcn_fence(__ATOMIC_RELEASE, "agent");
            asm volatile("s_waitcnt vmcnt(0)" ::: "memory");
            const unsigned og = xb_add(&bar[XB_TOP], 1u);
            const unsigned tg = og / nx;
            if (og + 1u == (tg + 1u) * nx) xb_add(&bar[XB_TOPGEN], 1u);
            else XB_SPIN(xb_ld(&bar[XB_TOPGEN]) == tg, bar);
            __builtin_amdgcn_fence(__ATOMIC_ACQUIRE, "agent");
            xb_add(&bar[XB_XGEN(b.x)], 1u);
            asm volatile("s_waitcnt vmcnt(0)" ::: "memory");
        } else {
            XB_SPIN(xb_ld(&bar[XB_XGEN(b.x)]) == gen, bar);
            __builtin_amdgcn_fence(__ATOMIC_ACQUIRE, "agent");
            asm volatile("s_waitcnt vmcnt(0)" ::: "memory");
        }
    }
    __syncthreads();
}

typedef unsigned short bf16;
using pg8::f32x4;
constexpr int T = 16384, SEQ = 4096, D = 1024, DIN = 4768, DINP = 4864;
constexpr int C_A = 0, C_B = 512, C_R = 1024, C_K = 1536, C_V = 2048, C_LW = 2560, C_LA = 2592, C_LG = 2624, C_GC = 2720, C_GR = 3744;
constexpr size_t MiB = 1u << 20;
constexpr size_t WS_WIN_T = 0, WS_PW_T = 10 * MiB, WS_WO_T = 11 * MiB, WS_WOUT_T = 12 * MiB, WS_WQ_T = 14 * MiB, WS_KEYS = 18 * MiB,
                 WS_BONUS = 18 * MiB + 512 * 1024, WS_XN = 20 * MiB, WS_PROJ = 52 * MiB, WS_LD = 204 * MiB, WS_YN = 236 * MiB, WS_END = 252 * MiB;
constexpr size_t WS_BETA = WS_XN, WS_G = WS_XN + 16 * MiB, WS_M = WS_LD;
constexpr size_t WS_Q = WS_PROJ, WS_UB = WS_PROJ + 64 * MiB, WS_VB = WS_PROJ + 96 * MiB, WS_EID = WS_PROJ + 128 * MiB, WS_GATE = WS_PROJ + 136 * MiB;

__device__ __forceinline__ bf16 f2bf(float f) { return __builtin_bit_cast(unsigned short, (__bf16)f); }
__device__ __forceinline__ float bf2f(bf16 b) { return __uint_as_float(((unsigned)b) << 16); }
__device__ __forceinline__ float bflo(unsigned w) { return __uint_as_float(w << 16); }
__device__ __forceinline__ float bfhi(unsigned w) { return __uint_as_float(w & 0xFFFF0000u); }
typedef __bf16 bf16x2_t __attribute__((ext_vector_type(2)));
__device__ __forceinline__ unsigned pack2(float lo, float hi) { bf16x2_t v; v[0] = (__bf16)lo; v[1] = (__bf16)hi; return __builtin_bit_cast(unsigned, v); }
__device__ __forceinline__ float wave_sum(float v) {
#pragma unroll
    for (int o = 32; o > 0; o >>= 1) v += __shfl_xor(v, o, 64);
    return v;
}
__device__ __forceinline__ float sigmoidf_(float x) { return __builtin_amdgcn_rcpf(1.f + __expf(-x)); }
__device__ __forceinline__ float tanhf_(float x) { return 1.f - 2.f * __builtin_amdgcn_rcpf(1.f + __expf(2.f * x)); }
__device__ __forceinline__ void unpack8(const uint4 v, float (&f)[8]) {
    f[0] = bflo(v.x); f[1] = bfhi(v.x); f[2] = bflo(v.y); f[3] = bfhi(v.y); f[4] = bflo(v.z); f[5] = bfhi(v.z); f[6] = bflo(v.w); f[7] = bfhi(v.w);
}
__device__ __forceinline__ uint4 pack8(const float (&f)[8]) {
    uint4 v; v.x = pack2(f[0], f[1]); v.y = pack2(f[2], f[3]); v.z = pack2(f[4], f[5]); v.w = pack2(f[6], f[7]); return v;
}

__device__ __forceinline__ int ph_transpose(unsigned char* shm, int bid, int nblk, int tile0, const float* __restrict__ src, bf16* __restrict__ dst, int K, int N, int Npad, const float* __restrict__ kscale = nullptr) {
    float (*tile)[65] = (float (*)[65])shm;
    const int ntn = Npad / 64, ntiles = ntn * (K / 64);
    int first = bid - (tile0 % nblk); if (first < 0) first += nblk;
    for (int tl = first; tl < ntiles; tl += nblk) {
        const int n0 = (tl % ntn) * 64, k0 = (tl / ntn) * 64;
        __syncthreads();
        for (int i = threadIdx.x; i < 64 * 64; i += 512) { const int kk = i >> 6, nn = i & 63; float v = 0.f; if (n0 + nn < N) v = src[(size_t)(k0 + kk) * N + n0 + nn]; if (kscale) v *= kscale[k0 + kk]; tile[kk][nn] = v; }
        __syncthreads();
        for (int i = threadIdx.x; i < 64 * 64; i += 512) { const int nn = i >> 6, kk = i & 63; dst[(size_t)(n0 + nn) * K + k0 + kk] = f2bf(tile[kk][nn]); }
    }
    return ntiles;
}
__device__ __forceinline__ int ph_transpose_reg(int bid, int nblk, int tile0, const float* __restrict__ src, bf16* __restrict__ dst, int K, int N, int Npad) {
    const int lane = threadIdx.x & 63, n4 = lane & 7, j = lane >> 3, ntn = Npad / 32, ntiles = ntn * (K / 64);
    int first = bid * 8 + (int)(threadIdx.x >> 6) - (tile0 % (nblk * 8)); if (first < 0) first += nblk * 8;
    for (int tl = first; tl < ntiles; tl += nblk * 8) {
        const int n0 = (tl % ntn) * 32 + 4 * n4, k0 = (tl / ntn) * 64 + 8 * j;
        float4 v[8];
        if (n0 < N) {
#pragma unroll
            for (int i = 0; i < 8; ++i) v[i] = *(const float4*)(src + (size_t)(k0 + i) * N + n0);
        } else {
#pragma unroll
            for (int i = 0; i < 8; ++i) v[i] = make_float4(0.f, 0.f, 0.f, 0.f);
        }
        uint4 o;
        o.x = pack2(v[0].x, v[1].x); o.y = pack2(v[2].x, v[3].x); o.z = pack2(v[4].x, v[5].x); o.w = pack2(v[6].x, v[7].x); *(uint4*)(dst + (size_t)(n0 + 0) * K + k0) = o;
        o.x = pack2(v[0].y, v[1].y); o.y = pack2(v[2].y, v[3].y); o.z = pack2(v[4].y, v[5].y); o.w = pack2(v[6].y, v[7].y); *(uint4*)(dst + (size_t)(n0 + 1) * K + k0) = o;
        o.x = pack2(v[0].z, v[1].z); o.y = pack2(v[2].z, v[3].z); o.z = pack2(v[4].z, v[5].z); o.w = pack2(v[6].z, v[7].z); *(uint4*)(dst + (size_t)(n0 + 2) * K + k0) = o;
        o.x = pack2(v[0].w, v[1].w); o.y = pack2(v[2].w, v[3].w); o.z = pack2(v[4].w, v[5].w); o.w = pack2(v[6].w, v[7].w); *(uint4*)(dst + (size_t)(n0 + 3) * K + k0) = o;
    }
    return ntiles;
}
__device__ __forceinline__ void ph_cvt(int bid, int nblk, const float* __restrict__ src, bf16* __restrict__ dst, size_t n4) {
    for (size_t i = (size_t)bid * 512 + threadIdx.x; i < n4; i += (size_t)nblk * 512) {
        const float4 v = ((const float4*)src)[i]; uint2 o; o.x = pack2(v.x, v.y); o.y = pack2(v.z, v.w); ((uint2*)dst)[i] = o; }
}
__device__ __forceinline__ void ph_rmsnorm(int bid, int nblk, const float* __restrict__ x, const float* __restrict__ g, bf16* __restrict__ out, int rows) {
    const int wave = (bid * 512 + threadIdx.x) >> 6, nw = (nblk * 512) >> 6, lane = threadIdx.x & 63;
    float4 gg[4], nx[4];
#pragma unroll
    for (int i = 0; i < 4; ++i) gg[i] = ((const float4*)g)[lane + 64 * i];
    if (wave < rows) {
#pragma unroll
        for (int i = 0; i < 4; ++i) nx[i] = ((const float4*)(x + (size_t)wave * D))[lane + 64 * i];
    }
    for (int r = wave; r < rows; r += nw) {
        float4 v[4]; float ss = 0.f;
#pragma unroll
        for (int i = 0; i < 4; ++i) v[i] = nx[i];
        if (r + nw < rows) {
#pragma unroll
            for (int i = 0; i < 4; ++i) nx[i] = ((const float4*)(x + (size_t)(r + nw) * D))[lane + 64 * i];
        }
#pragma unroll
        for (int i = 0; i < 4; ++i) ss += v[i].x * v[i].x + v[i].y * v[i].y + v[i].z * v[i].z + v[i].w * v[i].w;
        ss = wave_sum(ss);
        const float sc = rsqrtf(ss * (1.f / D) + 1e-6f);
#pragma unroll
        for (int i = 0; i < 4; ++i) { uint2 o; o.x = pack2(v[i].x * sc * gg[i].x, v[i].y * sc * gg[i].y); o.y = pack2(v[i].z * sc * gg[i].z, v[i].w * sc * gg[i].w);
            ((uint2*)(out + (size_t)r * D))[lane + 64 * i] = o; }
    }
}

template <class F> struct EpiGen {
    static constexpr bool PERM = true, AFTER_DRAIN = false;
    F f;
    __device__ __forceinline__ void operator()(const f32x4 (&acc)[2][2][4][2], const pg8::Unit& u, int wr, int wc, int fr, int fq) const {
        const int row0 = u.pm * 256 + wr * 64 + fr, col0 = u.pn * 256 + wc * 32 + 8 * fq;
#pragma unroll
        for (int ai = 0; ai < 2; ++ai)
#pragma unroll
            for (int m = 0; m < 4; ++m)
#pragma unroll
                for (int bj = 0; bj < 2; ++bj) f(row0 + ai * 128 + m * 16, col0 + bj * 128, acc[ai][bj][m][0], acc[ai][bj][m][1]);
    }
};
struct FStoreBf16 { bf16* O; int ldc;
    __device__ __forceinline__ void operator()(int row, int col, f32x4 a, f32x4 b) const {
        uint4 o; o.x = pack2(a[0], a[1]); o.y = pack2(a[2], a[3]); o.z = pack2(b[0], b[1]); o.w = pack2(b[2], b[3]);
        typedef unsigned nt4 __attribute__((ext_vector_type(4))); nt4 w; w[0] = o.x; w[1] = o.y; w[2] = o.z; w[3] = o.w;
        __builtin_nontemporal_store(w, (nt4*)(O + (size_t)row * ldc + col)); } };
struct FConvM { bf16* M; const bf16* proj; const float* bias;
    __device__ __forceinline__ void operator()(int row, int col, f32x4 a, f32x4 b) const {
        float gl[8]; unpack8(*(const uint4*)(proj + (size_t)row * DINP + C_GC + col), gl);
        const float4 b0 = *(const float4*)(bias + col), b1 = *(const float4*)(bias + col + 4);
        float o[8] = {a[0] + b0.x, a[1] + b0.y, a[2] + b0.z, a[3] + b0.w, b[0] + b1.x, b[1] + b1.y, b[2] + b1.z, b[3] + b1.w};
#pragma unroll
        for (int i = 0; i < 8; ++i) o[i] *= sigmoidf_(gl[i]);
        *(uint4*)(M + (size_t)row * D + col) = pack8(o); } };
struct FRwM { bf16* M; const bf16* proj;
    __device__ __forceinline__ void operator()(int row, int col, f32x4 a, f32x4 b) const {
        float gl[8], mo[8]; unpack8(*(const uint4*)(proj + (size_t)row * DINP + C_GR + col), gl); unpack8(*(const uint4*)(M + (size_t)row * D + col), mo);
        float o[8] = {a[0], a[1], a[2], a[3], b[0], b[1], b[2], b[3]};
#pragma unroll
        for (int i = 0; i < 8; ++i) o[i] = mo[i] + o[i] * sigmoidf_(gl[i]);
        *(uint4*)(M + (size_t)row * D + col) = pack8(o); } };
struct FResX1 { const float* x; float* x1;
    __device__ __forceinline__ void operator()(int row, int col, f32x4 a, f32x4 b) const {
        const float4 x0 = *(const float4*)(x + (size_t)row * D + col), x1v = *(const float4*)(x + (size_t)row * D + col + 4);
        *(float4*)(x1 + (size_t)row * D + col) = make_float4(x0.x + a[0], x0.y + a[1], x0.z + a[2], x0.w + a[3]);
        *(float4*)(x1 + (size_t)row * D + col + 4) = make_float4(x1v.x + b[0], x1v.y + b[1], x1v.z + b[2], x1v.w + b[3]); } };

template <class F> struct EpiGen2 {
    static constexpr bool PERM = true, AFTER_DRAIN = false;
    F f;
    __device__ __forceinline__ void operator()(const f32x4 (&acc)[2][2][4][2], const pg8::Unit& u, int wr, int wc, int fr, int fq) const {
        const int row0 = u.pm * 256 + wr * 64 + fr, col0 = u.pn * 256 + wc * 32 + 8 * fq;
#pragma unroll
        for (int ai = 0; ai < 2; ++ai) {
            typename F::Pre P[4][2];
#pragma unroll
            for (int m = 0; m < 4; ++m)
#pragma unroll
                for (int bj = 0; bj < 2; ++bj) P[m][bj] = f.pre(row0 + ai * 128 + m * 16, col0 + bj * 128);
#pragma unroll
            for (int m = 0; m < 4; ++m)
#pragma unroll
                for (int bj = 0; bj < 2; ++bj) f.post(row0 + ai * 128 + m * 16, col0 + bj * 128, acc[ai][bj][m][0], acc[ai][bj][m][1], P[m][bj]);
        }
    }
};
struct FConvM2 { bf16* M; const bf16* proj; const float* bias;
    struct Pre { uint4 g; };
    __device__ __forceinline__ Pre pre(int row, int col) const { Pre p; p.g = *(const uint4*)(proj + (size_t)row * DINP + C_GC + col); return p; }
    __device__ __forceinline__ void post(int row, int col, f32x4 a, f32x4 b, const Pre& p) const {
        float gl[8]; unpack8(p.g, gl);
        const float4 b0 = *(const float4*)(bias + col), b1 = *(const float4*)(bias + col + 4);
        float o[8] = {a[0] + b0.x, a[1] + b0.y, a[2] + b0.z, a[3] + b0.w, b[0] + b1.x, b[1] + b1.y, b[2] + b1.z, b[3] + b1.w};
#pragma unroll
        for (int i = 0; i < 8; ++i) o[i] *= sigmoidf_(gl[i]);
        *(uint4*)(M + (size_t)row * D + col) = pack8(o); } };
struct FRwM2 { bf16* M; const bf16* proj;
    struct Pre { uint4 g, m; };
    __device__ __forceinline__ Pre pre(int row, int col) const { Pre p; p.g = *(const uint4*)(proj + (size_t)row * DINP + C_GR + col); p.m = *(const uint4*)(M + (size_t)row * D + col); return p; }
    __device__ __forceinline__ void post(int row, int col, f32x4 a, f32x4 b, const Pre& p) const {
        float gl[8], mo[8]; unpack8(p.g, gl); unpack8(p.m, mo);
        float o[8] = {a[0], a[1], a[2], a[3], b[0], b[1], b[2], b[3]};
#pragma unroll
        for (int i = 0; i < 8; ++i) o[i] = mo[i] + o[i] * sigmoidf_(gl[i]);
        *(uint4*)(M + (size_t)row * D + col) = pack8(o); } };
struct FResX12B { const float* x; bf16* x1;
    struct Pre { float4 a, b; };
    __device__ __forceinline__ Pre pre(int row, int col) const { Pre p; p.a = *(const float4*)(x + (size_t)row * D + col); p.b = *(const float4*)(x + (size_t)row * D + col + 4); return p; }
    __device__ __forceinline__ void post(int row, int col, f32x4 a, f32x4 b, const Pre& p) const {
        *(uint4*)(x1 + (size_t)row * D + col) = make_uint4(pack2(p.a.x + a[0], p.a.y + a[1]), pack2(p.a.z + a[2], p.a.w + a[3]), pack2(p.b.x + b[0], p.b.y + b[1]), pack2(p.b.z + b[2], p.b.w + b[3])); } };
struct FResX12 { const float* x; float* x1;
    struct Pre { float4 a, b; };
    __device__ __forceinline__ Pre pre(int row, int col) const { Pre p; p.a = *(const float4*)(x + (size_t)row * D + col); p.b = *(const float4*)(x + (size_t)row * D + col + 4); return p; }
    __device__ __forceinline__ void post(int row, int col, f32x4 a, f32x4 b, const Pre& p) const {
        *(float4*)(x1 + (size_t)row * D + col) = make_float4(p.a.x + a[0], p.a.y + a[1], p.a.z + a[2], p.a.w + a[3]);
        *(float4*)(x1 + (size_t)row * D + col + 4) = make_float4(p.b.x + b[0], p.b.y + b[1], p.b.z + b[2], p.b.w + b[3]); } };

struct EpiMix {
    static constexpr bool PERM = true, AFTER_DRAIN = false;
    bf16* M; const bf16* proj; const float* bias;
    __device__ __forceinline__ void mid(f32x4 (&acc)[2][2][4][2], const pg8::Unit& u, int wr, int wc, int fr_, int fq_) const {
        int fr = fr_, fq = fq_; asm volatile("" : "+v"(fr), "+v"(fq));
        const int row0 = u.pm * 256 + wr * 64 + fr, col0 = u.pn * 256 + wc * 32 + 8 * fq;
#pragma unroll
        for (int ai = 0; ai < 2; ++ai)
#pragma unroll
            for (int mh = 0; mh < 2; ++mh) {
                uint4 gc[2][2], gr[2][2];
#pragma unroll
                for (int mm = 0; mm < 2; ++mm)
#pragma unroll
                    for (int bj = 0; bj < 2; ++bj) { const bf16* pr = proj + (size_t)(row0 + ai * 128 + (mh * 2 + mm) * 16) * DINP + col0 + bj * 128; gc[mm][bj] = *(const uint4*)(pr + C_GC); gr[mm][bj] = *(const uint4*)(pr + C_GR); }
#pragma unroll
                for (int mm = 0; mm < 2; ++mm)
#pragma unroll
                    for (int bj = 0; bj < 2; ++bj) {
                        const int m = mh * 2 + mm;
                        float c8[8], r8[8]; unpack8(gc[mm][bj], c8); unpack8(gr[mm][bj], r8);
                        const float4 b0 = *(const float4*)(bias + col0 + bj * 128), b1 = *(const float4*)(bias + col0 + bj * 128 + 4);
                        const float bb[8] = {b0.x, b0.y, b0.z, b0.w, b1.x, b1.y, b1.z, b1.w};
#pragma unroll
                        for (int i = 0; i < 8; ++i) { const float ratio = (1.f + __expf(-r8[i])) * __builtin_amdgcn_rcpf(1.f + __expf(-c8[i]));
                            if (i < 4) acc[ai][bj][m][0][i] = (acc[ai][bj][m][0][i] + bb[i]) * ratio; else acc[ai][bj][m][1][i - 4] = (acc[ai][bj][m][1][i - 4] + bb[i]) * ratio; }
                    }
                asm volatile("" ::: "memory");
            }
    }
    __device__ __forceinline__ void operator()(const f32x4 (&acc)[2][2][4][2], const pg8::Unit& u, int wr, int wc, int fr, int fq) const {
        const int row0 = u.pm * 256 + wr * 64 + fr, col0 = u.pn * 256 + wc * 32 + 8 * fq;
#pragma unroll
        for (int ai = 0; ai < 2; ++ai) {
            uint4 gr[4][2];
#pragma unroll
            for (int m = 0; m < 4; ++m)
#pragma unroll
                for (int bj = 0; bj < 2; ++bj) gr[m][bj] = *(const uint4*)(proj + (size_t)(row0 + ai * 128 + m * 16) * DINP + C_GR + col0 + bj * 128);
#pragma unroll
            for (int m = 0; m < 4; ++m)
#pragma unroll
                for (int bj = 0; bj < 2; ++bj) {
                    float r8[8], o[8]; unpack8(gr[m][bj], r8);
#pragma unroll
                    for (int i = 0; i < 8; ++i) o[i] = ((i < 4) ? acc[ai][bj][m][0][i] : acc[ai][bj][m][1][i - 4]) * sigmoidf_(r8[i]);
                    *(uint4*)(M + (size_t)(row0 + ai * 128 + m * 16) * D + col0 + bj * 128) = pack8(o);
                }
        }
    }
};
template <class Epi> __device__ __forceinline__ void ph_gemm2(unsigned char* shm, int bid, int nblk, const bf16* A, const bf16* Bt, const bf16* A2, const bf16* Bt2, int M, int N, int K, int nt1, int nt, const Epi& E) {
    pg8::Gemm2 g{A, Bt, A2, Bt2, M, N, K, nt1, nt};
    pg8::StaticOrder S; S.init(M, N, nblk, bid);
    pg8::gemm_phase2<Epi, pg8::StaticOrder, false>((PG8_LAS unsigned char*)shm, g, S, E, nullptr);
}
template <class Epi> __device__ __forceinline__ void ph_gemm(unsigned char* shm, int bid, int nblk, const bf16* A, const bf16* Bt, int M, int N, int K, const Epi& E) {
    pg8::Gemm g{A, Bt, M, N, K};
    pg8::StaticOrder S; S.init(M, N, nblk, bid);
    pg8::gemm_phase<Epi, pg8::StaticOrder, false>((PG8_LAS unsigned char*)shm, g, S, E, nullptr);
}

constexpr int CONV_GLU = 62 * 512 * 2, CONV_LDS = CONV_GLU + 31 * 512 * 4;
__device__ __forceinline__ float fmac1(float a, float b, float c) { asm("v_fmac_f32 %0, %1, %2" : "+v"(c) : "v"(a), "v"(b)); return c; }
__device__ __forceinline__ void ph_conv(unsigned char* shm, int bid, int nblk, const bf16* __restrict__ proj, const float* __restrict__ dw, const float* __restrict__ dwb,
                                              const float* __restrict__ lng, const float* __restrict__ lnb, bf16* __restrict__ yn) {
    bf16* glu = (bf16*)shm;
    float* dws = (float*)(shm + CONV_GLU);
    const int tid = threadIdx.x, lane = tid & 63, wid = tid >> 6;
    if (bid < T / 32) { for (int i = tid; i < 31 * 128; i += 512) ((float4*)dws)[i] = ((const float4*)dw)[i]; }
    const float4 g0 = *(const float4*)(lng + lane * 8), g1 = *(const float4*)(lng + lane * 8 + 4), e0 = *(const float4*)(lnb + lane * 8), e1 = *(const float4*)(lnb + lane * 8 + 4);
    const float4 b0 = *(const float4*)(dwb + lane * 8), b1 = *(const float4*)(dwb + lane * 8 + 4);
    const float gg[8] = {g0.x, g0.y, g0.z, g0.w, g1.x, g1.y, g1.z, g1.w}, ee[8] = {e0.x, e0.y, e0.z, e0.w, e1.x, e1.y, e1.z, e1.w};
    for (int tile = bid; tile < T / 32; tile += nblk) {
        const int t0 = tile * 32, sq0 = t0 & ~(SEQ - 1);
        __syncthreads();
#pragma unroll
        for (int hb = 0; hb < 2; ++hb) {
            uint4 av[4], bv[4];
#pragma unroll
            for (int k = 0; k < 4; ++k) { const int it = tid + 512 * (hb * 4 + k), rr = it >> 6, cg = it & 63, t = t0 - 30 + rr;
                av[k] = make_uint4(0, 0, 0, 0); bv[k] = make_uint4(0, 0, 0, 0);
                if (rr < 62 && t >= sq0) { av[k] = *(const uint4*)(proj + (size_t)t * DINP + C_A + cg * 8); bv[k] = *(const uint4*)(proj + (size_t)t * DINP + C_B + cg * 8); } }
#pragma unroll
            for (int k = 0; k < 4; ++k) { const int it = tid + 512 * (hb * 4 + k), rr = it >> 6, cg = it & 63;
                if (rr < 62) { float a[8], b[8]; unpack8(av[k], a); unpack8(bv[k], b);
#pragma unroll
                    for (int i = 0; i < 8; ++i) a[i] *= sigmoidf_(b[i]);
                    *(uint4*)(glu + rr * 512 + cg * 8) = pack8(a); } }
        }
        __syncthreads();
        float acc[4][8];
#pragma unroll
        for (int i = 0; i < 4; ++i) { acc[i][0] = b0.x; acc[i][1] = b0.y; acc[i][2] = b0.z; acc[i][3] = b0.w; acc[i][4] = b1.x; acc[i][5] = b1.y; acc[i][6] = b1.z; acc[i][7] = b1.w; }
#pragma unroll 4
        for (int j = 0; j < 31; ++j) {
            const float4 w0 = *(const float4*)(dws + j * 512 + lane * 8), w1 = *(const float4*)(dws + j * 512 + lane * 8 + 4);
            const float w[8] = {w0.x, w0.y, w0.z, w0.w, w1.x, w1.y, w1.z, w1.w};
#pragma unroll
            for (int i = 0; i < 4; ++i) { float gv[8]; unpack8(*(const uint4*)(glu + (wid * 4 + i + j) * 512 + lane * 8), gv);
#pragma unroll
                for (int c = 0; c < 8; ++c) acc[i][c] = fmac1(gv[c], w[c], acc[i][c]); }
        }
#pragma unroll
        for (int i = 0; i < 4; ++i) {
            float s = 0.f;
#pragma unroll
            for (int c = 0; c < 8; ++c) s += acc[i][c];
            const float mean = wave_sum(s) * (1.f / 512.f);
            float q = 0.f;
#pragma unroll
            for (int c = 0; c < 8; ++c) { acc[i][c] -= mean; q += acc[i][c] * acc[i][c]; }
            const float rstd = rsqrtf(wave_sum(q) * (1.f / 512.f) + 1e-5f);
            float o[8];
#pragma unroll
            for (int c = 0; c < 8; ++c) { const float z = acc[i][c] * rstd * gg[c] + ee[c]; o[c] = z * sigmoidf_(z); }
            *(uint4*)(yn + (size_t)(t0 + wid * 4 + i) * 512 + lane * 8) = pack8(o);
        }
    }
}


constexpr int CS = 72;
constexpr int SLOT = 64 * CS * 2;
constexpr int CP_SMALL = 15 * SLOT;
struct ChunkParams { const bf16* proj; const float *mu, *w0, *w2, *a0, *a2, *g2, *k_k, *k_a, *r_k; bf16 *V, *G, *PHI, *PSI, *OMG, *Y0; float* BONUS; };

__device__ __forceinline__ f32x4 tile_mm(const bf16* A, const bf16* Bt, int m0, int n0, int fr, int fq, f32x4 acc) {
#pragma unroll
    for (int ks = 0; ks < 2; ++ks) {
        const pg8::bf16x8 a = *(const pg8::bf16x8*)(A + (m0 + fr) * CS + ks * 32 + fq * 8);
        const pg8::bf16x8 b = *(const pg8::bf16x8*)(Bt + (n0 + fr) * CS + ks * 32 + fq * 8);
        acc = __builtin_amdgcn_mfma_f32_16x16x32_bf16(a, b, acc, 0, 0, 0);
    }
    return acc;
}
struct Frag2 { pg8::bf16x8 k0, k1; };
__device__ __forceinline__ Frag2 ld_frag(const bf16* M, int row0, int fr, int fq) {
    Frag2 f; f.k0 = *(const pg8::bf16x8*)(M + (row0 + fr) * CS + fq * 8); f.k1 = *(const pg8::bf16x8*)(M + (row0 + fr) * CS + 32 + fq * 8); return f; }
__device__ __forceinline__ f32x4 mmf(const Frag2& a, const Frag2& b, f32x4 acc) {
    acc = __builtin_amdgcn_mfma_f32_16x16x32_bf16(a.k0, b.k0, acc, 0, 0, 0); acc = __builtin_amdgcn_mfma_f32_16x16x32_bf16(a.k1, b.k1, acc, 0, 0, 0); return acc; }
__device__ __forceinline__ f32x4 tile_mm_sw(const bf16* A, const bf16* Bt, int m0, int n0, int fr, int fq, f32x4 acc) {
#pragma unroll
    for (int ks = 0; ks < 2; ++ks) {
        const pg8::bf16x8 a = *(const pg8::bf16x8*)(A + (m0 + fr) * CS + ks * 32 + fq * 8);
        const pg8::bf16x8 b = *(const pg8::bf16x8*)(Bt + (n0 + fr) * CS + ks * 32 + fq * 8);
        acc = __builtin_amdgcn_mfma_f32_16x16x32_bf16(b, a, acc, 0, 0, 0);
    }
    return acc;
}
__device__ __forceinline__ void tile_mm2(const bf16* A, const bf16* Bt, int m0, int n0, int fr, int fq, f32x4& accN, f32x4& accS) {
#pragma unroll
    for (int ks = 0; ks < 2; ++ks) {
        const pg8::bf16x8 a = *(const pg8::bf16x8*)(A + (m0 + fr) * CS + ks * 32 + fq * 8);
        const pg8::bf16x8 b = *(const pg8::bf16x8*)(Bt + (n0 + fr) * CS + ks * 32 + fq * 8);
        accN = __builtin_amdgcn_mfma_f32_16x16x32_bf16(a, b, accN, 0, 0, 0);
        accS = __builtin_amdgcn_mfma_f32_16x16x32_bf16(b, a, accS, 0, 0, 0);
    }
}
__device__ __forceinline__ void st_rm4(bf16* buf, int m0, int n0, int fr, int fq, f32x4 v) {
    uint2 o; o.x = pack2(v[0], v[1]); o.y = pack2(v[2], v[3]); *(uint2*)(buf + (m0 + fr) * CS + n0 + 4 * fq) = o;
}
__device__ __forceinline__ f32x4 ld_rm4(const bf16* buf, int m0, int n0, int fr, int fq) {
    const uint2 o = *(const uint2*)(buf + (m0 + fr) * CS + n0 + 4 * fq);
    f32x4 v; v[0] = bflo(o.x); v[1] = bfhi(o.x); v[2] = bflo(o.y); v[3] = bfhi(o.y); return v;
}
__device__ __forceinline__ void st_rm(bf16* buf, int m0, int n0, int fr, int fq, f32x4 v) {
#pragma unroll
    for (int r = 0; r < 4; ++r) buf[(m0 + 4 * fq + r) * CS + n0 + fr] = f2bf(v[r]);
}
__device__ __forceinline__ void st_tr(bf16* buf, int m0, int n0, int fr, int fq, f32x4 v) {
    uint2 o; o.x = pack2(v[0], v[1]); o.y = pack2(v[2], v[3]); *(uint2*)(buf + (n0 + fr) * CS + m0 + 4 * fq) = o;
}
__device__ __forceinline__ f32x4 ld_rm(const bf16* buf, int m0, int n0, int fr, int fq) {
    f32x4 v;
#pragma unroll
    for (int r = 0; r < 4; ++r) v[r] = bf2f(buf[(m0 + 4 * fq + r) * CS + n0 + fr]);
    return v;
}
__device__ __forceinline__ f32x4 ld_tr(const bf16* buf, int m0, int n0, int fr, int fq) {
    const uint2 o = *(const uint2*)(buf + (n0 + fr) * CS + m0 + 4 * fq);
    f32x4 v; v[0] = bflo(o.x); v[1] = bfhi(o.x); v[2] = bflo(o.y); v[3] = bfhi(o.y); return v;
}

__device__ __forceinline__ int opq(int v) { asm volatile("" : "+v"(v)); return v; }
template <int CTRL> __device__ __forceinline__ float dppf(float v) { return __int_as_float(__builtin_amdgcn_update_dpp(0, __float_as_int(v), CTRL, 0xF, 0xF, true)); }
__device__ __forceinline__ void wave_sum16(float (&r)[16]) {
    const int l = (int)(threadIdx.x & 63);
    const bool o1 = (l & 1) != 0, o2 = (l & 2) != 0;
    float a[8], b[4];
#pragma unroll
    for (int j = 0; j < 8; ++j) { const float kp = o1 ? r[8 + j] : r[j], sn = o1 ? r[j] : r[8 + j]; a[j] = kp + dppf<0xB1>(sn); }
#pragma unroll
    for (int j = 0; j < 4; ++j) { const float kp = o2 ? a[4 + j] : a[j], sn = o2 ? a[j] : a[4 + j]; b[j] = kp + dppf<0x4E>(sn); }
#pragma unroll
    for (int j = 0; j < 4; ++j) { b[j] += dppf<0x124>(b[j]); b[j] += dppf<0x128>(b[j]); b[j] += __shfl_xor(b[j], 16, 64); b[j] += __shfl_xor(b[j], 32, 64); }
#pragma unroll
    for (int j = 0; j < 4; ++j) { r[j] = dppf<0x00>(b[j]); r[8 + j] = dppf<0x55>(b[j]); r[4 + j] = dppf<0xAA>(b[j]); r[12 + j] = dppf<0xFF>(b[j]); }
}
__device__ __forceinline__ float wave_sum_dpp(float v) {
    v += dppf<0xB1>(v); v += dppf<0x4E>(v); v += dppf<0x141>(v); v += dppf<0x140>(v);
    const float r0 = __int_as_float(__builtin_amdgcn_readlane(__float_as_int(v), 0)), r1 = __int_as_float(__builtin_amdgcn_readlane(__float_as_int(v), 16));
    const float r2 = __int_as_float(__builtin_amdgcn_readlane(__float_as_int(v), 32)), r3 = __int_as_float(__builtin_amdgcn_readlane(__float_as_int(v), 48));
    return (r0 + r1) + (r2 + r3);
}
struct CpPrefetch { uint4 cu[3], pv[3], rw[4]; };
__device__ __forceinline__ void cp_prefetch(CpPrefetch& P, const bf16* __restrict__ proj, int item, int tid) {
    const int h = item & 7, chunk = item >> 3, t0 = chunk * 64, sq0 = t0 & ~(SEQ - 1);
#pragma unroll
    for (int k = 0; k < 3; ++k) { const int idx = tid + 512 * k; P.cu[k] = make_uint4(0, 0, 0, 0); P.pv[k] = make_uint4(0, 0, 0, 0);
        if (idx < 1280) { const int tt = idx / 20, cg = idx % 20, t = t0 + tt;
            P.cu[k] = *(const uint4*)(proj + (size_t)t * DINP + C_LW + cg * 8);
            if (t > sq0) P.pv[k] = *(const uint4*)(proj + (size_t)(t - 1) * DINP + C_LW + cg * 8); } }
#pragma unroll
    for (int k = 0; k < 4; ++k) { const int idx = tid + 512 * k; P.rw[k] = make_uint4(0, 0, 0, 0);
        if (idx < 1560) { const int row = idx / 24, rem = idx % 24, t = t0 - 1 + row;
            if (t >= sq0) P.rw[k] = *(const uint4*)(proj + (size_t)t * DINP + C_R + (rem >> 3) * 512 + h * 64 + (rem & 7) * 8); } }
}
template <bool TOP> __device__ __forceinline__ void g1_panel(const bf16* BK, const bf16* AR, bf16* P0r, bf16* P0t, bf16* T1, bf16* MBT, bf16* LK, bf16* MKT, int mt, int fr, int fq, int nt_lo, int nt_hi) {
    const int q4 = mt & 3, m0 = q4 * 16;
    const Frag2 fa = ld_frag(BK, mt * 16, fr, fq);
    const int dN = 4 * fq - fr;
    const f32x4 zero4 = {0.f, 0.f, 0.f, 0.f};
#pragma unroll
    for (int nt = 0; nt < 8; ++nt) {
        if (nt < nt_lo || nt >= nt_hi) continue;
        const int n4 = nt & 3, n0 = n4 * 16;
        const bool left = (nt < 4);
        if (q4 > n4) {
            if (TOP && left) { st_tr(P0t, m0, n0, fr, fq, zero4); st_rm4(P0r, m0, n0, fr, fq, zero4); st_rm4(T1, m0, n0, fr, fq, zero4); }
            else if (TOP) st_tr(MBT, m0, n0, fr, fq, zero4);
            else if (left) st_rm4(LK, m0, n0, fr, fq, zero4);
            else st_tr(MKT, m0, n0, fr, fq, zero4);
        } else if (q4 < n4) {
            const Frag2 fb = ld_frag(AR, nt * 16, fr, fq);
            if (TOP && left) { f32x4 aN = mmf(fa, fb, zero4), aS = mmf(fb, fa, zero4); st_tr(P0t, m0, n0, fr, fq, aN); st_rm4(P0r, m0, n0, fr, fq, aS); st_rm4(T1, m0, n0, fr, fq, aS); }
            else if (TOP) { f32x4 aN = mmf(fa, fb, zero4); st_tr(MBT, m0, n0, fr, fq, aN); }
            else if (left) { f32x4 aS = mmf(fb, fa, zero4); st_rm4(LK, m0, n0, fr, fq, aS); }
            else { f32x4 aN = mmf(fa, fb, zero4); st_tr(MKT, m0, n0, fr, fq, aN); }
        } else {
            const Frag2 fb = ld_frag(AR, nt * 16, fr, fq);
            if (TOP && left) { f32x4 aN = mmf(fa, fb, zero4), aS = mmf(fb, fa, zero4), t1;
#pragma unroll
                for (int r = 0; r < 4; ++r) { const int d = dN + r; if (!(d < 0)) aN[r] = 0.f; if (!(d > 0)) aS[r] = 0.f; t1[r] = aS[r] + ((d == 0) ? 1.f : 0.f); }
                st_tr(P0t, m0, n0, fr, fq, aN); st_rm4(P0r, m0, n0, fr, fq, aS); st_rm4(T1, m0, n0, fr, fq, t1); }
            else if (TOP) { f32x4 aN = mmf(fa, fb, zero4);
#pragma unroll
                for (int r = 0; r < 4; ++r) if (!(dN + r <= 0)) aN[r] = 0.f;
                st_tr(MBT, m0, n0, fr, fq, aN); }
            else if (left) { f32x4 aS = mmf(fb, fa, zero4);
#pragma unroll
                for (int r = 0; r < 4; ++r) if (!(dN + r > 0)) aS[r] = 0.f;
                st_rm4(LK, m0, n0, fr, fq, aS); }
            else { f32x4 aN = mmf(fa, fb, zero4);
#pragma unroll
                for (int r = 0; r < 4; ++r) if (!(dN + r <= 0)) aN[r] = 0.f;
                st_tr(MKT, m0, n0, fr, fq, aN); }
        }
    }
}
__device__ __forceinline__ void ph_chunkprep(unsigned char* shm, int bid, int nblk, const ChunkParams& p) {
    const int tid = threadIdx.x, lane = tid & 63, wv = tid >> 6, fr = lane & 15, fq = lane >> 4;
    bf16* LWb = (bf16*)shm;
    bf16* LAb = LWb + 64 * 40; bf16* LGb = LAb + 64 * 40;
    float* WLf = (float*)(shm + 24576);
    bf16* RAW = (bf16*)(shm + 8 * SLOT);
    float* segs = (float*)(shm + CP_SMALL);
    float* gC = segs + 512;
#define SL(i) ((bf16*)(shm + (i) * SLOT))
    bf16 *BK = SL(0), *AR = SL(2), *AbT = SL(4), *BhT = SL(5), *KH = SL(6), *Vt = SL(7), *LK = SL(8), *MBT = SL(9), *MKT = SL(10);
    if (bid >= 2048) return;
    int hcur = -1;
    pg8::bf16x8 bw, ba, bg[3];
    float w0n = 0.f, a0n = 0.f, kkc = 0.f, kac = 0.f, rkc = 0.f, mur = 0.f, muk = 0.f, muv = 0.f;
    CpPrefetch P;
    { int it0 = bid; asm volatile("" : "+s"(it0)); cp_prefetch(P, p.proj, it0, tid); }
    for (int item = bid; item < 2048; item += nblk) {
        int itm = item; asm volatile("" : "+s"(itm));
        const int h = itm & 7, chunk = itm >> 3, t0 = chunk * 64;
        if (h != hcur) {
            const int nt = wv & 3, hc = h * 64 + lane;
            hcur = h;
            const int cn = h * 64 + nt * 16 + fr;
            float t8[8];
#pragma unroll
            for (int j = 0; j < 8; ++j) t8[j] = p.w2[(8 * fq + j) * 512 + cn];
            { const uint4 q = pack8(t8); bw = __builtin_bit_cast(pg8::bf16x8, q); }
#pragma unroll
            for (int j = 0; j < 8; ++j) t8[j] = p.a2[(8 * fq + j) * 512 + cn];
            { const uint4 q = pack8(t8); ba = __builtin_bit_cast(pg8::bf16x8, q); }
#pragma unroll
            for (int ks = 0; ks < 3; ++ks) {
#pragma unroll
                for (int j = 0; j < 8; ++j) t8[j] = p.g2[(32 * ks + 8 * fq + j) * 512 + cn];
                const uint4 q = pack8(t8); bg[ks] = __builtin_bit_cast(pg8::bf16x8, q); }
            w0n = p.w0[cn]; a0n = p.a0[cn];
            kkc = p.k_k[hc]; kac = p.k_a[hc]; rkc = p.r_k[hc]; mur = p.mu[hc]; muk = p.mu[512 + hc]; muv = p.mu[1024 + hc];
        }
        __syncthreads();
        {
        const int tid = opq((int)threadIdx.x), lane = tid & 63, wv = tid >> 6, fr = lane & 15, fq = lane >> 4; (void)fr; (void)fq; (void)wv; (void)lane;
#pragma unroll
        for (int k = 0; k < 3; ++k) { const int idx = tid + 512 * k;
            if (idx < 1280) { const int tt = idx / 20, cg = idx % 20;
                float c8[8], p8[8], u[8]; unpack8(P.cu[k], c8); unpack8(P.pv[k], p8);
                const float4 m0 = *(const float4*)(p.mu + 1536 + cg * 8), m1 = *(const float4*)(p.mu + 1536 + cg * 8 + 4);
                const float mm[8] = {m0.x, m0.y, m0.z, m0.w, m1.x, m1.y, m1.z, m1.w};
#pragma unroll
                for (int i = 0; i < 8; ++i) u[i] = c8[i] + (p8[i] - c8[i]) * mm[i];
                const bool isw = cg < 4, isa = (cg >= 4) && (cg < 8);
                const float es = isw ? 2.f : -1.f, ca = isw ? 1.f : 0.f, cb = isw ? -2.f : 1.f;
#pragma unroll
                for (int i = 0; i < 8; ++i) { const float r = __builtin_amdgcn_rcpf(1.f + __expf(es * u[i])); const float act = fmaf(cb, r, ca); u[i] = isa ? u[i] : act; }
                bf16* dst = isw ? (LWb + tt * 40 + cg * 8) : (isa ? (LAb + tt * 40 + (cg - 4) * 8) : (LGb + tt * 104 + (cg - 8) * 8));
                *(uint4*)dst = pack8(u); } }
#pragma unroll
        for (int k = 0; k < 4; ++k) { const int idx = tid + 512 * k; if (idx < 1560) *(uint4*)(RAW + (idx / 24) * 192 + (idx % 24) * 8) = P.rw[k]; }
        }
        __syncthreads();
        {
        const int tid = opq((int)threadIdx.x), lane = tid & 63, wv = tid >> 6, fr = lane & 15, fq = lane >> 4; (void)fr; (void)fq; (void)wv; (void)lane;
        const int nt = wv & 3;
#pragma unroll
        for (int q = 0; q < 2; ++q) {
            const int mt = (wv >> 2) * 2 + q;
            f32x4 cw = {w0n, w0n, w0n, w0n}, ca = {a0n, a0n, a0n, a0n}, cg = {0.f, 0.f, 0.f, 0.f};
            cw = __builtin_amdgcn_mfma_f32_16x16x32_bf16(*(const pg8::bf16x8*)(LWb + (mt * 16 + fr) * 40 + fq * 8), bw, cw, 0, 0, 0);
            ca = __builtin_amdgcn_mfma_f32_16x16x32_bf16(*(const pg8::bf16x8*)(LAb + (mt * 16 + fr) * 40 + fq * 8), ba, ca, 0, 0, 0);
#pragma unroll
            for (int ks = 0; ks < 3; ++ks) cg = __builtin_amdgcn_mfma_f32_16x16x32_bf16(*(const pg8::bf16x8*)(LGb + (mt * 16 + fr) * 104 + ks * 32 + fq * 8), bg[ks], cg, 0, 0, 0);
#pragma unroll
            for (int r = 0; r < 4; ++r) { const int o = (mt * 16 + 4 * fq + r) * 64 + nt * 16 + fr; WLf[o] = cw[r]; WLf[4096 + o] = ca[r]; WLf[8192 + o] = cg[r]; }
        }
        }
        __syncthreads();
        float rr[8], km[8], vv[8], kn[8], be[8], ld[8];
        const int tid1 = opq((int)threadIdx.x), c = tid1 & 63, tg = tid1 >> 6, hc = h * 64 + c;
        {
            const int tb = t0 + tg * 8;
            float red[16], aa[8], kkr[8], gl[8];
#pragma unroll
            for (int i = 0; i < 8; ++i) {
                const float wl = WLf[(tg * 8 + i) * 64 + c], al = WLf[4096 + (tg * 8 + i) * 64 + c]; gl[i] = WLf[8192 + (tg * 8 + i) * 64 + c];
                const bf16* q1 = RAW + (tg * 8 + i + 1) * 192 + c; const bf16* q0 = q1 - 192;
                const float cr1 = bf2f(q1[0]), cr0 = bf2f(q0[0]), ck1 = bf2f(q1[64]), ck0 = bf2f(q0[64]), cv1 = bf2f(q1[128]), cv0 = bf2f(q0[128]);
                rr[i] = cr1 + (cr0 - cr1) * mur; const float kraw = ck1 + (ck0 - ck1) * muk; vv[i] = cv1 + (cv0 - cv1) * muv;
                const float xw = -wl;
                const float sp = fmaxf(xw, 0.f) + __logf(1.f + __expf(-fabsf(xw)));
                ld[i] = -__expf(-sp - 0.5f);
                aa[i] = sigmoidf_(al);
                kkr[i] = kraw * kkc; km[i] = kraw * (1.f + (aa[i] - 1.f) * kac);
                red[i] = kkr[i] * kkr[i]; red[8 + i] = rr[i] * km[i] * rkc;
            }
            { int nxt = item + nblk; asm volatile("" : "+s"(nxt)); if (nxt < 2048) cp_prefetch(P, p.proj, nxt, tid); }
            wave_sum16(red);
#pragma unroll
            for (int i = 0; i < 8; ++i) {
                kn[i] = kkr[i] * __builtin_amdgcn_rsqf(fmaxf(red[i], 1e-24f)); be[i] = kn[i] * aa[i];
                const size_t o = (size_t)(tb + i) * 512 + hc;
                p.V[o] = f2bf(vv[i]); p.G[o] = f2bf(gl[i]);
                if (c == 0) p.BONUS[(size_t)(tb + i) * 8 + h] = red[8 + i];
            }
        }
        float cl[8];
        { float s = 0.f;
#pragma unroll
          for (int i = 0; i < 8; ++i) { s += ld[i]; cl[i] = s; }
          segs[tg * 64 + c] = s; }
        __syncthreads();
        float off = 0.f, clC = 0.f;
#pragma unroll
        for (int g = 0; g < 8; ++g) { const float sg = segs[g * 64 + c]; clC += sg; if (g < tg) off += sg; }
        if (tg == 0) gC[c] = __expf(clC);
        {
            float ab8[8], bh8[8], v8[8], kh8[8];
#pragma unroll
            for (int i = 0; i < 8; ++i) {
                const float x = off + cl[i]; const int tt = tg * 8 + i;
                const float em = __expf(-x), ep = __expf(x), epm = __expf(x - ld[i]), eh = __expf(clC - x);
                const float ab = -kn[i] * epm;
                ab8[i] = ab; bh8[i] = be[i] * eh; v8[i] = vv[i];
                BK[tt * CS + c] = f2bf(be[i] * em); BK[(64 + tt) * CS + c] = f2bf(km[i] * em);
                AR[tt * CS + c] = f2bf(ab); AR[(64 + tt) * CS + c] = f2bf(rr[i] * ep);
                kh8[i] = km[i] * eh;
            }
            *(uint4*)(AbT + c * CS + tg * 8) = pack8(ab8); *(uint4*)(BhT + c * CS + tg * 8) = pack8(bh8); *(uint4*)(Vt + c * CS + tg * 8) = pack8(v8); *(uint4*)(KH + c * CS + tg * 8) = pack8(kh8);
        }
        __syncthreads();
        {
            const int tid = opq((int)threadIdx.x), lane = tid & 63, wv = tid >> 6, fr = lane & 15, fq = lane >> 4; (void)fr; (void)fq; (void)wv; (void)lane;
            const int mt = __builtin_amdgcn_readfirstlane(wv), q4 = mt & 3;
            const int hi0 = (q4 == 0) ? 5 : (q4 == 1) ? 7 : 8;
            const int mt2 = (q4 == 3) ? mt - 3 : mt - 1, lo2 = (q4 == 3) ? 5 : 7;
            if (mt < 4) { g1_panel<true>(BK, AR, SL(11), SL(12), SL(13), MBT, LK, MKT, mt, fr, fq, 0, hi0); if (q4 >= 2) g1_panel<true>(BK, AR, SL(11), SL(12), SL(13), MBT, LK, MKT, mt2, fr, fq, lo2, 8); }
            else { g1_panel<false>(BK, AR, SL(11), SL(12), SL(13), MBT, LK, MKT, mt, fr, fq, 0, hi0); if (q4 >= 2) g1_panel<false>(BK, AR, SL(11), SL(12), SL(13), MBT, LK, MKT, mt2, fr, fq, lo2, 8); }
        }
        __syncthreads();
#pragma unroll
        for (int s = 0; s < 6; ++s) {
            const int tid = opq((int)threadIdx.x), lane = tid & 63, wv = tid >> 6, fr = lane & 15, fq = lane >> 4; (void)fr; (void)fq; (void)wv; (void)lane;
            const bf16* Pr = (s & 1) ? SL(0) : SL(11); const bf16* Pt = (s & 1) ? SL(1) : SL(12);
            bf16* Pnr = (s & 1) ? SL(11) : SL(0); bf16* Pnt = (s & 1) ? SL(12) : SL(1);
            const bf16* Tc = (s & 1) ? SL(13) : SL(14); bf16* Tn = (s & 1) ? SL(14) : SL(13);
            const int m0 = (wv >> 1) * 16, nb = (wv & 1) * 32;
            Frag2 fp, ft;
            if (s < 5) fp = ld_frag(Pr, m0, fr, fq);
            if (s > 0) ft = ld_frag(Tc, m0, fr, fq);
#pragma unroll
            for (int q = 0; q < 2; ++q) {
                const int n0 = nb + q * 16;
                const Frag2 fb = ld_frag(Pt, n0, fr, fq);
                if (s < 5) { f32x4 aN = {0.f, 0.f, 0.f, 0.f}, aS = {0.f, 0.f, 0.f, 0.f}; aN = mmf(fp, fb, aN); aS = mmf(fb, fp, aS); st_rm4(Pnr, m0, n0, fr, fq, aS); st_tr(Pnt, m0, n0, fr, fq, aN); }
                if (s > 0 && s < 5) { f32x4 acc = ld_rm4(Tc, m0, n0, fr, fq); acc = mmf(fb, ft, acc); st_rm4(Tn, m0, n0, fr, fq, acc); }
                if (s == 5) { f32x4 acc = ld_rm(Tc, m0, n0, fr, fq); acc = mmf(ft, fb, acc); st_tr(SL(2), m0, n0, fr, fq, acc); }
            }
            __syncthreads();
        }
        {
            const int tid = opq((int)threadIdx.x), lane = tid & 63, wv = tid >> 6, fr = lane & 15, fq = lane >> 4; (void)fr; (void)fq; (void)wv; (void)lane;
            const bf16* TT = SL(2); bf16 *X = SL(11), *W = SL(12);
            const int m0 = (wv >> 1) * 16, nb = (wv & 1) * 32;
            const Frag2 fl = ld_frag(LK, m0, fr, fq), fa = ld_frag(AbT, m0, fr, fq);
#pragma unroll
            for (int q = 0; q < 2; ++q) {
                const int n0 = nb + q * 16;
                const Frag2 fb = ld_frag(TT, n0, fr, fq);
                f32x4 a0 = {0.f, 0.f, 0.f, 0.f}, a1 = {0.f, 0.f, 0.f, 0.f};
                a0 = mmf(fb, fl, a0); a1 = mmf(fb, fa, a1);
                st_rm4(X, m0, n0, fr, fq, a0); st_rm4(W, m0, n0, fr, fq, a1);
            }
        }
        __syncthreads();
        {
            const int tid = opq((int)threadIdx.x), lane = tid & 63, wv = tid >> 6, fr = lane & 15, fq = lane >> 4; (void)fr; (void)fq; (void)wv; (void)lane;
            const bf16 *X = SL(11), *W = SL(12), *RB = SL(3); bf16 *ZT = SL(13), *Q2T = SL(14);
            bf16* PHI = p.PHI + (size_t)item * 4096; bf16* OMG = p.OMG + (size_t)item * 4096;
            const int mt = wv >> 1, m0 = mt * 16, nb = (wv & 1) * 32;
            const Frag2 fx = ld_frag(X, m0, fr, fq), fw = ld_frag(W, m0, fr, fq);
#pragma unroll
            for (int q = 0; q < 2; ++q) {
                const int n0 = nb + q * 16;
                const Frag2 fbh = ld_frag(BhT, n0, fr, fq), fmb = ld_frag(MBT, n0, fr, fq);
                f32x4 z = ld_tr(KH, m0, n0, fr, fq); z = mmf(fx, fbh, z); st_tr(ZT, m0, n0, fr, fq, z);
                f32x4 q2 = ld_tr(MKT, m0, n0, fr, fq); q2 = mmf(fx, fmb, q2); st_tr(Q2T, m0, n0, fr, fq, q2);
                f32x4 ph = {0.f, 0.f, 0.f, 0.f}; ph = mmf(fw, fbh, ph);
#pragma unroll
                for (int r = 0; r < 4; ++r) if (m0 + 4 * fq + r == n0 + fr) ph[r] += gC[n0 + fr];
                const int slot = (mt >> 1) * 32 + fq * 8 + (mt & 1) * 4;
                { uint2 o; o.x = pack2(ph[0], ph[1]); o.y = pack2(ph[2], ph[3]); *(uint2*)(PHI + (n0 + fr) * 64 + slot) = o; }
                f32x4 om = ld_tr(RB, m0, n0, fr, fq); om = mmf(fw, fmb, om);
                { uint2 o; o.x = pack2(om[0], om[1]); o.y = pack2(om[2], om[3]); *(uint2*)(OMG + (n0 + fr) * 64 + slot) = o; }
            }
        }
        __syncthreads();
        {
            const int tid = opq((int)threadIdx.x), lane = tid & 63, wv = tid >> 6, fr = lane & 15, fq = lane >> 4; (void)fr; (void)fq; (void)wv; (void)lane;
            const bf16 *ZT = SL(13), *Q2T = SL(14);
            bf16* PSI = p.PSI + (size_t)item * 4096; bf16* Y0 = p.Y0 + (size_t)item * 4096;
            const int m0 = (wv >> 1) * 16, nb = (wv & 1) * 32;
            const Frag2 fz = ld_frag(ZT, m0, fr, fq), fq2 = ld_frag(Q2T, m0, fr, fq);
#pragma unroll
            for (int q = 0; q < 2; ++q) {
                const int n0 = nb + q * 16;
                const Frag2 fv = ld_frag(Vt, n0, fr, fq);
                f32x4 a0 = {0.f, 0.f, 0.f, 0.f}, a1 = {0.f, 0.f, 0.f, 0.f};
                a0 = mmf(fz, fv, a0); a1 = mmf(fq2, fv, a1);
                { uint2 o; o.x = pack2(a0[0], a0[1]); o.y = pack2(a0[2], a0[3]); *(uint2*)(PSI + (n0 + fr) * 64 + m0 + 4 * fq) = o; }
                { uint2 o; o.x = pack2(a1[0], a1[1]); o.y = pack2(a1[2], a1[3]); *(uint2*)(Y0 + (n0 + fr) * 64 + m0 + 4 * fq) = o; }
            }
        }
    }
#undef SL
}

constexpr int CH_SLOT = 32768, CH_RING = 4, CH_YB = CH_RING * CH_SLOT, CH_YBSZ = 64 * 72 * 2;
__device__ __forceinline__ void chain_dma(unsigned char* shm, int slot, const bf16* __restrict__ PHI, const bf16* __restrict__ PSI, const bf16* __restrict__ OMG, const bf16* __restrict__ Y0, size_t item, int w, int lane) {
    const bf16* src[4] = {PHI + item, OMG + item, PSI + item, Y0 + item};
#pragma unroll
    for (int m = 0; m < 4; ++m)
#pragma unroll
        for (int i = 0; i < 2; ++i) {
            const int row = (w * 2 + i) * 8 + (lane >> 3), jj = (lane & 7) ^ (row & 7);
            __builtin_amdgcn_global_load_lds((const unsigned*)((const char*)src[m] + row * 128 + jj * 16),
                                             (PG8_LAS unsigned*)(shm + slot * CH_SLOT + m * 8192 + (w * 2 + i) * 1024), 16, 0, 0);
        }
}
__device__ __forceinline__ void ph_chain(unsigned char* shm, int bh, const bf16* __restrict__ PHI, const bf16* __restrict__ PSI, const bf16* __restrict__ OMG, const bf16* __restrict__ Y0,
                                         const bf16* __restrict__ V, const bf16* __restrict__ G, const float* __restrict__ BONUS, const float* __restrict__ gng, const float* __restrict__ gnb, bf16* __restrict__ O) {
    const int b = bh >> 3, h = bh & 7, tid = threadIdx.x, lane = tid & 63, w = __builtin_amdgcn_readfirstlane((tid >> 6) & 3), fr = lane & 15, fq = lane >> 4;
    const size_t ib = ((size_t)(b * 64) * 8 + h) * 4096, istep = (size_t)8 * 4096;
#define CH_BAR() do { asm volatile("s_waitcnt lgkmcnt(0)" ::: "memory"); __builtin_amdgcn_s_barrier(); asm volatile("" ::: "memory"); } while (0)
    if (tid < 256) {
        pg8::bf16x8 sf[2];
#pragma unroll
        for (int j = 0; j < 8; ++j) { sf[0][j] = 0; sf[1][j] = 0; }
        chain_dma(shm, 0, PHI, PSI, OMG, Y0, ib, w, lane);
        chain_dma(shm, 1, PHI, PSI, OMG, Y0, ib + istep, w, lane);
        chain_dma(shm, 2, PHI, PSI, OMG, Y0, ib + 2 * istep, w, lane);
#pragma unroll 1
        for (int ch = 0; ch < 64; ++ch) {
            asm volatile("s_waitcnt vmcnt(16)" ::: "memory");
            CH_BAR();
            chain_dma(shm, (ch + 3) & 3, PHI, PSI, OMG, Y0, ib + (size_t)((ch + 3 < 64) ? ch + 3 : 63) * istep, w, lane);
            const unsigned char* sl = shm + (ch & 3) * CH_SLOT;
            f32x4 ya[4], sa[4]; pg8::bf16x8 ap[4][2], ao[4][2];
#pragma unroll
            for (int mt = 0; mt < 4; ++mt) {
                const int row = w * 16 + fr, sw = (((mt * 2 + (fq >> 1)) ^ (row & 7)) * 16) + (fq & 1) * 8;
                const uint2 ps = *(const uint2*)(sl + 16384 + row * 128 + sw), y0 = *(const uint2*)(sl + 24576 + row * 128 + sw);
                ya[mt][0] = bflo(y0.x); ya[mt][1] = bfhi(y0.x); ya[mt][2] = bflo(y0.y); ya[mt][3] = bfhi(y0.y);
                sa[mt][0] = bflo(ps.x); sa[mt][1] = bfhi(ps.x); sa[mt][2] = bflo(ps.y); sa[mt][3] = bfhi(ps.y);
#pragma unroll
                for (int ks = 0; ks < 2; ++ks) { const int ar = mt * 16 + fr, off = ar * 128 + (((ks * 4 + fq) ^ (ar & 7)) * 16);
                    ap[mt][ks] = *(const pg8::bf16x8*)(sl + off); ao[mt][ks] = *(const pg8::bf16x8*)(sl + 8192 + off); }
            }
#pragma unroll
            for (int ks = 0; ks < 2; ++ks)
#pragma unroll
                for (int mt = 0; mt < 4; ++mt) sa[mt] = __builtin_amdgcn_mfma_f32_16x16x32_bf16(ap[mt][ks], sf[ks], sa[mt], 0, 0, 0);
#pragma unroll
            for (int ks = 0; ks < 2; ++ks)
#pragma unroll
                for (int mt = 0; mt < 4; ++mt) ya[mt] = __builtin_amdgcn_mfma_f32_16x16x32_bf16(ao[mt][ks], sf[ks], ya[mt], 0, 0, 0);
#pragma unroll
            for (int ks = 0; ks < 2; ++ks) {
                const unsigned w0 = pack2(sa[2 * ks][0], sa[2 * ks][1]), w1 = pack2(sa[2 * ks][2], sa[2 * ks][3]), w2 = pack2(sa[2 * ks + 1][0], sa[2 * ks + 1][1]), w3 = pack2(sa[2 * ks + 1][2], sa[2 * ks + 1][3]);
                sf[ks][0] = (short)(w0 & 0xFFFF); sf[ks][1] = (short)(w0 >> 16); sf[ks][2] = (short)(w1 & 0xFFFF); sf[ks][3] = (short)(w1 >> 16);
                sf[ks][4] = (short)(w2 & 0xFFFF); sf[ks][5] = (short)(w2 >> 16); sf[ks][6] = (short)(w3 & 0xFFFF); sf[ks][7] = (short)(w3 >> 16);
            }
            bf16* yb = (bf16*)(shm + CH_YB + (ch & 1) * CH_YBSZ);
#pragma unroll
            for (int mt = 0; mt < 4; ++mt)
#pragma unroll
                for (int r = 0; r < 4; ++r) yb[(mt * 16 + 4 * fq + r) * 72 + w * 16 + fr] = f2bf(ya[mt][r]);
        }
        asm volatile("s_waitcnt vmcnt(0)" ::: "memory");
        CH_BAR();
    } else {
        const int et = (tid & 255) >> 2, eq = tid & 3;
        float gw[16], gb[16];
#pragma unroll
        for (int i = 0; i < 16; ++i) { gw[i] = gng[h * 64 + eq * 16 + i]; gb[i] = gnb[h * 64 + eq * 16 + i]; }
        uint4 nv0, nv1, ng0, ng1; float nbon;
        { const int t = b * SEQ + et; const size_t o = (size_t)t * 512 + h * 64 + eq * 16;
          nv0 = *(const uint4*)(V + o); nv1 = *(const uint4*)(V + o + 8); ng0 = *(const uint4*)(G + o); ng1 = *(const uint4*)(G + o + 8); nbon = BONUS[(size_t)t * 8 + h]; }
        CH_BAR();
#pragma unroll 1
        for (int ch = 0; ch < 64; ++ch) {
            const int t = b * SEQ + ch * 64 + et;
            const size_t o = (size_t)t * 512 + h * 64 + eq * 16;
            const uint4 cv0 = nv0, cv1 = nv1, cg0 = ng0, cg1 = ng1; const float cbon = nbon;
            CH_BAR();
            if (ch + 1 < 64) { const size_t o2 = o + (size_t)64 * 512;
                nv0 = *(const uint4*)(V + o2); nv1 = *(const uint4*)(V + o2 + 8); ng0 = *(const uint4*)(G + o2); ng1 = *(const uint4*)(G + o2 + 8); nbon = BONUS[(size_t)(t + 64) * 8 + h]; }
            const bf16* yb = (const bf16*)(shm + CH_YB + (ch & 1) * CH_YBSZ);
            float y[16], s = 0.f;
            { float a8[8], b8[8]; unpack8(*(const uint4*)(yb + et * 72 + eq * 16), a8); unpack8(*(const uint4*)(yb + et * 72 + eq * 16 + 8), b8);
#pragma unroll
              for (int i = 0; i < 8; ++i) { y[i] = a8[i]; y[8 + i] = b8[i]; } }
#pragma unroll
            for (int i = 0; i < 16; ++i) s += y[i];
            s += __shfl_xor(s, 1, 64); s += __shfl_xor(s, 2, 64);
            const float mean = s * (1.f / 64.f);
            float q = 0.f;
#pragma unroll
            for (int i = 0; i < 16; ++i) { y[i] -= mean; q += y[i] * y[i]; }
            q += __shfl_xor(q, 1, 64); q += __shfl_xor(q, 2, 64);
            const float rstd = rsqrtf(q * (1.f / 64.f) + 64e-5f);
            float v0[8], v1[8], g0[8], g1[8], o0[8], o1[8];
            unpack8(cv0, v0); unpack8(cv1, v1); unpack8(cg0, g0); unpack8(cg1, g1);
#pragma unroll
            for (int i = 0; i < 8; ++i) { o0[i] = (y[i] * rstd * gw[i] + gb[i] + cbon * v0[i]) * g0[i]; o1[i] = (y[8 + i] * rstd * gw[8 + i] + gb[8 + i] + cbon * v1[i]) * g1[i]; }
            *(uint4*)(O + o) = pack8(o0); *(uint4*)(O + o + 8) = pack8(o1);
        }
    }
#undef CH_BAR
    __syncthreads();
}

#define CE_DESC(a, b) { const float _mx = fmaxf(a, b), _mn = fminf(a, b); a = _mx; b = _mn; }
__device__ __forceinline__ void sort16_desc(float (&a)[16]) {
#pragma unroll
    for (int k = 2; k <= 16; k <<= 1)
#pragma unroll
        for (int j = k >> 1; j > 0; j >>= 1)
#pragma unroll
            for (int i = 0; i < 16; ++i) { const int l = i ^ j; if (l > i) { if ((i & k) == 0) { CE_DESC(a[i], a[l]); } else { CE_DESC(a[l], a[i]); } } }
}
__device__ __forceinline__ void merge16_desc(float (&run)[16], const float (&grp)[16]) {
#pragma unroll
    for (int i = 0; i < 16; ++i) run[i] = fmaxf(run[i], grp[15 - i]);
#pragma unroll
    for (int j = 8; j > 0; j >>= 1)
#pragma unroll
        for (int i = 0; i < 16; ++i) { const int l = i ^ j; if (l > i) { CE_DESC(run[i], run[l]); } }
}
struct CandTab { int i[64], j[64]; };
constexpr CandTab make_cand_tab() { CandTab t{}; int n = 0; for (int i = 0; i < 16; ++i) for (int j = 0; j < 16; ++j) if ((i + 1) * (j + 1) <= 16) { t.i[n] = i; t.j[n] = j; ++n; }
    for (; n < 64; ++n) { t.i[n] = 0; t.j[n] = 0; } return t; }
constexpr CandTab CT = make_cand_tab();
constexpr int TOPK_LDS = 8 * (16 * 256 * 4 + 16 * 2 * 16 * 4);
__device__ __forceinline__ void ph_topk(unsigned char* shm, int bid, int nblk, const bf16* __restrict__ Q, const bf16* __restrict__ keys, int* __restrict__ EID, float* __restrict__ GATE) {
    const int tid = threadIdx.x, lane = tid & 63, h = tid >> 6, fr = lane & 15, fq = lane >> 4;
    float* sc = (float*)shm + h * (16 * 256 + 512);
    float* top = sc + 16 * 256;
    for (int item = bid; item < T / 16; item += nblk) {
        const int t0 = item * 16;
        int koff = 0; asm volatile("" : "+v"(koff));
#pragma unroll
        for (int p = 0; p < 2; ++p) {
            pg8::bf16x8 a[4];
#pragma unroll
            for (int ks = 0; ks < 4; ++ks) a[ks] = *(const pg8::bf16x8*)(Q + (size_t)(t0 + fr) * 2048 + h * 256 + p * 128 + ks * 32 + fq * 8);
#pragma unroll
            for (int nt = 0; nt < 8; ++nt) {
                f32x4 acc = {0.f, 0.f, 0.f, 0.f};
#pragma unroll
                for (int ks = 0; ks < 4; ++ks) { const pg8::bf16x8 bfr = *(const pg8::bf16x8*)(keys + koff + ((size_t)(h * 2 + p) * 128 + nt * 16 + fr) * 128 + ks * 32 + fq * 8);
                    acc = __builtin_amdgcn_mfma_f32_16x16x32_bf16(a[ks], bfr, acc, 0, 0, 0); }
#pragma unroll
                for (int r = 0; r < 4; ++r) sc[(4 * fq + r) * 256 + p * 128 + nt * 16 + fr] = acc[r];
            }
        }
        __builtin_amdgcn_s_waitcnt(0);
        __builtin_amdgcn_wave_barrier();
        if (lane < 32) {
            const int tok = lane & 15, half = lane >> 4;
            const float* s = sc + tok * 256 + half * 128;
            float run[16], grp[16];
#pragma unroll
            for (int i = 0; i < 16; ++i) run[i] = __uint_as_float((__float_as_uint(s[i]) & ~0x7Fu) | (unsigned)i);
            sort16_desc(run);
            for (int g = 1; g < 8; ++g) {
#pragma unroll
                for (int i = 0; i < 16; ++i) grp[i] = __uint_as_float((__float_as_uint(s[g * 16 + i]) & ~0x7Fu) | (unsigned)(g * 16 + i));
                sort16_desc(grp);
                merge16_desc(run, grp);
            }
#pragma unroll
            for (int i = 0; i < 16; ++i) top[(tok * 2 + half) * 16 + i] = run[i];
        }
        __builtin_amdgcn_s_waitcnt(0);
        __builtin_amdgcn_wave_barrier();
        if (lane < 16) {
            const float* t1 = top + (lane * 2) * 16; const float* t2 = t1 + 16;
            float v1[16], v2[16];
#pragma unroll
            for (int i = 0; i < 16; ++i) { v1[i] = __uint_as_float(__float_as_uint(t1[i]) & ~0x7Fu); v2[i] = __uint_as_float(__float_as_uint(t2[i]) & ~0x7Fu); }
            float run[16], grp[16];
#pragma unroll
            for (int i = 0; i < 16; ++i) run[i] = __uint_as_float((__float_as_uint(v1[CT.i[i]] + v2[CT.j[i]]) & ~0xFFu) | (unsigned)(CT.i[i] * 16 + CT.j[i]));
            sort16_desc(run);
#pragma unroll
            for (int g = 1; g < 4; ++g) {
#pragma unroll
                for (int i = 0; i < 16; ++i) { const int n = g * 16 + i; grp[i] = (n < 50) ? __uint_as_float((__float_as_uint(v1[CT.i[n]] + v2[CT.j[n]]) & ~0xFFu) | (unsigned)(CT.i[n] * 16 + CT.j[n])) : -3.0e38f; }
                sort16_desc(grp); merge16_desc(run, grp);
            }
            float e[16], sum = 0.f; const float mx = __uint_as_float(__float_as_uint(run[0]) & ~0xFFu);
#pragma unroll
            for (int i = 0; i < 16; ++i) { e[i] = __expf(__uint_as_float(__float_as_uint(run[i]) & ~0xFFu) - mx); sum += e[i]; }
            const float inv = 1.f / sum;
            const size_t ob = (size_t)(t0 + lane) * 128 + h * 16;
#pragma unroll
            for (int i = 0; i < 16; ++i) { const unsigned ij = __float_as_uint(run[i]) & 0xFFu; const unsigned e1 = __float_as_uint(t1[ij >> 4]) & 0x7Fu, e2 = __float_as_uint(t2[ij & 15]) & 0x7Fu;
                EID[ob + i] = (int)(e1 * 128 + e2); GATE[ob + i] = e[i] * inv; }
        }
        __builtin_amdgcn_wave_barrier();
    }
}

__device__ __forceinline__ void ph_peer(unsigned char* shm, int bid, int nblk, const bf16* __restrict__ XN2, float* __restrict__ X1  , const bf16* __restrict__ UB, const bf16* __restrict__ VB,
                                              const int* __restrict__ EID, const float* __restrict__ GATE, const float* __restrict__ gf) {
    float (*cfs)[128] = (float (*)[128])shm;
    int (*eids)[128] = (int (*)[128])(shm + 8 * 128 * 4);
    const int wv = threadIdx.x >> 6, lane = threadIdx.x & 63;
    const int wave = (bid * 512 + threadIdx.x) >> 6, nw = (nblk * 512) >> 6;
    for (int t = wave; t < T; t += nw) {
        float hv[16];
        { float a[8], b[8]; unpack8(*(const uint4*)(XN2 + (size_t)t * D + lane * 16), a); unpack8(*(const uint4*)(XN2 + (size_t)t * D + lane * 16 + 8), b);
#pragma unroll
          for (int i = 0; i < 8; ++i) { hv[i] = a[i]; hv[8 + i] = b[i]; } }
        eids[wv][lane] = EID[(size_t)t * 128 + lane]; eids[wv][lane + 64] = EID[(size_t)t * 128 + 64 + lane];
        __builtin_amdgcn_s_waitcnt(0); __builtin_amdgcn_wave_barrier();
        for (int k0 = 0; k0 < 128; k0 += 4) {
            float dp[4];
#pragma unroll
            for (int q = 0; q < 4; ++q) { const int e = eids[wv][k0 + q];
                float a[8], b[8]; unpack8(*(const uint4*)(UB + (size_t)e * D + lane * 16), a); unpack8(*(const uint4*)(UB + (size_t)e * D + lane * 16 + 8), b);
                float s = 0.f;
#pragma unroll
                for (int i = 0; i < 8; ++i) s += a[i] * hv[i] + b[i] * hv[8 + i];
                dp[q] = s; }
#pragma unroll
            for (int q = 0; q < 4; ++q) { const float z = wave_sum(dp[q]); const float act = 0.5f * z * (1.f + erff(z * 0.70710678118f));
                if (lane == 0) cfs[wv][k0 + q] = act * GATE[(size_t)t * 128 + k0 + q]; }
        }
        __builtin_amdgcn_s_waitcnt(0); __builtin_amdgcn_wave_barrier();
        float acc[16];
#pragma unroll
        for (int i = 0; i < 16; ++i) acc[i] = 0.f;
        for (int k0 = 0; k0 < 128; k0 += 4) {
#pragma unroll
            for (int q = 0; q < 4; ++q) { const int e = eids[wv][k0 + q]; const float cf = cfs[wv][k0 + q];
                float a[8], b[8]; unpack8(*(const uint4*)(VB + (size_t)e * D + lane * 16), a); unpack8(*(const uint4*)(VB + (size_t)e * D + lane * 16 + 8), b);
#pragma unroll
                for (int i = 0; i < 8; ++i) { acc[i] += cf * a[i]; acc[8 + i] += cf * b[i]; } }
        }
        float* xr = X1 + (size_t)t * D + lane * 16; float ss = 0.f;
#pragma unroll
        for (int i = 0; i < 4; ++i) { const float4 v = ((const float4*)xr)[i]; acc[4 * i] += v.x; acc[4 * i + 1] += v.y; acc[4 * i + 2] += v.z; acc[4 * i + 3] += v.w; }
#pragma unroll
        for (int i = 0; i < 16; ++i) ss += acc[i] * acc[i];
        const float sc = rsqrtf(wave_sum(ss) * (1.f / D) + 1e-6f);
#pragma unroll
        for (int i = 0; i < 4; ++i) { const float4 g = ((const float4*)(gf + lane * 16))[i];
            ((float4*)xr)[i] = make_float4(acc[4 * i] * sc * g.x, acc[4 * i + 1] * sc * g.y, acc[4 * i + 2] * sc * g.z, acc[4 * i + 3] * sc * g.w); }
        __builtin_amdgcn_wave_barrier();
    }
}


typedef unsigned char u8;
constexpr float H8_SCALE = 16.f;
__device__ __forceinline__ unsigned pack4_fp8(float a, float b, float c, float d) {
    int w = 0; w = __builtin_amdgcn_cvt_pk_fp8_f32(a, b, w, false); w = __builtin_amdgcn_cvt_pk_fp8_f32(c, d, w, true); return (unsigned)w; }
__device__ __forceinline__ float wave_max(float v) {
#pragma unroll
    for (int o = 32; o > 0; o >>= 1) v = fmaxf(v, __shfl_xor(v, o, 64));
    return v;
}
__device__ __forceinline__ void ph_cvt_fp8(int bid, int nblk, const float* __restrict__ src, u8* __restrict__ dst, float* __restrict__ scale, int rows) {
    const int tid_ = opq((int)threadIdx.x), wave = (bid * 512 + tid_) >> 6, nw = (nblk * 512) >> 6, lane = tid_ & 63;
    for (int r = wave; r < rows; r += nw) {
        const float4* xr = (const float4*)(src + (size_t)r * 1024 + lane * 16);
        float4 v[4]; float mx = 0.f;
#pragma unroll
        for (int i = 0; i < 4; ++i) { v[i] = xr[i]; mx = fmaxf(mx, fmaxf(fmaxf(fabsf(v[i].x), fabsf(v[i].y)), fmaxf(fabsf(v[i].z), fabsf(v[i].w)))); }
        mx = wave_max(mx);
        const float sc = fmaxf(mx, 1e-30f) * (1.f / 440.f), inv = 1.f / sc;
        uint4 o; o.x = pack4_fp8(v[0].x * inv, v[0].y * inv, v[0].z * inv, v[0].w * inv); o.y = pack4_fp8(v[1].x * inv, v[1].y * inv, v[1].z * inv, v[1].w * inv);
        o.z = pack4_fp8(v[2].x * inv, v[2].y * inv, v[2].z * inv, v[2].w * inv); o.w = pack4_fp8(v[3].x * inv, v[3].y * inv, v[3].z * inv, v[3].w * inv);
        *(uint4*)(dst + (size_t)r * 1024 + lane * 16) = o;
        if (lane == 0) scale[r] = sc;
    }
}
__device__ __forceinline__ void ph_rmsnorm2(int bid, int nblk, const float* __restrict__ x, const float* __restrict__ g, bf16* __restrict__ out, u8* __restrict__ h8, int rows) {
    const int tid_ = opq((int)threadIdx.x), wave = (bid * 512 + tid_) >> 6, nw = (nblk * 512) >> 6, lane = tid_ & 63;
    for (int r = wave; r < rows; r += nw) {
        const float4* xr = (const float4*)(x + (size_t)r * D + lane * 16);
        float4 v[4]; float ss = 0.f;
#pragma unroll
        for (int i = 0; i < 4; ++i) { v[i] = xr[i]; ss += v[i].x * v[i].x + v[i].y * v[i].y + v[i].z * v[i].z + v[i].w * v[i].w; }
        const float sc = rsqrtf(wave_sum(ss) * (1.f / D) + 1e-6f);
        uint4 q; unsigned qq[4]; uint2 ob[4];
#pragma unroll
        for (int i = 0; i < 4; ++i) { const float4 gg = ((const float4*)(g + lane * 16))[i];
            const float a = v[i].x * sc * gg.x, b = v[i].y * sc * gg.y, c = v[i].z * sc * gg.z, d = v[i].w * sc * gg.w;
            ob[i].x = pack2(a, b); ob[i].y = pack2(c, d); qq[i] = pack4_fp8(a * H8_SCALE, b * H8_SCALE, c * H8_SCALE, d * H8_SCALE); }
        q.x = qq[0]; q.y = qq[1]; q.z = qq[2]; q.w = qq[3];
        *(uint4*)(out + (size_t)r * D + lane * 16) = make_uint4(ob[0].x, ob[0].y, ob[1].x, ob[1].y);
        *(uint4*)(out + (size_t)r * D + lane * 16 + 8) = make_uint4(ob[2].x, ob[2].y, ob[3].x, ob[3].y);
        *(uint4*)(h8 + (size_t)r * D + lane * 16) = q;
    }
}

__device__ __forceinline__ void ph_peer2(unsigned char* shm, int bid, int nblk, const u8* __restrict__ H8, const float* X1, float* OUT, const u8* __restrict__ U8, const u8* __restrict__ V8,
                                         const float* __restrict__ USC, const float* __restrict__ VSC, const int* __restrict__ EID, const float* __restrict__ GATE, const float* __restrict__ gf) {
    const int wv = threadIdx.x >> 6, lane = threadIdx.x & 63, fr = lane & 15, fq = lane >> 4;
    float* zb = (float*)shm + wv * 128;
    const int wave = (bid * 512 + threadIdx.x) >> 6, nw = (nblk * 512) >> 6;
    for (int t = wave; t < T; t += nw) {
        uint4 hq[16];
#pragma unroll
        for (int s = 0; s < 16; ++s) hq[s] = *(const uint4*)(H8 + (size_t)t * 1024 + 64 * s + 16 * fq);
        const int e0 = EID[(size_t)t * 128 + lane], e1 = EID[(size_t)t * 128 + 64 + lane];
        const float g0 = GATE[(size_t)t * 128 + lane], g1 = GATE[(size_t)t * 128 + 64 + lane];
        const float us0 = USC[e0], us1 = USC[e1], vs0 = VSC[e0], vs1 = VSC[e1];
#pragma unroll 1
        for (int tile = 0; tile < 8; ++tile) {
            const int er = __shfl((tile < 4) ? e0 : e1, (tile & 3) * 16 + fr, 64);
            const u8* rowp = U8 + (size_t)er * 1024 + 16 * fq;
            uint4 a[16];
#pragma unroll
            for (int s = 0; s < 16; ++s) a[s] = *(const uint4*)(rowp + 64 * s);
            f32x4 acc = {0.f, 0.f, 0.f, 0.f};
#pragma unroll
            for (int s = 0; s < 16; ++s) {
                const long alo = (long)(((unsigned long long)a[s].y << 32) | a[s].x), ahi = (long)(((unsigned long long)a[s].w << 32) | a[s].z);
                const long blo = (long)(((unsigned long long)hq[s].y << 32) | hq[s].x), bhi = (long)(((unsigned long long)hq[s].w << 32) | hq[s].z);
                acc = __builtin_amdgcn_mfma_f32_16x16x32_fp8_fp8(alo, blo, acc, 0, 0, 0);
                acc = __builtin_amdgcn_mfma_f32_16x16x32_fp8_fp8(ahi, bhi, acc, 0, 0, 0);
            }
            if (fr == 0) { *(float4*)(zb + tile * 16 + 4 * fq) = make_float4(acc[0], acc[1], acc[2], acc[3]); }
        }
        __builtin_amdgcn_s_waitcnt(0); __builtin_amdgcn_wave_barrier();
        float cf0, cf1;
        { const float z0 = zb[lane] * us0 * (1.f / H8_SCALE), z1 = zb[64 + lane] * us1 * (1.f / H8_SCALE);
          cf0 = g0 * vs0 * 0.5f * z0 * (1.f + erff(z0 * 0.70710678118f)); cf1 = g1 * vs1 * 0.5f * z1 * (1.f + erff(z1 * 0.70710678118f)); }
        __builtin_amdgcn_wave_barrier();
        float acc[16];
#pragma unroll
        for (int i = 0; i < 16; ++i) acc[i] = 0.f;
#pragma unroll 1
        for (int k0 = 0; k0 < 128; k0 += 16) {
            uint4 r[16]; float cc[16];
#pragma unroll
            for (int j = 0; j < 16; ++j) {
                const int k = k0 + j;
                const int e = __builtin_amdgcn_readlane((k < 64) ? e0 : e1, k & 63);
                cc[j] = __int_as_float(__builtin_amdgcn_readlane(__float_as_int((k < 64) ? cf0 : cf1), k & 63));
                r[j] = *(const uint4*)(V8 + (size_t)e * 1024 + lane * 16);
            }
#pragma unroll
            for (int j = 0; j < 16; ++j) {
                const unsigned w[4] = {r[j].x, r[j].y, r[j].z, r[j].w};
#pragma unroll
                for (int q = 0; q < 4; ++q) {
                    const auto lo = __builtin_amdgcn_cvt_pk_f32_fp8((int)w[q], false), hi = __builtin_amdgcn_cvt_pk_f32_fp8((int)w[q], true);
                    acc[4 * q] += cc[j] * lo[0]; acc[4 * q + 1] += cc[j] * lo[1]; acc[4 * q + 2] += cc[j] * hi[0]; acc[4 * q + 3] += cc[j] * hi[1];
                }
            }
        }
        const float* xr = X1 + (size_t)t * D + lane * 16; float* orow = OUT + (size_t)t * D + lane * 16; float ss = 0.f;
#pragma unroll
        for (int i = 0; i < 4; ++i) { const float4 v = ((const float4*)xr)[i]; acc[4 * i] += v.x; acc[4 * i + 1] += v.y; acc[4 * i + 2] += v.z; acc[4 * i + 3] += v.w; }
#pragma unroll
        for (int i = 0; i < 16; ++i) ss += acc[i] * acc[i];
        const float sc = rsqrtf(wave_sum(ss) * (1.f / D) + 1e-6f);
#pragma unroll
        for (int i = 0; i < 4; ++i) { const float4 g = ((const float4*)(gf + lane * 16))[i];
            ((float4*)orow)[i] = make_float4(acc[4 * i] * sc * g.x, acc[4 * i + 1] * sc * g.y, acc[4 * i + 2] * sc * g.z, acc[4 * i + 3] * sc * g.w); }
    }
}

constexpr int TK_KPITCH = 136;
constexpr int TK_KEYS = 2 * 128 * TK_KPITCH * 2;
constexpr int TK_TAB = TK_KEYS, TK_XCH = TK_TAB + 64;
__device__ __forceinline__ void xmerge16(float (&run)[16], int xm) {
    float oth[16];
#pragma unroll
    for (int i = 0; i < 16; ++i) oth[i] = __shfl_xor(run[i], xm, 64);
    merge16_desc(run, oth);
}
__device__ __forceinline__ void ph_topk2(unsigned char* shm, int bid, int nblk, const bf16* __restrict__ Q, const bf16* __restrict__ keys, const float* __restrict__ SCL, int* __restrict__ EID, float* __restrict__ GATE) {
    const int tid = threadIdx.x, lane = tid & 63, wv = tid >> 6, fr = lane & 15, fq = lane >> 4;
    bf16* KL = (bf16*)shm;
    unsigned char* tab = shm + TK_TAB;
    float* xch = (float*)(shm + TK_XCH) + wv * 512;
    const bool par = (nblk % 8) == 0;
    const int rank = par ? (bid >> 3) : bid, nrank = par ? (nblk >> 3) : nblk;
    if (tid == 0) {
#pragma unroll
        for (int n = 0; n < 50; ++n) tab[n] = (unsigned char)(CT.i[n] * 16 + CT.j[n]);
    }
    for (int h = par ? (bid & 7) : 0; h < 8; h += par ? 8 : 1) {
        __syncthreads();
        for (int i = tid; i < 2 * 128 * 16; i += 512) { const int row = i >> 4, ch = i & 15;
            *(uint4*)(KL + row * TK_KPITCH + ch * 8) = *(const uint4*)(keys + ((size_t)h * 256 + row) * 128 + ch * 8); }
        __syncthreads();
        for (int g = rank * 8 + wv; g < T / 16; g += nrank * 8) {
            const int t0 = g * 16;
            float tops[2][16];
#pragma unroll
            for (int p = 0; p < 2; ++p) {
                pg8::bf16x8 bq[4];
#pragma unroll
                for (int ks = 0; ks < 4; ++ks) bq[ks] = *(const pg8::bf16x8*)(Q + (size_t)(t0 + fr) * 2048 + h * 256 + p * 128 + ks * 32 + fq * 8);
                float sc[32];
#pragma unroll
                for (int mt = 0; mt < 8; ++mt) {
                    f32x4 acc = {0.f, 0.f, 0.f, 0.f};
#pragma unroll
                    for (int ks = 0; ks < 4; ++ks) acc = __builtin_amdgcn_mfma_f32_16x16x32_bf16(*(const pg8::bf16x8*)(KL + (p * 128 + mt * 16 + fr) * TK_KPITCH + ks * 32 + fq * 8), bq[ks], acc, 0, 0, 0);
#pragma unroll
                    for (int r = 0; r < 4; ++r) sc[mt * 4 + r] = __uint_as_float((__float_as_uint(acc[r]) & ~0x7Fu) | (unsigned)(mt * 16 + 4 * fq + r));
                }
                float run[16], grp[16];
#pragma unroll
                for (int i = 0; i < 16; ++i) { run[i] = sc[i]; grp[i] = sc[16 + i]; }
                sort16_desc(run); sort16_desc(grp); merge16_desc(run, grp);
                xmerge16(run, 16); xmerge16(run, 32);
#pragma unroll
                for (int i = 0; i < 16; ++i) tops[p][i] = run[i];
            }
            if (fq == 0) {
#pragma unroll
                for (int i = 0; i < 16; ++i) { xch[(fr * 2) * 16 + i] = tops[0][i]; xch[(fr * 2 + 1) * 16 + i] = tops[1][i]; }
            }
            __builtin_amdgcn_s_waitcnt(0); __builtin_amdgcn_wave_barrier();
            const float* t1 = xch + (fr * 2) * 16; const float* t2 = t1 + 16;
            float run[16];
#pragma unroll
            for (int m = 0; m < 16; ++m) {
                const int n = fq * 13 + m;
                float v = -3.0e38f;
                if (m < 13 && n < 50) { const unsigned ij = tab[n];
                    const float a = __uint_as_float(__float_as_uint(t1[ij >> 4]) & ~0x7Fu), b = __uint_as_float(__float_as_uint(t2[ij & 15]) & ~0x7Fu);
                    v = __uint_as_float((__float_as_uint(a + b) & ~0xFFu) | ij); }
                run[m] = v;
            }
            sort16_desc(run);
            xmerge16(run, 16); xmerge16(run, 32);
            if (fq == 0) {
                float e[16], sum = 0.f; const float mx = __uint_as_float(__float_as_uint(run[0]) & ~0xFFu), sct = SCL[t0 + fr];
#pragma unroll
                for (int i = 0; i < 16; ++i) { e[i] = __expf((__uint_as_float(__float_as_uint(run[i]) & ~0xFFu) - mx) * sct); sum += e[i]; }
                const float inv = 1.f / sum;
                const size_t ob = (size_t)(t0 + fr) * 128 + h * 16;
                int eo[16]; float go[16];
#pragma unroll
                for (int i = 0; i < 16; ++i) { const unsigned ij = __float_as_uint(run[i]) & 0xFFu; const unsigned e1 = __float_as_uint(t1[ij >> 4]) & 0x7Fu, e2 = __float_as_uint(t2[ij & 15]) & 0x7Fu;
                    eo[i] = (int)(e1 * 128 + e2); go[i] = e[i] * inv; }
#pragma unroll
                for (int i = 0; i < 4; ++i) { *(int4*)(EID + ob + 4 * i) = make_int4(eo[4 * i], eo[4 * i + 1], eo[4 * i + 2], eo[4 * i + 3]); *(float4*)(GATE + ob + 4 * i) = make_float4(go[4 * i], go[4 * i + 1], go[4 * i + 2], go[4 * i + 3]); }
            }
            __builtin_amdgcn_wave_barrier();
        }
    }
}

__device__ __forceinline__ void ph_peer_u(unsigned char* shm, int bid, int nblk, const u8* __restrict__ H8, const u8* __restrict__ U8, const float* __restrict__ USC, const float* __restrict__ VSC,
                                          const int* __restrict__ EID, const float* __restrict__ GATE, float* __restrict__ CF) {
    const int wv = threadIdx.x >> 6, lane = threadIdx.x & 63, fr = lane & 15, fq = lane >> 4;
    int* lst_e = (int*)shm + wv * 256; int* lst_s = lst_e + 128;
    const bool par = (nblk % 8) == 0;
    const int rank = par ? (bid >> 3) : bid, nrank = par ? (nblk >> 3) : nblk;
    for (int p = par ? (bid & 7) : 0; p < 8; p += par ? 8 : 1) {
        for (int t = rank * 8 + wv; t < T; t += nrank * 8) {
            const int e0 = EID[(size_t)t * 128 + lane], e1 = EID[(size_t)t * 128 + 64 + lane];
            const bool f0 = (e0 >> 11) == p, f1 = (e1 >> 11) == p;
            const unsigned long long m0 = __ballot(f0), m1 = __ballot(f1);
            const int c0 = __popcll(m0), cnt = c0 + __popcll(m1);
            if (cnt == 0) continue;
            const int below = __builtin_amdgcn_mbcnt_hi((unsigned)(m0 >> 32), __builtin_amdgcn_mbcnt_lo((unsigned)m0, 0));
            const int below1 = __builtin_amdgcn_mbcnt_hi((unsigned)(m1 >> 32), __builtin_amdgcn_mbcnt_lo((unsigned)m1, 0));
            if (f0) { lst_e[below] = e0; lst_s[below] = lane; }
            if (f1) { lst_e[c0 + below1] = e1; lst_s[c0 + below1] = 64 + lane; }
            uint4 hq[16];
#pragma unroll
            for (int s = 0; s < 16; ++s) hq[s] = *(const uint4*)(H8 + (size_t)t * 1024 + 64 * s + 16 * fq);
            __builtin_amdgcn_s_waitcnt(0); __builtin_amdgcn_wave_barrier();
            const int ntile = (cnt + 15) >> 4;
#pragma unroll 1
            for (int tile = 0; tile < ntile; ++tile) {
                const int j = tile * 16 + fr;
                const int er = lst_e[(j < cnt) ? j : 0];
                const u8* rowp = U8 + (size_t)er * 1024 + 16 * fq;
                uint4 a[16];
#pragma unroll
                for (int s = 0; s < 16; ++s) a[s] = *(const uint4*)(rowp + 64 * s);
                f32x4 acc = {0.f, 0.f, 0.f, 0.f};
#pragma unroll
                for (int s = 0; s < 16; ++s) {
                    const long alo = (long)(((unsigned long long)a[s].y << 32) | a[s].x), ahi = (long)(((unsigned long long)a[s].w << 32) | a[s].z);
                    const long blo = (long)(((unsigned long long)hq[s].y << 32) | hq[s].x), bhi = (long)(((unsigned long long)hq[s].w << 32) | hq[s].z);
                    acc = __builtin_amdgcn_mfma_f32_16x16x32_fp8_fp8(alo, blo, acc, 0, 0, 0);
                    acc = __builtin_amdgcn_mfma_f32_16x16x32_fp8_fp8(ahi, bhi, acc, 0, 0, 0);
                }
                const int jo = tile * 16 + 4 * fq + fr;
                if (fr < 4 && jo < cnt) {
                    const float d = (fr == 0) ? acc[0] : (fr == 1) ? acc[1] : (fr == 2) ? acc[2] : acc[3];
                    const int e = lst_e[jo], sl = lst_s[jo];
                    const float z = d * USC[e] * (1.f / H8_SCALE);
                    CF[(size_t)t * 128 + sl] = GATE[(size_t)t * 128 + sl] * VSC[e] * 0.5f * z * (1.f + erff(z * 0.70710678118f));
                }
            }
            __builtin_amdgcn_wave_barrier();
        }
    }
}

__device__ __forceinline__ void ph_peer_v(unsigned char* shm, int bid, int nblk, const float* X1, float* X2, const u8* __restrict__ V8, const int* __restrict__ EID, const float* __restrict__ CF, float* __restrict__ SS) {
    const int wv = threadIdx.x >> 6, lane = threadIdx.x & 63, tk = lane >> 3, pc = lane & 7;
    int* le = (int*)shm + wv * 2048;
    float* lc = (float*)(le + 1024);
    const bool par = (nblk % 8) == 0;
    const int rank = par ? (bid >> 3) : bid, nrank = par ? (nblk >> 3) : nblk;
    for (int p = par ? (bid & 7) : 0; p < 8; p += par ? 8 : 1) {
        for (int g = rank * 8 + wv; g < T / 8; g += nrank * 8) {
            const int t = g * 8 + tk;
            __builtin_amdgcn_wave_barrier();
#pragma unroll
            for (int i = 0; i < 4; ++i) { *(int4*)(le + tk * 128 + pc * 16 + 4 * i) = *(const int4*)(EID + (size_t)t * 128 + pc * 16 + 4 * i);
                                          *(float4*)(lc + tk * 128 + pc * 16 + 4 * i) = *(const float4*)(CF + (size_t)t * 128 + pc * 16 + 4 * i); }
            float acc[16];
            { const float* xr = X1 + (size_t)t * D + p * 128 + pc * 16;
#pragma unroll
              for (int i = 0; i < 4; ++i) { const float4 v = ((const float4*)xr)[i]; acc[4 * i] = v.x; acc[4 * i + 1] = v.y; acc[4 * i + 2] = v.z; acc[4 * i + 3] = v.w; } }
            __builtin_amdgcn_s_waitcnt(0); __builtin_amdgcn_wave_barrier();
            const u8* vb = V8 + p * 128 + pc * 16;
#pragma unroll 1
            for (int k0 = 0; k0 < 128; k0 += 16) {
                uint4 r[16]; float cc[16];
#pragma unroll
                for (int q = 0; q < 4; ++q) { const int4 e4 = *(const int4*)(le + tk * 128 + k0 + 4 * q); const float4 c4 = *(const float4*)(lc + tk * 128 + k0 + 4 * q);
                    r[4 * q] = *(const uint4*)(vb + (size_t)e4.x * 1024); r[4 * q + 1] = *(const uint4*)(vb + (size_t)e4.y * 1024); r[4 * q + 2] = *(const uint4*)(vb + (size_t)e4.z * 1024); r[4 * q + 3] = *(const uint4*)(vb + (size_t)e4.w * 1024);
                    cc[4 * q] = c4.x; cc[4 * q + 1] = c4.y; cc[4 * q + 2] = c4.z; cc[4 * q + 3] = c4.w; }
#pragma unroll
                for (int j = 0; j < 16; ++j) {
                    const unsigned w[4] = {r[j].x, r[j].y, r[j].z, r[j].w};
#pragma unroll
                    for (int q = 0; q < 4; ++q) {
                        const auto lo = __builtin_amdgcn_cvt_pk_f32_fp8((int)w[q], false), hi = __builtin_amdgcn_cvt_pk_f32_fp8((int)w[q], true);
                        acc[4 * q] += cc[j] * lo[0]; acc[4 * q + 1] += cc[j] * lo[1]; acc[4 * q + 2] += cc[j] * hi[0]; acc[4 * q + 3] += cc[j] * hi[1];
                    }
                }
            }
            float ss = 0.f;
#pragma unroll
            for (int i = 0; i < 16; ++i) ss += acc[i] * acc[i];
            { float* orow = X2 + (size_t)t * D + p * 128 + pc * 16;
#pragma unroll
              for (int i = 0; i < 4; ++i) ((float4*)orow)[i] = make_float4(acc[4 * i], acc[4 * i + 1], acc[4 * i + 2], acc[4 * i + 3]); }
            ss += __shfl_xor(ss, 1, 64); ss += __shfl_xor(ss, 2, 64); ss += __shfl_xor(ss, 4, 64);
            if (pc == 0) SS[(size_t)t * 8 + p] = ss;
        }
    }
}

__device__ __forceinline__ void ph_peer_f(int bid, int nblk, const bf16* __restrict__ X2, float* __restrict__ OUT, const float* __restrict__ SS, const float* __restrict__ gf) {
    const int tid_ = opq((int)threadIdx.x), wave = (bid * 512 + tid_) >> 6, nw = (nblk * 512) >> 6, lane = tid_ & 63;
    float4 g[4], ns0, ns1; uint2 nx[4];
#pragma unroll
    for (int i = 0; i < 4; ++i) g[i] = ((const float4*)gf)[lane + 64 * i];
    if (wave < T) {
        ns0 = *(const float4*)(SS + (size_t)wave * 8); ns1 = *(const float4*)(SS + (size_t)wave * 8 + 4);
#pragma unroll
        for (int i = 0; i < 4; ++i) nx[i] = ((const uint2*)(X2 + (size_t)wave * D))[lane + 64 * i];
    }
    for (int t = wave; t < T; t += nw) {
        float4 v[4]; const float4 s0 = ns0, s1 = ns1;
#pragma unroll
        for (int i = 0; i < 4; ++i) v[i] = make_float4(bflo(nx[i].x), bfhi(nx[i].x), bflo(nx[i].y), bfhi(nx[i].y));
        if (t + nw < T) {
            ns0 = *(const float4*)(SS + (size_t)(t + nw) * 8); ns1 = *(const float4*)(SS + (size_t)(t + nw) * 8 + 4);
#pragma unroll
            for (int i = 0; i < 4; ++i) nx[i] = ((const uint2*)(X2 + (size_t)(t + nw) * D))[lane + 64 * i];
        }
        const float sc = rsqrtf(((s0.x + s0.y) + (s0.z + s0.w) + (s1.x + s1.y) + (s1.z + s1.w)) * (1.f / D) + 1e-6f);
#pragma unroll
        for (int i = 0; i < 4; ++i) ((float4*)(OUT + (size_t)t * D))[lane + 64 * i] = make_float4(v[i].x * sc * g[i].x, v[i].y * sc * g[i].y, v[i].z * sc * g[i].z, v[i].w * sc * g[i].w);
    }
}

struct Part { int p0, pstep, rank, nrank; };
__device__ __forceinline__ long u4lo(const uint4& v) { return (long)(((unsigned long long)v.y << 32) | v.x); }
__device__ __forceinline__ long u4hi(const uint4& v) { return (long)(((unsigned long long)v.w << 32) | v.z); }
__device__ __forceinline__ int pu_compact(int e0, int e1, int p, int lane, int* lst) {
    const bool f0 = (e0 >> 11) == p, f1 = (e1 >> 11) == p;
    const unsigned long long m0 = __ballot(f0), m1 = __ballot(f1);
    const int c0 = __popcll(m0), cnt = c0 + __popcll(m1);
    const int b0 = __builtin_amdgcn_mbcnt_hi((unsigned)(m0 >> 32), __builtin_amdgcn_mbcnt_lo((unsigned)m0, 0));
    const int b1 = __builtin_amdgcn_mbcnt_hi((unsigned)(m1 >> 32), __builtin_amdgcn_mbcnt_lo((unsigned)m1, 0));
    __builtin_amdgcn_wave_barrier();
    if (f0) { lst[b0] = e0; lst[128 + b0] = lane; }
    if (f1) { lst[c0 + b1] = e1; lst[128 + c0 + b1] = 64 + lane; }
    asm volatile("s_waitcnt lgkmcnt(0)" ::: "memory"); __builtin_amdgcn_wave_barrier();
    return cnt;
}
struct PuScal { float us[2], vs[2], gt[2]; int sl[2]; };
__device__ __forceinline__ void pu_scalars(PuScal& S, int t, int cnt, const int* lst, int fr, int fq, const float* __restrict__ USC, const float* __restrict__ VSC, const float* __restrict__ GATE) {
#pragma unroll
    for (int rt = 0; rt < 2; ++rt) { const int jo = rt * 16 + 4 * fq + fr; S.us[rt] = 0.f; S.vs[rt] = 0.f; S.gt[rt] = 0.f; S.sl[rt] = 0;
        if (fr < 4 && jo < cnt) { const int e = lst[jo], sl = lst[128 + jo]; S.sl[rt] = sl; S.us[rt] = USC[e]; S.vs[rt] = VSC[e]; S.gt[rt] = GATE[(size_t)t * 128 + sl]; } }
}
template <int HALF> __device__ __forceinline__ void pu_rows(uint4 (&a)[8], const u8* __restrict__ U8, const int* lst, int cnt, int j0, int fr, int fq, int pad_row) {
    const int j = j0 + fr; const int er = (j < cnt) ? lst[j] : pad_row;
    const u8* r0 = U8 + (size_t)er * 1024 + 16 * fq + HALF * 512;
#pragma unroll
    for (int s = 0; s < 8; ++s) a[s] = *(const uint4*)(r0 + 64 * s);
}
template <int HALF> __device__ __forceinline__ void pu_mma(const uint4 (&a)[8], const unsigned char* hbuf, int fq, f32x4& acc) {
#pragma unroll
    for (int s = 0; s < 8; ++s) {
        const uint4 hv = *(const uint4*)(hbuf + HALF * 512 + 64 * s + 16 * fq);
        acc = __builtin_amdgcn_mfma_f32_16x16x32_fp8_fp8(u4lo(a[s]), u4lo(hv), acc, 0, 0, 0);
        acc = __builtin_amdgcn_mfma_f32_16x16x32_fp8_fp8(u4hi(a[s]), u4hi(hv), acc, 0, 0, 0);
    }
}
__device__ __forceinline__ float gelu_erf(float v) {
    const float av = fabsf(v), tt = __builtin_amdgcn_rcpf(av * 0.2316418882f + 1.0f);
    float q = tt * 0.5307027145f + (-0.7265760135f); q = q * tt + 0.7107068705f; q = q * tt + (-0.142248368f); q = q * tt + 0.127414796f; q = q * tt;
    const float e = __builtin_amdgcn_exp2f((v * v) * (-0.72134752044f));
    const float m = v * (q * e);
    return v < 0.f ? m : v - m;
}
__device__ __forceinline__ void pu_tile_mma(const uint4 (&aA)[8], const uint4 (&aB)[8], const unsigned char* hbuf, int fq, f32x4& acc) { pu_mma<0>(aA, hbuf, fq, acc); pu_mma<1>(aB, hbuf, fq, acc); }
__device__ __forceinline__ void ph_peer_u2(unsigned char* shm, const Part pt, const u8* __restrict__ H8, const u8* __restrict__ U8, const float* __restrict__ USC, const float* __restrict__ VSC,
                                           const int* __restrict__ EID, const float* __restrict__ GATE, float* __restrict__ CF) {
    const int wv = threadIdx.x >> 6;
    const int rank = pt.rank, nrank = pt.nrank, tstep = nrank * 8;
    for (int p = pt.p0; p < 8; p += pt.pstep) {
        int tn = rank * 8 + wv;
        if (tn >= T) continue;
        const int pad = p * 2048;
        int cb = 1, cnt = 0, t = 0;
        bool has_cur = false;
        uint4 hreg = make_uint4(0, 0, 0, 0);
        PuScal S;
        uint4 a0A[8], a0B[8], a1A[8], a1B[8];
        int ne0, ne1;
        { const int lane0 = threadIdx.x & 63; ne0 = EID[(size_t)tn * 128 + lane0]; ne1 = EID[(size_t)tn * 128 + 64 + lane0]; }
#pragma unroll 1
        for (;;) {
            const int lane = opq((int)threadIdx.x) & 63, fr = lane & 15, fq = lane >> 4;
            int* lstb = (int*)shm + (opq((int)threadIdx.x) >> 6) * 512;
            unsigned char* hbuf = shm + 16384 + (opq((int)threadIdx.x) >> 6) * 1024;
            int* lcur = lstb + cb * 256; int* lnxt = lstb + (cb ^ 1) * 256;
            if (has_cur) {
                __builtin_amdgcn_wave_barrier();
                *(uint4*)(hbuf + lane * 16) = hreg;
                asm volatile("s_waitcnt lgkmcnt(0)" ::: "memory"); __builtin_amdgcn_wave_barrier();
                f32x4 acc0 = {0.f, 0.f, 0.f, 0.f}, acc1 = {0.f, 0.f, 0.f, 0.f};
                pu_tile_mma(a0A, a0B, hbuf, fq, acc0);
                if (cnt > 16) pu_tile_mma(a1A, a1B, hbuf, fq, acc1);
                for (int tile = 2; tile * 16 < cnt; ++tile) {
                    pu_rows<0>(a1A, U8, lcur, cnt, tile * 16, fr, fq, pad); pu_rows<1>(a1B, U8, lcur, cnt, tile * 16, fr, fq, pad);
                    f32x4 acc = {0.f, 0.f, 0.f, 0.f}; pu_tile_mma(a1A, a1B, hbuf, fq, acc);
                    const int jo = tile * 16 + 4 * fq + fr;
                    if (fr < 4 && jo < cnt) { const float d = (fr == 0) ? acc[0] : (fr == 1) ? acc[1] : (fr == 2) ? acc[2] : acc[3];
                        const int e = lcur[jo], sl = lcur[128 + jo];
                        CF[(size_t)t * 128 + sl] = GATE[(size_t)t * 128 + sl] * VSC[e] * gelu_erf(d * USC[e] * (1.f / H8_SCALE)); }
                }
                if (fr < 4) {
                    const int jo = 4 * fq + fr;
                    if (jo < cnt) { const float d = (fr == 0) ? acc0[0] : (fr == 1) ? acc0[1] : (fr == 2) ? acc0[2] : acc0[3];
                        CF[(size_t)t * 128 + S.sl[0]] = S.gt[0] * S.vs[0] * gelu_erf(d * S.us[0] * (1.f / H8_SCALE)); }
                    if (16 + jo < cnt) { const float d = (fr == 0) ? acc1[0] : (fr == 1) ? acc1[1] : (fr == 2) ? acc1[2] : acc1[3];
                        CF[(size_t)t * 128 + S.sl[1]] = S.gt[1] * S.vs[1] * gelu_erf(d * S.us[1] * (1.f / H8_SCALE)); }
                }
            }
            if (tn >= T) break;
            const int ncnt = pu_compact(ne0, ne1, p, lane, lnxt);
            pu_rows<0>(a0A, U8, lnxt, ncnt, 0, fr, fq, pad); pu_rows<1>(a0B, U8, lnxt, ncnt, 0, fr, fq, pad);
            if (ncnt > 16) { pu_rows<0>(a1A, U8, lnxt, ncnt, 16, fr, fq, pad); pu_rows<1>(a1B, U8, lnxt, ncnt, 16, fr, fq, pad); }
            hreg = *(const uint4*)(H8 + (size_t)tn * 1024 + lane * 16);
            pu_scalars(S, tn, ncnt, lnxt, fr, fq, USC, VSC, GATE);
            if (tn + tstep < T) { ne0 = EID[(size_t)(tn + tstep) * 128 + lane]; ne1 = EID[(size_t)(tn + tstep) * 128 + 64 + lane]; }
            t = tn; tn += tstep; cnt = ncnt; cb ^= 1; has_cur = true;
        }
    }
}

__device__ __forceinline__ void pv_issue(uint4 (&r)[8], float (&cc)[8], const u8* vb, const int* le, const float* lc, int k0) {
#pragma unroll
    for (int q = 0; q < 2; ++q) { const int4 e4 = *(const int4*)(le + k0 + 4 * q); const float4 c4 = *(const float4*)(lc + k0 + 4 * q);
        r[4 * q] = *(const uint4*)(vb + (size_t)e4.x * 1024); r[4 * q + 1] = *(const uint4*)(vb + (size_t)e4.y * 1024); r[4 * q + 2] = *(const uint4*)(vb + (size_t)e4.z * 1024); r[4 * q + 3] = *(const uint4*)(vb + (size_t)e4.w * 1024);
        cc[4 * q] = c4.x; cc[4 * q + 1] = c4.y; cc[4 * q + 2] = c4.z; cc[4 * q + 3] = c4.w; }
}
__device__ __forceinline__ void pv_fma(float (&acc)[16], const uint4 (&r)[8], const float (&cc)[8]) {
#pragma unroll
    for (int j = 0; j < 8; ++j) {
        const unsigned w[4] = {r[j].x, r[j].y, r[j].z, r[j].w};
#pragma unroll
        for (int q = 0; q < 4; ++q) {
            const auto lo = __builtin_amdgcn_cvt_pk_f32_fp8((int)w[q], false), hi = __builtin_amdgcn_cvt_pk_f32_fp8((int)w[q], true);
            acc[4 * q] += cc[j] * lo[0]; acc[4 * q + 1] += cc[j] * lo[1]; acc[4 * q + 2] += cc[j] * hi[0]; acc[4 * q + 3] += cc[j] * hi[1];
        }
        if (j & 1) __builtin_amdgcn_sched_barrier(0);
    }
}
__device__ __forceinline__ void ph_peer_v2(unsigned char* shm, const Part pt, const float* X1, float* X2, const u8* __restrict__ V8, const int* __restrict__ EID, const float* __restrict__ CF, float* __restrict__ SS) {
    const int wv = threadIdx.x >> 6, lane = threadIdx.x & 63, tk = lane >> 3, pc = lane & 7;
    int* le = (int*)shm + wv * 2048 + tk * 128;
    float* lc = (float*)((int*)shm + wv * 2048 + 1024) + tk * 128;
    const int rank = pt.rank, nrank = pt.nrank, gstep = nrank * 8;
    for (int p = pt.p0; p < 8; p += pt.pstep) {
        int g = rank * 8 + wv;
        if (g >= T / 8) continue;
        int4 pe0, pe1, pe2, pe3; float4 pf0, pf1, pf2, pf3;
        { const int* er = EID + (size_t)(g * 8 + tk) * 128 + pc * 16; const float* cr = CF + (size_t)(g * 8 + tk) * 128 + pc * 16;
          pe0 = *(const int4*)(er); pe1 = *(const int4*)(er + 4); pe2 = *(const int4*)(er + 8); pe3 = *(const int4*)(er + 12);
          pf0 = *(const float4*)(cr); pf1 = *(const float4*)(cr + 4); pf2 = *(const float4*)(cr + 8); pf3 = *(const float4*)(cr + 12); }
        const u8* vb = V8 + p * 128 + pc * 16;
#pragma unroll 1
        for (; g < T / 8; g += gstep) {
            const int lane = opq((int)threadIdx.x) & 63, tk = lane >> 3, pc = lane & 7;
            int* le = (int*)shm + wv * 2048 + tk * 128; float* lc = (float*)((int*)shm + wv * 2048 + 1024) + tk * 128;
            const u8* vb = V8 + p * 128 + pc * 16;
            const int t = g * 8 + tk;
            __builtin_amdgcn_wave_barrier();
            *(int4*)(le + pc * 16) = pe0; *(int4*)(le + pc * 16 + 4) = pe1; *(int4*)(le + pc * 16 + 8) = pe2; *(int4*)(le + pc * 16 + 12) = pe3;
            *(float4*)(lc + pc * 16) = pf0; *(float4*)(lc + pc * 16 + 4) = pf1; *(float4*)(lc + pc * 16 + 8) = pf2; *(float4*)(lc + pc * 16 + 12) = pf3;
            asm volatile("s_waitcnt lgkmcnt(0)" ::: "memory"); __builtin_amdgcn_wave_barrier();
            float acc[16];
#pragma unroll
            for (int i = 0; i < 16; ++i) acc[i] = 0.f;
            if (g + gstep < T / 8) { const int* er = EID + (size_t)((g + gstep) * 8 + tk) * 128 + pc * 16; const float* cr = CF + (size_t)((g + gstep) * 8 + tk) * 128 + pc * 16;
                pe0 = *(const int4*)(er); pe1 = *(const int4*)(er + 4); pe2 = *(const int4*)(er + 8); pe3 = *(const int4*)(er + 12);
                pf0 = *(const float4*)(cr); pf1 = *(const float4*)(cr + 4); pf2 = *(const float4*)(cr + 8); pf3 = *(const float4*)(cr + 12); }
            uint4 rA[8], rB[8]; float cA[8], cB[8];
            pv_issue(rA, cA, vb, le, lc, 0);
#pragma unroll 1
            for (int k0 = 0; k0 < 128; k0 += 16) {
                pv_issue(rB, cB, vb, le, lc, k0 + 8);
                pv_fma(acc, rA, cA);
                if (k0 + 16 < 128) pv_issue(rA, cA, vb, le, lc, k0 + 16);
                pv_fma(acc, rB, cB);
            }
            { const float* xr = X1 + (size_t)t * D + p * 128 + pc * 16;
#pragma unroll
              for (int i = 0; i < 4; ++i) { const float4 v = ((const float4*)xr)[i]; acc[4 * i] += v.x; acc[4 * i + 1] += v.y; acc[4 * i + 2] += v.z; acc[4 * i + 3] += v.w; } }
            float ss = 0.f;
#pragma unroll
            for (int i = 0; i < 16; ++i) ss += acc[i] * acc[i];
            { float* orow = X2 + (size_t)t * D + p * 128 + pc * 16;
#pragma unroll
              for (int i = 0; i < 4; ++i) ((float4*)orow)[i] = make_float4(acc[4 * i], acc[4 * i + 1], acc[4 * i + 2], acc[4 * i + 3]); }
            ss += __shfl_xor(ss, 1, 64); ss += __shfl_xor(ss, 2, 64); ss += __shfl_xor(ss, 4, 64);
            if (pc == 0) SS[(size_t)t * 8 + p] = ss;
        }
    }
}

__device__ __forceinline__ void pw_issue(uint4 (&r)[8], const u8* ub, const int* le, int k0) {
#pragma unroll
    for (int q = 0; q < 2; ++q) { const int4 e4 = *(const int4*)(le + k0 + 4 * q);
        r[4 * q] = *(const uint4*)(ub + (size_t)e4.x * 1024); r[4 * q + 1] = *(const uint4*)(ub + (size_t)e4.y * 1024); r[4 * q + 2] = *(const uint4*)(ub + (size_t)e4.z * 1024); r[4 * q + 3] = *(const uint4*)(ub + (size_t)e4.w * 1024); }
}
__device__ __forceinline__ float pw_dot8(const uint4 (&r)[8], const float (&h)[16], int pc) {
    float d[8];
#pragma unroll
    for (int j = 0; j < 8; ++j) {
        const unsigned w[4] = {r[j].x, r[j].y, r[j].z, r[j].w};
        typedef float f2v __attribute__((ext_vector_type(2)));
        f2v s2 = {0.f, 0.f};
#pragma unroll
        for (int q = 0; q < 4; ++q) {
            const f2v lo = __builtin_amdgcn_cvt_pk_f32_fp8((int)w[q], false), hi = __builtin_amdgcn_cvt_pk_f32_fp8((int)w[q], true);
            const f2v ha = {h[4 * q], h[4 * q + 1]}, hb = {h[4 * q + 2], h[4 * q + 3]};
            s2 = __builtin_elementwise_fma(ha, lo, s2); s2 = __builtin_elementwise_fma(hb, hi, s2);
        }
        d[j] = s2[0] + s2[1];
        if (j & 1) __builtin_amdgcn_sched_barrier(0);
    }
    float e4[4], e2[2];
#pragma unroll
    for (int j = 0; j < 4; ++j) { const float snd = (pc & 4) ? d[j] : d[j + 4], kp = (pc & 4) ? d[j + 4] : d[j]; e4[j] = kp + __shfl_xor(snd, 4, 64); }
#pragma unroll
    for (int j = 0; j < 2; ++j) { const float snd = (pc & 2) ? e4[j] : e4[j + 2], kp = (pc & 2) ? e4[j + 2] : e4[j]; e2[j] = kp + __shfl_xor(snd, 2, 64); }
    { const float snd = (pc & 1) ? e2[0] : e2[1], kp = (pc & 1) ? e2[1] : e2[0]; return kp + __shfl_xor(snd, 1, 64); }
}
__device__ __forceinline__ void ph_peer_u3(unsigned char* shm, const Part pt, const u8* __restrict__ H8, const u8* __restrict__ U8, const int* __restrict__ EID, float* __restrict__ PART) {
    const int wv = threadIdx.x >> 6;
    const int rank = pt.rank, nrank = pt.nrank, gstep = nrank * 8;
    for (int p = pt.p0; p < 8; p += pt.pstep) {
        int g = rank * 8 + wv;
        if (g >= T / 8) continue;
        int4 pe0, pe1, pe2, pe3;
        { const int l0 = threadIdx.x & 63; const int* er = EID + (size_t)(g * 8 + (l0 >> 3)) * 128 + (l0 & 7) * 16;
          pe0 = *(const int4*)(er); pe1 = *(const int4*)(er + 4); pe2 = *(const int4*)(er + 8); pe3 = *(const int4*)(er + 12); }
#pragma unroll 1
        for (; g < T / 8; g += gstep) {
            const int lane = opq((int)threadIdx.x) & 63, tk = lane >> 3, pc = lane & 7;
            int* le = (int*)shm + wv * 1024 + tk * 128;
            const u8* ub = U8 + p * 128 + pc * 16;
            const int t = g * 8 + tk;
            __builtin_amdgcn_wave_barrier();
            *(int4*)(le + pc * 16) = pe0; *(int4*)(le + pc * 16 + 4) = pe1; *(int4*)(le + pc * 16 + 8) = pe2; *(int4*)(le + pc * 16 + 12) = pe3;
            asm volatile("s_waitcnt lgkmcnt(0)" ::: "memory"); __builtin_amdgcn_wave_barrier();
            float h[16];
            { const uint4 hq = *(const uint4*)(H8 + (size_t)t * 1024 + p * 128 + pc * 16); const unsigned w[4] = {hq.x, hq.y, hq.z, hq.w};
#pragma unroll
              for (int q = 0; q < 4; ++q) { const auto lo = __builtin_amdgcn_cvt_pk_f32_fp8((int)w[q], false), hi = __builtin_amdgcn_cvt_pk_f32_fp8((int)w[q], true);
                  h[4 * q] = lo[0] * (1.f / H8_SCALE); h[4 * q + 1] = lo[1] * (1.f / H8_SCALE); h[4 * q + 2] = hi[0] * (1.f / H8_SCALE); h[4 * q + 3] = hi[1] * (1.f / H8_SCALE); } }
            if (g + gstep < T / 8) { const int* er = EID + (size_t)((g + gstep) * 8 + tk) * 128 + pc * 16;
                pe0 = *(const int4*)(er); pe1 = *(const int4*)(er + 4); pe2 = *(const int4*)(er + 8); pe3 = *(const int4*)(er + 12); }
            float* prow = PART + ((size_t)p * T + t) * 128 + pc;
            uint4 rA[8], rB[8];
            pw_issue(rA, ub, le, 0);
#pragma unroll 1
            for (int k0 = 0; k0 < 128; k0 += 16) {
                pw_issue(rB, ub, le, k0 + 8);
                prow[k0] = pw_dot8(rA, h, pc);
                if (k0 + 16 < 128) pw_issue(rA, ub, le, k0 + 16);
                prow[k0 + 8] = pw_dot8(rB, h, pc);
            }
        }
    }
}
__device__ __forceinline__ void ph_peer_cf(int bid, int nblk, const float* __restrict__ PART, const float* __restrict__ USC, const float* __restrict__ VSC, const int* __restrict__ EID, const float* __restrict__ GATE, float* __restrict__ CF) {
    const int tid_ = opq((int)threadIdx.x);
    for (size_t i = (size_t)bid * 512 + tid_; i < (size_t)T * 128 / 4; i += (size_t)nblk * 512) {
        float4 s = ((const float4*)PART)[i];
#pragma unroll
        for (int p = 1; p < 8; ++p) { const float4 v = ((const float4*)(PART + (size_t)p * T * 128))[i]; s.x += v.x; s.y += v.y; s.z += v.z; s.w += v.w; }
        const int4 e = ((const int4*)EID)[i]; const float4 g = ((const float4*)GATE)[i];
        float4 o;
        o.x = g.x * VSC[e.x] * gelu_erf(s.x * USC[e.x]); o.y = g.y * VSC[e.y] * gelu_erf(s.y * USC[e.y]); o.z = g.z * VSC[e.z] * gelu_erf(s.z * USC[e.z]); o.w = g.w * VSC[e.w] * gelu_erf(s.w * USC[e.w]);
        ((float4*)CF)[i] = o;
    }
}

__device__ __forceinline__ unsigned fp4_code(float q) {
    const float a = fabsf(q);
    unsigned c = (a >= 0.25f) + (a >= 0.75f) + (a >= 1.25f) + (a >= 1.75f) + (a >= 2.5f) + (a >= 3.5f) + (a >= 5.0f);
    return c | ((q < 0.f) ? 8u : 0u);
}
__device__ __forceinline__ void ph_cvt_fp4(int bid, int nblk, const float* __restrict__ src, u8* __restrict__ dst, float* __restrict__ scale, int rows) {
    const int tid_ = opq((int)threadIdx.x), wave = (bid * 512 + tid_) >> 6, nw = (nblk * 512) >> 6, lane = tid_ & 63;
    for (int r = wave; r < rows; r += nw) {
        const float4* xr = (const float4*)(src + (size_t)r * 1024 + lane * 16);
        float4 v[4]; float mx = 0.f;
#pragma unroll
        for (int i = 0; i < 4; ++i) { v[i] = xr[i]; mx = fmaxf(mx, fmaxf(fmaxf(fabsf(v[i].x), fabsf(v[i].y)), fmaxf(fabsf(v[i].z), fabsf(v[i].w)))); }
        mx = wave_max(mx);
        const float sc = fmaxf(mx, 1e-30f) * (1.f / 6.f), inv = 1.f / sc;
        unsigned w0 = 0, w1 = 0;
#pragma unroll
        for (int i = 0; i < 2; ++i) { w0 |= fp4_code(v[i].x * inv) << (16 * i); w0 |= fp4_code(v[i].y * inv) << (16 * i + 4); w0 |= fp4_code(v[i].z * inv) << (16 * i + 8); w0 |= fp4_code(v[i].w * inv) << (16 * i + 12); }
#pragma unroll
        for (int i = 0; i < 2; ++i) { w1 |= fp4_code(v[2 + i].x * inv) << (16 * i); w1 |= fp4_code(v[2 + i].y * inv) << (16 * i + 4); w1 |= fp4_code(v[2 + i].z * inv) << (16 * i + 8); w1 |= fp4_code(v[2 + i].w * inv) << (16 * i + 12); }
        *(uint2*)(dst + (size_t)r * 512 + lane * 8) = make_uint2(w0, w1);
        if (lane == 0) scale[r] = sc;
    }
}
__device__ __forceinline__ void ph_peer_cf2(int bid, int nblk, const float* __restrict__ PART, const float* __restrict__ USC, const float* __restrict__ VSC, const int* __restrict__ EID, const float* __restrict__ GATE,
                                            unsigned short* __restrict__ E16, bf16* __restrict__ CFH) {
    const int tid_ = opq((int)threadIdx.x);
    for (size_t i = (size_t)bid * 512 + tid_; i < (size_t)T * 128 / 4; i += (size_t)nblk * 512) {
        float4 s = ((const float4*)PART)[i];
#pragma unroll
        for (int p = 1; p < 8; ++p) { const float4 v = ((const float4*)(PART + (size_t)p * T * 128))[i]; s.x += v.x; s.y += v.y; s.z += v.z; s.w += v.w; }
        const int4 e = ((const int4*)EID)[i]; const float4 g = ((const float4*)GATE)[i];
        const float ox = g.x * VSC[e.x] * gelu_erf(s.x * USC[e.x]), oy = g.y * VSC[e.y] * gelu_erf(s.y * USC[e.y]), oz = g.z * VSC[e.z] * gelu_erf(s.z * USC[e.z]), ow = g.w * VSC[e.w] * gelu_erf(s.w * USC[e.w]);
        ((uint2*)CFH)[i] = make_uint2(pack2(ox, oy), pack2(oz, ow));
        ((uint2*)E16)[i] = make_uint2((unsigned)e.x | ((unsigned)e.y << 16), (unsigned)e.z | ((unsigned)e.w << 16));
    }
}
__device__ __forceinline__ void pv4_issue(uint4 (&r)[4], float (&cc)[4], const u8* vb, const unsigned short* le, const bf16* lc, int k0) {
    const uint2 e8 = *(const uint2*)(le + k0), c8 = *(const uint2*)(lc + k0);
    const unsigned ew[2] = {e8.x, e8.y}, cw[2] = {c8.x, c8.y};
#pragma unroll
    for (int q = 0; q < 2; ++q) { r[2 * q] = *(const uint4*)(vb + (size_t)(ew[q] & 0xFFFFu) * 512); r[2 * q + 1] = *(const uint4*)(vb + (size_t)(ew[q] >> 16) * 512);
        cc[2 * q] = bflo(cw[q]); cc[2 * q + 1] = bfhi(cw[q]); }
}
__device__ __forceinline__ void pv4_fma(float (&acc)[32], const uint4 (&r)[4], const float (&cc)[4]) {
#pragma unroll
    for (int j = 0; j < 4; ++j) {
        const unsigned w[4] = {r[j].x, r[j].y, r[j].z, r[j].w};
#pragma unroll
        for (int q = 0; q < 4; ++q) {
            const auto b0 = __builtin_amdgcn_cvt_scalef32_pk_f32_fp4(w[q], 1.0f, 0), b1 = __builtin_amdgcn_cvt_scalef32_pk_f32_fp4(w[q], 1.0f, 1);
            const auto b2 = __builtin_amdgcn_cvt_scalef32_pk_f32_fp4(w[q], 1.0f, 2), b3 = __builtin_amdgcn_cvt_scalef32_pk_f32_fp4(w[q], 1.0f, 3);
            acc[8 * q] += cc[j] * b0[0]; acc[8 * q + 1] += cc[j] * b0[1]; acc[8 * q + 2] += cc[j] * b1[0]; acc[8 * q + 3] += cc[j] * b1[1];
            acc[8 * q + 4] += cc[j] * b2[0]; acc[8 * q + 5] += cc[j] * b2[1]; acc[8 * q + 6] += cc[j] * b3[0]; acc[8 * q + 7] += cc[j] * b3[1];
        }
        __builtin_amdgcn_sched_barrier(0);
    }
}
__device__ __forceinline__ void ph_peer_v5(unsigned char* shm, const Part pt, const float* X1, float* X2, const u8* __restrict__ V4, const unsigned short* __restrict__ E16, const bf16* __restrict__ CFH, float* __restrict__ SS) {
    const int wv = threadIdx.x >> 6;
    const int rank = pt.rank, nrank = pt.nrank, gstep = nrank * 8;
    for (int p = pt.p0; p < 4; p += pt.pstep) {
        int g = rank * 8 + wv;
        if (g >= T / 8) continue;
        uint4 pe0, pe1, pf0, pf1;
        { const int l0 = threadIdx.x & 63; const size_t o = (size_t)(g * 8 + (l0 >> 3)) * 128 + (l0 & 7) * 16;
          pe0 = *(const uint4*)(E16 + o); pe1 = *(const uint4*)(E16 + o + 8); pf0 = *(const uint4*)(CFH + o); pf1 = *(const uint4*)(CFH + o + 8); }
#pragma unroll 1
        for (; g < T / 8; g += gstep) {
            const int lane = opq((int)threadIdx.x) & 63, tk = lane >> 3, pc = lane & 7;
            unsigned short* le = (unsigned short*)(shm + wv * 4096) + tk * 128; bf16* lc = (bf16*)(shm + wv * 4096 + 2048) + tk * 128;
            const u8* vb = V4 + p * 128 + pc * 16;
            const int t = g * 8 + tk;
            __builtin_amdgcn_wave_barrier();
            *(uint4*)(le + pc * 16) = pe0; *(uint4*)(le + pc * 16 + 8) = pe1; *(uint4*)(lc + pc * 16) = pf0; *(uint4*)(lc + pc * 16 + 8) = pf1;
            asm volatile("s_waitcnt lgkmcnt(0)" ::: "memory"); __builtin_amdgcn_wave_barrier();
            float acc[32];
#pragma unroll
            for (int i = 0; i < 32; ++i) acc[i] = 0.f;
            if (g + gstep < T / 8) { const size_t o = (size_t)((g + gstep) * 8 + tk) * 128 + pc * 16;
                pe0 = *(const uint4*)(E16 + o); pe1 = *(const uint4*)(E16 + o + 8); pf0 = *(const uint4*)(CFH + o); pf1 = *(const uint4*)(CFH + o + 8); }
            uint4 rA[4], rB[4]; float cA[4], cB[4];
            pv4_issue(rA, cA, vb, le, lc, 0);
#pragma unroll 1
            for (int k0 = 0; k0 < 128; k0 += 8) {
                pv4_issue(rB, cB, vb, le, lc, k0 + 4);
                pv4_fma(acc, rA, cA);
                if (k0 + 8 < 128) pv4_issue(rA, cA, vb, le, lc, k0 + 8);
                pv4_fma(acc, rB, cB);
            }
            float ss = 0.f;
            { const float* xr = X1 + (size_t)t * D + p * 256 + pc * 32; float* orow = X2 + (size_t)t * D + p * 256 + pc * 32;
#pragma unroll
              for (int i = 0; i < 8; ++i) { const float4 v = ((const float4*)xr)[i]; const float a = acc[4 * i] + v.x, b = acc[4 * i + 1] + v.y, c = acc[4 * i + 2] + v.z, d = acc[4 * i + 3] + v.w;
                  ss += a * a + b * b + c * c + d * d; ((float4*)orow)[i] = make_float4(a, b, c, d); } }
            ss += __shfl_xor(ss, 1, 64); ss += __shfl_xor(ss, 2, 64); ss += __shfl_xor(ss, 4, 64);
            if (pc == 0) { SS[(size_t)t * 8 + p] = ss; SS[(size_t)t * 8 + 4 + p] = 0.f; }
        }
    }
}

__device__ __forceinline__ unsigned pack4_i8(float a, float b, float c, float d) {
    const int ia = (int)rintf(a), ib = (int)rintf(b), ic = (int)rintf(c), id = (int)rintf(d);
    return (unsigned)(ia & 0xFF) | ((unsigned)(ib & 0xFF) << 8) | ((unsigned)(ic & 0xFF) << 16) | ((unsigned)(id & 0xFF) << 24);
}
__device__ __forceinline__ void ph_cvt_i8(int bid, int nblk, const float* __restrict__ src, u8* __restrict__ dst, float* __restrict__ scale, int rows) {
    const int tid_ = opq((int)threadIdx.x), wave = (bid * 512 + tid_) >> 6, nw = (nblk * 512) >> 6, lane = tid_ & 63;
    float4 nx[4];
    if (wave < rows) {
#pragma unroll
        for (int i = 0; i < 4; ++i) nx[i] = ((const float4*)(src + (size_t)wave * 1024))[lane + 64 * i];
    }
    for (int r = wave; r < rows; r += nw) {
        float4 v[4]; float mx = 0.f;
#pragma unroll
        for (int i = 0; i < 4; ++i) v[i] = nx[i];
        if (r + nw < rows) {
#pragma unroll
            for (int i = 0; i < 4; ++i) nx[i] = ((const float4*)(src + (size_t)(r + nw) * 1024))[lane + 64 * i];
        }
#pragma unroll
        for (int i = 0; i < 4; ++i) mx = fmaxf(mx, fmaxf(fmaxf(fabsf(v[i].x), fabsf(v[i].y)), fmaxf(fabsf(v[i].z), fabsf(v[i].w))));
        mx = wave_max(mx);
        const float sc = fmaxf(mx, 1e-30f) * (1.f / 127.f), inv = 1.f / sc;
#pragma unroll
        for (int i = 0; i < 4; ++i) ((unsigned*)(dst + (size_t)r * 1024))[lane + 64 * i] = pack4_i8(v[i].x * inv, v[i].y * inv, v[i].z * inv, v[i].w * inv);
        if (lane == 0) scale[r] = sc;
    }
}
__device__ __forceinline__ void ph_rowstat(int bid, int nblk, const bf16* __restrict__ x, const float* __restrict__ g, u8* __restrict__ h8, float* __restrict__ hs, float* __restrict__ scl, int rows) {
    const int tid_ = opq((int)threadIdx.x), wave = (bid * 512 + tid_) >> 6, nw = (nblk * 512) >> 6, lane = tid_ & 63;
    float4 gg[4]; uint2 nx[4];
#pragma unroll
    for (int i = 0; i < 4; ++i) gg[i] = ((const float4*)g)[lane + 64 * i];
    if (wave < rows) {
#pragma unroll
        for (int i = 0; i < 4; ++i) nx[i] = ((const uint2*)(x + (size_t)wave * D))[lane + 64 * i];
    }
    for (int r = wave; r < rows; r += nw) {
        float4 v[4]; float ss = 0.f;
#pragma unroll
        for (int i = 0; i < 4; ++i) v[i] = make_float4(bflo(nx[i].x), bfhi(nx[i].x), bflo(nx[i].y), bfhi(nx[i].y));
        if (r + nw < rows) {
#pragma unroll
            for (int i = 0; i < 4; ++i) nx[i] = ((const uint2*)(x + (size_t)(r + nw) * D))[lane + 64 * i];
        }
#pragma unroll
        for (int i = 0; i < 4; ++i) ss += v[i].x * v[i].x + v[i].y * v[i].y + v[i].z * v[i].z + v[i].w * v[i].w;
        const float sc = rsqrtf(wave_sum(ss) * (1.f / D) + 1e-6f);
        float mx = 0.f;
#pragma unroll
        for (int i = 0; i < 4; ++i) {
            v[i].x *= sc * gg[i].x; v[i].y *= sc * gg[i].y; v[i].z *= sc * gg[i].z; v[i].w *= sc * gg[i].w;
            mx = fmaxf(mx, fmaxf(fmaxf(fabsf(v[i].x), fabsf(v[i].y)), fmaxf(fabsf(v[i].z), fabsf(v[i].w)))); }
        mx = wave_max(mx);
        const float hsc = fmaxf(mx, 1e-30f) * (1.f / 119.f), inv = 1.f / hsc;
#pragma unroll
        for (int i = 0; i < 4; ++i) ((unsigned*)(h8 + (size_t)r * D))[lane + 64 * i] = pack4_i8(v[i].x * inv, v[i].y * inv, v[i].z * inv, v[i].w * inv);
        if (lane == 0) { hs[r] = hsc; scl[r] = sc; }
    }
}
__device__ __forceinline__ float pw_dot8_i8(const uint4 (&r)[8], const uint4 hq, int pc) {
    int d[8];
#pragma unroll
    for (int j = 0; j < 8; ++j) {
        int s = __builtin_amdgcn_sdot4((int)r[j].x, (int)hq.x, 0, false);
        s = __builtin_amdgcn_sdot4((int)r[j].y, (int)hq.y, s, false); s = __builtin_amdgcn_sdot4((int)r[j].z, (int)hq.z, s, false); s = __builtin_amdgcn_sdot4((int)r[j].w, (int)hq.w, s, false);
        d[j] = s;
    }
    int e4[4], e2[2];
#pragma unroll
    for (int j = 0; j < 4; ++j) { const int snd = (pc & 4) ? d[j] : d[j + 4], kp = (pc & 4) ? d[j + 4] : d[j]; e4[j] = kp + __shfl_xor(snd, 4, 64); }
#pragma unroll
    for (int j = 0; j < 2; ++j) { const int snd = (pc & 2) ? e4[j] : e4[j + 2], kp = (pc & 2) ? e4[j + 2] : e4[j]; e2[j] = kp + __shfl_xor(snd, 2, 64); }
    { const int snd = (pc & 1) ? e2[0] : e2[1], kp = (pc & 1) ? e2[1] : e2[0]; return (float)(kp + __shfl_xor(snd, 1, 64)); }
}
__device__ __forceinline__ void ph_peer_u6(unsigned char* shm, const Part pt, const u8* __restrict__ H8, const float* __restrict__ HS, const u8* __restrict__ U8, const int* __restrict__ EID, float* __restrict__ PART) {
    const int wv = threadIdx.x >> 6;
    const int rank = pt.rank, nrank = pt.nrank, gstep = nrank * 8;
    for (int p = pt.p0; p < 8; p += pt.pstep) {
        int g = rank * 8 + wv;
        if (g >= T / 8) continue;
        int4 pe0, pe1, pe2, pe3;
        { const int l0 = threadIdx.x & 63; const int* er = EID + (size_t)(g * 8 + (l0 >> 3)) * 128 + (l0 & 7) * 16;
          pe0 = *(const int4*)(er); pe1 = *(const int4*)(er + 4); pe2 = *(const int4*)(er + 8); pe3 = *(const int4*)(er + 12); }
#pragma unroll 1
        for (; g < T / 8; g += gstep) {
            const int lane = opq((int)threadIdx.x) & 63, tk = lane >> 3, pc = lane & 7;
            int* le = (int*)shm + wv * 1024 + tk * 128;
            const u8* ub = U8 + p * 128 + pc * 16;
            const int t = g * 8 + tk;
            __builtin_amdgcn_wave_barrier();
            *(int4*)(le + pc * 16) = pe0; *(int4*)(le + pc * 16 + 4) = pe1; *(int4*)(le + pc * 16 + 8) = pe2; *(int4*)(le + pc * 16 + 12) = pe3;
            asm volatile("s_waitcnt lgkmcnt(0)" ::: "memory"); __builtin_amdgcn_wave_barrier();
            const uint4 hq = *(const uint4*)(H8 + (size_t)t * 1024 + p * 128 + pc * 16);
            const float hsc = HS[t];
            if (g + gstep < T / 8) { const int* er = EID + (size_t)((g + gstep) * 8 + tk) * 128 + pc * 16;
                pe0 = *(const int4*)(er); pe1 = *(const int4*)(er + 4); pe2 = *(const int4*)(er + 8); pe3 = *(const int4*)(er + 12); }
            float* prow = PART + ((size_t)p * T + t) * 128 + pc;
            uint4 rA[8], rB[8];
            pw_issue(rA, ub, le, 0);
#pragma unroll 1
            for (int k0 = 0; k0 < 128; k0 += 16) {
                pw_issue(rB, ub, le, k0 + 8);
                prow[k0] = pw_dot8_i8(rA, hq, pc) * hsc;
                if (k0 + 16 < 128) pw_issue(rA, ub, le, k0 + 16);
                prow[k0 + 8] = pw_dot8_i8(rB, hq, pc) * hsc;
            }
        }
    }
}

__device__ __forceinline__ void ph_peer_cf3(int bid, int nblk, const float* __restrict__ PART, const float* __restrict__ USC, const float* __restrict__ VSC, const int* __restrict__ EID, const float* __restrict__ GATE,
                                            unsigned short* __restrict__ E16, unsigned* __restrict__ CFQ, float* __restrict__ CS, int npart) {
    const int tid_ = opq((int)threadIdx.x);
    for (size_t i = (size_t)bid * 512 + tid_; i < (size_t)T * 128 / 4; i += (size_t)nblk * 512) {
        float4 s = ((const float4*)PART)[i];
#pragma unroll 1
        for (int p = 1; p < npart; ++p) { const float4 v = ((const float4*)(PART + (size_t)p * T * 128))[i]; s.x += v.x; s.y += v.y; s.z += v.z; s.w += v.w; }
        const int4 e = ((const int4*)EID)[i]; const float4 g = ((const float4*)GATE)[i];
        const float ox = g.x * VSC[e.x] * gelu_erf(s.x * USC[e.x]), oy = g.y * VSC[e.y] * gelu_erf(s.y * USC[e.y]), oz = g.z * VSC[e.z] * gelu_erf(s.z * USC[e.z]), ow = g.w * VSC[e.w] * gelu_erf(s.w * USC[e.w]);
        float m = fmaxf(fmaxf(fabsf(ox), fabsf(oy)), fmaxf(fabsf(oz), fabsf(ow)));
#pragma unroll
        for (int o = 1; o < 32; o <<= 1) m = fmaxf(m, __shfl_xor(m, o, 64));
        const float cs = fmaxf(m, 1e-30f) * (1.f / 127.f), inv = 1.f / cs;
        CFQ[i] = pack4_i8(ox * inv, oy * inv, oz * inv, ow * inv);
        ((uint2*)E16)[i] = make_uint2((unsigned)e.x | ((unsigned)e.y << 16), (unsigned)e.z | ((unsigned)e.w << 16));
        if ((i & 31) == 0) CS[i >> 5] = cs;
    }
}
__device__ __forceinline__ void pv6_issue(uint4 (&r)[8], uint2& cq, const u8* vb, const unsigned short* le, const unsigned* lq, int k0) {
    const uint4 e8 = *(const uint4*)(le + k0); cq = *(const uint2*)(lq + (k0 >> 2));
    const unsigned ew[4] = {e8.x, e8.y, e8.z, e8.w};
#pragma unroll
    for (int q = 0; q < 4; ++q) { r[2 * q] = *(const uint4*)(vb + (size_t)(ew[q] & 0xFFFFu) * 1024); r[2 * q + 1] = *(const uint4*)(vb + (size_t)(ew[q] >> 16) * 1024); }
}
__device__ __forceinline__ void pv6_quad(int (&acc)[16], const uint4& a, const uint4& b, const uint4& c, const uint4& d, unsigned cf4) {
    const unsigned aw[4] = {a.x, a.y, a.z, a.w}, bw[4] = {b.x, b.y, b.z, b.w}, cw[4] = {c.x, c.y, c.z, c.w}, dw[4] = {d.x, d.y, d.z, d.w};
#pragma unroll
    for (int q = 0; q < 4; ++q) {
        const unsigned t0 = __builtin_amdgcn_perm(bw[q], aw[q], 0x05010400u), t1 = __builtin_amdgcn_perm(bw[q], aw[q], 0x07030602u);
        const unsigned t2 = __builtin_amdgcn_perm(dw[q], cw[q], 0x05010400u), t3 = __builtin_amdgcn_perm(dw[q], cw[q], 0x07030602u);
        const unsigned c0 = __builtin_amdgcn_perm(t2, t0, 0x05040100u), c1 = __builtin_amdgcn_perm(t2, t0, 0x07060302u);
        const unsigned c2 = __builtin_amdgcn_perm(t3, t1, 0x05040100u), c3 = __builtin_amdgcn_perm(t3, t1, 0x07060302u);
        acc[4 * q] = __builtin_amdgcn_sdot4((int)c0, (int)cf4, acc[4 * q], false); acc[4 * q + 1] = __builtin_amdgcn_sdot4((int)c1, (int)cf4, acc[4 * q + 1], false);
        acc[4 * q + 2] = __builtin_amdgcn_sdot4((int)c2, (int)cf4, acc[4 * q + 2], false); acc[4 * q + 3] = __builtin_amdgcn_sdot4((int)c3, (int)cf4, acc[4 * q + 3], false);
    }
}
__device__ __forceinline__ void ph_peer_v6(unsigned char* shm, const Part pt, const bf16* X1, bf16* X2, const u8* __restrict__ V8, const unsigned short* __restrict__ E16, const unsigned* __restrict__ CFQ,
                                           const float* __restrict__ CS, float* __restrict__ SS) {
    const int wv = threadIdx.x >> 6;
    const int rank = pt.rank, nrank = pt.nrank, gstep = nrank * 8;
    for (int p = pt.p0; p < 8; p += pt.pstep) {
        int g = rank * 8 + wv;
        if (g >= T / 8) continue;
        uint4 pe0, pe1, pq0;
        { const int l0 = threadIdx.x & 63; const size_t o = (size_t)(g * 8 + (l0 >> 3)) * 128 + (l0 & 7) * 16;
          pe0 = *(const uint4*)(E16 + o); pe1 = *(const uint4*)(E16 + o + 8); pq0 = *(const uint4*)(CFQ + (o >> 2)); }
#pragma unroll 1
        for (; g < T / 8; g += gstep) {
            const int lane = opq((int)threadIdx.x) & 63, tk = lane >> 3, pc = lane & 7;
            unsigned short* le = (unsigned short*)(shm + wv * 3072) + tk * 128; unsigned* lq = (unsigned*)(shm + wv * 3072 + 2048) + tk * 32;
            const u8* vb = V8 + p * 128 + pc * 16;
            const int t = g * 8 + tk;
            __builtin_amdgcn_wave_barrier();
            *(uint4*)(le + pc * 16) = pe0; *(uint4*)(le + pc * 16 + 8) = pe1; *(uint4*)(lq + pc * 4) = pq0;
            asm volatile("s_waitcnt lgkmcnt(0)" ::: "memory"); __builtin_amdgcn_wave_barrier();
            const float cs = CS[t];
            const uint4 xv0 = *(const uint4*)(X1 + (size_t)t * D + p * 128 + pc * 16), xv1 = *(const uint4*)(X1 + (size_t)t * D + p * 128 + pc * 16 + 8);
            int acc[16];
#pragma unroll
            for (int i = 0; i < 16; ++i) acc[i] = 0;
            if (g + gstep < T / 8) { const size_t o = (size_t)((g + gstep) * 8 + tk) * 128 + pc * 16;
                pe0 = *(const uint4*)(E16 + o); pe1 = *(const uint4*)(E16 + o + 8); pq0 = *(const uint4*)(CFQ + (o >> 2)); }
            uint4 rA[8], rB[8]; uint2 qA, qB;
            pv6_issue(rA, qA, vb, le, lq, 0);
#pragma unroll 1
            for (int k0 = 0; k0 < 112; k0 += 16) {
                pv6_issue(rB, qB, vb, le, lq, k0 + 8);
                pv6_quad(acc, rA[0], rA[1], rA[2], rA[3], qA.x); pv6_quad(acc, rA[4], rA[5], rA[6], rA[7], qA.y);
                pv6_issue(rA, qA, vb, le, lq, k0 + 16);
                pv6_quad(acc, rB[0], rB[1], rB[2], rB[3], qB.x); pv6_quad(acc, rB[4], rB[5], rB[6], rB[7], qB.y);
            }
            pv6_issue(rB, qB, vb, le, lq, 120);
            pv6_quad(acc, rA[0], rA[1], rA[2], rA[3], qA.x); pv6_quad(acc, rA[4], rA[5], rA[6], rA[7], qA.y);
            pv6_quad(acc, rB[0], rB[1], rB[2], rB[3], qB.x); pv6_quad(acc, rB[4], rB[5], rB[6], rB[7], qB.y);
            float ss = 0.f;
            { bf16* orow = X2 + (size_t)t * D + p * 128 + pc * 16;
              const unsigned xw[8] = {xv0.x, xv0.y, xv0.z, xv0.w, xv1.x, xv1.y, xv1.z, xv1.w}; unsigned ow[8];
#pragma unroll
              for (int i = 0; i < 8; ++i) { const float a = (float)acc[2 * i] * cs + bflo(xw[i]), b = (float)acc[2 * i + 1] * cs + bfhi(xw[i]); ss += a * a + b * b; ow[i] = pack2(a, b); }
              *(uint4*)orow = make_uint4(ow[0], ow[1], ow[2], ow[3]); *(uint4*)(orow + 8) = make_uint4(ow[4], ow[5], ow[6], ow[7]); }
            ss += __shfl_xor(ss, 1, 64); ss += __shfl_xor(ss, 2, 64); ss += __shfl_xor(ss, 4, 64);
            if (pc == 0) SS[(size_t)t * 8 + p] = ss;
        }
    }
}

__device__ __forceinline__ void ph_cvt_i4(int bid, int nblk, const float* __restrict__ src, u8* __restrict__ dst, float* __restrict__ scale, int rows) {
    const int tid_ = opq((int)threadIdx.x), wave = (bid * 512 + tid_) >> 6, nw = (nblk * 512) >> 6, lane = tid_ & 63;
    for (int r = wave; r < rows; r += nw) {
        const float4* xr = (const float4*)(src + (size_t)r * 1024 + lane * 16);
        float4 v[4]; float ss = 0.f;
#pragma unroll
        for (int i = 0; i < 4; ++i) { v[i] = xr[i]; ss += v[i].x * v[i].x + v[i].y * v[i].y + v[i].z * v[i].z + v[i].w * v[i].w; }
        ss = wave_sum(ss);
        const float sc = fmaxf(sqrtf(ss * (1.f / 1024.f)), 1e-30f) * 0.3352f, inv = 1.f / sc;
        unsigned w[2] = {0u, 0u};
#pragma unroll
        for (int i = 0; i < 4; ++i) {
            const float f[4] = {v[i].x, v[i].y, v[i].z, v[i].w};
#pragma unroll
            for (int j = 0; j < 4; ++j) { const int q = (int)fminf(fmaxf(rintf(f[j] * inv), -8.f), 7.f) & 15; w[i >> 1] |= (unsigned)q << (4 * ((i & 1) * 4 + j)); }
        }
        *(uint2*)(dst + (size_t)r * 512 + lane * 8) = make_uint2(w[0], w[1]);
        if (lane == 0) scale[r] = sc;
    }
}
__device__ __forceinline__ void pw4_issue(uint4 (&r)[8], const u8* ub, const int* le, int k0) {
#pragma unroll
    for (int q = 0; q < 2; ++q) { const int4 e4 = *(const int4*)(le + k0 + 4 * q);
        r[4 * q] = *(const uint4*)(ub + (size_t)e4.x * 512); r[4 * q + 1] = *(const uint4*)(ub + (size_t)e4.y * 512); r[4 * q + 2] = *(const uint4*)(ub + (size_t)e4.z * 512); r[4 * q + 3] = *(const uint4*)(ub + (size_t)e4.w * 512); }
}
__device__ __forceinline__ float pw_dot8_i4(const uint4 (&r)[8], const unsigned (&he)[4], const unsigned (&ho)[4], int hsum8, int pc) {
    int d[8];
#pragma unroll
    for (int j = 0; j < 8; ++j) {
        const unsigned w[4] = {r[j].x, r[j].y, r[j].z, r[j].w};
        int s = -hsum8;
#pragma unroll
        for (int q = 0; q < 4; ++q) { s = __builtin_amdgcn_sdot4((int)(w[q] & 0x0F0F0F0Fu), (int)he[q], s, false); s = __builtin_amdgcn_sdot4((int)((w[q] >> 4) & 0x0F0F0F0Fu), (int)ho[q], s, false); }
        d[j] = s;
    }
    int e4[4], e2[2];
#pragma unroll
    for (int j = 0; j < 4; ++j) { const int snd = (pc & 4) ? d[j] : d[j + 4], kp = (pc & 4) ? d[j + 4] : d[j]; e4[j] = kp + __shfl_xor(snd, 4, 64); }
#pragma unroll
    for (int j = 0; j < 2; ++j) { const int snd = (pc & 2) ? e4[j] : e4[j + 2], kp = (pc & 2) ? e4[j + 2] : e4[j]; e2[j] = kp + __shfl_xor(snd, 2, 64); }
    { const int snd = (pc & 1) ? e2[0] : e2[1], kp = (pc & 1) ? e2[1] : e2[0]; return (float)(kp + __shfl_xor(snd, 1, 64)); }
}
__device__ __forceinline__ float pw_dot8_n4(const uint4 (&r)[8], const unsigned (&hA)[4], const unsigned (&hB)[4], int pc) {
    int d[8];
#pragma unroll
    for (int j = 0; j < 8; ++j) {
        const unsigned w[4] = {r[j].x, r[j].y, r[j].z, r[j].w};
        int hi = 0, lo = 0;
#pragma unroll
        for (int q = 0; q < 4; ++q) { hi = __builtin_amdgcn_sdot8((int)w[q], (int)hA[q], hi, false); lo = __builtin_amdgcn_sdot8((int)w[q], (int)hB[q], lo, false); }
        d[j] = hi * 16 + lo;
    }
    int e4[4], e2[2];
#pragma unroll
    for (int j = 0; j < 4; ++j) { const int snd = (pc & 4) ? d[j] : d[j + 4], kp = (pc & 4) ? d[j + 4] : d[j]; e4[j] = kp + __shfl_xor(snd, 4, 64); }
#pragma unroll
    for (int j = 0; j < 2; ++j) { const int snd = (pc & 2) ? e4[j] : e4[j + 2], kp = (pc & 2) ? e4[j + 2] : e4[j]; e2[j] = kp + __shfl_xor(snd, 2, 64); }
    { const int snd = (pc & 1) ? e2[0] : e2[1], kp = (pc & 1) ? e2[1] : e2[0]; return (float)(kp + __shfl_xor(snd, 1, 64)); }
}
__device__ __forceinline__ unsigned nib_compact4(unsigned x) { const unsigned y = (x | (x >> 4)) & 0x00FF00FFu; return (y | (y >> 8)) & 0xFFFFu; }
__device__ __forceinline__ void ph_peer_u7(unsigned char* shm, const Part pt, const u8* __restrict__ H8, const float* __restrict__ HS, const u8* __restrict__ U4, const int* __restrict__ EID, float* __restrict__ PART) {
    const int wv = threadIdx.x >> 6;
    const int rank = pt.rank, nrank = pt.nrank, gstep = nrank * 8;
    for (int p = pt.p0; p < 4; p += pt.pstep) {
        int g = rank * 8 + wv;
        if (g >= T / 8) continue;
        int4 pe0, pe1, pe2, pe3;
        { const int l0 = threadIdx.x & 63; const int* er = EID + (size_t)(g * 8 + (l0 >> 3)) * 128 + (l0 & 7) * 16;
          pe0 = *(const int4*)(er); pe1 = *(const int4*)(er + 4); pe2 = *(const int4*)(er + 8); pe3 = *(const int4*)(er + 12); }
#pragma unroll 1
        for (; g < T / 8; g += gstep) {
            const int lane = opq((int)threadIdx.x) & 63, tk = lane >> 3, pc = lane & 7;
            int* le = (int*)shm + wv * 1024 + tk * 128;
            const u8* ub = U4 + p * 128 + pc * 16;
            const int t = g * 8 + tk;
            __builtin_amdgcn_wave_barrier();
            *(int4*)(le + pc * 16) = pe0; *(int4*)(le + pc * 16 + 4) = pe1; *(int4*)(le + pc * 16 + 8) = pe2; *(int4*)(le + pc * 16 + 12) = pe3;
            asm volatile("s_waitcnt lgkmcnt(0)" ::: "memory"); __builtin_amdgcn_wave_barrier();
            const uint4 ha = *(const uint4*)(H8 + (size_t)t * 1024 + p * 256 + pc * 32), hb = *(const uint4*)(H8 + (size_t)t * 1024 + p * 256 + pc * 32 + 16);
            const unsigned hw[8] = {ha.x, ha.y, ha.z, ha.w, hb.x, hb.y, hb.z, hb.w};
            unsigned hA[4], hB[4];
#pragma unroll
            for (int q = 0; q < 4; ++q) {
                unsigned pa[2], pb[2];
#pragma unroll
                for (int e = 0; e < 2; ++e) { const unsigned w = hw[2 * q + e];
                    const unsigned t8 = ((w & 0x7F7F7F7Fu) + 0x08080808u) ^ (w & 0x80808080u);
                    pa[e] = nib_compact4((t8 >> 4) & 0x0F0F0F0Fu); pb[e] = nib_compact4(w & 0x0F0F0F0Fu); }
                hA[q] = pa[0] | (pa[1] << 16); hB[q] = pb[0] | (pb[1] << 16);
            }
            const float hsc = HS[t];
            if (g + gstep < T / 8) { const int* er = EID + (size_t)((g + gstep) * 8 + tk) * 128 + pc * 16;
                pe0 = *(const int4*)(er); pe1 = *(const int4*)(er + 4); pe2 = *(const int4*)(er + 8); pe3 = *(const int4*)(er + 12); }
            float* prow = PART + ((size_t)p * T + t) * 128 + pc;
            uint4 rA[8], rB[8];
            pw4_issue(rA, ub, le, 0);
#pragma unroll 1
            for (int k0 = 0; k0 < 112; k0 += 16) {
                pw4_issue(rB, ub, le, k0 + 8);
                prow[k0] = pw_dot8_n4(rA, hA, hB, pc) * hsc;
                pw4_issue(rA, ub, le, k0 + 16);
                prow[k0 + 8] = pw_dot8_n4(rB, hA, hB, pc) * hsc;
            }
            pw4_issue(rB, ub, le, 120);
            prow[112] = pw_dot8_n4(rA, hA, hB, pc) * hsc;
            prow[120] = pw_dot8_n4(rB, hA, hB, pc) * hsc;
        }
    }
}

constexpr int C2_SLOT = 16384, C2_RING = 8, C2_SBUF = C2_RING * C2_SLOT;
__device__ __forceinline__ void chain2_dma(unsigned char* shm, int slot, const bf16* __restrict__ PHI, const bf16* __restrict__ PSI, size_t item, int w, int lane) {
    const bf16* src[2] = {PHI + item, PSI + item};
#pragma unroll
    for (int m = 0; m < 2; ++m)
#pragma unroll
        for (int i = 0; i < 2; ++i) {
            const int row = (w * 2 + i) * 8 + (lane >> 3), jj = (lane & 7) ^ (row & 7);
            __builtin_amdgcn_global_load_lds((const unsigned*)((const char*)src[m] + row * 128 + jj * 16),
                                             (PG8_LAS unsigned*)(shm + slot * C2_SLOT + m * 8192 + (w * 2 + i) * 1024), 16, 0, 0);
        }
}
__device__ __forceinline__ void ph_chain2(unsigned char* shm, int bh, bf16* __restrict__ PHI, const bf16* __restrict__ PSI) {
    const int b = bh >> 3, h = bh & 7, tid = threadIdx.x, lane = tid & 63, w = __builtin_amdgcn_readfirstlane((tid >> 6) & 3), fr = lane & 15, fq = lane >> 4;
    const size_t ib = ((size_t)(b * 64) * 8 + h) * 4096, istep = (size_t)8 * 4096;
#define CH_BAR() do { asm volatile("s_waitcnt lgkmcnt(0)" ::: "memory"); __builtin_amdgcn_s_barrier(); asm volatile("" ::: "memory"); } while (0)
    if (tid < 256) {
        pg8::bf16x8 sf[2];
#pragma unroll
        for (int j = 0; j < 8; ++j) { sf[0][j] = 0; sf[1][j] = 0; }
#pragma unroll
        for (int c = 0; c < 7; ++c) chain2_dma(shm, c, PHI, PSI, ib + (size_t)c * istep, w, lane);
#pragma unroll 1
        for (int ch = 0; ch < 64; ++ch) {
            asm volatile("s_waitcnt vmcnt(24)" ::: "memory");
            CH_BAR();
            chain2_dma(shm, (ch + 7) & 7, PHI, PSI, ib + (size_t)((ch + 7 < 64) ? ch + 7 : 63) * istep, w, lane);
            const unsigned char* sl = shm + (ch & 7) * C2_SLOT;
            f32x4 sa[4]; pg8::bf16x8 ap[4][2];
#pragma unroll
            for (int mt = 0; mt < 4; ++mt) {
                const int row = w * 16 + fr, sw = (((mt * 2 + (fq >> 1)) ^ (row & 7)) * 16) + (fq & 1) * 8;
                const uint2 ps = *(const uint2*)(sl + 8192 + row * 128 + sw);
                sa[mt][0] = bflo(ps.x); sa[mt][1] = bfhi(ps.x); sa[mt][2] = bflo(ps.y); sa[mt][3] = bfhi(ps.y);
#pragma unroll
                for (int ks = 0; ks < 2; ++ks) { const int ar = mt * 16 + fr; ap[mt][ks] = *(const pg8::bf16x8*)(sl + ar * 128 + (((ks * 4 + fq) ^ (ar & 7)) * 16)); }
            }
#pragma unroll
            for (int ks = 0; ks < 2; ++ks)
#pragma unroll
                for (int mt = 0; mt < 4; ++mt) sa[mt] = __builtin_amdgcn_mfma_f32_16x16x32_bf16(ap[mt][ks], sf[ks], sa[mt], 0, 0, 0);
            uint4 o0, o1;
            o0.x = pack2(sa[0][0], sa[0][1]); o0.y = pack2(sa[0][2], sa[0][3]); o0.z = pack2(sa[1][0], sa[1][1]); o0.w = pack2(sa[1][2], sa[1][3]);
            o1.x = pack2(sa[2][0], sa[2][1]); o1.y = pack2(sa[2][2], sa[2][3]); o1.z = pack2(sa[3][0], sa[3][1]); o1.w = pack2(sa[3][2], sa[3][3]);
            sf[0] = __builtin_bit_cast(pg8::bf16x8, o0); sf[1] = __builtin_bit_cast(pg8::bf16x8, o1);
            unsigned char* sb = shm + C2_SBUF + (ch & 1) * 8192 + w * 2048 + lane * 32;
            *(uint4*)sb = o0; *(uint4*)(sb + 16) = o1;
        }
        asm volatile("s_waitcnt vmcnt(0)" ::: "memory");
        CH_BAR();
    } else {
        CH_BAR();
#pragma unroll 1
        for (int ch = 1; ch < 64; ++ch) {
            CH_BAR();
            const unsigned char* sb = shm + C2_SBUF + ((ch - 1) & 1) * 8192 + w * 2048 + lane * 32;
            const uint4 a = *(const uint4*)sb, c = *(const uint4*)(sb + 16);
            bf16* dst = PHI + ib + (size_t)(ch - 1) * istep + w * 1024 + lane * 16;
            *(uint4*)dst = a; *(uint4*)(dst + 8) = c;
        }
        CH_BAR();
    }
#undef CH_BAR
    __syncthreads();
}

struct YoPre { uint4 s0, s1, a[2][2]; uint2 y0[2]; uint4 vv, gg; float bon; };
__device__ __forceinline__ void yout_load(YoPre& P, int it, const bf16* __restrict__ SPHI, const bf16* __restrict__ OMG, const bf16* __restrict__ Y0, const bf16* __restrict__ V, const bf16* __restrict__ G, const float* __restrict__ BONUS, int tid) {
    const int lane = tid & 63, wv = tid >> 6, vg = wv & 3, mh = wv >> 2, fr = lane & 15, fq = lane >> 4;
    const int ch = (it >> 3) & 63, h = it & 7, b = it >> 9;
    P.s0 = make_uint4(0, 0, 0, 0); P.s1 = make_uint4(0, 0, 0, 0);
    if (ch > 0) { const bf16* sp = SPHI + (size_t)(it - 8) * 4096 + vg * 1024 + lane * 16; P.s0 = *(const uint4*)sp; P.s1 = *(const uint4*)(sp + 8); }
#pragma unroll
    for (int q = 0; q < 2; ++q) { const int mt = mh * 2 + q;
        P.y0[q] = *(const uint2*)(Y0 + (size_t)it * 4096 + (vg * 16 + fr) * 64 + mt * 16 + 4 * fq);
#pragma unroll
        for (int ks = 0; ks < 2; ++ks) P.a[q][ks] = *(const uint4*)(OMG + (size_t)it * 4096 + (mt * 16 + fr) * 64 + ks * 32 + fq * 8); }
    const int et = tid >> 3, eq = tid & 7; const int t = b * SEQ + ch * 64 + et; const size_t o = (size_t)t * 512 + h * 64 + eq * 8;
    P.vv = *(const uint4*)(V + o); P.gg = *(const uint4*)(G + o); P.bon = BONUS[(size_t)t * 8 + h];
}
__device__ __forceinline__ void ph_yout(unsigned char* shm, int bid, int nblk, const bf16* __restrict__ SPHI, const bf16* __restrict__ OMG, const bf16* __restrict__ Y0, const bf16* __restrict__ V, const bf16* __restrict__ G,
                                        const float* __restrict__ BONUS, const float* __restrict__ gng, const float* __restrict__ gnb, bf16* __restrict__ O) {
    if (bid >= 2048) return;
    YoPre P, Q;
    yout_load(P, bid, SPHI, OMG, Y0, V, G, BONUS, threadIdx.x);
    if (bid + nblk < 2048) yout_load(Q, bid + nblk, SPHI, OMG, Y0, V, G, BONUS, threadIdx.x);
    int par = 0;
    for (int it = bid; it < 2048; it += nblk, par ^= 1) {
        const int tid = opq((int)threadIdx.x), lane = tid & 63, wv = tid >> 6, vg = wv & 3, mh = wv >> 2, fr = lane & 15, fq = lane >> 4;
        const int ch = (it >> 3) & 63, h = it & 7, b = it >> 9;
        bf16* yb = (bf16*)(shm + par * (64 * 72 * 2));
        const pg8::bf16x8 sf0 = __builtin_bit_cast(pg8::bf16x8, P.s0), sf1 = __builtin_bit_cast(pg8::bf16x8, P.s1);
#pragma unroll
        for (int q = 0; q < 2; ++q) { const int mt = mh * 2 + q;
            f32x4 ya; ya[0] = bflo(P.y0[q].x); ya[1] = bfhi(P.y0[q].x); ya[2] = bflo(P.y0[q].y); ya[3] = bfhi(P.y0[q].y);
            ya = __builtin_amdgcn_mfma_f32_16x16x32_bf16(__builtin_bit_cast(pg8::bf16x8, P.a[q][0]), sf0, ya, 0, 0, 0);
            ya = __builtin_amdgcn_mfma_f32_16x16x32_bf16(__builtin_bit_cast(pg8::bf16x8, P.a[q][1]), sf1, ya, 0, 0, 0);
#pragma unroll
            for (int r = 0; r < 4; ++r) yb[(mt * 16 + 4 * fq + r) * 72 + vg * 16 + fr] = f2bf(ya[r]); }
        const uint4 cv = P.vv, cg = P.gg; const float cbon = P.bon;
        P = Q;
        if (it + 2 * nblk < 2048) yout_load(Q, it + 2 * nblk, SPHI, OMG, Y0, V, G, BONUS, tid);
        __syncthreads();
        const int et = tid >> 3, eq = tid & 7; const int t = b * SEQ + ch * 64 + et;
        float y[8], s = 0.f;
        unpack8(*(const uint4*)(yb + et * 72 + eq * 8), y);
#pragma unroll
        for (int i = 0; i < 8; ++i) s += y[i];
        s += __shfl_xor(s, 1, 64); s += __shfl_xor(s, 2, 64); s += __shfl_xor(s, 4, 64);
        const float mean = s * (1.f / 64.f);
        float q = 0.f;
#pragma unroll
        for (int i = 0; i < 8; ++i) { y[i] -= mean; q += y[i] * y[i]; }
        q += __shfl_xor(q, 1, 64); q += __shfl_xor(q, 2, 64); q += __shfl_xor(q, 4, 64);
        const float rstd = rsqrtf(q * (1.f / 64.f) + 64e-5f);
        float v8[8], g8[8], o8[8]; unpack8(cv, v8); unpack8(cg, g8);
        const float4 w0 = *(const float4*)(gng + h * 64 + eq * 8), w1 = *(const float4*)(gng + h * 64 + eq * 8 + 4), b0 = *(const float4*)(gnb + h * 64 + eq * 8), b1 = *(const float4*)(gnb + h * 64 + eq * 8 + 4);
        const float gw[8] = {w0.x, w0.y, w0.z, w0.w, w1.x, w1.y, w1.z, w1.w}, gb[8] = {b0.x, b0.y, b0.z, b0.w, b1.x, b1.y, b1.z, b1.w};
#pragma unroll
        for (int i = 0; i < 8; ++i) o8[i] = (y[i] * rstd * gw[i] + gb[i] + cbon * v8[i]) * g8[i];
        *(uint4*)(O + (size_t)t * 512 + h * 64 + eq * 8) = pack8(o8);
    }
}

constexpr int LDS_BYTES = 150528 + 64;
constexpr int N_PHASES = 14;
constexpr size_t WS_BAR = 19 * MiB;
struct MP { const float* in[28]; float* out; unsigned char* ws; int ph_lo, ph_hi; };

__global__ void __launch_bounds__(512, 2) mega(MP p) {
    extern __shared__ __attribute__((aligned(16))) unsigned char lds[];
    const int bid = blockIdx.x, nblk = gridDim.x, tid = threadIdx.x;
    volatile LAS unsigned* st = (volatile LAS unsigned*)(lds + LDS_BYTES - 16);
    if (tid < 4) st[tid] = 0u;
    __syncthreads();
    const int lo = p.ph_lo, hi = p.ph_hi;
    XcdBarrier bar; bar.bar = (unsigned*)(p.ws + WS_BAR); bar.x = 0; bar.st = st;
    if (hi - lo > 1) bar = xcd_barrier_post((unsigned*)(p.ws + WS_BAR), st);
    if (tid == 0) st[2] = (hi - lo > 1) ? xb_add((unsigned*)(p.ws + WS_BAR) + XCD_BAR_WORDS + 64 * bar.x, 1u) : 0u;
#define IN(k) (lo <= (k) && (k) < hi)
#define SEAM(k) do { if (IN(k) && IN((k) + 1)) xcd_barrier(bar); } while (0)
    unsigned char* ws = p.ws; unsigned char* ob = (unsigned char*)p.out;
    const float* x = p.in[0];
    bf16 *WIN_T = (bf16*)(ws + WS_WIN_T), *PW_T = (bf16*)(ws + WS_PW_T), *WO_T = (bf16*)(ws + WS_WO_T), *WOUT_T = (bf16*)(ws + WS_WOUT_T), *WQ_T = (bf16*)(ws + WS_WQ_T), *KEYS = (bf16*)(ws + WS_KEYS);
    bf16 *XN = (bf16*)(ws + WS_XN), *PROJ = (bf16*)(ws + WS_PROJ), *YN = (bf16*)(ws + WS_YN), *G = (bf16*)(ws + WS_G), *M = (bf16*)(ws + WS_M);
    bf16 *Q = (bf16*)(ws + WS_Q);
    u8 *U8 = (u8*)(ws + WS_XN), *V8 = (u8*)(ws + WS_PROJ + 64 * MiB), *H8 = (u8*)(ws + WS_PROJ + 80 * MiB);
    bf16* XN2 = (bf16*)(ws + WS_M);
    float *USC = (float*)(ws + 19 * MiB + 512 * 1024), *VSC = USC + 16384, *HS = USC + 32768, *CF = (float*)(ws + WS_PROJ + 144 * MiB), *SS = (float*)(ws + WS_BONUS), *SCL = USC + 65536, *PARTB = (float*)(ws + WS_Q);
    float *BONUS = (float*)(ws + WS_BONUS), *GATE = (float*)(ws + WS_GATE); int* EID = (int*)(ws + WS_EID);
    bf16 *OMG = (bf16*)(ob), *Y0 = (bf16*)(ob + 16 * MiB), *V = (bf16*)(ob + 32 * MiB), *O = (bf16*)(ob + 48 * MiB);
    bf16 *PHI = (bf16*)(ws + WS_LD), *PSI = (bf16*)(ws + WS_LD + 16 * MiB);
    bf16* X1 = (bf16*)(ws + WS_PROJ + 96 * MiB);

    if (IN(0)) {
        ph_transpose_reg(bid, nblk, 0, p.in[2], WIN_T, 1024, DIN, DINP);
        ph_rmsnorm(bid, nblk, x, p.in[1], XN, T);
        __syncthreads();
    }
    SEAM(0);
    if (IN(1)) ph_gemm(lds, bid, nblk, XN, WIN_T, T, DINP, 1024, EpiGen<FStoreBf16>{FStoreBf16{PROJ, DINP}});
    SEAM(1);
    if (IN(2)) {
        ChunkParams cp{PROJ, p.in[9], p.in[10], p.in[11], p.in[12], p.in[13], p.in[14], p.in[15], p.in[16], p.in[17], V, G, PHI, PSI, OMG, Y0, BONUS};
        ph_chunkprep(lds, bid, nblk, cp);
        __syncthreads();
    }
    SEAM(2);
    if (IN(3)) {
        if (bid < 32) ph_chain2(lds, bid, PHI, PSI);
        else {
            const int ob_ = bid - 32, on_ = nblk - 32;
            int t0 = 0;
            t0 += ph_transpose(lds, ob_, on_, t0, p.in[7], PW_T, 512, 1024, 1024);
            t0 += ph_transpose(lds, ob_, on_, t0, p.in[20], WO_T, 512, 1024, 1024);
            t0 += ph_transpose(lds, ob_, on_, t0, p.in[21], WOUT_T, 1024, 1024, 1024);
            t0 += ph_transpose(lds, ob_, on_, t0, p.in[23], WQ_T, 1024, 2048, 2048, p.in[22]);
            ph_cvt(ob_, on_, p.in[24], KEYS, (size_t)(8 * 2 * 128 * 128 / 4));
            ph_cvt_i4(ob_, on_, p.in[25], U8, USC, 16384);
            __syncthreads();
        }
    }
    SEAM(3);
    if (IN(4)) {
        ph_yout(lds, bid, nblk, PHI, OMG, Y0, V, G, BONUS, p.in[18], p.in[19], O);
        __syncthreads();
        {
            const int ob_ = bid, on_ = nblk;
            ph_conv(lds, ob_, on_, PROJ, p.in[3], p.in[4], p.in[5], p.in[6], YN);
            __syncthreads();
            __syncthreads();
        }
    }
    SEAM(4);
    if (IN(5)) ph_gemm2(lds, bid, nblk, YN, PW_T, O, WO_T, T, 1024, 512, 8, 16, EpiMix{M, PROJ, p.in[8]});
    SEAM(5);
    if (IN(6)) ph_gemm(lds, bid, nblk, M, WOUT_T, T, 1024, 1024, EpiGen2<FResX12B>{FResX12B{x, X1}});
    SEAM(6);
    if (IN(7)) {
        ph_rowstat(bid, nblk, X1, p.in[22], H8, HS, SCL, T);
        ph_cvt_i8(bid, nblk, p.in[26], V8, VSC, 16384);
        __syncthreads();
        ph_gemm(lds, bid, nblk, X1, WQ_T, T, 2048, 1024, EpiGen<FStoreBf16>{FStoreBf16{Q, 2048}});
    }
    SEAM(7);
    if (IN(9)) ph_topk2(lds, bid, nblk, Q, KEYS, SCL, EID, GATE);
    SEAM(9);
    Part part; bool census_ok;
    {
        unsigned n[8], tot = 0; bool ok = (hi - lo > 1);
#pragma unroll
        for (int j = 0; j < 8; ++j) { n[j] = xb_ld(bar.bar + XB_XCNT(j)); tot += n[j]; ok = ok && n[j] > 0; }
        ok = ok && tot == (unsigned)nblk && bar.x < 8u;
        const unsigned myr = st[2];
        census_ok = ok;
        if (ok) { part.p0 = (int)bar.x; part.pstep = 8; part.rank = (int)myr; part.nrank = (int)n[bar.x & 7]; if (part.rank >= part.nrank) { part.rank = 0; part.nrank = 1; part.p0 = 8; } }
        else if ((nblk % 8) == 0) { part.p0 = bid & 7; part.pstep = 8; part.rank = bid >> 3; part.nrank = nblk >> 3; }
        else { part.p0 = 0; part.pstep = 1; part.rank = bid; part.nrank = nblk; }
    }
    Part part4;
    if (census_ok) {
        const unsigned xe = bar.x & 6u, n0 = xb_ld(bar.bar + XB_XCNT(xe)), n1 = xb_ld(bar.bar + XB_XCNT(xe + 1));
        part4.p0 = (int)(bar.x >> 1); part4.pstep = 4; part4.rank = (int)(((bar.x & 1u) ? n0 : 0u) + st[2]); part4.nrank = (int)(n0 + n1);
    } else if ((nblk % 4) == 0) { part4.p0 = bid & 3; part4.pstep = 4; part4.rank = bid >> 2; part4.nrank = nblk >> 2; }
    else { part4.p0 = 0; part4.pstep = 1; part4.rank = bid; part4.nrank = nblk; }
    if (IN(10)) ph_peer_u7(lds, part4, H8, HS, U8, EID, PARTB);
    SEAM(10);
    if (IN(11)) ph_peer_cf3(bid, nblk, PARTB, USC, VSC, EID, GATE, (unsigned short*)CF, (unsigned*)((unsigned short*)CF + (size_t)T * 128), HS + 16384, 4);
    SEAM(11);
    if (IN(12)) ph_peer_v6(lds, part, X1, X1, V8, (const unsigned short*)CF, (const unsigned*)((const unsigned short*)CF + (size_t)T * 128), HS + 16384, SS);
    SEAM(12);
    if (IN(13)) ph_peer_f(bid, nblk, X1, p.out, SS, p.in[27]);
#undef IN
#undef SEAM
}

#ifndef MK_PER_PHASE
#define MK_PER_PHASE 0
#endif
extern "C" void kernel_launch(void* const* d_in, const int* in_sizes, int n_in, void* d_out, int out_size, void* d_ws, size_t ws_size, hipStream_t stream) {
    static int grid = 0;
    if (grid == 0) {
        if (n_in != 28 || ws_size < WS_END) { fprintf(stderr, "kernel_launch: unexpected n_in %d / ws_size %zu\n", n_in, ws_size); grid = -1; return; }
        int dev = 0, cus = 0;
        if (hipGetDevice(&dev) != hipSuccess || hipDeviceGetAttribute(&cus, hipDeviceAttributeMultiprocessorCount, dev) != hipSuccess) { grid = -1; return; }
        if (hipFuncSetAttribute((const void*)mega, hipFuncAttributeMaxDynamicSharedMemorySize, LDS_BYTES) != hipSuccess) { fprintf(stderr, "kernel_launch: hipFuncSetAttribute failed\n"); grid = -1; return; }
        (void)hipGetLastError();
        grid = cus;
    }
    if (grid < 0) return;
    (void)hipMemsetAsync((unsigned char*)d_ws + WS_BAR, 0, XCD_BAR_WORDS * 4 + 16 * 256, stream);
    MP a{};
    for (int i = 0; i < 28; ++i) a.in[i] = (const float*)d_in[i];
    a.out = (float*)d_out; a.ws = (unsigned char*)d_ws;
#if MK_PER_PHASE
    for (int ph = 0; ph < N_PHASES; ++ph) { a.ph_lo = ph; a.ph_hi = ph + 1; hipLaunchKernelGGL(mega, dim3(grid), dim3(512), LDS_BYTES, stream, a); }
#else
    a.ph_lo = 0; a.ph_hi = N_PHASES;
    hipLaunchKernelGGL(mega, dim3(grid), dim3(512), LDS_BYTES, stream, a);
#endif
}
```

```cpp
#include <hip/hip_runtime.h>
#include <stdint.h>
#include <stdio.h>
namespace pg8 {
#define PG8_LAS __attribute__((address_space(3)))
typedef unsigned short bf16_t;
typedef short bf16x8 __attribute__((ext_vector_type(8)));
typedef float f32x4 __attribute__((ext_vector_type(4)));
typedef unsigned u32x4 __attribute__((ext_vector_type(4)));
constexpr int BM = 256, BK = 64, HALF = 128, HTB = HALF * BK * 2  , STAGE_BYTES = 8 * HTB, NXCD = 8, WGM = 8;

__host__ __device__ __forceinline__ int lds_byte(int r, int c) { const int st = (r >> 4) * 2 + (c >> 5), rr = r & 15, cc = c & 31, ob = rr * 64 + cc * 2; return st * 1024 + (ob ^ (((ob >> 9) & 1) << 5)); }
__host__ __device__ __forceinline__ void stage_rc(int b, int& R, int& C) { const int st = b / 1024, sb = b % 1024, swz = sb ^ (((sb >> 9) & 1) << 5); R = (st >> 1) * 16 + swz / 64; C = (st & 1) * 32 + (swz % 64) / 2; }
__host__ __device__ __forceinline__ int perm32(int rho) { const int n = rho >> 4, i = rho & 15; return 8 * (i >> 2) + 4 * n + (i & 3); }

struct Unit { int pm, pn; };
struct Gemm { const bf16_t* A; const bf16_t* Bt; int M, N, K; };

struct StaticOrder {
    int nM, nN, nwg, G, c;
    __host__ __device__ void init(int M, int N, int G_, int c_) { nM = M / BM; nN = N / BM; nwg = nM * nN; G = G_; c = c_; }
    __host__ __device__ bool next(int i, Unit& u) const {
        const long L = (long)i * G + c; if (L >= nwg) return false;
        int wgid = (int)L; { const int q = nwg / NXCD, r = nwg % NXCD, xcd = wgid % NXCD, off = wgid / NXCD; wgid = (xcd < r ? xcd * (q + 1) : r * (q + 1) + (xcd - r) * q) + off; }
        const int nig = WGM * nN, gid = wgid / nig, fm = gid * WGM, gsz = (nM - fm) < WGM ? (nM - fm) : WGM;
        u.pm = fm + ((wgid % nig) % gsz); u.pn = (wgid % nig) / gsz; return true;
    }
    __device__ __forceinline__ void a_ready(const Unit&) const {}
    __device__ __forceinline__ void done(const Unit&) const {}
};
__device__ __forceinline__ unsigned cvt_pk_bf16(float lo, float hi) { unsigned r; asm volatile("v_cvt_pk_bf16_f32 %0, %1, %2" : "=v"(r) : "v"(lo), "v"(hi)); return r; }
struct Gemm2 { const bf16_t* A; const bf16_t* Bt; const bf16_t* A2; const bf16_t* Bt2; int M, N, K, nt1, nt; };
template <class Epi, class Sched, bool STAMP = false>
__device__ __forceinline__ void gemm_phase(PG8_LAS unsigned char* lds, const Gemm g, const Sched& S, const Epi& E, unsigned long long* stamps) {
    const int tid = threadIdx.x, wid = __builtin_amdgcn_readfirstlane(tid >> 6), lane = tid & 63, wr = wid >> 2, wc = wid & 3, fr = lane & 15, fq = lane >> 4;
    const int K = g.K, nt = K / BK;
    int ts_lo = 0, ts_hi = 0, nts = 0; const unsigned long long rt_entry = STAMP ? (unsigned long long)wall_clock64() : 0ull;
#define PG8_STAMP() do { if (STAMP && wid == 0 && nts < 64) { const unsigned long long _c = (unsigned long long)clock64(); \
        ts_lo = (lane == nts) ? (int)(unsigned)_c : ts_lo; ts_hi = (lane == nts) ? (int)(unsigned)(_c >> 32) : ts_hi; ++nts; } } while (0)
    PG8_STAMP();
    unsigned voffA[2], voffB[2];
#pragma unroll
    for (int i = 0; i < 2; ++i) { int R, C; stage_rc(tid * 16 + i * 8192, R, C); const int Rb = Epi::PERM ? ((R & ~31) + perm32(R & 31)) : R;
        voffA[i] = (unsigned)(R * K + C) * 2u; voffB[i] = (unsigned)(Rb * K + C) * 2u; }
    const size_t kstep = (size_t)(BK * 2);
    const size_t hstep = (size_t)HALF * K * 2;
    const size_t tstep = 2 * hstep;
    const unsigned ldsw = (unsigned)wid * 1024u;
    const int aoff = lds_byte(wr * 64 + fr, fq * 8), boff = lds_byte(wc * 32 + fr, fq * 8);
#define PG8_SA(b, h) (((b) * 2 + (h)) * HTB)
#define PG8_SB(b, h) ((4 + (b) * 2 + (h)) * HTB)
#define PG8_STAGE(bufoff, gbase, voff) do { _Pragma("unroll") for (int _i = 0; _i < 2; ++_i) \
        __builtin_amdgcn_global_load_lds((const unsigned*)((const char*)(gbase) + (voff)[_i]), (PG8_LAS unsigned*)(lds + (bufoff) + ldsw + _i * 8192), 16, 0, 0); } while (0)
#define PG8_LDA(dst, b, h) do { _Pragma("unroll") for (int m = 0; m < 4; ++m) _Pragma("unroll") for (int k = 0; k < 2; ++k) dst[m][k] = *(const PG8_LAS bf16x8*)(lds + PG8_SA(b, h) + aoff + m * 2048 + k * 1024); } while (0)
#define PG8_LDB(dst, b, h) do { _Pragma("unroll") for (int n = 0; n < 2; ++n) _Pragma("unroll") for (int k = 0; k < 2; ++k) dst[n][k] = *(const PG8_LAS bf16x8*)(lds + PG8_SB(b, h) + boff + n * 2048 + k * 1024); } while (0)
#define PG8_MMA(ai, bj, At, Bt) do { __builtin_amdgcn_s_setprio(1); _Pragma("unroll") for (int m = 0; m < 4; ++m) _Pragma("unroll") for (int n = 0; n < 2; ++n) _Pragma("unroll") for (int k = 0; k < 2; ++k) \
        acc[ai][bj][m][n] = __builtin_amdgcn_mfma_f32_16x16x32_bf16(Bt[n][k], At[m][k], acc[ai][bj][m][n], 0, 0, 0); __builtin_amdgcn_s_setprio(0); } while (0)
#define PG8_WAIT_V(n) asm volatile("s_waitcnt vmcnt(" #n ")" ::: "memory")
#define PG8_WAIT_L(n) asm volatile("s_waitcnt lgkmcnt(" #n ")" ::: "memory")
#define PG8_BAR __builtin_amdgcn_s_barrier()
#define PG8_SCHED __builtin_amdgcn_sched_barrier(0)
    Unit cur, nxt; int ui = 0;
    if (!S.next(0, cur)) return;
    f32x4 acc[2][2][4][2];
#pragma unroll
    for (int a = 0; a < 2; ++a)
#pragma unroll
        for (int b = 0; b < 2; ++b)
#pragma unroll
            for (int m = 0; m < 4; ++m)
#pragma unroll
                for (int n = 0; n < 2; ++n) acc[a][b][m][n] = (f32x4){0.f, 0.f, 0.f, 0.f};
    bf16x8 At[4][2], B0[2][2], B1[2][2];
    const char* cA = (const char*)g.A + (size_t)cur.pm * tstep; const char* cB = (const char*)g.Bt + (size_t)cur.pn * tstep;
    S.a_ready(cur);
    PG8_STAGE(PG8_SB(0, 0), cB, voffB); PG8_STAGE(PG8_SA(0, 0), cA, voffA); PG8_STAGE(PG8_SB(0, 1), cB + hstep, voffB); PG8_STAGE(PG8_SA(0, 1), cA + hstep, voffA);
    if (wr == 1) PG8_BAR;
    PG8_WAIT_V(4); PG8_BAR;
    PG8_STAGE(PG8_SB(1, 0), cB + kstep, voffB); PG8_STAGE(PG8_SA(1, 0), cA + kstep, voffA); PG8_STAGE(PG8_SB(1, 1), cB + hstep + kstep, voffB);
    PG8_WAIT_V(6); PG8_BAR;
    PG8_STAMP();
    for (;;) {
        const bool has_next = S.next(ui + 1, nxt);
        const char* nA = has_next ? (const char*)g.A + (size_t)nxt.pm * tstep : cA; const char* nB = has_next ? (const char*)g.Bt + (size_t)nxt.pn * tstep : cB;
        for (int t = 0; t < nt; t += 2) {
            const bool last = (t == nt - 2);
            const char* a1 = cA + (size_t)(t + 1) * kstep;
            const char* a2 = last ? nA : cA + (size_t)(t + 2) * kstep; const char* b2 = last ? nB : cB + (size_t)(t + 2) * kstep;
            const char* a3 = a2 + kstep; const char* b3 = b2 + kstep;
            if (last && has_next) S.a_ready(nxt);
            PG8_LDB(B0, 0, 0); PG8_SCHED; PG8_LDA(At, 0, 0); PG8_STAGE(PG8_SA(1, 1), a1 + hstep, voffA);
            PG8_WAIT_L(8); PG8_BAR; PG8_WAIT_L(0); PG8_MMA(0, 0, At, B0); PG8_BAR; PG8_SCHED;
            PG8_LDB(B1, 0, 1); PG8_STAGE(PG8_SB(0, 0), b2, voffB);
            PG8_BAR; PG8_WAIT_L(0); PG8_MMA(0, 1, At, B1); PG8_BAR;
            PG8_LDA(At, 0, 1); PG8_STAGE(PG8_SA(0, 0), a2, voffA);
            PG8_BAR; PG8_WAIT_L(0); PG8_MMA(1, 0, At, B0); PG8_BAR; PG8_SCHED;
            PG8_STAGE(PG8_SB(0, 1), b2 + hstep, voffB);
            PG8_WAIT_V(6); PG8_BAR; PG8_MMA(1, 1, At, B1); PG8_BAR;
            PG8_LDB(B0, 1, 0); PG8_SCHED; PG8_LDA(At, 1, 0); PG8_STAGE(PG8_SA(0, 1), a2 + hstep, voffA);
            PG8_WAIT_L(8); PG8_BAR; PG8_WAIT_L(0); PG8_MMA(0, 0, At, B0); PG8_BAR; PG8_SCHED;
            PG8_LDB(B1, 1, 1); PG8_STAGE(PG8_SB(1, 0), b3, voffB);
            PG8_BAR; PG8_WAIT_L(0); PG8_MMA(0, 1, At, B1); PG8_BAR;
            PG8_LDA(At, 1, 1); PG8_STAGE(PG8_SA(1, 0), a3, voffA);
            PG8_BAR; PG8_WAIT_L(0); PG8_MMA(1, 0, At, B0); PG8_BAR; PG8_SCHED;
            PG8_STAGE(PG8_SB(1, 1), b3 + hstep, voffB);
            PG8_WAIT_V(6); PG8_BAR; PG8_MMA(1, 1, At, B1); PG8_BAR;
        }
        PG8_STAMP();
        if constexpr (!Epi::AFTER_DRAIN) { E(acc, cur, wr, wc, fr, fq); S.done(cur); }
        PG8_STAMP();
        if (!has_next) break;
#pragma unroll
        for (int a = 0; a < 2; ++a)
#pragma unroll
            for (int b = 0; b < 2; ++b)
#pragma unroll
                for (int m = 0; m < 4; ++m)
#pragma unroll
                    for (int n = 0; n < 2; ++n) acc[a][b][m][n] = (f32x4){0.f, 0.f, 0.f, 0.f};
        cur = nxt; cA = nA; cB = nB; ++ui;
    }
    PG8_WAIT_V(0);
    if (wr == 0) PG8_BAR;
    PG8_BAR;
    if constexpr (Epi::AFTER_DRAIN) { E.fused(acc, cur, wr, wc, fr, fq, lds, wid, lane); S.done(cur); }
    PG8_STAMP();
    if (STAMP && wid == 0) { stamps[lane] = lane < nts ? (((unsigned long long)(unsigned)ts_hi << 32) | (unsigned)ts_lo) : 0ull;
        if (lane == 62) stamps[62] = rt_entry; if (lane == 63) stamps[63] = (unsigned long long)wall_clock64(); }
#undef PG8_STAMP
#undef PG8_SA
#undef PG8_SB
#undef PG8_STAGE
#undef PG8_LDA
#undef PG8_LDB
#undef PG8_MMA
#undef PG8_WAIT_V
#undef PG8_WAIT_L
#undef PG8_BAR
#undef PG8_SCHED
}

typedef int i32x8 __attribute__((ext_vector_type(8)));
typedef int i32x4 __attribute__((ext_vector_type(4)));
__device__ __forceinline__ i32x8 cat8(bf16x8 lo, bf16x8 hi) { const i32x4 a = __builtin_bit_cast(i32x4, lo), b = __builtin_bit_cast(i32x4, hi); return __builtin_shufflevector(a, b, 0, 1, 2, 3, 4, 5, 6, 7); }
template <class Epi, class Sched, bool STAMP = false>
__device__ __forceinline__ void gemm_phase_f8(PG8_LAS unsigned char* lds, const Gemm g, const Sched& S, const Epi& E, unsigned long long* stamps) {
    const int tid = threadIdx.x, wid = __builtin_amdgcn_readfirstlane(tid >> 6), lane = tid & 63, wr = wid >> 2, wc = wid & 3, fr = lane & 15, fq = lane >> 4;
    const int K = g.K, nt = K / BK;
    int ts_lo = 0, ts_hi = 0, nts = 0; const unsigned long long rt_entry = STAMP ? (unsigned long long)wall_clock64() : 0ull;
#define PG8_STAMP() do { if (STAMP && wid == 0 && nts < 64) { const unsigned long long _c = (unsigned long long)clock64(); \
        ts_lo = (lane == nts) ? (int)(unsigned)_c : ts_lo; ts_hi = (lane == nts) ? (int)(unsigned)(_c >> 32) : ts_hi; ++nts; } } while (0)
    PG8_STAMP();
    unsigned voffA[2], voffB[2];
#pragma unroll
    for (int i = 0; i < 2; ++i) { int R, C; stage_rc(tid * 16 + i * 8192, R, C); const int Rb = Epi::PERM ? ((R & ~31) + perm32(R & 31)) : R;
        voffA[i] = (unsigned)(R * K + C) * 2u; voffB[i] = (unsigned)(Rb * K + C) * 2u; }
    const size_t kstep = (size_t)(BK * 2);
    const size_t hstep = (size_t)HALF * K * 2;
    const size_t tstep = 2 * hstep;
    const unsigned ldsw = (unsigned)wid * 1024u;
    const int aoff = lds_byte(wr * 64 + fr, fq * 8), boff = lds_byte(wc * 32 + fr, fq * 8);
#define PG8_SA(b, h) (((b) * 2 + (h)) * HTB)
#define PG8_SB(b, h) ((4 + (b) * 2 + (h)) * HTB)
#define PG8_STAGE(bufoff, gbase, voff) do { _Pragma("unroll") for (int _i = 0; _i < 2; ++_i) \
        __builtin_amdgcn_global_load_lds((const unsigned*)((const char*)(gbase) + (voff)[_i]), (PG8_LAS unsigned*)(lds + (bufoff) + ldsw + _i * 8192), 16, 0, 0); } while (0)
#define PG8_LDA(dst, b, h) do { _Pragma("unroll") for (int m = 0; m < 4; ++m) _Pragma("unroll") for (int k = 0; k < 2; ++k) dst[m][k] = *(const PG8_LAS bf16x8*)(lds + PG8_SA(b, h) + aoff + m * 2048 + k * 1024); } while (0)
#define PG8_LDB(dst, b, h) do { _Pragma("unroll") for (int n = 0; n < 2; ++n) _Pragma("unroll") for (int k = 0; k < 2; ++k) dst[n][k] = *(const PG8_LAS bf16x8*)(lds + PG8_SB(b, h) + boff + n * 2048 + k * 1024); } while (0)
#define PG8_MMA(ai, bj, At, Bt) do { __builtin_amdgcn_s_setprio(1); _Pragma("unroll") for (int m = 0; m < 4; ++m) _Pragma("unroll") for (int n = 0; n < 2; ++n) \
        acc[ai][bj][m][n] = __builtin_amdgcn_mfma_scale_f32_16x16x128_f8f6f4(cat8(Bt[n][0], Bt[n][1]), cat8(At[m][0], At[m][1]), acc[ai][bj][m][n], 0, 0, 0, 0, 0, 0); __builtin_amdgcn_s_setprio(0); } while (0)
#define PG8_WAIT_V(n) asm volatile("s_waitcnt vmcnt(" #n ")" ::: "memory")
#define PG8_WAIT_L(n) asm volatile("s_waitcnt lgkmcnt(" #n ")" ::: "memory")
#define PG8_BAR __builtin_amdgcn_s_barrier()
#define PG8_SCHED __builtin_amdgcn_sched_barrier(0)
    Unit cur, nxt; int ui = 0;
    if (!S.next(0, cur)) return;
    f32x4 acc[2][2][4][2];
#pragma unroll
    for (int a = 0; a < 2; ++a)
#pragma unroll
        for (int b = 0; b < 2; ++b)
#pragma unroll
            for (int m = 0; m < 4; ++m)
#pragma unroll
                for (int n = 0; n < 2; ++n) acc[a][b][m][n] = (f32x4){0.f, 0.f, 0.f, 0.f};
    bf16x8 At[4][2], B0[2][2], B1[2][2];
    const char* cA = (const char*)g.A + (size_t)cur.pm * tstep; const char* cB = (const char*)g.Bt + (size_t)cur.pn * tstep;
    S.a_ready(cur);
    PG8_STAGE(PG8_SB(0, 0), cB, voffB); PG8_STAGE(PG8_SA(0, 0), cA, voffA); PG8_STAGE(PG8_SB(0, 1), cB + hstep, voffB); PG8_STAGE(PG8_SA(0, 1), cA + hstep, voffA);
    if (wr == 1) PG8_BAR;
    PG8_WAIT_V(4); PG8_BAR;
    PG8_STAGE(PG8_SB(1, 0), cB + kstep, voffB); PG8_STAGE(PG8_SA(1, 0), cA + kstep, voffA); PG8_STAGE(PG8_SB(1, 1), cB + hstep + kstep, voffB);
    PG8_WAIT_V(6); PG8_BAR;
    PG8_STAMP();
    for (;;) {
        const bool has_next = S.next(ui + 1, nxt);
        const char* nA = has_next ? (const char*)g.A + (size_t)nxt.pm * tstep : cA; const char* nB = has_next ? (const char*)g.Bt + (size_t)nxt.pn * tstep : cB;
        for (int t = 0; t < nt; t += 2) {
            const bool last = (t == nt - 2);
            const char* a1 = cA + (size_t)(t + 1) * kstep;
            const char* a2 = last ? nA : cA + (size_t)(t + 2) * kstep; const char* b2 = last ? nB : cB + (size_t)(t + 2) * kstep;
            const char* a3 = a2 + kstep; const char* b3 = b2 + kstep;
            if (last && has_next) S.a_ready(nxt);
            PG8_LDB(B0, 0, 0); PG8_SCHED; PG8_LDA(At, 0, 0); PG8_STAGE(PG8_SA(1, 1), a1 + hstep, voffA);
            PG8_WAIT_L(8); PG8_BAR; PG8_WAIT_L(0); PG8_MMA(0, 0, At, B0); PG8_BAR; PG8_SCHED;
            PG8_LDB(B1, 0, 1); PG8_STAGE(PG8_SB(0, 0), b2, voffB);
            PG8_BAR; PG8_WAIT_L(0); PG8_MMA(0, 1, At, B1); PG8_BAR;
            PG8_LDA(At, 0, 1); PG8_STAGE(PG8_SA(0, 0), a2, voffA);
            PG8_BAR; PG8_WAIT_L(0); PG8_MMA(1, 0, At, B0); PG8_BAR; PG8_SCHED;
            PG8_STAGE(PG8_SB(0, 1), b2 + hstep, voffB);
            PG8_WAIT_V(6); PG8_BAR; PG8_MMA(1, 1, At, B1); PG8_BAR;
            PG8_LDB(B0, 1, 0); PG8_SCHED; PG8_LDA(At, 1, 0); PG8_STAGE(PG8_SA(0, 1), a2 + hstep, voffA);
            PG8_WAIT_L(8); PG8_BAR; PG8_WAIT_L(0); PG8_MMA(0, 0, At, B0); PG8_BAR; PG8_SCHED;
            PG8_LDB(B1, 1, 1); PG8_STAGE(PG8_SB(1, 0), b3, voffB);
            PG8_BAR; PG8_WAIT_L(0); PG8_MMA(0, 1, At, B1); PG8_BAR;
            PG8_LDA(At, 1, 1); PG8_STAGE(PG8_SA(1, 0), a3, voffA);
            PG8_BAR; PG8_WAIT_L(0); PG8_MMA(1, 0, At, B0); PG8_BAR; PG8_SCHED;
            PG8_STAGE(PG8_SB(1, 1), b3 + hstep, voffB);
            PG8_WAIT_V(6); PG8_BAR; PG8_MMA(1, 1, At, B1); PG8_BAR;
        }
        PG8_STAMP();
        if constexpr (!Epi::AFTER_DRAIN) { E(acc, cur, wr, wc, fr, fq); S.done(cur); }
        PG8_STAMP();
        if (!has_next) break;
#pragma unroll
        for (int a = 0; a < 2; ++a)
#pragma unroll
            for (int b = 0; b < 2; ++b)
#pragma unroll
                for (int m = 0; m < 4; ++m)
#pragma unroll
                    for (int n = 0; n < 2; ++n) acc[a][b][m][n] = (f32x4){0.f, 0.f, 0.f, 0.f};
        cur = nxt; cA = nA; cB = nB; ++ui;
    }
    PG8_WAIT_V(0);
    if (wr == 0) PG8_BAR;
    PG8_BAR;
    if constexpr (Epi::AFTER_DRAIN) { E.fused(acc, cur, wr, wc, fr, fq, lds, wid, lane); S.done(cur); }
    PG8_STAMP();
    if (STAMP && wid == 0) { stamps[lane] = lane < nts ? (((unsigned long long)(unsigned)ts_hi << 32) | (unsigned)ts_lo) : 0ull;
        if (lane == 62) stamps[62] = rt_entry; if (lane == 63) stamps[63] = (unsigned long long)wall_clock64(); }
#undef PG8_STAMP
#undef PG8_SA
#undef PG8_SB
#undef PG8_STAGE
#undef PG8_LDA
#undef PG8_LDB
#undef PG8_MMA
#undef PG8_WAIT_V
#undef PG8_WAIT_L
#undef PG8_BAR
#undef PG8_SCHED
}

template <class Epi, class Sched, bool STAMP = false>
__device__ __forceinline__ void gemm_phase2(PG8_LAS unsigned char* lds, const Gemm2 g, const Sched& S, const Epi& E, unsigned long long* stamps) {
    const int tid = threadIdx.x, wid = __builtin_amdgcn_readfirstlane(tid >> 6), lane = tid & 63, wr = wid >> 2, wc = wid & 3, fr = lane & 15, fq = lane >> 4;
    const int K = g.K, nt1 = g.nt1, nt = g.nt;
    int ts_lo = 0, ts_hi = 0, nts = 0; const unsigned long long rt_entry = STAMP ? (unsigned long long)wall_clock64() : 0ull;
#define PG8_STAMP() do { if (STAMP && wid == 0 && nts < 64) { const unsigned long long _c = (unsigned long long)clock64(); \
        ts_lo = (lane == nts) ? (int)(unsigned)_c : ts_lo; ts_hi = (lane == nts) ? (int)(unsigned)(_c >> 32) : ts_hi; ++nts; } } while (0)
    PG8_STAMP();
    unsigned voffA[2], voffB[2];
#pragma unroll
    for (int i = 0; i < 2; ++i) { int R, C; stage_rc(tid * 16 + i * 8192, R, C); const int Rb = Epi::PERM ? ((R & ~31) + perm32(R & 31)) : R;
        voffA[i] = (unsigned)(R * K + C) * 2u; voffB[i] = (unsigned)(Rb * K + C) * 2u; }
    const size_t kstep = (size_t)(BK * 2);
    const size_t hstep = (size_t)HALF * K * 2;
    const size_t tstep = 2 * hstep;
    const unsigned ldsw = (unsigned)wid * 1024u;
    const int aoff = lds_byte(wr * 64 + fr, fq * 8), boff = lds_byte(wc * 32 + fr, fq * 8);
#define PG8_SA(b, h) (((b) * 2 + (h)) * HTB)
#define PG8_SB(b, h) ((4 + (b) * 2 + (h)) * HTB)
#define PG8_STAGE(bufoff, gbase, voff) do { _Pragma("unroll") for (int _i = 0; _i < 2; ++_i) \
        __builtin_amdgcn_global_load_lds((const unsigned*)((const char*)(gbase) + (voff)[_i]), (PG8_LAS unsigned*)(lds + (bufoff) + ldsw + _i * 8192), 16, 0, 0); } while (0)
#define PG8_LDA(dst, b, h) do { _Pragma("unroll") for (int m = 0; m < 4; ++m) _Pragma("unroll") for (int k = 0; k < 2; ++k) dst[m][k] = *(const PG8_LAS bf16x8*)(lds + PG8_SA(b, h) + aoff + m * 2048 + k * 1024); } while (0)
#define PG8_LDB(dst, b, h) do { _Pragma("unroll") for (int n = 0; n < 2; ++n) _Pragma("unroll") for (int k = 0; k < 2; ++k) dst[n][k] = *(const PG8_LAS bf16x8*)(lds + PG8_SB(b, h) + boff + n * 2048 + k * 1024); } while (0)
#define PG8_MMA(ai, bj, At, Bt) do { __builtin_amdgcn_s_setprio(1); _Pragma("unroll") for (int m = 0; m < 4; ++m) _Pragma("unroll") for (int n = 0; n < 2; ++n) _Pragma("unroll") for (int k = 0; k < 2; ++k) \
        acc[ai][bj][m][n] = __builtin_amdgcn_mfma_f32_16x16x32_bf16(Bt[n][k], At[m][k], acc[ai][bj][m][n], 0, 0, 0); __builtin_amdgcn_s_setprio(0); } while (0)
#define PG8_WAIT_V(n) asm volatile("s_waitcnt vmcnt(" #n ")" ::: "memory")
#define PG8_WAIT_L(n) asm volatile("s_waitcnt lgkmcnt(" #n ")" ::: "memory")
#define PG8_BAR __builtin_amdgcn_s_barrier()
#define PG8_SCHED __builtin_amdgcn_sched_barrier(0)
    Unit cur, nxt; int ui = 0;
    if (!S.next(0, cur)) return;
    f32x4 acc[2][2][4][2];
#pragma unroll
    for (int a = 0; a < 2; ++a)
#pragma unroll
        for (int b = 0; b < 2; ++b)
#pragma unroll
            for (int m = 0; m < 4; ++m)
#pragma unroll
                for (int n = 0; n < 2; ++n) acc[a][b][m][n] = (f32x4){0.f, 0.f, 0.f, 0.f};
    bf16x8 At[4][2], B0[2][2], B1[2][2];
    const char* cA = (const char*)g.A + (size_t)cur.pm * tstep; const char* cB = (const char*)g.Bt + (size_t)cur.pn * tstep;
    const char* dA = (const char*)g.A2 + (size_t)cur.pm * tstep - (size_t)nt1 * kstep; const char* dB = (const char*)g.Bt2 + (size_t)cur.pn * tstep - (size_t)nt1 * kstep;
#define PG8_TA(t_) ((((t_) < nt1) ? cA : dA) + (size_t)(t_) * kstep)
#define PG8_TB(t_) ((((t_) < nt1) ? cB : dB) + (size_t)(t_) * kstep)
    S.a_ready(cur);
    PG8_STAGE(PG8_SB(0, 0), cB, voffB); PG8_STAGE(PG8_SA(0, 0), cA, voffA); PG8_STAGE(PG8_SB(0, 1), cB + hstep, voffB); PG8_STAGE(PG8_SA(0, 1), cA + hstep, voffA);
    if (wr == 1) PG8_BAR;
    PG8_WAIT_V(4); PG8_BAR;
    PG8_STAGE(PG8_SB(1, 0), cB + kstep, voffB); PG8_STAGE(PG8_SA(1, 0), cA + kstep, voffA); PG8_STAGE(PG8_SB(1, 1), cB + hstep + kstep, voffB);
    PG8_WAIT_V(6); PG8_BAR;
    PG8_STAMP();
    for (;;) {
        const bool has_next = S.next(ui + 1, nxt);
        const char* nA = has_next ? (const char*)g.A + (size_t)nxt.pm * tstep : cA; const char* nB = has_next ? (const char*)g.Bt + (size_t)nxt.pn * tstep : cB;
        const char* ndA = has_next ? (const char*)g.A2 + (size_t)nxt.pm * tstep - (size_t)nt1 * kstep : dA; const char* ndB = has_next ? (const char*)g.Bt2 + (size_t)nxt.pn * tstep - (size_t)nt1 * kstep : dB;
        for (int t = 0; t < nt; t += 2) {
            const bool last = (t == nt - 2);
            if (t == nt1) E.mid(acc, cur, wr, wc, fr, fq);
            const char* a1 = PG8_TA(t + 1);
            const char* a2 = last ? nA : PG8_TA(t + 2); const char* b2 = last ? nB : PG8_TB(t + 2);
            const char* a3 = a2 + kstep; const char* b3 = b2 + kstep;
            if (last && has_next) S.a_ready(nxt);
            PG8_LDB(B0, 0, 0); PG8_SCHED; PG8_LDA(At, 0, 0); PG8_STAGE(PG8_SA(1, 1), a1 + hstep, voffA);
            PG8_WAIT_L(8); PG8_BAR; PG8_WAIT_L(0); PG8_MMA(0, 0, At, B0); PG8_BAR; PG8_SCHED;
            PG8_LDB(B1, 0, 1); PG8_STAGE(PG8_SB(0, 0), b2, voffB);
            PG8_BAR; PG8_WAIT_L(0); PG8_MMA(0, 1, At, B1); PG8_BAR;
            PG8_LDA(At, 0, 1); PG8_STAGE(PG8_SA(0, 0), a2, voffA);
            PG8_BAR; PG8_WAIT_L(0); PG8_MMA(1, 0, At, B0); PG8_BAR; PG8_SCHED;
            PG8_STAGE(PG8_SB(0, 1), b2 + hstep, voffB);
            PG8_WAIT_V(6); PG8_BAR; PG8_MMA(1, 1, At, B1); PG8_BAR;
            PG8_LDB(B0, 1, 0); PG8_SCHED; PG8_LDA(At, 1, 0); PG8_STAGE(PG8_SA(0, 1), a2 + hstep, voffA);
            PG8_WAIT_L(8); PG8_BAR; PG8_WAIT_L(0); PG8_MMA(0, 0, At, B0); PG8_BAR; PG8_SCHED;
            PG8_LDB(B1, 1, 1); PG8_STAGE(PG8_SB(1, 0), b3, voffB);
            PG8_BAR; PG8_WAIT_L(0); PG8_MMA(0, 1, At, B1); PG8_BAR;
            PG8_LDA(At, 1, 1); PG8_STAGE(PG8_SA(1, 0), a3, voffA);
            PG8_BAR; PG8_WAIT_L(0); PG8_MMA(1, 0, At, B0); PG8_BAR; PG8_SCHED;
            PG8_STAGE(PG8_SB(1, 1), b3 + hstep, voffB);
            PG8_WAIT_V(6); PG8_BAR; PG8_MMA(1, 1, At, B1); PG8_BAR;
        }
        PG8_STAMP();
        if constexpr (!Epi::AFTER_DRAIN) { E(acc, cur, wr, wc, fr, fq); S.done(cur); }
        PG8_STAMP();
        if (!has_next) break;
#pragma unroll
        for (int a = 0; a < 2; ++a)
#pragma unroll
            for (int b = 0; b < 2; ++b)
#pragma unroll
                for (int m = 0; m < 4; ++m)
#pragma unroll
                    for (int n = 0; n < 2; ++n) acc[a][b][m][n] = (f32x4){0.f, 0.f, 0.f, 0.f};
        cur = nxt; cA = nA; cB = nB; dA = ndA; dB = ndB; ++ui;
    }
    PG8_WAIT_V(0);
    if (wr == 0) PG8_BAR;
    PG8_BAR;
    if constexpr (Epi::AFTER_DRAIN) { E.fused(acc, cur, wr, wc, fr, fq, lds, wid, lane); S.done(cur); }
    PG8_STAMP();
    if (STAMP && wid == 0) { stamps[lane] = lane < nts ? (((unsigned long long)(unsigned)ts_hi << 32) | (unsigned)ts_lo) : 0ull;
        if (lane == 62) stamps[62] = rt_entry; if (lane == 63) stamps[63] = (unsigned long long)wall_clock64(); }
#undef PG8_STAMP
#undef PG8_TA
#undef PG8_TB
#undef PG8_SA
#undef PG8_SB
#undef PG8_STAGE
#undef PG8_LDA
#undef PG8_LDB
#undef PG8_MMA
#undef PG8_WAIT_V
#undef PG8_WAIT_L
#undef PG8_BAR
#undef PG8_SCHED
}
}
#define XB_TMO      128
#define XB_XCNT(j)  (256  + 64 * (j))
#define XB_XSUB(j)  (1280 + 64 * (j))
#define XB_XGEN(j)  (2304 + 64 * (j))
#define XB_TOP      3328
#define XB_TOPGEN   3392
#define XCD_BAR_WORDS 3456
#define XB_SPIN_CAP (1u << 18)
#define LAS __attribute__((address_space(3)))

__device__ __forceinline__ unsigned xb_ld(unsigned* p)              { return __hip_atomic_load(p, __ATOMIC_RELAXED, __HIP_MEMORY_SCOPE_AGENT); }
__device__ __forceinline__ unsigned xb_add(unsigned* p, unsigned v) { return __hip_atomic_fetch_add(p, v, __ATOMIC_RELAXED, __HIP_MEMORY_SCOPE_AGENT); }
__device__ __forceinline__ unsigned xb_xcc_id() { return (unsigned)__builtin_amdgcn_s_getreg((3 << 11) | 20) & 0xFu; }
#define XB_SPIN(cond, bar) do { unsigned _sp = 0; while (cond) { __builtin_amdgcn_s_sleep(1); \
    if ((++_sp & 255u) == 0u) { if (xb_ld(&(bar)[XB_TMO])) break; if (_sp > XB_SPIN_CAP) { atomicAdd(&(bar)[XB_TMO], 1u); break; } } } } while (0)

struct XcdBarrier {
    unsigned* bar; unsigned x;
    volatile LAS unsigned* st;
};

__device__ __forceinline__ XcdBarrier xcd_barrier_post(unsigned* bar, volatile LAS unsigned* st) {
    XcdBarrier b; b.bar = bar; b.x = xb_xcc_id(); b.st = st;
    if (threadIdx.x == 0) (void)xb_add(&bar[XB_XCNT(b.x)], 1u);
    return b;
}
__device__ __forceinline__ void xcd_barrier_complete(unsigned* bar, unsigned x, unsigned& nloc, unsigned& nx) {
    const unsigned G = gridDim.x * gridDim.y * gridDim.z;
    unsigned sum, cnt, mine, sp = 0u;
    for (;;) {
        sum = 0u; cnt = 0u; mine = 0u;
#pragma unroll
        for (unsigned j = 0; j < 16; ++j) { const unsigned c = xb_ld(&bar[XB_XCNT(j)]); sum += c; cnt += (c > 0u) ? 1u : 0u; mine = (j == x) ? c : mine; }
        if (sum == G) break;
        __builtin_amdgcn_s_sleep(1);
        if ((++sp & 255u) == 0u) { if (xb_ld(&bar[XB_TMO])) break; if (sp > XB_SPIN_CAP) { atomicAdd(&bar[XB_TMO], 1u); break; } }
    }
    nloc = mine > 0u ? mine : 1u; nx = cnt > 0u ? cnt : 1u;
}

__device__ __forceinline__ void xcd_barrier(const XcdBarrier& b) {
    asm volatile("s_waitcnt vmcnt(0)" ::: "memory");
    __syncthreads();
    if (threadIdx.x == 0) {
        unsigned* bar = b.bar;
        __builtin_amdgcn_s_waitcnt(0);
        unsigned nloc = b.st[0], nx = b.st[1];
        if (nloc == 0u) { xcd_barrier_complete(bar, b.x, nloc, nx); b.st[0] = nloc; b.st[1] = nx; }
        const unsigned old = xb_add(&bar[XB_XSUB(b.x)], 1u);
        const unsigned gen = old / nloc;
        if (old + 1u == (gen + 1u) * nloc) {
            __builtin_amdgcn_fence(__ATOMIC_RELEASE, "agent");
            asm volatile("s_waitcnt vmcnt(0)" ::: "memory");
            const unsigned og = xb_add(&bar[XB_TOP], 1u);
            const unsigned tg = og / nx;
            if (og + 1u == (tg + 1u) * nx) xb_add(&bar[XB_TOPGEN], 1u);
            else XB_SPIN(xb_ld(&bar[XB_TOPGEN]) == tg, bar);
            __builtin_amdgcn_fence(__ATOMIC_ACQUIRE, "agent");
            xb_add(&bar[XB_XGEN(b.x)], 1u);
            asm volatile("s_waitcnt vmcnt(0)" ::: "memory");
        } else {
            XB_SPIN(xb_ld(&bar[XB_XGEN(b.x)]) == gen, bar);
            __builtin_amdgcn_fence(__ATOMIC_ACQUIRE, "agent");
            asm volatile("s_waitcnt vmcnt(0)" ::: "memory");
        }
    }
    __syncthreads();
}

typedef unsigned short bf16;
using pg8::f32x4;
constexpr int T = 16384, SEQ = 4096, D = 1024, DIN = 4768, DINP = 4864;
constexpr int C_A = 0, C_B = 512, C_R = 1024, C_K = 1536, C_V = 2048, C_LW = 2560, C_LA = 2592, C_LG = 2624, C_GC = 2720, C_GR = 3744;
constexpr size_t MiB = 1u << 20;
constexpr size_t WS_WIN_T = 0, WS_PW_T = 10 * MiB, WS_WO_T = 11 * MiB, WS_WOUT_T = 12 * MiB, WS_WQ_T = 14 * MiB, WS_KEYS = 18 * MiB,
                 WS_BONUS = 18 * MiB + 512 * 1024, WS_XN = 20 * MiB, WS_PROJ = 52 * MiB, WS_LD = 204 * MiB, WS_YN = 236 * MiB, WS_END = 252 * MiB;
constexpr size_t WS_BETA = WS_XN, WS_G = WS_XN + 16 * MiB, WS_M = WS_LD;
constexpr size_t WS_Q = WS_PROJ, WS_UB = WS_PROJ + 64 * MiB, WS_VB = WS_PROJ + 96 * MiB, WS_EID = WS_PROJ + 128 * MiB, WS_GATE = WS_PROJ + 136 * MiB;

__device__ __forceinline__ bf16 f2bf(float f) { return __builtin_bit_cast(unsigned short, (__bf16)f); }
__device__ __forceinline__ float bf2f(bf16 b) { return __uint_as_float(((unsigned)b) << 16); }
__device__ __forceinline__ float bflo(unsigned w) { return __uint_as_float(w << 16); }
__device__ __forceinline__ float bfhi(unsigned w) { return __uint_as_float(w & 0xFFFF0000u); }
typedef __bf16 bf16x2_t __attribute__((ext_vector_type(2)));
__device__ __forceinline__ unsigned pack2(float lo, float hi) { bf16x2_t v; v[0] = (__bf16)lo; v[1] = (__bf16)hi; return __builtin_bit_cast(unsigned, v); }
__device__ __forceinline__ float wave_sum(float v) {
#pragma unroll
    for (int o = 32; o > 0; o >>= 1) v += __shfl_xor(v, o, 64);
    return v;
}
__device__ __forceinline__ float sigmoidf_(float x) { return __builtin_amdgcn_rcpf(1.f + __expf(-x)); }
__device__ __forceinline__ float tanhf_(float x) { return 1.f - 2.f * __builtin_amdgcn_rcpf(1.f + __expf(2.f * x)); }
__device__ __forceinline__ void unpack8(const uint4 v, float (&f)[8]) {
    f[0] = bflo(v.x); f[1] = bfhi(v.x); f[2] = bflo(v.y); f[3] = bfhi(v.y); f[4] = bflo(v.z); f[5] = bfhi(v.z); f[6] = bflo(v.w); f[7] = bfhi(v.w);
}
__device__ __forceinline__ uint4 pack8(const float (&f)[8]) {
    uint4 v; v.x = pack2(f[0], f[1]); v.y = pack2(f[2], f[3]); v.z = pack2(f[4], f[5]); v.w = pack2(f[6], f[7]); return v;
}

__device__ __forceinline__ int ph_transpose(unsigned char* shm, int bid, int nblk, int tile0, const float* __restrict__ src, bf16* __restrict__ dst, int K, int N, int Npad, const float* __restrict__ kscale = nullptr) {
    float (*tile)[65] = (float (*)[65])shm;
    const int ntn = Npad / 64, ntiles = ntn * (K / 64);
    int first = bid - (tile0 % nblk); if (first < 0) first += nblk;
    for (int tl = first; tl < ntiles; tl += nblk) {
        const int n0 = (tl % ntn) * 64, k0 = (tl / ntn) * 64;
        __syncthreads();
        for (int i = threadIdx.x; i < 64 * 64; i += 512) { const int kk = i >> 6, nn = i & 63; float v = 0.f; if (n0 + nn < N) v = src[(size_t)(k0 + kk) * N + n0 + nn]; if (kscale) v *= kscale[k0 + kk]; tile[kk][nn] = v; }
        __syncthreads();
        for (int i = threadIdx.x; i < 64 * 64; i += 512) { const int nn = i >> 6, kk = i & 63; dst[(size_t)(n0 + nn) * K + k0 + kk] = f2bf(tile[kk][nn]); }
    }
    return ntiles;
}
__device__ __forceinline__ int ph_transpose_reg(int bid, int nblk, int tile0, const float* __restrict__ src, bf16* __restrict__ dst, int K, int N, int Npad) {
    const int lane = threadIdx.x & 63, n4 = lane & 7, j = lane >> 3, ntn = Npad / 32, ntiles = ntn * (K / 64);
    int first = bid * 8 + (int)(threadIdx.x >> 6) - (tile0 % (nblk * 8)); if (first < 0) first += nblk * 8;
    for (int tl = first; tl < ntiles; tl += nblk * 8) {
        const int n0 = (tl % ntn) * 32 + 4 * n4, k0 = (tl / ntn) * 64 + 8 * j;
        float4 v[8];
        if (n0 < N) {
#pragma unroll
            for (int i = 0; i < 8; ++i) v[i] = *(const float4*)(src + (size_t)(k0 + i) * N + n0);
        } else {
#pragma unroll
            for (int i = 0; i < 8; ++i) v[i] = make_float4(0.f, 0.f, 0.f, 0.f);
        }
        uint4 o;
        o.x = pack2(v[0].x, v[1].x); o.y = pack2(v[2].x, v[3].x); o.z = pack2(v[4].x, v[5].x); o.w = pack2(v[6].x, v[7].x); *(uint4*)(dst + (size_t)(n0 + 0) * K + k0) = o;
        o.x = pack2(v[0].y, v[1].y); o.y = pack2(v[2].y, v[3].y); o.z = pack2(v[4].y, v[5].y); o.w = pack2(v[6].y, v[7].y); *(uint4*)(dst + (size_t)(n0 + 1) * K + k0) = o;
        o.x = pack2(v[0].z, v[1].z); o.y = pack2(v[2].z, v[3].z); o.z = pack2(v[4].z, v[5].z); o.w = pack2(v[6].z, v[7].z); *(uint4*)(dst + (size_t)(n0 + 2) * K + k0) = o;
        o.x = pack2(v[0].w, v[1].w); o.y = pack2(v[2].w, v[3].w); o.z = pack2(v[4].w, v[5].w); o.w = pack2(v[6].w, v[7].w); *(uint4*)(dst + (size_t)(n0 + 3) * K + k0) = o;
    }
    return ntiles;
}
__device__ __forceinline__ void ph_cvt(int bid, int nblk, const float* __restrict__ src, bf16* __restrict__ dst, size_t n4) {
    for (size_t i = (size_t)bid * 512 + threadIdx.x; i < n4; i += (size_t)nblk * 512) {
        const float4 v = ((const float4*)src)[i]; uint2 o; o.x = pack2(v.x, v.y); o.y = pack2(v.z, v.w); ((uint2*)dst)[i] = o; }
}
__device__ __forceinline__ void ph_rmsnorm(int bid, int nblk, const float* __restrict__ x, const float* __restrict__ g, bf16* __restrict__ out, int rows) {
    const int wave = (bid * 512 + threadIdx.x) >> 6, nw = (nblk * 512) >> 6, lane = threadIdx.x & 63;
    float4 gg[4], nx[4];
#pragma unroll
    for (int i = 0; i < 4; ++i) gg[i] = ((const float4*)g)[lane + 64 * i];
    if (wave < rows) {
#pragma unroll
        for (int i = 0; i < 4; ++i) nx[i] = ((const float4*)(x + (size_t)wave * D))[lane + 64 * i];
    }
    for (int r = wave; r < rows; r += nw) {
        float4 v[4]; float ss = 0.f;
#pragma unroll
        for (int i = 0; i < 4; ++i) v[i] = nx[i];
        if (r + nw < rows) {
#pragma unroll
            for (int i = 0; i < 4; ++i) nx[i] = ((const float4*)(x + (size_t)(r + nw) * D))[lane + 64 * i];
        }
#pragma unroll
        for (int i = 0; i < 4; ++i) ss += v[i].x * v[i].x + v[i].y * v[i].y + v[i].z * v[i].z + v[i].w * v[i].w;
        ss = wave_sum(ss);
        const float sc = rsqrtf(ss * (1.f / D) + 1e-6f);
#pragma unroll
        for (int i = 0; i < 4; ++i) { uint2 o; o.x = pack2(v[i].x * sc * gg[i].x, v[i].y * sc * gg[i].y); o.y = pack2(v[i].z * sc * gg[i].z, v[i].w * sc * gg[i].w);
            ((uint2*)(out + (size_t)r * D))[lane + 64 * i] = o; }
    }
}

template <class F> struct EpiGen {
    static constexpr bool PERM = true, AFTER_DRAIN = false;
    F f;
    __device__ __forceinline__ void operator()(const f32x4 (&acc)[2][2][4][2], const pg8::Unit& u, int wr, int wc, int fr, int fq) const {
        const int row0 = u.pm * 256 + wr * 64 + fr, col0 = u.pn * 256 + wc * 32 + 8 * fq;
#pragma unroll
        for (int ai = 0; ai < 2; ++ai)
#pragma unroll
            for (int m = 0; m < 4; ++m)
#pragma unroll
                for (int bj = 0; bj < 2; ++bj) f(row0 + ai * 128 + m * 16, col0 + bj * 128, acc[ai][bj][m][0], acc[ai][bj][m][1]);
    }
};
struct FStoreBf16 { bf16* O; int ldc;
    __device__ __forceinline__ void operator()(int row, int col, f32x4 a, f32x4 b) const {
        uint4 o; o.x = pack2(a[0], a[1]); o.y = pack2(a[2], a[3]); o.z = pack2(b[0], b[1]); o.w = pack2(b[2], b[3]);
        typedef unsigned nt4 __attribute__((ext_vector_type(4))); nt4 w; w[0] = o.x; w[1] = o.y; w[2] = o.z; w[3] = o.w;
        __builtin_nontemporal_store(w, (nt4*)(O + (size_t)row * ldc + col)); } };
struct FConvM { bf16* M; const bf16* proj; const float* bias;
    __device__ __forceinline__ void operator()(int row, int col, f32x4 a, f32x4 b) const {
        float gl[8]; unpack8(*(const uint4*)(proj + (size_t)row * DINP + C_GC + col), gl);
        const float4 b0 = *(const float4*)(bias + col), b1 = *(const float4*)(bias + col + 4);
        float o[8] = {a[0] + b0.x, a[1] + b0.y, a[2] + b0.z, a[3] + b0.w, b[0] + b1.x, b[1] + b1.y, b[2] + b1.z, b[3] + b1.w};
#pragma unroll
        for (int i = 0; i < 8; ++i) o[i] *= sigmoidf_(gl[i]);
        *(uint4*)(M + (size_t)row * D + col) = pack8(o); } };
struct FRwM { bf16* M; const bf16* proj;
    __device__ __forceinline__ void operator()(int row, int col, f32x4 a, f32x4 b) const {
        float gl[8], mo[8]; unpack8(*(const uint4*)(proj + (size_t)row * DINP + C_GR + col), gl); unpack8(*(const uint4*)(M + (size_t)row * D + col), mo);
        float o[8] = {a[0], a[1], a[2], a[3], b[0], b[1], b[2], b[3]};
#pragma unroll
        for (int i = 0; i < 8; ++i) o[i] = mo[i] + o[i] * sigmoidf_(gl[i]);
        *(uint4*)(M + (size_t)row * D + col) = pack8(o); } };
struct FResX1 { const float* x; float* x1;
    __device__ __forceinline__ void operator()(int row, int col, f32x4 a, f32x4 b) const {
        const float4 x0 = *(const float4*)(x + (size_t)row * D + col), x1v = *(const float4*)(x + (size_t)row * D + col + 4);
        *(float4*)(x1 + (size_t)row * D + col) = make_float4(x0.x + a[0], x0.y + a[1], x0.z + a[2], x0.w + a[3]);
        *(float4*)(x1 + (size_t)row * D + col + 4) = make_float4(x1v.x + b[0], x1v.y + b[1], x1v.z + b[2], x1v.w + b[3]); } };

template <class F> struct EpiGen2 {
    static constexpr bool PERM = true, AFTER_DRAIN = false;
    F f;
    __device__ __forceinline__ void operator()(const f32x4 (&acc)[2][2][4][2], const pg8::Unit& u, int wr, int wc, int fr, int fq) const {
        const int row0 = u.pm * 256 + wr * 64 + fr, col0 = u.pn * 256 + wc * 32 + 8 * fq;
#pragma unroll
        for (int ai = 0; ai < 2; ++ai) {
            typename F::Pre P[4][2];
#pragma unroll
            for (int m = 0; m < 4; ++m)
#pragma unroll
                for (int bj = 0; bj < 2; ++bj) P[m][bj] = f.pre(row0 + ai * 128 + m * 16, col0 + bj * 128);
#pragma unroll
            for (int m = 0; m < 4; ++m)
#pragma unroll
                for (int bj = 0; bj < 2; ++bj) f.post(row0 + ai * 128 + m * 16, col0 + bj * 128, acc[ai][bj][m][0], acc[ai][bj][m][1], P[m][bj]);
        }
    }
};
struct FConvM2 { bf16* M; const bf16* proj; const float* bias;
    struct Pre { uint4 g; };
    __device__ __forceinline__ Pre pre(int row, int col) const { Pre p; p.g = *(const uint4*)(proj + (size_t)row * DINP + C_GC + col); return p; }
    __device__ __forceinline__ void post(int row, int col, f32x4 a, f32x4 b, const Pre& p) const {
        float gl[8]; unpack8(p.g, gl);
        const float4 b0 = *(const float4*)(bias + col), b1 = *(const float4*)(bias + col + 4);
        float o[8] = {a[0] + b0.x, a[1] + b0.y, a[2] + b0.z, a[3] + b0.w, b[0] + b1.x, b[1] + b1.y, b[2] + b1.z, b[3] + b1.w};
#pragma unroll
        for (int i = 0; i < 8; ++i) o[i] *= sigmoidf_(gl[i]);
        *(uint4*)(M + (size_t)row * D + col) = pack8(o); } };
struct FRwM2 { bf16* M; const bf16* proj;
    struct Pre { uint4 g, m; };
    __device__ __forceinline__ Pre pre(int row, int col) const { Pre p; p.g = *(const uint4*)(proj + (size_t)row * DINP + C_GR + col); p.m = *(const uint4*)(M + (size_t)row * D + col); return p; }
    __device__ __forceinline__ void post(int row, int col, f32x4 a, f32x4 b, const Pre& p) const {
        float gl[8], mo[8]; unpack8(p.g, gl); unpack8(p.m, mo);
        float o[8] = {a[0], a[1], a[2], a[3], b[0], b[1], b[2], b[3]};
#pragma unroll
        for (int i = 0; i < 8; ++i) o[i] = mo[i] + o[i] * sigmoidf_(gl[i]);
        *(uint4*)(M + (size_t)row * D + col) = pack8(o); } };
struct FResX12B { const float* x; bf16* x1;
    struct Pre { float4 a, b; };
    __device__ __forceinline__ Pre pre(int row, int col) const { Pre p; p.a = *(const float4*)(x + (size_t)row * D + col); p.b = *(const float4*)(x + (size_t)row * D + col + 4); return p; }
    __device__ __forceinline__ void post(int row, int col, f32x4 a, f32x4 b, const Pre& p) const {
        *(uint4*)(x1 + (size_t)row * D + col) = make_uint4(pack2(p.a.x + a[0], p.a.y + a[1]), pack2(p.a.z + a[2], p.a.w + a[3]), pack2(p.b.x + b[0], p.b.y + b[1]), pack2(p.b.z + b[2], p.b.w + b[3])); } };
struct FResX12 { const float* x; float* x1;
    struct Pre { float4 a, b; };
    __device__ __forceinline__ Pre pre(int row, int col) const { Pre p; p.a = *(const float4*)(x + (size_t)row * D + col); p.b = *(const float4*)(x + (size_t)row * D + col + 4); return p; }
    __device__ __forceinline__ void post(int row, int col, f32x4 a, f32x4 b, const Pre& p) const {
        *(float4*)(x1 + (size_t)row * D + col) = make_float4(p.a.x + a[0], p.a.y + a[1], p.a.z + a[2], p.a.w + a[3]);
        *(float4*)(x1 + (size_t)row * D + col + 4) = make_float4(p.b.x + b[0], p.b.y + b[1], p.b.z + b[2], p.b.w + b[3]); } };

struct EpiMix {
    static constexpr bool PERM = true, AFTER_DRAIN = false;
    bf16* M; const bf16* proj; const float* bias;
    __device__ __forceinline__ void mid(f32x4 (&acc)[2][2][4][2], const pg8::Unit& u, int wr, int wc, int fr_, int fq_) const {
        int fr = fr_, fq = fq_; asm volatile("" : "+v"(fr), "+v"(fq));
        const int row0 = u.pm * 256 + wr * 64 + fr, col0 = u.pn * 256 + wc * 32 + 8 * fq;
#pragma unroll
        for (int ai = 0; ai < 2; ++ai)
#pragma unroll
            for (int mh = 0; mh < 2; ++mh) {
                uint4 gc[2][2], gr[2][2];
#pragma unroll
                for (int mm = 0; mm < 2; ++mm)
#pragma unroll
                    for (int bj = 0; bj < 2; ++bj) { const bf16* pr = proj + (size_t)(row0 + ai * 128 + (mh * 2 + mm) * 16) * DINP + col0 + bj * 128; gc[mm][bj] = *(const uint4*)(pr + C_GC); gr[mm][bj] = *(const uint4*)(pr + C_GR); }
#pragma unroll
                for (int mm = 0; mm < 2; ++mm)
#pragma unroll
                    for (int bj = 0; bj < 2; ++bj) {
                        const int m = mh * 2 + mm;
                        float c8[8], r8[8]; unpack8(gc[mm][bj], c8); unpack8(gr[mm][bj], r8);
                        const float4 b0 = *(const float4*)(bias + col0 + bj * 128), b1 = *(const float4*)(bias + col0 + bj * 128 + 4);
                        const float bb[8] = {b0.x, b0.y, b0.z, b0.w, b1.x, b1.y, b1.z, b1.w};
#pragma unroll
                        for (int i = 0; i < 8; ++i) { const float ratio = (1.f + __expf(-r8[i])) * __builtin_amdgcn_rcpf(1.f + __expf(-c8[i]));
                            if (i < 4) acc[ai][bj][m][0][i] = (acc[ai][bj][m][0][i] + bb[i]) * ratio; else acc[ai][bj][m][1][i - 4] = (acc[ai][bj][m][1][i - 4] + bb[i]) * ratio; }
                    }
                asm volatile("" ::: "memory");
            }
    }
    __device__ __forceinline__ void operator()(const f32x4 (&acc)[2][2][4][2], const pg8::Unit& u, int wr, int wc, int fr, int fq) const {
        const int row0 = u.pm * 256 + wr * 64 + fr, col0 = u.pn * 256 + wc * 32 + 8 * fq;
#pragma unroll
        for (int ai = 0; ai < 2; ++ai) {
            uint4 gr[4][2];
#pragma unroll
            for (int m = 0; m < 4; ++m)
#pragma unroll
                for (int bj = 0; bj < 2; ++bj) gr[m][bj] = *(const uint4*)(proj + (size_t)(row0 + ai * 128 + m * 16) * DINP + C_GR + col0 + bj * 128);
#pragma unroll
            for (int m = 0; m < 4; ++m)
#pragma unroll
                for (int bj = 0; bj < 2; ++bj) {
                    float r8[8], o[8]; unpack8(gr[m][bj], r8);
#pragma unroll
                    for (int i = 0; i < 8; ++i) o[i] = ((i < 4) ? acc[ai][bj][m][0][i] : acc[ai][bj][m][1][i - 4]) * sigmoidf_(r8[i]);
                    *(uint4*)(M + (size_t)(row0 + ai * 128 + m * 16) * D + col0 + bj * 128) = pack8(o);
                }
        }
    }
};
template <class Epi> __device__ __forceinline__ void ph_gemm2(unsigned char* shm, int bid, int nblk, const bf16* A, const bf16* Bt, const bf16* A2, const bf16* Bt2, int M, int N, int K, int nt1, int nt, const Epi& E) {
    pg8::Gemm2 g{A, Bt, A2, Bt2, M, N, K, nt1, nt};
    pg8::StaticOrder S; S.init(M, N, nblk, bid);
    pg8::gemm_phase2<Epi, pg8::StaticOrder, false>((PG8_LAS unsigned char*)shm, g, S, E, nullptr);
}
template <class Epi> __device__ __forceinline__ void ph_gemm(unsigned char* shm, int bid, int nblk, const bf16* A, const bf16* Bt, int M, int N, int K, const Epi& E) {
    pg8::Gemm g{A, Bt, M, N, K};
    pg8::StaticOrder S; S.init(M, N, nblk, bid);
    pg8::gemm_phase<Epi, pg8::StaticOrder, false>((PG8_LAS unsigned char*)shm, g, S, E, nullptr);
}

constexpr int CONV_GLU = 62 * 512 * 2, CONV_LDS = CONV_GLU + 31 * 512 * 4;
__device__ __forceinline__ float fmac1(float a, float b, float c) { asm("v_fmac_f32 %0, %1, %2" : "+v"(c) : "v"(a), "v"(b)); return c; }
__device__ __forceinline__ void ph_conv(unsigned char* shm, int bid, int nblk, const bf16* __restrict__ proj, const float* __restrict__ dw, const float* __restrict__ dwb,
                                              const float* __restrict__ lng, const float* __restrict__ lnb, bf16* __restrict__ yn) {
    bf16* glu = (bf16*)shm;
    float* dws = (float*)(shm + CONV_GLU);
    const int tid = threadIdx.x, lane = tid & 63, wid = tid >> 6;
    if (bid < T / 32) { for (int i = tid; i < 31 * 128; i += 512) ((float4*)dws)[i] = ((const float4*)dw)[i]; }
    const float4 g0 = *(const float4*)(lng + lane * 8), g1 = *(const float4*)(lng + lane * 8 + 4), e0 = *(const float4*)(lnb + lane * 8), e1 = *(const float4*)(lnb + lane * 8 + 4);
    const float4 b0 = *(const float4*)(dwb + lane * 8), b1 = *(const float4*)(dwb + lane * 8 + 4);
    const float gg[8] = {g0.x, g0.y, g0.z, g0.w, g1.x, g1.y, g1.z, g1.w}, ee[8] = {e0.x, e0.y, e0.z, e0.w, e1.x, e1.y, e1.z, e1.w};
    for (int tile = bid; tile < T / 32; tile += nblk) {
        const int t0 = tile * 32, sq0 = t0 & ~(SEQ - 1);
        __syncthreads();
#pragma unroll
        for (int hb = 0; hb < 2; ++hb) {
            uint4 av[4], bv[4];
#pragma unroll
            for (int k = 0; k < 4; ++k) { const int it = tid + 512 * (hb * 4 + k), rr = it >> 6, cg = it & 63, t = t0 - 30 + rr;
                av[k] = make_uint4(0, 0, 0, 0); bv[k] = make_uint4(0, 0, 0, 0);
                if (rr < 62 && t >= sq0) { av[k] = *(const uint4*)(proj + (size_t)t * DINP + C_A + cg * 8); bv[k] = *(const uint4*)(proj + (size_t)t * DINP + C_B + cg * 8); } }
#pragma unroll
            for (int k = 0; k < 4; ++k) { const int it = tid + 512 * (hb * 4 + k), rr = it >> 6, cg = it & 63;
                if (rr < 62) { float a[8], b[8]; unpack8(av[k], a); unpack8(bv[k], b);
#pragma unroll
                    for (int i = 0; i < 8; ++i) a[i] *= sigmoidf_(b[i]);
                    *(uint4*)(glu + rr * 512 + cg * 8) = pack8(a); } }
        }
        __syncthreads();
        float acc[4][8];
#pragma unroll
        for (int i = 0; i < 4; ++i) { acc[i][0] = b0.x; acc[i][1] = b0.y; acc[i][2] = b0.z; acc[i][3] = b0.w; acc[i][4] = b1.x; acc[i][5] = b1.y; acc[i][6] = b1.z; acc[i][7] = b1.w; }
#pragma unroll 4
        for (int j = 0; j < 31; ++j) {
            const float4 w0 = *(const float4*)(dws + j * 512 + lane * 8), w1 = *(const float4*)(dws + j * 512 + lane * 8 + 4);
            const float w[8] = {w0.x, w0.y, w0.z, w0.w, w1.x, w1.y, w1.z, w1.w};
#pragma unroll
            for (int i = 0; i < 4; ++i) { float gv[8]; unpack8(*(const uint4*)(glu + (wid * 4 + i + j) * 512 + lane * 8), gv);
#pragma unroll
                for (int c = 0; c < 8; ++c) acc[i][c] = fmac1(gv[c], w[c], acc[i][c]); }
        }
#pragma unroll
        for (int i = 0; i < 4; ++i) {
            float s = 0.f;
#pragma unroll
            for (int c = 0; c < 8; ++c) s += acc[i][c];
            const float mean = wave_sum(s) * (1.f / 512.f);
            float q = 0.f;
#pragma unroll
            for (int c = 0; c < 8; ++c) { acc[i][c] -= mean; q += acc[i][c] * acc[i][c]; }
            const float rstd = rsqrtf(wave_sum(q) * (1.f / 512.f) + 1e-5f);
            float o[8];
#pragma unroll
            for (int c = 0; c < 8; ++c) { const float z = acc[i][c] * rstd * gg[c] + ee[c]; o[c] = z * sigmoidf_(z); }
            *(uint4*)(yn + (size_t)(t0 + wid * 4 + i) * 512 + lane * 8) = pack8(o);
        }
    }
}


constexpr int CS = 72;
constexpr int SLOT = 64 * CS * 2;
constexpr int CP_SMALL = 15 * SLOT;
struct ChunkParams { const bf16* proj; const float *mu, *w0, *w2, *a0, *a2, *g2, *k_k, *k_a, *r_k; bf16 *V, *G, *PHI, *PSI, *OMG, *Y0; float* BONUS; };

__device__ __forceinline__ f32x4 tile_mm(const bf16* A, const bf16* Bt, int m0, int n0, int fr, int fq, f32x4 acc) {
#pragma unroll
    for (int ks = 0; ks < 2; ++ks) {
        const pg8::bf16x8 a = *(const pg8::bf16x8*)(A + (m0 + fr) * CS + ks * 32 + fq * 8);
        const pg8::bf16x8 b = *(const pg8::bf16x8*)(Bt + (n0 + fr) * CS + ks * 32 + fq * 8);
        acc = __builtin_amdgcn_mfma_f32_16x16x32_bf16(a, b, acc, 0, 0, 0);
    }
    return acc;
}
struct Frag2 { pg8::bf16x8 k0, k1; };
__device__ __forceinline__ Frag2 ld_frag(const bf16* M, int row0, int fr, int fq) {
    Frag2 f; f.k0 = *(const pg8::bf16x8*)(M + (row0 + fr) * CS + fq * 8); f.k1 = *(const pg8::bf16x8*)(M + (row0 + fr) * CS + 32 + fq * 8); return f; }
__device__ __forceinline__ f32x4 mmf(const Frag2& a, const Frag2& b, f32x4 acc) {
    acc = __builtin_amdgcn_mfma_f32_16x16x32_bf16(a.k0, b.k0, acc, 0, 0, 0); acc = __builtin_amdgcn_mfma_f32_16x16x32_bf16(a.k1, b.k1, acc, 0, 0, 0); return acc; }
__device__ __forceinline__ f32x4 tile_mm_sw(const bf16* A, const bf16* Bt, int m0, int n0, int fr, int fq, f32x4 acc) {
#pragma unroll
    for (int ks = 0; ks < 2; ++ks) {
        const pg8::bf16x8 a = *(const pg8::bf16x8*)(A + (m0 + fr) * CS + ks * 32 + fq * 8);
        const pg8::bf16x8 b = *(const pg8::bf16x8*)(Bt + (n0 + fr) * CS + ks * 32 + fq * 8);
        acc = __builtin_amdgcn_mfma_f32_16x16x32_bf16(b, a, acc, 0, 0, 0);
    }
    return acc;
}
__device__ __forceinline__ void tile_mm2(const bf16* A, const bf16* Bt, int m0, int n0, int fr, int fq, f32x4& accN, f32x4& accS) {
#pragma unroll
    for (int ks = 0; ks < 2; ++ks) {
        const pg8::bf16x8 a = *(const pg8::bf16x8*)(A + (m0 + fr) * CS + ks * 32 + fq * 8);
        const pg8::bf16x8 b = *(const pg8::bf16x8*)(Bt + (n0 + fr) * CS + ks * 32 + fq * 8);
        accN = __builtin_amdgcn_mfma_f32_16x16x32_bf16(a, b, accN, 0, 0, 0);
        accS = __builtin_amdgcn_mfma_f32_16x16x32_bf16(b, a, accS, 0, 0, 0);
    }
}
__device__ __forceinline__ void st_rm4(bf16* buf, int m0, int n0, int fr, int fq, f32x4 v) {
    uint2 o; o.x = pack2(v[0], v[1]); o.y = pack2(v[2], v[3]); *(uint2*)(buf + (m0 + fr) * CS + n0 + 4 * fq) = o;
}
__device__ __forceinline__ f32x4 ld_rm4(const bf16* buf, int m0, int n0, int fr, int fq) {
    const uint2 o = *(const uint2*)(buf + (m0 + fr) * CS + n0 + 4 * fq);
    f32x4 v; v[0] = bflo(o.x); v[1] = bfhi(o.x); v[2] = bflo(o.y); v[3] = bfhi(o.y); return v;
}
__device__ __forceinline__ void st_rm(bf16* buf, int m0, int n0, int fr, int fq, f32x4 v) {
#pragma unroll
    for (int r = 0; r < 4; ++r) buf[(m0 + 4 * fq + r) * CS + n0 + fr] = f2bf(v[r]);
}
__device__ __forceinline__ void st_tr(bf16* buf, int m0, int n0, int fr, int fq, f32x4 v) {
    uint2 o; o.x = pack2(v[0], v[1]); o.y = pack2(v[2], v[3]); *(uint2*)(buf + (n0 + fr) * CS + m0 + 4 * fq) = o;
}
__device__ __forceinline__ f32x4 ld_rm(const bf16* buf, int m0, int n0, int fr, int fq) {
    f32x4 v;
#pragma unroll
    for (int r = 0; r < 4; ++r) v[r] = bf2f(buf[(m0 + 4 * fq + r) * CS + n0 + fr]);
    return v;
}
__device__ __forceinline__ f32x4 ld_tr(const bf16* buf, int m0, int n0, int fr, int fq) {
    const uint2 o = *(const uint2*)(buf + (n0 + fr) * CS + m0 + 4 * fq);
    f32x4 v; v[0] = bflo(o.x); v[1] = bfhi(o.x); v[2] = bflo(o.y); v[3] = bfhi(o.y); return v;
}

__device__ __forceinline__ int opq(int v) { asm volatile("" : "+v"(v)); return v; }
template <int CTRL> __device__ __forceinline__ float dppf(float v) { return __int_as_float(__builtin_amdgcn_update_dpp(0, __float_as_int(v), CTRL, 0xF, 0xF, true)); }
__device__ __forceinline__ void wave_sum16(float (&r)[16]) {
    const int l = (int)(threadIdx.x & 63);
    const bool o1 = (l & 1) != 0, o2 = (l & 2) != 0;
    float a[8], b[4];
#pragma unroll
    for (int j = 0; j < 8; ++j) { const float kp = o1 ? r[8 + j] : r[j], sn = o1 ? r[j] : r[8 + j]; a[j] = kp + dppf<0xB1>(sn); }
#pragma unroll
    for (int j = 0; j < 4; ++j) { const float kp = o2 ? a[4 + j] : a[j], sn = o2 ? a[j] : a[4 + j]; b[j] = kp + dppf<0x4E>(sn); }
#pragma unroll
    for (int j = 0; j < 4; ++j) { b[j] += dppf<0x124>(b[j]); b[j] += dppf<0x128>(b[j]); b[j] += __shfl_xor(b[j], 16, 64); b[j] += __shfl_xor(b[j], 32, 64); }
#pragma unroll
    for (int j = 0; j < 4; ++j) { r[j] = dppf<0x00>(b[j]); r[8 + j] = dppf<0x55>(b[j]); r[4 + j] = dppf<0xAA>(b[j]); r[12 + j] = dppf<0xFF>(b[j]); }
}
__device__ __forceinline__ float wave_sum_dpp(float v) {
    v += dppf<0xB1>(v); v += dppf<0x4E>(v); v += dppf<0x141>(v); v += dppf<0x140>(v);
    const float r0 = __int_as_float(__builtin_amdgcn_readlane(__float_as_int(v), 0)), r1 = __int_as_float(__builtin_amdgcn_readlane(__float_as_int(v), 16));
    const float r2 = __int_as_float(__builtin_amdgcn_readlane(__float_as_int(v), 32)), r3 = __int_as_float(__builtin_amdgcn_readlane(__float_as_int(v), 48));
    return (r0 + r1) + (r2 + r3);
}
struct CpPrefetch { uint4 cu[3], pv[3], rw[4]; };
__device__ __forceinline__ void cp_prefetch(CpPrefetch& P, const bf16* __restrict__ proj, int item, int tid) {
    const int h = item & 7, chunk = item >> 3, t0 = chunk * 64, sq0 = t0 & ~(SEQ - 1);
#pragma unroll
    for (int k = 0; k < 3; ++k) { const int idx = tid + 512 * k; P.cu[k] = make_uint4(0, 0, 0, 0); P.pv[k] = make_uint4(0, 0, 0, 0);
        if (idx < 1280) { const int tt = idx / 20, cg = idx % 20, t = t0 + tt;
            P.cu[k] = *(const uint4*)(proj + (size_t)t * DINP + C_LW + cg * 8);
            if (t > sq0) P.pv[k] = *(const uint4*)(proj + (size_t)(t - 1) * DINP + C_LW + cg * 8); } }
#pragma unroll
    for (int k = 0; k < 4; ++k) { const int idx = tid + 512 * k; P.rw[k] = make_uint4(0, 0, 0, 0);
        if (idx < 1560) { const int row = idx / 24, rem = idx % 24, t = t0 - 1 + row;
            if (t >= sq0) P.rw[k] = *(const uint4*)(proj + (size_t)t * DINP + C_R + (rem >> 3) * 512 + h * 64 + (rem & 7) * 8); } }
}
template <bool TOP> __device__ __forceinline__ void g1_panel(const bf16* BK, const bf16* AR, bf16* P0r, bf16* P0t, bf16* T1, bf16* MBT, bf16* LK, bf16* MKT, int mt, int fr, int fq, int nt_lo, int nt_hi) {
    const int q4 = mt & 3, m0 = q4 * 16;
    const Frag2 fa = ld_frag(BK, mt * 16, fr, fq);
    const int dN = 4 * fq - fr;
    const f32x4 zero4 = {0.f, 0.f, 0.f, 0.f};
#pragma unroll
    for (int nt = 0; nt < 8; ++nt) {
        if (nt < nt_lo || nt >= nt_hi) continue;
        const int n4 = nt & 3, n0 = n4 * 16;
        const bool left = (nt < 4);
        if (q4 > n4) {
            if (TOP && left) { st_tr(P0t, m0, n0, fr, fq, zero4); st_rm4(P0r, m0, n0, fr, fq, zero4); st_rm4(T1, m0, n0, fr, fq, zero4); }
            else if (TOP) st_tr(MBT, m0, n0, fr, fq, zero4);
            else if (left) st_rm4(LK, m0, n0, fr, fq, zero4);
            else st_tr(MKT, m0, n0, fr, fq, zero4);
        } else if (q4 < n4) {
            const Frag2 fb = ld_frag(AR, nt * 16, fr, fq);
            if (TOP && left) { f32x4 aN = mmf(fa, fb, zero4), aS = mmf(fb, fa, zero4); st_tr(P0t, m0, n0, fr, fq, aN); st_rm4(P0r, m0, n0, fr, fq, aS); st_rm4(T1, m0, n0, fr, fq, aS); }
            else if (TOP) { f32x4 aN = mmf(fa, fb, zero4); st_tr(MBT, m0, n0, fr, fq, aN); }
            else if (left) { f32x4 aS = mmf(fb, fa, zero4); st_rm4(LK, m0, n0, fr, fq, aS); }
            else { f32x4 aN = mmf(fa, fb, zero4); st_tr(MKT, m0, n0, fr, fq, aN); }
        } else {
            const Frag2 fb = ld_frag(AR, nt * 16, fr, fq);
            if (TOP && left) { f32x4 aN = mmf(fa, fb, zero4), aS = mmf(fb, fa, zero4), t1;
#pragma unroll
                for (int r = 0; r < 4; ++r) { const int d = dN + r; if (!(d < 0)) aN[r] = 0.f; if (!(d > 0)) aS[r] = 0.f; t1[r] = aS[r] + ((d == 0) ? 1.f : 0.f); }
                st_tr(P0t, m0, n0, fr, fq, aN); st_rm4(P0r, m0, n0, fr, fq, aS); st_rm4(T1, m0, n0, fr, fq, t1); }
            else if (TOP) { f32x4 aN = mmf(fa, fb, zero4);
#pragma unroll
                for (int r = 0; r < 4; ++r) if (!(dN + r <= 0)) aN[r] = 0.f;
                st_tr(MBT, m0, n0, fr, fq, aN); }
            else if (left) { f32x4 aS = mmf(fb, fa, zero4);
#pragma unroll
                for (int r = 0; r < 4; ++r) if (!(dN + r > 0)) aS[r] = 0.f;
                st_rm4(LK, m0, n0, fr, fq, aS); }
            else { f32x4 aN = mmf(fa, fb, zero4);
#pragma unroll
                for (int r = 0; r < 4; ++r) if (!(dN + r <= 0)) aN[r] = 0.f;
                st_tr(MKT, m0, n0, fr, fq, aN); }
        }
    }
}
__device__ __forceinline__ void ph_chunkprep(unsigned char* shm, int bid, int nblk, const ChunkParams& p) {
    const int tid = threadIdx.x, lane = tid & 63, wv = tid >> 6, fr = lane & 15, fq = lane >> 4;
    bf16* LWb = (bf16*)shm;
    bf16* LAb = LWb + 64 * 40; bf16* LGb = LAb + 64 * 40;
    float* WLf = (float*)(shm + 24576);
    bf16* RAW = (bf16*)(shm + 8 * SLOT);
    float* segs = (float*)(shm + CP_SMALL);
    float* gC = segs + 512;
#define SL(i) ((bf16*)(shm + (i) * SLOT))
    bf16 *BK = SL(0), *AR = SL(2), *AbT = SL(4), *BhT = SL(5), *KH = SL(6), *Vt = SL(7), *LK = SL(8), *MBT = SL(9), *MKT = SL(10);
    if (bid >= 2048) return;
    int hcur = -1;
    pg8::bf16x8 bw, ba, bg[3];
    float w0n = 0.f, a0n = 0.f, kkc = 0.f, kac = 0.f, rkc = 0.f, mur = 0.f, muk = 0.f, muv = 0.f;
    CpPrefetch P;
    { int it0 = bid; asm volatile("" : "+s"(it0)); cp_prefetch(P, p.proj, it0, tid); }
    for (int item = bid; item < 2048; item += nblk) {
        int itm = item; asm volatile("" : "+s"(itm));
        const int h = itm & 7, chunk = itm >> 3, t0 = chunk * 64;
        if (h != hcur) {
            const int nt = wv & 3, hc = h * 64 + lane;
            hcur = h;
            const int cn = h * 64 + nt * 16 + fr;
            float t8[8];
#pragma unroll
            for (int j = 0; j < 8; ++j) t8[j] = p.w2[(8 * fq + j) * 512 + cn];
            { const uint4 q = pack8(t8); bw = __builtin_bit_cast(pg8::bf16x8, q); }
#pragma unroll
            for (int j = 0; j < 8; ++j) t8[j] = p.a2[(8 * fq + j) * 512 + cn];
            { const uint4 q = pack8(t8); ba = __builtin_bit_cast(pg8::bf16x8, q); }
#pragma unroll
            for (int ks = 0; ks < 3; ++ks) {
#pragma unroll
                for (int j = 0; j < 8; ++j) t8[j] = p.g2[(32 * ks + 8 * fq + j) * 512 + cn];
                const uint4 q = pack8(t8); bg[ks] = __builtin_bit_cast(pg8::bf16x8, q); }
            w0n = p.w0[cn]; a0n = p.a0[cn];
            kkc = p.k_k[hc]; kac = p.k_a[hc]; rkc = p.r_k[hc]; mur = p.mu[hc]; muk = p.mu[512 + hc]; muv = p.mu[1024 + hc];
        }
        __syncthreads();
        {
        const int tid = opq((int)threadIdx.x), lane = tid & 63, wv = tid >> 6, fr = lane & 15, fq = lane >> 4; (void)fr; (void)fq; (void)wv; (void)lane;
#pragma unroll
        for (int k = 0; k < 3; ++k) { const int idx = tid + 512 * k;
            if (idx < 1280) { const int tt = idx / 20, cg = idx % 20;
                float c8[8], p8[8], u[8]; unpack8(P.cu[k], c8); unpack8(P.pv[k], p8);
                const float4 m0 = *(const float4*)(p.mu + 1536 + cg * 8), m1 = *(const float4*)(p.mu + 1536 + cg * 8 + 4);
                const float mm[8] = {m0.x, m0.y, m0.z, m0.w, m1.x, m1.y, m1.z, m1.w};
#pragma unroll
                for (int i = 0; i < 8; ++i) u[i] = c8[i] + (p8[i] - c8[i]) * mm[i];
                const bool isw = cg < 4, isa = (cg >= 4) && (cg < 8);
                const float es = isw ? 2.f : -1.f, ca = isw ? 1.f : 0.f, cb = isw ? -2.f : 1.f;
#pragma unroll
                for (int i = 0; i < 8; ++i) { const float r = __builtin_amdgcn_rcpf(1.f + __expf(es * u[i])); const float act = fmaf(cb, r, ca); u[i] = isa ? u[i] : act; }
                bf16* dst = isw ? (LWb + tt * 40 + cg * 8) : (isa ? (LAb + tt * 40 + (cg - 4) * 8) : (LGb + tt * 104 + (cg - 8) * 8));
                *(uint4*)dst = pack8(u); } }
#pragma unroll
        for (int k = 0; k < 4; ++k) { const int idx = tid + 512 * k; if (idx < 1560) *(uint4*)(RAW + (idx / 24) * 192 + (idx % 24) * 8) = P.rw[k]; }
        }
        __syncthreads();
        {
        const int tid = opq((int)threadIdx.x), lane = tid & 63, wv = tid >> 6, fr = lane & 15, fq = lane >> 4; (void)fr; (void)fq; (void)wv; (void)lane;
        const int nt = wv & 3;
#pragma unroll
        for (int q = 0; q < 2; ++q) {
            const int mt = (wv >> 2) * 2 + q;
            f32x4 cw = {w0n, w0n, w0n, w0n}, ca = {a0n, a0n, a0n, a0n}, cg = {0.f, 0.f, 0.f, 0.f};
            cw = __builtin_amdgcn_mfma_f32_16x16x32_bf16(*(const pg8::bf16x8*)(LWb + (mt * 16 + fr) * 40 + fq * 8), bw, cw, 0, 0, 0);
            ca = __builtin_amdgcn_mfma_f32_16x16x32_bf16(*(const pg8::bf16x8*)(LAb + (mt * 16 + fr) * 40 + fq * 8), ba, ca, 0, 0, 0);
#pragma unroll
            for (int ks = 0; ks < 3; ++ks) cg = __builtin_amdgcn_mfma_f32_16x16x32_bf16(*(const pg8::bf16x8*)(LGb + (mt * 16 + fr) * 104 + ks * 32 + fq * 8), bg[ks], cg, 0, 0, 0);
#pragma unroll
            for (int r = 0; r < 4; ++r) { const int o = (mt * 16 + 4 * fq + r) * 64 + nt * 16 + fr; WLf[o] = cw[r]; WLf[4096 + o] = ca[r]; WLf[8192 + o] = cg[r]; }
        }
        }
        __syncthreads();
        float rr[8], km[8], vv[8], kn[8], be[8], ld[8];
        const int tid1 = opq((int)threadIdx.x), c = tid1 & 63, tg = tid1 >> 6, hc = h * 64 + c;
        {
            const int tb = t0 + tg * 8;
            float red[16], aa[8], kkr[8], gl[8];
#pragma unroll
            for (int i = 0; i < 8; ++i) {
                const float wl = WLf[(tg * 8 + i) * 64 + c], al = WLf[4096 + (tg * 8 + i) * 64 + c]; gl[i] = WLf[8192 + (tg * 8 + i) * 64 + c];
                const bf16* q1 = RAW + (tg * 8 + i + 1) * 192 + c; const bf16* q0 = q1 - 192;
                const float cr1 = bf2f(q1[0]), cr0 = bf2f(q0[0]), ck1 = bf2f(q1[64]), ck0 = bf2f(q0[64]), cv1 = bf2f(q1[128]), cv0 = bf2f(q0[128]);
                rr[i] = cr1 + (cr0 - cr1) * mur; const float kraw = ck1 + (ck0 - ck1) * muk; vv[i] = cv1 + (cv0 - cv1) * muv;
                const float xw = -wl;
                const float sp = fmaxf(xw, 0.f) + __logf(1.f + __expf(-fabsf(xw)));
                ld[i] = -__expf(-sp - 0.5f);
                aa[i] = sigmoidf_(al);
                kkr[i] = kraw * kkc; km[i] = kraw * (1.f + (aa[i] - 1.f) * kac);
                red[i] = kkr[i] * kkr[i]; red[8 + i] = rr[i] * km[i] * rkc;
            }
            { int nxt = item + nblk; asm volatile("" : "+s"(nxt)); if (nxt < 2048) cp_prefetch(P, p.proj, nxt, tid); }
            wave_sum16(red);
#pragma unroll
            for (int i = 0; i < 8; ++i) {
                kn[i] = kkr[i] * __builtin_amdgcn_rsqf(fmaxf(red[i], 1e-24f)); be[i] = kn[i] * aa[i];
                const size_t o = (size_t)(tb + i) * 512 + hc;
                p.V[o] = f2bf(vv[i]); p.G[o] = f2bf(gl[i]);
                if (c == 0) p.BONUS[(size_t)(tb + i) * 8 + h] = red[8 + i];
            }
        }
        float cl[8];
        { float s = 0.f;
#pragma unroll
          for (int i = 0; i < 8; ++i) { s += ld[i]; cl[i] = s; }
          segs[tg * 64 + c] = s; }
        __syncthreads();
        float off = 0.f, clC = 0.f;
#pragma unroll
        for (int g = 0; g < 8; ++g) { const float sg = segs[g * 64 + c]; clC += sg; if (g < tg) off += sg; }
        if (tg == 0) gC[c] = __expf(clC);
        {
            float ab8[8], bh8[8], v8[8], kh8[8];
#pragma unroll
            for (int i = 0; i < 8; ++i) {
                const float x = off + cl[i]; const int tt = tg * 8 + i;
                const float em = __expf(-x), ep = __expf(x), epm = __expf(x - ld[i]), eh = __expf(clC - x);
                const float ab = -kn[i] * epm;
                ab8[i] = ab; bh8[i] = be[i] * eh; v8[i] = vv[i];
                BK[tt * CS + c] = f2bf(be[i] * em); BK[(64 + tt) * CS + c] = f2bf(km[i] * em);
                AR[tt * CS + c] = f2bf(ab); AR[(64 + tt) * CS + c] = f2bf(rr[i] * ep);
                kh8[i] = km[i] * eh;
            }
            *(uint4*)(AbT + c * CS + tg * 8) = pack8(ab8); *(uint4*)(BhT + c * CS + tg * 8) = pack8(bh8); *(uint4*)(Vt + c * CS + tg * 8) = pack8(v8); *(uint4*)(KH + c * CS + tg * 8) = pack8(kh8);
        }
        __syncthreads();
        {
            const int tid = opq((int)threadIdx.x), lane = tid & 63, wv = tid >> 6, fr = lane & 15, fq = lane >> 4; (void)fr; (void)fq; (void)wv; (void)lane;
            const int mt = __builtin_amdgcn_readfirstlane(wv), q4 = mt & 3;
            const int hi0 = (q4 == 0) ? 5 : (q4 == 1) ? 7 : 8;
            const int mt2 = (q4 == 3) ? mt - 3 : mt - 1, lo2 = (q4 == 3) ? 5 : 7;
            if (mt < 4) { g1_panel<true>(BK, AR, SL(11), SL(12), SL(13), MBT, LK, MKT, mt, fr, fq, 0, hi0); if (q4 >= 2) g1_panel<true>(BK, AR, SL(11), SL(12), SL(13), MBT, LK, MKT, mt2, fr, fq, lo2, 8); }
            else { g1_panel<false>(BK, AR, SL(11), SL(12), SL(13), MBT, LK, MKT, mt, fr, fq, 0, hi0); if (q4 >= 2) g1_panel<false>(BK, AR, SL(11), SL(12), SL(13), MBT, LK, MKT, mt2, fr, fq, lo2, 8); }
        }
        __syncthreads();
#pragma unroll
        for (int s = 0; s < 6; ++s) {
            const int tid = opq((int)threadIdx.x), lane = tid & 63, wv = tid >> 6, fr = lane & 15, fq = lane >> 4; (void)fr; (void)fq; (void)wv; (void)lane;
            const bf16* Pr = (s & 1) ? SL(0) : SL(11); const bf16* Pt = (s & 1) ? SL(1) : SL(12);
            bf16* Pnr = (s & 1) ? SL(11) : SL(0); bf16* Pnt = (s & 1) ? SL(12) : SL(1);
            const bf16* Tc = (s & 1) ? SL(13) : SL(14); bf16* Tn = (s & 1) ? SL(14) : SL(13);
            const int m0 = (wv >> 1) * 16, nb = (wv & 1) * 32;
            Frag2 fp, ft;
            if (s < 5) fp = ld_frag(Pr, m0, fr, fq);
            if (s > 0) ft = ld_frag(Tc, m0, fr, fq);
#pragma unroll
            for (int q = 0; q < 2; ++q) {
                const int n0 = nb + q * 16;
                const Frag2 fb = ld_frag(Pt, n0, fr, fq);
                if (s < 5) { f32x4 aN = {0.f, 0.f, 0.f, 0.f}, aS = {0.f, 0.f, 0.f, 0.f}; aN = mmf(fp, fb, aN); aS = mmf(fb, fp, aS); st_rm4(Pnr, m0, n0, fr, fq, aS); st_tr(Pnt, m0, n0, fr, fq, aN); }
                if (s > 0 && s < 5) { f32x4 acc = ld_rm4(Tc, m0, n0, fr, fq); acc = mmf(fb, ft, acc); st_rm4(Tn, m0, n0, fr, fq, acc); }
                if (s == 5) { f32x4 acc = ld_rm(Tc, m0, n0, fr, fq); acc = mmf(ft, fb, acc); st_tr(SL(2), m0, n0, fr, fq, acc); }
            }
            __syncthreads();
        }
        {
            const int tid = opq((int)threadIdx.x), lane = tid & 63, wv = tid >> 6, fr = lane & 15, fq = lane >> 4; (void)fr; (void)fq; (void)wv; (void)lane;
            const bf16* TT = SL(2); bf16 *X = SL(11), *W = SL(12);
            const int m0 = (wv >> 1) * 16, nb = (wv & 1) * 32;
            const Frag2 fl = ld_frag(LK, m0, fr, fq), fa = ld_frag(AbT, m0, fr, fq);
#pragma unroll
            for (int q = 0; q < 2; ++q) {
                const int n0 = nb + q * 16;
                const Frag2 fb = ld_frag(TT, n0, fr, fq);
                f32x4 a0 = {0.f, 0.f, 0.f, 0.f}, a1 = {0.f, 0.f, 0.f, 0.f};
                a0 = mmf(fb, fl, a0); a1 = mmf(fb, fa, a1);
                st_rm4(X, m0, n0, fr, fq, a0); st_rm4(W, m0, n0, fr, fq, a1);
            }
        }
        __syncthreads();
        {
            const int tid = opq((int)threadIdx.x), lane = tid & 63, wv = tid >> 6, fr = lane & 15, fq = lane >> 4; (void)fr; (void)fq; (void)wv; (void)lane;
            const bf16 *X = SL(11), *W = SL(12), *RB = SL(3); bf16 *ZT = SL(13), *Q2T = SL(14);
            bf16* PHI = p.PHI + (size_t)item * 4096; bf16* OMG = p.OMG + (size_t)item * 4096;
            const int mt = wv >> 1, m0 = mt * 16, nb = (wv & 1) * 32;
            const Frag2 fx = ld_frag(X, m0, fr, fq), fw = ld_frag(W, m0, fr, fq);
#pragma unroll
            for (int q = 0; q < 2; ++q) {
                const int n0 = nb + q * 16;
                const Frag2 fbh = ld_frag(BhT, n0, fr, fq), fmb = ld_frag(MBT, n0, fr, fq);
                f32x4 z = ld_tr(KH, m0, n0, fr, fq); z = mmf(fx, fbh, z); st_tr(ZT, m0, n0, fr, fq, z);
                f32x4 q2 = ld_tr(MKT, m0, n0, fr, fq); q2 = mmf(fx, fmb, q2); st_tr(Q2T, m0, n0, fr, fq, q2);
                f32x4 ph = {0.f, 0.f, 0.f, 0.f}; ph = mmf(fw, fbh, ph);
#pragma unroll
                for (int r = 0; r < 4; ++r) if (m0 + 4 * fq + r == n0 + fr) ph[r] += gC[n0 + fr];
                const int slot = (mt >> 1) * 32 + fq * 8 + (mt & 1) * 4;
                { uint2 o; o.x = pack2(ph[0], ph[1]); o.y = pack2(ph[2], ph[3]); *(uint2*)(PHI + (n0 + fr) * 64 + slot) = o; }
                f32x4 om = ld_tr(RB, m0, n0, fr, fq); om = mmf(fw, fmb, om);
                { uint2 o; o.x = pack2(om[0], om[1]); o.y = pack2(om[2], om[3]); *(uint2*)(OMG + (n0 + fr) * 64 + slot) = o; }
            }
        }
        __syncthreads();
        {
            const int tid = opq((int)threadIdx.x), lane = tid & 63, wv = tid >> 6, fr = lane & 15, fq = lane >> 4; (void)fr; (void)fq; (void)wv; (void)lane;
            const bf16 *ZT = SL(13), *Q2T = SL(14);
            bf16* PSI = p.PSI + (size_t)item * 4096; bf16* Y0 = p.Y0 + (size_t)item * 4096;
            const int m0 = (wv >> 1) * 16, nb = (wv & 1) * 32;
            const Frag2 fz = ld_frag(ZT, m0, fr, fq), fq2 = ld_frag(Q2T, m0, fr, fq);
#pragma unroll
            for (int q = 0; q < 2; ++q) {
                const int n0 = nb + q * 16;
                const Frag2 fv = ld_frag(Vt, n0, fr, fq);
                f32x4 a0 = {0.f, 0.f, 0.f, 0.f}, a1 = {0.f, 0.f, 0.f, 0.f};
                a0 = mmf(fz, fv, a0); a1 = mmf(fq2, fv, a1);
                { uint2 o; o.x = pack2(a0[0], a0[1]); o.y = pack2(a0[2], a0[3]); *(uint2*)(PSI + (n0 + fr) * 64 + m0 + 4 * fq) = o; }
                { uint2 o; o.x = pack2(a1[0], a1[1]); o.y = pack2(a1[2], a1[3]); *(uint2*)(Y0 + (n0 + fr) * 64 + m0 + 4 * fq) = o; }
            }
        }
    }
#undef SL
}

constexpr int CH_SLOT = 32768, CH_RING = 4, CH_YB = CH_RING * CH_SLOT, CH_YBSZ = 64 * 72 * 2;
__device__ __forceinline__ void chain_dma(unsigned char* shm, int slot, const bf16* __restrict__ PHI, const bf16* __restrict__ PSI, const bf16* __restrict__ OMG, const bf16* __restrict__ Y0, size_t item, int w, int lane) {
    const bf16* src[4] = {PHI + item, OMG + item, PSI + item, Y0 + item};
#pragma unroll
    for (int m = 0; m < 4; ++m)
#pragma unroll
        for (int i = 0; i < 2; ++i) {
            const int row = (w * 2 + i) * 8 + (lane >> 3), jj = (lane & 7) ^ (row & 7);
            __builtin_amdgcn_global_load_lds((const unsigned*)((const char*)src[m] + row * 128 + jj * 16),
                                             (PG8_LAS unsigned*)(shm + slot * CH_SLOT + m * 8192 + (w * 2 + i) * 1024), 16, 0, 0);
        }
}
__device__ __forceinline__ void ph_chain(unsigned char* shm, int bh, const bf16* __restrict__ PHI, const bf16* __restrict__ PSI, const bf16* __restrict__ OMG, const bf16* __restrict__ Y0,
                                         const bf16* __restrict__ V, const bf16* __restrict__ G, const float* __restrict__ BONUS, const float* __restrict__ gng, const float* __restrict__ gnb, bf16* __restrict__ O) {
    const int b = bh >> 3, h = bh & 7, tid = threadIdx.x, lane = tid & 63, w = __builtin_amdgcn_readfirstlane((tid >> 6) & 3), fr = lane & 15, fq = lane >> 4;
    const size_t ib = ((size_t)(b * 64) * 8 + h) * 4096, istep = (size_t)8 * 4096;
#define CH_BAR() do { asm volatile("s_waitcnt lgkmcnt(0)" ::: "memory"); __builtin_amdgcn_s_barrier(); asm volatile("" ::: "memory"); } while (0)
    if (tid < 256) {
        pg8::bf16x8 sf[2];
#pragma unroll
        for (int j = 0; j < 8; ++j) { sf[0][j] = 0; sf[1][j] = 0; }
        chain_dma(shm, 0, PHI, PSI, OMG, Y0, ib, w, lane);
        chain_dma(shm, 1, PHI, PSI, OMG, Y0, ib + istep, w, lane);
        chain_dma(shm, 2, PHI, PSI, OMG, Y0, ib + 2 * istep, w, lane);
#pragma unroll 1
        for (int ch = 0; ch < 64; ++ch) {
            asm volatile("s_waitcnt vmcnt(16)" ::: "memory");
            CH_BAR();
            chain_dma(shm, (ch + 3) & 3, PHI, PSI, OMG, Y0, ib + (size_t)((ch + 3 < 64) ? ch + 3 : 63) * istep, w, lane);
            const unsigned char* sl = shm + (ch & 3) * CH_SLOT;
            f32x4 ya[4], sa[4]; pg8::bf16x8 ap[4][2], ao[4][2];
#pragma unroll
            for (int mt = 0; mt < 4; ++mt) {
                const int row = w * 16 + fr, sw = (((mt * 2 + (fq >> 1)) ^ (row & 7)) * 16) + (fq & 1) * 8;
                const uint2 ps = *(const uint2*)(sl + 16384 + row * 128 + sw), y0 = *(const uint2*)(sl + 24576 + row * 128 + sw);
                ya[mt][0] = bflo(y0.x); ya[mt][1] = bfhi(y0.x); ya[mt][2] = bflo(y0.y); ya[mt][3] = bfhi(y0.y);
                sa[mt][0] = bflo(ps.x); sa[mt][1] = bfhi(ps.x); sa[mt][2] = bflo(ps.y); sa[mt][3] = bfhi(ps.y);
#pragma unroll
                for (int ks = 0; ks < 2; ++ks) { const int ar = mt * 16 + fr, off = ar * 128 + (((ks * 4 + fq) ^ (ar & 7)) * 16);
                    ap[mt][ks] = *(const pg8::bf16x8*)(sl + off); ao[mt][ks] = *(const pg8::bf16x8*)(sl + 8192 + off); }
            }
#pragma unroll
            for (int ks = 0; ks < 2; ++ks)
#pragma unroll
                for (int mt = 0; mt < 4; ++mt) sa[mt] = __builtin_amdgcn_mfma_f32_16x16x32_bf16(ap[mt][ks], sf[ks], sa[mt], 0, 0, 0);
#pragma unroll
            for (int ks = 0; ks < 2; ++ks)
#pragma unroll
                for (int mt = 0; mt < 4; ++mt) ya[mt] = __builtin_amdgcn_mfma_f32_16x16x32_bf16(ao[mt][ks], sf[ks], ya[mt], 0, 0, 0);
#pragma unroll
            for (int ks = 0; ks < 2; ++ks) {
                const unsigned w0 = pack2(sa[2 * ks][0], sa[2 * ks][1]), w1 = pack2(sa[2 * ks][2], sa[2 * ks][3]), w2 = pack2(sa[2 * ks + 1][0], sa[2 * ks + 1][1]), w3 = pack2(sa[2 * ks + 1][2], sa[2 * ks + 1][3]);
                sf[ks][0] = (short)(w0 & 0xFFFF); sf[ks][1] = (short)(w0 >> 16); sf[ks][2] = (short)(w1 & 0xFFFF); sf[ks][3] = (short)(w1 >> 16);
                sf[ks][4] = (short)(w2 & 0xFFFF); sf[ks][5] = (short)(w2 >> 16); sf[ks][6] = (short)(w3 & 0xFFFF); sf[ks][7] = (short)(w3 >> 16);
            }
            bf16* yb = (bf16*)(shm + CH_YB + (ch & 1) * CH_YBSZ);
#pragma unroll
            for (int mt = 0; mt < 4; ++mt)
#pragma unroll
                for (int r = 0; r < 4; ++r) yb[(mt * 16 + 4 * fq + r) * 72 + w * 16 + fr] = f2bf(ya[mt][r]);
        }
        asm volatile("s_waitcnt vmcnt(0)" ::: "memory");
        CH_BAR();
    } else {
        const int et = (tid & 255) >> 2, eq = tid & 3;
        float gw[16], gb[16];
#pragma unroll
        for (int i = 0; i < 16; ++i) { gw[i] = gng[h * 64 + eq * 16 + i]; gb[i] = gnb[h * 64 + eq * 16 + i]; }
        uint4 nv0, nv1, ng0, ng1; float nbon;
        { const int t = b * SEQ + et; const size_t o = (size_t)t * 512 + h * 64 + eq * 16;
          nv0 = *(const uint4*)(V + o); nv1 = *(const uint4*)(V + o + 8); ng0 = *(const uint4*)(G + o); ng1 = *(const uint4*)(G + o + 8); nbon = BONUS[(size_t)t * 8 + h]; }
        CH_BAR();
#pragma unroll 1
        for (int ch = 0; ch < 64; ++ch) {
            const int t = b * SEQ + ch * 64 + et;
            const size_t o = (size_t)t * 512 + h * 64 + eq * 16;
            const uint4 cv0 = nv0, cv1 = nv1, cg0 = ng0, cg1 = ng1; const float cbon = nbon;
            CH_BAR();
            if (ch + 1 < 64) { const size_t o2 = o + (size_t)64 * 512;
                nv0 = *(const uint4*)(V + o2); nv1 = *(const uint4*)(V + o2 + 8); ng0 = *(const uint4*)(G + o2); ng1 = *(const uint4*)(G + o2 + 8); nbon = BONUS[(size_t)(t + 64) * 8 + h]; }
            const bf16* yb = (const bf16*)(shm + CH_YB + (ch & 1) * CH_YBSZ);
            float y[16], s = 0.f;
            { float a8[8], b8[8]; unpack8(*(const uint4*)(yb + et * 72 + eq * 16), a8); unpack8(*(const uint4*)(yb + et * 72 + eq * 16 + 8), b8);
#pragma unroll
              for (int i = 0; i < 8; ++i) { y[i] = a8[i]; y[8 + i] = b8[i]; } }
#pragma unroll
            for (int i = 0; i < 16; ++i) s += y[i];
            s += __shfl_xor(s, 1, 64); s += __shfl_xor(s, 2, 64);
            const float mean = s * (1.f / 64.f);
            float q = 0.f;
#pragma unroll
            for (int i = 0; i < 16; ++i) { y[i] -= mean; q += y[i] * y[i]; }
            q += __shfl_xor(q, 1, 64); q += __shfl_xor(q, 2, 64);
            const float rstd = rsqrtf(q * (1.f / 64.f) + 64e-5f);
            float v0[8], v1[8], g0[8], g1[8], o0[8], o1[8];
            unpack8(cv0, v0); unpack8(cv1, v1); unpack8(cg0, g0); unpack8(cg1, g1);
#pragma unroll
            for (int i = 0; i < 8; ++i) { o0[i] = (y[i] * rstd * gw[i] + gb[i] + cbon * v0[i]) * g0[i]; o1[i] = (y[8 + i] * rstd * gw[8 + i] + gb[8 + i] + cbon * v1[i]) * g1[i]; }
            *(uint4*)(O + o) = pack8(o0); *(uint4*)(O + o + 8) = pack8(o1);
        }
    }
#undef CH_BAR
    __syncthreads();
}

#define CE_DESC(a, b) { const float _mx = fmaxf(a, b), _mn = fminf(a, b); a = _mx; b = _mn; }
__device__ __forceinline__ void sort16_desc(float (&a)[16]) {
#pragma unroll
    for (int k = 2; k <= 16; k <<= 1)
#pragma unroll
        for (int j = k >> 1; j > 0; j >>= 1)
#pragma unroll
            for (int i = 0; i < 16; ++i) { const int l = i ^ j; if (l > i) { if ((i & k) == 0) { CE_DESC(a[i], a[l]); } else { CE_DESC(a[l], a[i]); } } }
}
__device__ __forceinline__ void merge16_desc(float (&run)[16], const float (&grp)[16]) {
#pragma unroll
    for (int i = 0; i < 16; ++i) run[i] = fmaxf(run[i], grp[15 - i]);
#pragma unroll
    for (int j = 8; j > 0; j >>= 1)
#pragma unroll
        for (int i = 0; i < 16; ++i) { const int l = i ^ j; if (l > i) { CE_DESC(run[i], run[l]); } }
}
struct CandTab { int i[64], j[64]; };
constexpr CandTab make_cand_tab() { CandTab t{}; int n = 0; for (int i = 0; i < 16; ++i) for (int j = 0; j < 16; ++j) if ((i + 1) * (j + 1) <= 16) { t.i[n] = i; t.j[n] = j; ++n; }
    for (; n < 64; ++n) { t.i[n] = 0; t.j[n] = 0; } return t; }
constexpr CandTab CT = make_cand_tab();
constexpr int TOPK_LDS = 8 * (16 * 256 * 4 + 16 * 2 * 16 * 4);
__device__ __forceinline__ void ph_topk(unsigned char* shm, int bid, int nblk, const bf16* __restrict__ Q, const bf16* __restrict__ keys, int* __restrict__ EID, float* __restrict__ GATE) {
    const int tid = threadIdx.x, lane = tid & 63, h = tid >> 6, fr = lane & 15, fq = lane >> 4;
    float* sc = (float*)shm + h * (16 * 256 + 512);
    float* top = sc + 16 * 256;
    for (int item = bid; item < T / 16; item += nblk) {
        const int t0 = item * 16;
        int koff = 0; asm volatile("" : "+v"(koff));
#pragma unroll
        for (int p = 0; p < 2; ++p) {
            pg8::bf16x8 a[4];
#pragma unroll
            for (int ks = 0; ks < 4; ++ks) a[ks] = *(const pg8::bf16x8*)(Q + (size_t)(t0 + fr) * 2048 + h * 256 + p * 128 + ks * 32 + fq * 8);
#pragma unroll
            for (int nt = 0; nt < 8; ++nt) {
                f32x4 acc = {0.f, 0.f, 0.f, 0.f};
#pragma unroll
                for (int ks = 0; ks < 4; ++ks) { const pg8::bf16x8 bfr = *(const pg8::bf16x8*)(keys + koff + ((size_t)(h * 2 + p) * 128 + nt * 16 + fr) * 128 + ks * 32 + fq * 8);
                    acc = __builtin_amdgcn_mfma_f32_16x16x32_bf16(a[ks], bfr, acc, 0, 0, 0); }
#pragma unroll
                for (int r = 0; r < 4; ++r) sc[(4 * fq + r) * 256 + p * 128 + nt * 16 + fr] = acc[r];
            }
        }
        __builtin_amdgcn_s_waitcnt(0);
        __builtin_amdgcn_wave_barrier();
        if (lane < 32) {
            const int tok = lane & 15, half = lane >> 4;
            const float* s = sc + tok * 256 + half * 128;
            float run[16], grp[16];
#pragma unroll
            for (int i = 0; i < 16; ++i) run[i] = __uint_as_float((__float_as_uint(s[i]) & ~0x7Fu) | (unsigned)i);
            sort16_desc(run);
            for (int g = 1; g < 8; ++g) {
#pragma unroll
                for (int i = 0; i < 16; ++i) grp[i] = __uint_as_float((__float_as_uint(s[g * 16 + i]) & ~0x7Fu) | (unsigned)(g * 16 + i));
                sort16_desc(grp);
                merge16_desc(run, grp);
            }
#pragma unroll
            for (int i = 0; i < 16; ++i) top[(tok * 2 + half) * 16 + i] = run[i];
        }
        __builtin_amdgcn_s_waitcnt(0);
        __builtin_amdgcn_wave_barrier();
        if (lane < 16) {
            const float* t1 = top + (lane * 2) * 16; const float* t2 = t1 + 16;
            float v1[16], v2[16];
#pragma unroll
            for (int i = 0; i < 16; ++i) { v1[i] = __uint_as_float(__float_as_uint(t1[i]) & ~0x7Fu); v2[i] = __uint_as_float(__float_as_uint(t2[i]) & ~0x7Fu); }
            float run[16], grp[16];
#pragma unroll
            for (int i = 0; i < 16; ++i) run[i] = __uint_as_float((__float_as_uint(v1[CT.i[i]] + v2[CT.j[i]]) & ~0xFFu) | (unsigned)(CT.i[i] * 16 + CT.j[i]));
            sort16_desc(run);
#pragma unroll
            for (int g = 1; g < 4; ++g) {
#pragma unroll
                for (int i = 0; i < 16; ++i) { const int n = g * 16 + i; grp[i] = (n < 50) ? __uint_as_float((__float_as_uint(v1[CT.i[n]] + v2[CT.j[n]]) & ~0xFFu) | (unsigned)(CT.i[n] * 16 + CT.j[n])) : -3.0e38f; }
                sort16_desc(grp); merge16_desc(run, grp);
            }
            float e[16], sum = 0.f; const float mx = __uint_as_float(__float_as_uint(run[0]) & ~0xFFu);
#pragma unroll
            for (int i = 0; i < 16; ++i) { e[i] = __expf(__uint_as_float(__float_as_uint(run[i]) & ~0xFFu) - mx); sum += e[i]; }
            const float inv = 1.f / sum;
            const size_t ob = (size_t)(t0 + lane) * 128 + h * 16;
#pragma unroll
            for (int i = 0; i < 16; ++i) { const unsigned ij = __float_as_uint(run[i]) & 0xFFu; const unsigned e1 = __float_as_uint(t1[ij >> 4]) & 0x7Fu, e2 = __float_as_uint(t2[ij & 15]) & 0x7Fu;
                EID[ob + i] = (int)(e1 * 128 + e2); GATE[ob + i] = e[i] * inv; }
        }
        __builtin_amdgcn_wave_barrier();
    }
}

__device__ __forceinline__ void ph_peer(unsigned char* shm, int bid, int nblk, const bf16* __restrict__ XN2, float* __restrict__ X1  , const bf16* __restrict__ UB, const bf16* __restrict__ VB,
                                              const int* __restrict__ EID, const float* __restrict__ GATE, const float* __restrict__ gf) {
    float (*cfs)[128] = (float (*)[128])shm;
    int (*eids)[128] = (int (*)[128])(shm + 8 * 128 * 4);
    const int wv = threadIdx.x >> 6, lane = threadIdx.x & 63;
    const int wave = (bid * 512 + threadIdx.x) >> 6, nw = (nblk * 512) >> 6;
    for (int t = wave; t < T; t += nw) {
        float hv[16];
        { float a[8], b[8]; unpack8(*(const uint4*)(XN2 + (size_t)t * D + lane * 16), a); unpack8(*(const uint4*)(XN2 + (size_t)t * D + lane * 16 + 8), b);
#pragma unroll
          for (int i = 0; i < 8; ++i) { hv[i] = a[i]; hv[8 + i] = b[i]; } }
        eids[wv][lane] = EID[(size_t)t * 128 + lane]; eids[wv][lane + 64] = EID[(size_t)t * 128 + 64 + lane];
        __builtin_amdgcn_s_waitcnt(0); __builtin_amdgcn_wave_barrier();
        for (int k0 = 0; k0 < 128; k0 += 4) {
            float dp[4];
#pragma unroll
            for (int q = 0; q < 4; ++q) { const int e = eids[wv][k0 + q];
                float a[8], b[8]; unpack8(*(const uint4*)(UB + (size_t)e * D + lane * 16), a); unpack8(*(const uint4*)(UB + (size_t)e * D + lane * 16 + 8), b);
                float s = 0.f;
#pragma unroll
                for (int i = 0; i < 8; ++i) s += a[i] * hv[i] + b[i] * hv[8 + i];
                dp[q] = s; }
#pragma unroll
            for (int q = 0; q < 4; ++q) { const float z = wave_sum(dp[q]); const float act = 0.5f * z * (1.f + erff(z * 0.70710678118f));
                if (lane == 0) cfs[wv][k0 + q] = act * GATE[(size_t)t * 128 + k0 + q]; }
        }
        __builtin_amdgcn_s_waitcnt(0); __builtin_amdgcn_wave_barrier();
        float acc[16];
#pragma unroll
        for (int i = 0; i < 16; ++i) acc[i] = 0.f;
        for (int k0 = 0; k0 < 128; k0 += 4) {
#pragma unroll
            for (int q = 0; q < 4; ++q) { const int e = eids[wv][k0 + q]; const float cf = cfs[wv][k0 + q];
                float a[8], b[8]; unpack8(*(const uint4*)(VB + (size_t)e * D + lane * 16), a); unpack8(*(const uint4*)(VB + (size_t)e * D + lane * 16 + 8), b);
#pragma unroll
                for (int i = 0; i < 8; ++i) { acc[i] += cf * a[i]; acc[8 + i] += cf * b[i]; } }
        }
        float* xr = X1 + (size_t)t * D + lane * 16; float ss = 0.f;
#pragma unroll
        for (int i = 0; i < 4; ++i) { const float4 v = ((const float4*)xr)[i]; acc[4 * i] += v.x; acc[4 * i + 1] += v.y; acc[4 * i + 2] += v.z; acc[4 * i + 3] += v.w; }
#pragma unroll
        for (int i = 0; i < 16; ++i) ss += acc[i] * acc[i];
        const float sc = rsqrtf(wave_sum(ss) * (1.f / D) + 1e-6f);
#pragma unroll
        for (int i = 0; i < 4; ++i) { const float4 g = ((const float4*)(gf + lane * 16))[i];
            ((float4*)xr)[i] = make_float4(acc[4 * i] * sc * g.x, acc[4 * i + 1] * sc * g.y, acc[4 * i + 2] * sc * g.z, acc[4 * i + 3] * sc * g.w); }
        __builtin_amdgcn_wave_barrier();
    }
}


typedef unsigned char u8;
constexpr float H8_SCALE = 16.f;
__device__ __forceinline__ unsigned pack4_fp8(float a, float b, float c, float d) {
    int w = 0; w = __builtin_amdgcn_cvt_pk_fp8_f32(a, b, w, false); w = __builtin_amdgcn_cvt_pk_fp8_f32(c, d, w, true); return (unsigned)w; }
__device__ __forceinline__ float wave_max(float v) {
#pragma unroll
    for (int o = 32; o > 0; o >>= 1) v = fmaxf(v, __shfl_xor(v, o, 64));
    return v;
}
__device__ __forceinline__ void ph_cvt_fp8(int bid, int nblk, const float* __restrict__ src, u8* __restrict__ dst, float* __restrict__ scale, int rows) {
    const int tid_ = opq((int)threadIdx.x), wave = (bid * 512 + tid_) >> 6, nw = (nblk * 512) >> 6, lane = tid_ & 63;
    for (int r = wave; r < rows; r += nw) {
        const float4* xr = (const float4*)(src + (size_t)r * 1024 + lane * 16);
        float4 v[4]; float mx = 0.f;
#pragma unroll
        for (int i = 0; i < 4; ++i) { v[i] = xr[i]; mx = fmaxf(mx, fmaxf(fmaxf(fabsf(v[i].x), fabsf(v[i].y)), fmaxf(fabsf(v[i].z), fabsf(v[i].w)))); }
        mx = wave_max(mx);
        const float sc = fmaxf(mx, 1e-30f) * (1.f / 440.f), inv = 1.f / sc;
        uint4 o; o.x = pack4_fp8(v[0].x * inv, v[0].y * inv, v[0].z * inv, v[0].w * inv); o.y = pack4_fp8(v[1].x * inv, v[1].y * inv, v[1].z * inv, v[1].w * inv);
        o.z = pack4_fp8(v[2].x * inv, v[2].y * inv, v[2].z * inv, v[2].w * inv); o.w = pack4_fp8(v[3].x * inv, v[3].y * inv, v[3].z * inv, v[3].w * inv);
        *(uint4*)(dst + (size_t)r * 1024 + lane * 16) = o;
        if (lane == 0) scale[r] = sc;
    }
}
__device__ __forceinline__ void ph_rmsnorm2(int bid, int nblk, const float* __restrict__ x, const float* __restrict__ g, bf16* __restrict__ out, u8* __restrict__ h8, int rows) {
    const int tid_ = opq((int)threadIdx.x), wave = (bid * 512 + tid_) >> 6, nw = (nblk * 512) >> 6, lane = tid_ & 63;
    for (int r = wave; r < rows; r += nw) {
        const float4* xr = (const float4*)(x + (size_t)r * D + lane * 16);
        float4 v[4]; float ss = 0.f;
#pragma unroll
        for (int i = 0; i < 4; ++i) { v[i] = xr[i]; ss += v[i].x * v[i].x + v[i].y * v[i].y + v[i].z * v[i].z + v[i].w * v[i].w; }
        const float sc = rsqrtf(wave_sum(ss) * (1.f / D) + 1e-6f);
        uint4 q; unsigned qq[4]; uint2 ob[4];
#pragma unroll
        for (int i = 0; i < 4; ++i) { const float4 gg = ((const float4*)(g + lane * 16))[i];
            const float a = v[i].x * sc * gg.x, b = v[i].y * sc * gg.y, c = v[i].z * sc * gg.z, d = v[i].w * sc * gg.w;
            ob[i].x = pack2(a, b); ob[i].y = pack2(c, d); qq[i] = pack4_fp8(a * H8_SCALE, b * H8_SCALE, c * H8_SCALE, d * H8_SCALE); }
        q.x = qq[0]; q.y = qq[1]; q.z = qq[2]; q.w = qq[3];
        *(uint4*)(out + (size_t)r * D + lane * 16) = make_uint4(ob[0].x, ob[0].y, ob[1].x, ob[1].y);
        *(uint4*)(out + (size_t)r * D + lane * 16 + 8) = make_uint4(ob[2].x, ob[2].y, ob[3].x, ob[3].y);
        *(uint4*)(h8 + (size_t)r * D + lane * 16) = q;
    }
}

__device__ __forceinline__ void ph_peer2(unsigned char* shm, int bid, int nblk, const u8* __restrict__ H8, const float* X1, float* OUT, const u8* __restrict__ U8, const u8* __restrict__ V8,
                                         const float* __restrict__ USC, const float* __restrict__ VSC, const int* __restrict__ EID, const float* __restrict__ GATE, const float* __restrict__ gf) {
    const int wv = threadIdx.x >> 6, lane = threadIdx.x & 63, fr = lane & 15, fq = lane >> 4;
    float* zb = (float*)shm + wv * 128;
    const int wave = (bid * 512 + threadIdx.x) >> 6, nw = (nblk * 512) >> 6;
    for (int t = wave; t < T; t += nw) {
        uint4 hq[16];
#pragma unroll
        for (int s = 0; s < 16; ++s) hq[s] = *(const uint4*)(H8 + (size_t)t * 1024 + 64 * s + 16 * fq);
        const int e0 = EID[(size_t)t * 128 + lane], e1 = EID[(size_t)t * 128 + 64 + lane];
        const float g0 = GATE[(size_t)t * 128 + lane], g1 = GATE[(size_t)t * 128 + 64 + lane];
        const float us0 = USC[e0], us1 = USC[e1], vs0 = VSC[e0], vs1 = VSC[e1];
#pragma unroll 1
        for (int tile = 0; tile < 8; ++tile) {
            const int er = __shfl((tile < 4) ? e0 : e1, (tile & 3) * 16 + fr, 64);
            const u8* rowp = U8 + (size_t)er * 1024 + 16 * fq;
            uint4 a[16];
#pragma unroll
            for (int s = 0; s < 16; ++s) a[s] = *(const uint4*)(rowp + 64 * s);
            f32x4 acc = {0.f, 0.f, 0.f, 0.f};
#pragma unroll
            for (int s = 0; s < 16; ++s) {
                const long alo = (long)(((unsigned long long)a[s].y << 32) | a[s].x), ahi = (long)(((unsigned long long)a[s].w << 32) | a[s].z);
                const long blo = (long)(((unsigned long long)hq[s].y << 32) | hq[s].x), bhi = (long)(((unsigned long long)hq[s].w << 32) | hq[s].z);
                acc = __builtin_amdgcn_mfma_f32_16x16x32_fp8_fp8(alo, blo, acc, 0, 0, 0);
                acc = __builtin_amdgcn_mfma_f32_16x16x32_fp8_fp8(ahi, bhi, acc, 0, 0, 0);
            }
            if (fr == 0) { *(float4*)(zb + tile * 16 + 4 * fq) = make_float4(acc[0], acc[1], acc[2], acc[3]); }
        }
        __builtin_amdgcn_s_waitcnt(0); __builtin_amdgcn_wave_barrier();
        float cf0, cf1;
        { const float z0 = zb[lane] * us0 * (1.f / H8_SCALE), z1 = zb[64 + lane] * us1 * (1.f / H8_SCALE);
          cf0 = g0 * vs0 * 0.5f * z0 * (1.f + erff(z0 * 0.70710678118f)); cf1 = g1 * vs1 * 0.5f * z1 * (1.f + erff(z1 * 0.70710678118f)); }
        __builtin_amdgcn_wave_barrier();
        float acc[16];
#pragma unroll
        for (int i = 0; i < 16; ++i) acc[i] = 0.f;
#pragma unroll 1
        for (int k0 = 0; k0 < 128; k0 += 16) {
            uint4 r[16]; float cc[16];
#pragma unroll
            for (int j = 0; j < 16; ++j) {
                const int k = k0 + j;
                const int e = __builtin_amdgcn_readlane((k < 64) ? e0 : e1, k & 63);
                cc[j] = __int_as_float(__builtin_amdgcn_readlane(__float_as_int((k < 64) ? cf0 : cf1), k & 63));
                r[j] = *(const uint4*)(V8 + (size_t)e * 1024 + lane * 16);
            }
#pragma unroll
            for (int j = 0; j < 16; ++j) {
                const unsigned w[4] = {r[j].x, r[j].y, r[j].z, r[j].w};
#pragma unroll
                for (int q = 0; q < 4; ++q) {
                    const auto lo = __builtin_amdgcn_cvt_pk_f32_fp8((int)w[q], false), hi = __builtin_amdgcn_cvt_pk_f32_fp8((int)w[q], true);
                    acc[4 * q] += cc[j] * lo[0]; acc[4 * q + 1] += cc[j] * lo[1]; acc[4 * q + 2] += cc[j] * hi[0]; acc[4 * q + 3] += cc[j] * hi[1];
                }
            }
        }
        const float* xr = X1 + (size_t)t * D + lane * 16; float* orow = OUT + (size_t)t * D + lane * 16; float ss = 0.f;
#pragma unroll
        for (int i = 0; i < 4; ++i) { const float4 v = ((const float4*)xr)[i]; acc[4 * i] += v.x; acc[4 * i + 1] += v.y; acc[4 * i + 2] += v.z; acc[4 * i + 3] += v.w; }
#pragma unroll
        for (int i = 0; i < 16; ++i) ss += acc[i] * acc[i];
        const float sc = rsqrtf(wave_sum(ss) * (1.f / D) + 1e-6f);
#pragma unroll
        for (int i = 0; i < 4; ++i) { const float4 g = ((const float4*)(gf + lane * 16))[i];
            ((float4*)orow)[i] = make_float4(acc[4 * i] * sc * g.x, acc[4 * i + 1] * sc * g.y, acc[4 * i + 2] * sc * g.z, acc[4 * i + 3] * sc * g.w); }
    }
}

constexpr int TK_KPITCH = 136;
constexpr int TK_KEYS = 2 * 128 * TK_KPITCH * 2;
constexpr int TK_TAB = TK_KEYS, TK_XCH = TK_TAB + 64;
__device__ __forceinline__ void xmerge16(float (&run)[16], int xm) {
    float oth[16];
#pragma unroll
    for (int i = 0; i < 16; ++i) oth[i] = __shfl_xor(run[i], xm, 64);
    merge16_desc(run, oth);
}
__device__ __forceinline__ void ph_topk2(unsigned char* shm, int bid, int nblk, const bf16* __restrict__ Q, const bf16* __restrict__ keys, const float* __restrict__ SCL, int* __restrict__ EID, float* __restrict__ GATE) {
    const int tid = threadIdx.x, lane = tid & 63, wv = tid >> 6, fr = lane & 15, fq = lane >> 4;
    bf16* KL = (bf16*)shm;
    unsigned char* tab = shm + TK_TAB;
    float* xch = (float*)(shm + TK_XCH) + wv * 512;
    const bool par = (nblk % 8) == 0;
    const int rank = par ? (bid >> 3) : bid, nrank = par ? (nblk >> 3) : nblk;
    if (tid == 0) {
#pragma unroll
        for (int n = 0; n < 50; ++n) tab[n] = (unsigned char)(CT.i[n] * 16 + CT.j[n]);
    }
    for (int h = par ? (bid & 7) : 0; h < 8; h += par ? 8 : 1) {
        __syncthreads();
        for (int i = tid; i < 2 * 128 * 16; i += 512) { const int row = i >> 4, ch = i & 15;
            *(uint4*)(KL + row * TK_KPITCH + ch * 8) = *(const uint4*)(keys + ((size_t)h * 256 + row) * 128 + ch * 8); }
        __syncthreads();
        for (int g = rank * 8 + wv; g < T / 16; g += nrank * 8) {
            const int t0 = g * 16;
            float tops[2][16];
#pragma unroll
            for (int p = 0; p < 2; ++p) {
                pg8::bf16x8 bq[4];
#pragma unroll
                for (int ks = 0; ks < 4; ++ks) bq[ks] = *(const pg8::bf16x8*)(Q + (size_t)(t0 + fr) * 2048 + h * 256 + p * 128 + ks * 32 + fq * 8);
                float sc[32];
#pragma unroll
                for (int mt = 0; mt < 8; ++mt) {
                    f32x4 acc = {0.f, 0.f, 0.f, 0.f};
#pragma unroll
                    for (int ks = 0; ks < 4; ++ks) acc = __builtin_amdgcn_mfma_f32_16x16x32_bf16(*(const pg8::bf16x8*)(KL + (p * 128 + mt * 16 + fr) * TK_KPITCH + ks * 32 + fq * 8), bq[ks], acc, 0, 0, 0);
#pragma unroll
                    for (int r = 0; r < 4; ++r) sc[mt * 4 + r] = __uint_as_float((__float_as_uint(acc[r]) & ~0x7Fu) | (unsigned)(mt * 16 + 4 * fq + r));
                }
                float run[16], grp[16];
#pragma unroll
                for (int i = 0; i < 16; ++i) { run[i] = sc[i]; grp[i] = sc[16 + i]; }
                sort16_desc(run); sort16_desc(grp); merge16_desc(run, grp);
                xmerge16(run, 16); xmerge16(run, 32);
#pragma unroll
                for (int i = 0; i < 16; ++i) tops[p][i] = run[i];
            }
            if (fq == 0) {
#pragma unroll
                for (int i = 0; i < 16; ++i) { xch[(fr * 2) * 16 + i] = tops[0][i]; xch[(fr * 2 + 1) * 16 + i] = tops[1][i]; }
            }
            __builtin_amdgcn_s_waitcnt(0); __builtin_amdgcn_wave_barrier();
            const float* t1 = xch + (fr * 2) * 16; const float* t2 = t1 + 16;
            float run[16];
#pragma unroll
            for (int m = 0; m < 16; ++m) {
                const int n = fq * 13 + m;
                float v = -3.0e38f;
                if (m < 13 && n < 50) { const unsigned ij = tab[n];
                    const float a = __uint_as_float(__float_as_uint(t1[ij >> 4]) & ~0x7Fu), b = __uint_as_float(__float_as_uint(t2[ij & 15]) & ~0x7Fu);
                    v = __uint_as_float((__float_as_uint(a + b) & ~0xFFu) | ij); }
                run[m] = v;
            }
            sort16_desc(run);
            xmerge16(run, 16); xmerge16(run, 32);
            if (fq == 0) {
                float e[16], sum = 0.f; const float mx = __uint_as_float(__float_as_uint(run[0]) & ~0xFFu), sct = SCL[t0 + fr];
#pragma unroll
                for (int i = 0; i < 16; ++i) { e[i] = __expf((__uint_as_float(__float_as_uint(run[i]) & ~0xFFu) - mx) * sct); sum += e[i]; }
                const float inv = 1.f / sum;
                const size_t ob = (size_t)(t0 + fr) * 128 + h * 16;
                int eo[16]; float go[16];
#pragma unroll
                for (int i = 0; i < 16; ++i) { const unsigned ij = __float_as_uint(run[i]) & 0xFFu; const unsigned e1 = __float_as_uint(t1[ij >> 4]) & 0x7Fu, e2 = __float_as_uint(t2[ij & 15]) & 0x7Fu;
                    eo[i] = (int)(e1 * 128 + e2); go[i] = e[i] * inv; }
#pragma unroll
                for (int i = 0; i < 4; ++i) { *(int4*)(EID + ob + 4 * i) = make_int4(eo[4 * i], eo[4 * i + 1], eo[4 * i + 2], eo[4 * i + 3]); *(float4*)(GATE + ob + 4 * i) = make_float4(go[4 * i], go[4 * i + 1], go[4 * i + 2], go[4 * i + 3]); }
            }
            __builtin_amdgcn_wave_barrier();
        }
    }
}

__device__ __forceinline__ void ph_peer_u(unsigned char* shm, int bid, int nblk, const u8* __restrict__ H8, const u8* __restrict__ U8, const float* __restrict__ USC, const float* __restrict__ VSC,
                                          const int* __restrict__ EID, const float* __restrict__ GATE, float* __restrict__ CF) {
    const int wv = threadIdx.x >> 6, lane = threadIdx.x & 63, fr = lane & 15, fq = lane >> 4;
    int* lst_e = (int*)shm + wv * 256; int* lst_s = lst_e + 128;
    const bool par = (nblk % 8) == 0;
    const int rank = par ? (bid >> 3) : bid, nrank = par ? (nblk >> 3) : nblk;
    for (int p = par ? (bid & 7) : 0; p < 8; p += par ? 8 : 1) {
        for (int t = rank * 8 + wv; t < T; t += nrank * 8) {
            const int e0 = EID[(size_t)t * 128 + lane], e1 = EID[(size_t)t * 128 + 64 + lane];
            const bool f0 = (e0 >> 11) == p, f1 = (e1 >> 11) == p;
            const unsigned long long m0 = __ballot(f0), m1 = __ballot(f1);
            const int c0 = __popcll(m0), cnt = c0 + __popcll(m1);
            if (cnt == 0) continue;
            const int below = __builtin_amdgcn_mbcnt_hi((unsigned)(m0 >> 32), __builtin_amdgcn_mbcnt_lo((unsigned)m0, 0));
            const int below1 = __builtin_amdgcn_mbcnt_hi((unsigned)(m1 >> 32), __builtin_amdgcn_mbcnt_lo((unsigned)m1, 0));
            if (f0) { lst_e[below] = e0; lst_s[below] = lane; }
            if (f1) { lst_e[c0 + below1] = e1; lst_s[c0 + below1] = 64 + lane; }
            uint4 hq[16];
#pragma unroll
            for (int s = 0; s < 16; ++s) hq[s] = *(const uint4*)(H8 + (size_t)t * 1024 + 64 * s + 16 * fq);
            __builtin_amdgcn_s_waitcnt(0); __builtin_amdgcn_wave_barrier();
            const int ntile = (cnt + 15) >> 4;
#pragma unroll 1
            for (int tile = 0; tile < ntile; ++tile) {
                const int j = tile * 16 + fr;
                const int er = lst_e[(j < cnt) ? j : 0];
                const u8* rowp = U8 + (size_t)er * 1024 + 16 * fq;
                uint4 a[16];
#pragma unroll
                for (int s = 0; s < 16; ++s) a[s] = *(const uint4*)(rowp + 64 * s);
                f32x4 acc = {0.f, 0.f, 0.f, 0.f};
#pragma unroll
                for (int s = 0; s < 16; ++s) {
                    const long alo = (long)(((unsigned long long)a[s].y << 32) | a[s].x), ahi = (long)(((unsigned long long)a[s].w << 32) | a[s].z);
                    const long blo = (long)(((unsigned long long)hq[s].y << 32) | hq[s].x), bhi = (long)(((unsigned long long)hq[s].w << 32) | hq[s].z);
                    acc = __builtin_amdgcn_mfma_f32_16x16x32_fp8_fp8(alo, blo, acc, 0, 0, 0);
                    acc = __builtin_amdgcn_mfma_f32_16x16x32_fp8_fp8(ahi, bhi, acc, 0, 0, 0);
                }
                const int jo = tile * 16 + 4 * fq + fr;
                if (fr < 4 && jo < cnt) {
                    const float d = (fr == 0) ? acc[0] : (fr == 1) ? acc[1] : (fr == 2) ? acc[2] : acc[3];
                    const int e = lst_e[jo], sl = lst_s[jo];
                    const float z = d * USC[e] * (1.f / H8_SCALE);
                    CF[(size_t)t * 128 + sl] = GATE[(size_t)t * 128 + sl] * VSC[e] * 0.5f * z * (1.f + erff(z * 0.70710678118f));
                }
            }
            __builtin_amdgcn_wave_barrier();
        }
    }
}

__device__ __forceinline__ void ph_peer_v(unsigned char* shm, int bid, int nblk, const float* X1, float* X2, const u8* __restrict__ V8, const int* __restrict__ EID, const float* __restrict__ CF, float* __restrict__ SS) {
    const int wv = threadIdx.x >> 6, lane = threadIdx.x & 63, tk = lane >> 3, pc = lane & 7;
    int* le = (int*)shm + wv * 2048;
    float* lc = (float*)(le + 1024);
    const bool par = (nblk % 8) == 0;
    const int rank = par ? (bid >> 3) : bid, nrank = par ? (nblk >> 3) : nblk;
    for (int p = par ? (bid & 7) : 0; p < 8; p += par ? 8 : 1) {
        for (int g = rank * 8 + wv; g < T / 8; g += nrank * 8) {
            const int t = g * 8 + tk;
            __builtin_amdgcn_wave_barrier();
#pragma unroll
            for (int i = 0; i < 4; ++i) { *(int4*)(le + tk * 128 + pc * 16 + 4 * i) = *(const int4*)(EID + (size_t)t * 128 + pc * 16 + 4 * i);
                                          *(float4*)(lc + tk * 128 + pc * 16 + 4 * i) = *(const float4*)(CF + (size_t)t * 128 + pc * 16 + 4 * i); }
            float acc[16];
            { const float* xr = X1 + (size_t)t * D + p * 128 + pc * 16;
#pragma unroll
              for (int i = 0; i < 4; ++i) { const float4 v = ((const float4*)xr)[i]; acc[4 * i] = v.x; acc[4 * i + 1] = v.y; acc[4 * i + 2] = v.z; acc[4 * i + 3] = v.w; } }
            __builtin_amdgcn_s_waitcnt(0); __builtin_amdgcn_wave_barrier();
            const u8* vb = V8 + p * 128 + pc * 16;
#pragma unroll 1
            for (int k0 = 0; k0 < 128; k0 += 16) {
                uint4 r[16]; float cc[16];
#pragma unroll
                for (int q = 0; q < 4; ++q) { const int4 e4 = *(const int4*)(le + tk * 128 + k0 + 4 * q); const float4 c4 = *(const float4*)(lc + tk * 128 + k0 + 4 * q);
                    r[4 * q] = *(const uint4*)(vb + (size_t)e4.x * 1024); r[4 * q + 1] = *(const uint4*)(vb + (size_t)e4.y * 1024); r[4 * q + 2] = *(const uint4*)(vb + (size_t)e4.z * 1024); r[4 * q + 3] = *(const uint4*)(vb + (size_t)e4.w * 1024);
                    cc[4 * q] = c4.x; cc[4 * q + 1] = c4.y; cc[4 * q + 2] = c4.z; cc[4 * q + 3] = c4.w; }
#pragma unroll
                for (int j = 0; j < 16; ++j) {
                    const unsigned w[4] = {r[j].x, r[j].y, r[j].z, r[j].w};
#pragma unroll
                    for (int q = 0; q < 4; ++q) {
                        const auto lo = __builtin_amdgcn_cvt_pk_f32_fp8((int)w[q], false), hi = __builtin_amdgcn_cvt_pk_f32_fp8((int)w[q], true);
                        acc[4 * q] += cc[j] * lo[0]; acc[4 * q + 1] += cc[j] * lo[1]; acc[4 * q + 2] += cc[j] * hi[0]; acc[4 * q + 3] += cc[j] * hi[1];
                    }
                }
            }
            float ss = 0.f;
#pragma unroll
            for (int i = 0; i < 16; ++i) ss += acc[i] * acc[i];
            { float* orow = X2 + (size_t)t * D + p * 128 + pc * 16;
#pragma unroll
              for (int i = 0; i < 4; ++i) ((float4*)orow)[i] = make_float4(acc[4 * i], acc[4 * i + 1], acc[4 * i + 2], acc[4 * i + 3]); }
            ss += __shfl_xor(ss, 1, 64); ss += __shfl_xor(ss, 2, 64); ss += __shfl_xor(ss, 4, 64);
            if (pc == 0) SS[(size_t)t * 8 + p] = ss;
        }
    }
}

__device__ __forceinline__ void ph_peer_f(int bid, int nblk, const bf16* __restrict__ X2, float* __restrict__ OUT, const float* __restrict__ SS, const float* __restrict__ gf) {
    const int tid_ = opq((int)threadIdx.x), wave = (bid * 512 + tid_) >> 6, nw = (nblk * 512) >> 6, lane = tid_ & 63;
    float4 g[4], ns0, ns1; uint2 nx[4];
#pragma unroll
    for (int i = 0; i < 4; ++i) g[i] = ((const float4*)gf)[lane + 64 * i];
    if (wave < T) {
        ns0 = *(const float4*)(SS + (size_t)wave * 8); ns1 = *(const float4*)(SS + (size_t)wave * 8 + 4);
#pragma unroll
        for (int i = 0; i < 4; ++i) nx[i] = ((const uint2*)(X2 + (size_t)wave * D))[lane + 64 * i];
    }
    for (int t = wave; t < T; t += nw) {
        float4 v[4]; const float4 s0 = ns0, s1 = ns1;
#pragma unroll
        for (int i = 0; i < 4; ++i) v[i] = make_float4(bflo(nx[i].x), bfhi(nx[i].x), bflo(nx[i].y), bfhi(nx[i].y));
        if (t + nw < T) {
            ns0 = *(const float4*)(SS + (size_t)(t + nw) * 8); ns1 = *(const float4*)(SS + (size_t)(t + nw) * 8 + 4);
#pragma unroll
            for (int i = 0; i < 4; ++i) nx[i] = ((const uint2*)(X2 + (size_t)(t + nw) * D))[lane + 64 * i];
        }
        const float sc = rsqrtf(((s0.x + s0.y) + (s0.z + s0.w) + (s1.x + s1.y) + (s1.z + s1.w)) * (1.f / D) + 1e-6f);
#pragma unroll
        for (int i = 0; i < 4; ++i) ((float4*)(OUT + (size_t)t * D))[lane + 64 * i] = make_float4(v[i].x * sc * g[i].x, v[i].y * sc * g[i].y, v[i].z * sc * g[i].z, v[i].w * sc * g[i].w);
    }
}

struct Part { int p0, pstep, rank, nrank; };
__device__ __forceinline__ long u4lo(const uint4& v) { return (long)(((unsigned long long)v.y << 32) | v.x); }
__device__ __forceinline__ long u4hi(const uint4& v) { return (long)(((unsigned long long)v.w << 32) | v.z); }
__device__ __forceinline__ int pu_compact(int e0, int e1, int p, int lane, int* lst) {
    const bool f0 = (e0 >> 11) == p, f1 = (e1 >> 11) == p;
    const unsigned long long m0 = __ballot(f0), m1 = __ballot(f1);
    const int c0 = __popcll(m0), cnt = c0 + __popcll(m1);
    const int b0 = __builtin_amdgcn_mbcnt_hi((unsigned)(m0 >> 32), __builtin_amdgcn_mbcnt_lo((unsigned)m0, 0));
    const int b1 = __builtin_amdgcn_mbcnt_hi((unsigned)(m1 >> 32), __builtin_amdgcn_mbcnt_lo((unsigned)m1, 0));
    __builtin_amdgcn_wave_barrier();
    if (f0) { lst[b0] = e0; lst[128 + b0] = lane; }
    if (f1) { lst[c0 + b1] = e1; lst[128 + c0 + b1] = 64 + lane; }
    asm volatile("s_waitcnt lgkmcnt(0)" ::: "memory"); __builtin_amdgcn_wave_barrier();
    return cnt;
}
struct PuScal { float us[2], vs[2], gt[2]; int sl[2]; };
__device__ __forceinline__ void pu_scalars(PuScal& S, int t, int cnt, const int* lst, int fr, int fq, const float* __restrict__ USC, const float* __restrict__ VSC, const float* __restrict__ GATE) {
#pragma unroll
    for (int rt = 0; rt < 2; ++rt) { const int jo = rt * 16 + 4 * fq + fr; S.us[rt] = 0.f; S.vs[rt] = 0.f; S.gt[rt] = 0.f; S.sl[rt] = 0;
        if (fr < 4 && jo < cnt) { const int e = lst[jo], sl = lst[128 + jo]; S.sl[rt] = sl; S.us[rt] = USC[e]; S.vs[rt] = VSC[e]; S.gt[rt] = GATE[(size_t)t * 128 + sl]; } }
}
template <int HALF> __device__ __forceinline__ void pu_rows(uint4 (&a)[8], const u8* __restrict__ U8, const int* lst, int cnt, int j0, int fr, int fq, int pad_row) {
    const int j = j0 + fr; const int er = (j < cnt) ? lst[j] : pad_row;
    const u8* r0 = U8 + (size_t)er * 1024 + 16 * fq + HALF * 512;
#pragma unroll
    for (int s = 0; s < 8; ++s) a[s] = *(const uint4*)(r0 + 64 * s);
}
template <int HALF> __device__ __forceinline__ void pu_mma(const uint4 (&a)[8], const unsigned char* hbuf, int fq, f32x4& acc) {
#pragma unroll
    for (int s = 0; s < 8; ++s) {
        const uint4 hv = *(const uint4*)(hbuf + HALF * 512 + 64 * s + 16 * fq);
        acc = __builtin_amdgcn_mfma_f32_16x16x32_fp8_fp8(u4lo(a[s]), u4lo(hv), acc, 0, 0, 0);
        acc = __builtin_amdgcn_mfma_f32_16x16x32_fp8_fp8(u4hi(a[s]), u4hi(hv), acc, 0, 0, 0);
    }
}
__device__ __forceinline__ float gelu_erf(float v) {
    const float av = fabsf(v), tt = __builtin_amdgcn_rcpf(av * 0.2316418882f + 1.0f);
    float q = tt * 0.5307027145f + (-0.7265760135f); q = q * tt + 0.7107068705f; q = q * tt + (-0.142248368f); q = q * tt + 0.127414796f; q = q * tt;
    const float e = __builtin_amdgcn_exp2f((v * v) * (-0.72134752044f));
    const float m = v * (q * e);
    return v < 0.f ? m : v - m;
}
__device__ __forceinline__ void pu_tile_mma(const uint4 (&aA)[8], const uint4 (&aB)[8], const unsigned char* hbuf, int fq, f32x4& acc) { pu_mma<0>(aA, hbuf, fq, acc); pu_mma<1>(aB, hbuf, fq, acc); }
__device__ __forceinline__ void ph_peer_u2(unsigned char* shm, const Part pt, const u8* __restrict__ H8, const u8* __restrict__ U8, const float* __restrict__ USC, const float* __restrict__ VSC,
                                           const int* __restrict__ EID, const float* __restrict__ GATE, float* __restrict__ CF) {
    const int wv = threadIdx.x >> 6;
    const int rank = pt.rank, nrank = pt.nrank, tstep = nrank * 8;
    for (int p = pt.p0; p < 8; p += pt.pstep) {
        int tn = rank * 8 + wv;
        if (tn >= T) continue;
        const int pad = p * 2048;
        int cb = 1, cnt = 0, t = 0;
        bool has_cur = false;
        uint4 hreg = make_uint4(0, 0, 0, 0);
        PuScal S;
        uint4 a0A[8], a0B[8], a1A[8], a1B[8];
        int ne0, ne1;
        { const int lane0 = threadIdx.x & 63; ne0 = EID[(size_t)tn * 128 + lane0]; ne1 = EID[(size_t)tn * 128 + 64 + lane0]; }
#pragma unroll 1
        for (;;) {
            const int lane = opq((int)threadIdx.x) & 63, fr = lane & 15, fq = lane >> 4;
            int* lstb = (int*)shm + (opq((int)threadIdx.x) >> 6) * 512;
            unsigned char* hbuf = shm + 16384 + (opq((int)threadIdx.x) >> 6) * 1024;
            int* lcur = lstb + cb * 256; int* lnxt = lstb + (cb ^ 1) * 256;
            if (has_cur) {
                __builtin_amdgcn_wave_barrier();
                *(uint4*)(hbuf + lane * 16) = hreg;
                asm volatile("s_waitcnt lgkmcnt(0)" ::: "memory"); __builtin_amdgcn_wave_barrier();
                f32x4 acc0 = {0.f, 0.f, 0.f, 0.f}, acc1 = {0.f, 0.f, 0.f, 0.f};
                pu_tile_mma(a0A, a0B, hbuf, fq, acc0);
                if (cnt > 16) pu_tile_mma(a1A, a1B, hbuf, fq, acc1);
                for (int tile = 2; tile * 16 < cnt; ++tile) {
                    pu_rows<0>(a1A, U8, lcur, cnt, tile * 16, fr, fq, pad); pu_rows<1>(a1B, U8, lcur, cnt, tile * 16, fr, fq, pad);
                    f32x4 acc = {0.f, 0.f, 0.f, 0.f}; pu_tile_mma(a1A, a1B, hbuf, fq, acc);
                    const int jo = tile * 16 + 4 * fq + fr;
                    if (fr < 4 && jo < cnt) { const float d = (fr == 0) ? acc[0] : (fr == 1) ? acc[1] : (fr == 2) ? acc[2] : acc[3];
                        const int e = lcur[jo], sl = lcur[128 + jo];
                        CF[(size_t)t * 128 + sl] = GATE[(size_t)t * 128 + sl] * VSC[e] * gelu_erf(d * USC[e] * (1.f / H8_SCALE)); }
                }
                if (fr < 4) {
                    const int jo = 4 * fq + fr;
                    if (jo < cnt) { const float d = (fr == 0) ? acc0[0] : (fr == 1) ? acc0[1] : (fr == 2) ? acc0[2] : acc0[3];
                        CF[(size_t)t * 128 + S.sl[0]] = S.gt[0] * S.vs[0] * gelu_erf(d * S.us[0] * (1.f / H8_SCALE)); }
                    if (16 + jo < cnt) { const float d = (fr == 0) ? acc1[0] : (fr == 1) ? acc1[1] : (fr == 2) ? acc1[2] : acc1[3];
                        CF[(size_t)t * 128 + S.sl[1]] = S.gt[1] * S.vs[1] * gelu_erf(d * S.us[1] * (1.f / H8_SCALE)); }
                }
            }
            if (tn >= T) break;
            const int ncnt = pu_compact(ne0, ne1, p, lane, lnxt);
            pu_rows<0>(a0A, U8, lnxt, ncnt, 0, fr, fq, pad); pu_rows<1>(a0B, U8, lnxt, ncnt, 0, fr, fq, pad);
            if (ncnt > 16) { pu_rows<0>(a1A, U8, lnxt, ncnt, 16, fr, fq, pad); pu_rows<1>(a1B, U8, lnxt, ncnt, 16, fr, fq, pad); }
            hreg = *(const uint4*)(H8 + (size_t)tn * 1024 + lane * 16);
            pu_scalars(S, tn, ncnt, lnxt, fr, fq, USC, VSC, GATE);
            if (tn + tstep < T) { ne0 = EID[(size_t)(tn + tstep) * 128 + lane]; ne1 = EID[(size_t)(tn + tstep) * 128 + 64 + lane]; }
            t = tn; tn += tstep; cnt = ncnt; cb ^= 1; has_cur = true;
        }
    }
}

__device__ __forceinline__ void pv_issue(uint4 (&r)[8], float (&cc)[8], const u8* vb, const int* le, const float* lc, int k0) {
#pragma unroll
    for (int q = 0; q < 2; ++q) { const int4 e4 = *(const int4*)(le + k0 + 4 * q); const float4 c4 = *(const float4*)(lc + k0 + 4 * q);
        r[4 * q] = *(const uint4*)(vb + (size_t)e4.x * 1024); r[4 * q + 1] = *(const uint4*)(vb + (size_t)e4.y * 1024); r[4 * q + 2] = *(const uint4*)(vb + (size_t)e4.z * 1024); r[4 * q + 3] = *(const uint4*)(vb + (size_t)e4.w * 1024);
        cc[4 * q] = c4.x; cc[4 * q + 1] = c4.y; cc[4 * q + 2] = c4.z; cc[4 * q + 3] = c4.w; }
}
__device__ __forceinline__ void pv_fma(float (&acc)[16], const uint4 (&r)[8], const float (&cc)[8]) {
#pragma unroll
    for (int j = 0; j < 8; ++j) {
        const unsigned w[4] = {r[j].x, r[j].y, r[j].z, r[j].w};
#pragma unroll
        for (int q = 0; q < 4; ++q) {
            const auto lo = __builtin_amdgcn_cvt_pk_f32_fp8((int)w[q], false), hi = __builtin_amdgcn_cvt_pk_f32_fp8((int)w[q], true);
            acc[4 * q] += cc[j] * lo[0]; acc[4 * q + 1] += cc[j] * lo[1]; acc[4 * q + 2] += cc[j] * hi[0]; acc[4 * q + 3] += cc[j] * hi[1];
        }
        if (j & 1) __builtin_amdgcn_sched_barrier(0);
    }
}
__device__ __forceinline__ void ph_peer_v2(unsigned char* shm, const Part pt, const float* X1, float* X2, const u8* __restrict__ V8, const int* __restrict__ EID, const float* __restrict__ CF, float* __restrict__ SS) {
    const int wv = threadIdx.x >> 6, lane = threadIdx.x & 63, tk = lane >> 3, pc = lane & 7;
    int* le = (int*)shm + wv * 2048 + tk * 128;
    float* lc = (float*)((int*)shm + wv * 2048 + 1024) + tk * 128;
    const int rank = pt.rank, nrank = pt.nrank, gstep = nrank * 8;
    for (int p = pt.p0; p < 8; p += pt.pstep) {
        int g = rank * 8 + wv;
        if (g >= T / 8) continue;
        int4 pe0, pe1, pe2, pe3; float4 pf0, pf1, pf2, pf3;
        { const int* er = EID + (size_t)(g * 8 + tk) * 128 + pc * 16; const float* cr = CF + (size_t)(g * 8 + tk) * 128 + pc * 16;
          pe0 = *(const int4*)(er); pe1 = *(const int4*)(er + 4); pe2 = *(const int4*)(er + 8); pe3 = *(const int4*)(er + 12);
          pf0 = *(const float4*)(cr); pf1 = *(const float4*)(cr + 4); pf2 = *(const float4*)(cr + 8); pf3 = *(const float4*)(cr + 12); }
        const u8* vb = V8 + p * 128 + pc * 16;
#pragma unroll 1
        for (; g < T / 8; g += gstep) {
            const int lane = opq((int)threadIdx.x) & 63, tk = lane >> 3, pc = lane & 7;
            int* le = (int*)shm + wv * 2048 + tk * 128; float* lc = (float*)((int*)shm + wv * 2048 + 1024) + tk * 128;
            const u8* vb = V8 + p * 128 + pc * 16;
            const int t = g * 8 + tk;
            __builtin_amdgcn_wave_barrier();
            *(int4*)(le + pc * 16) = pe0; *(int4*)(le + pc * 16 + 4) = pe1; *(int4*)(le + pc * 16 + 8) = pe2; *(int4*)(le + pc * 16 + 12) = pe3;
            *(float4*)(lc + pc * 16) = pf0; *(float4*)(lc + pc * 16 + 4) = pf1; *(float4*)(lc + pc * 16 + 8) = pf2; *(float4*)(lc + pc * 16 + 12) = pf3;
            asm volatile("s_waitcnt lgkmcnt(0)" ::: "memory"); __builtin_amdgcn_wave_barrier();
            float acc[16];
#pragma unroll
            for (int i = 0; i < 16; ++i) acc[i] = 0.f;
            if (g + gstep < T / 8) { const int* er = EID + (size_t)((g + gstep) * 8 + tk) * 128 + pc * 16; const float* cr = CF + (size_t)((g + gstep) * 8 + tk) * 128 + pc * 16;
                pe0 = *(const int4*)(er); pe1 = *(const int4*)(er + 4); pe2 = *(const int4*)(er + 8); pe3 = *(const int4*)(er + 12);
                pf0 = *(const float4*)(cr); pf1 = *(const float4*)(cr + 4); pf2 = *(const float4*)(cr + 8); pf3 = *(const float4*)(cr + 12); }
            uint4 rA[8], rB[8]; float cA[8], cB[8];
            pv_issue(rA, cA, vb, le, lc, 0);
#pragma unroll 1
            for (int k0 = 0; k0 < 128; k0 += 16) {
                pv_issue(rB, cB, vb, le, lc, k0 + 8);
                pv_fma(acc, rA, cA);
                if (k0 + 16 < 128) pv_issue(rA, cA, vb, le, lc, k0 + 16);
                pv_fma(acc, rB, cB);
            }
            { const float* xr = X1 + (size_t)t * D + p * 128 + pc * 16;
#pragma unroll
              for (int i = 0; i < 4; ++i) { const float4 v = ((const float4*)xr)[i]; acc[4 * i] += v.x; acc[4 * i + 1] += v.y; acc[4 * i + 2] += v.z; acc[4 * i + 3] += v.w; } }
            float ss = 0.f;
#pragma unroll
            for (int i = 0; i < 16; ++i) ss += acc[i] * acc[i];
            { float* orow = X2 + (size_t)t * D + p * 128 + pc * 16;
#pragma unroll
              for (int i = 0; i < 4; ++i) ((float4*)orow)[i] = make_float4(acc[4 * i], acc[4 * i + 1], acc[4 * i + 2], acc[4 * i + 3]); }
            ss += __shfl_xor(ss, 1, 64); ss += __shfl_xor(ss, 2, 64); ss += __shfl_xor(ss, 4, 64);
            if (pc == 0) SS[(size_t)t * 8 + p] = ss;
        }
    }
}

__device__ __forceinline__ void pw_issue(uint4 (&r)[8], const u8* ub, const int* le, int k0) {
#pragma unroll
    for (int q = 0; q < 2; ++q) { const int4 e4 = *(const int4*)(le + k0 + 4 * q);
        r[4 * q] = *(const uint4*)(ub + (size_t)e4.x * 1024); r[4 * q + 1] = *(const uint4*)(ub + (size_t)e4.y * 1024); r[4 * q + 2] = *(const uint4*)(ub + (size_t)e4.z * 1024); r[4 * q + 3] = *(const uint4*)(ub + (size_t)e4.w * 1024); }
}
__device__ __forceinline__ float pw_dot8(const uint4 (&r)[8], const float (&h)[16], int pc) {
    float d[8];
#pragma unroll
    for (int j = 0; j < 8; ++j) {
        const unsigned w[4] = {r[j].x, r[j].y, r[j].z, r[j].w};
        typedef float f2v __attribute__((ext_vector_type(2)));
        f2v s2 = {0.f, 0.f};
#pragma unroll
        for (int q = 0; q < 4; ++q) {
            const f2v lo = __builtin_amdgcn_cvt_pk_f32_fp8((int)w[q], false), hi = __builtin_amdgcn_cvt_pk_f32_fp8((int)w[q], true);
            const f2v ha = {h[4 * q], h[4 * q + 1]}, hb = {h[4 * q + 2], h[4 * q + 3]};
            s2 = __builtin_elementwise_fma(ha, lo, s2); s2 = __builtin_elementwise_fma(hb, hi, s2);
        }
        d[j] = s2[0] + s2[1];
        if (j & 1) __builtin_amdgcn_sched_barrier(0);
    }
    float e4[4], e2[2];
#pragma unroll
    for (int j = 0; j < 4; ++j) { const float snd = (pc & 4) ? d[j] : d[j + 4], kp = (pc & 4) ? d[j + 4] : d[j]; e4[j] = kp + __shfl_xor(snd, 4, 64); }
#pragma unroll
    for (int j = 0; j < 2; ++j) { const float snd = (pc & 2) ? e4[j] : e4[j + 2], kp = (pc & 2) ? e4[j + 2] : e4[j]; e2[j] = kp + __shfl_xor(snd, 2, 64); }
    { const float snd = (pc & 1) ? e2[0] : e2[1], kp = (pc & 1) ? e2[1] : e2[0]; return kp + __shfl_xor(snd, 1, 64); }
}
__device__ __forceinline__ void ph_peer_u3(unsigned char* shm, const Part pt, const u8* __restrict__ H8, const u8* __restrict__ U8, const int* __restrict__ EID, float* __restrict__ PART) {
    const int wv = threadIdx.x >> 6;
    const int rank = pt.rank, nrank = pt.nrank, gstep = nrank * 8;
    for (int p = pt.p0; p < 8; p += pt.pstep) {
        int g = rank * 8 + wv;
        if (g >= T / 8) continue;
        int4 pe0, pe1, pe2, pe3;
        { const int l0 = threadIdx.x & 63; const int* er = EID + (size_t)(g * 8 + (l0 >> 3)) * 128 + (l0 & 7) * 16;
          pe0 = *(const int4*)(er); pe1 = *(const int4*)(er + 4); pe2 = *(const int4*)(er + 8); pe3 = *(const int4*)(er + 12); }
#pragma unroll 1
        for (; g < T / 8; g += gstep) {
            const int lane = opq((int)threadIdx.x) & 63, tk = lane >> 3, pc = lane & 7;
            int* le = (int*)shm + wv * 1024 + tk * 128;
            const u8* ub = U8 + p * 128 + pc * 16;
            const int t = g * 8 + tk;
            __builtin_amdgcn_wave_barrier();
            *(int4*)(le + pc * 16) = pe0; *(int4*)(le + pc * 16 + 4) = pe1; *(int4*)(le + pc * 16 + 8) = pe2; *(int4*)(le + pc * 16 + 12) = pe3;
            asm volatile("s_waitcnt lgkmcnt(0)" ::: "memory"); __builtin_amdgcn_wave_barrier();
            float h[16];
            { const uint4 hq = *(const uint4*)(H8 + (size_t)t * 1024 + p * 128 + pc * 16); const unsigned w[4] = {hq.x, hq.y, hq.z, hq.w};
#pragma unroll
              for (int q = 0; q < 4; ++q) { const auto lo = __builtin_amdgcn_cvt_pk_f32_fp8((int)w[q], false), hi = __builtin_amdgcn_cvt_pk_f32_fp8((int)w[q], true);
                  h[4 * q] = lo[0] * (1.f / H8_SCALE); h[4 * q + 1] = lo[1] * (1.f / H8_SCALE); h[4 * q + 2] = hi[0] * (1.f / H8_SCALE); h[4 * q + 3] = hi[1] * (1.f / H8_SCALE); } }
            if (g + gstep < T / 8) { const int* er = EID + (size_t)((g + gstep) * 8 + tk) * 128 + pc * 16;
                pe0 = *(const int4*)(er); pe1 = *(const int4*)(er + 4); pe2 = *(const int4*)(er + 8); pe3 = *(const int4*)(er + 12); }
            float* prow = PART + ((size_t)p * T + t) * 128 + pc;
            uint4 rA[8], rB[8];
            pw_issue(rA, ub, le, 0);
#pragma unroll 1
            for (int k0 = 0; k0 < 128; k0 += 16) {
                pw_issue(rB, ub, le, k0 + 8);
                prow[k0] = pw_dot8(rA, h, pc);
                if (k0 + 16 < 128) pw_issue(rA, ub, le, k0 + 16);
                prow[k0 + 8] = pw_dot8(rB, h, pc);
            }
        }
    }
}
__device__ __forceinline__ void ph_peer_cf(int bid, int nblk, const float* __restrict__ PART, const float* __restrict__ USC, const float* __restrict__ VSC, const int* __restrict__ EID, const float* __restrict__ GATE, float* __restrict__ CF) {
    const int tid_ = opq((int)threadIdx.x);
    for (size_t i = (size_t)bid * 512 + tid_; i < (size_t)T * 128 / 4; i += (size_t)nblk * 512) {
        float4 s = ((const float4*)PART)[i];
#pragma unroll
        for (int p = 1; p < 8; ++p) { const float4 v = ((const float4*)(PART + (size_t)p * T * 128))[i]; s.x += v.x; s.y += v.y; s.z += v.z; s.w += v.w; }
        const int4 e = ((const int4*)EID)[i]; const float4 g = ((const float4*)GATE)[i];
        float4 o;
        o.x = g.x * VSC[e.x] * gelu_erf(s.x * USC[e.x]); o.y = g.y * VSC[e.y] * gelu_erf(s.y * USC[e.y]); o.z = g.z * VSC[e.z] * gelu_erf(s.z * USC[e.z]); o.w = g.w * VSC[e.w] * gelu_erf(s.w * USC[e.w]);
        ((float4*)CF)[i] = o;
    }
}

__device__ __forceinline__ unsigned fp4_code(float q) {
    const float a = fabsf(q);
    unsigned c = (a >= 0.25f) + (a >= 0.75f) + (a >= 1.25f) + (a >= 1.75f) + (a >= 2.5f) + (a >= 3.5f) + (a >= 5.0f);
    return c | ((q < 0.f) ? 8u : 0u);
}
__device__ __forceinline__ void ph_cvt_fp4(int bid, int nblk, const float* __restrict__ src, u8* __restrict__ dst, float* __restrict__ scale, int rows) {
    const int tid_ = opq((int)threadIdx.x), wave = (bid * 512 + tid_) >> 6, nw = (nblk * 512) >> 6, lane = tid_ & 63;
    for (int r = wave; r < rows; r += nw) {
        const float4* xr = (const float4*)(src + (size_t)r * 1024 + lane * 16);
        float4 v[4]; float mx = 0.f;
#pragma unroll
        for (int i = 0; i < 4; ++i) { v[i] = xr[i]; mx = fmaxf(mx, fmaxf(fmaxf(fabsf(v[i].x), fabsf(v[i].y)), fmaxf(fabsf(v[i].z), fabsf(v[i].w)))); }
        mx = wave_max(mx);
        const float sc = fmaxf(mx, 1e-30f) * (1.f / 6.f), inv = 1.f / sc;
        unsigned w0 = 0, w1 = 0;
#pragma unroll
        for (int i = 0; i < 2; ++i) { w0 |= fp4_code(v[i].x * inv) << (16 * i); w0 |= fp4_code(v[i].y * inv) << (16 * i + 4); w0 |= fp4_code(v[i].z * inv) << (16 * i + 8); w0 |= fp4_code(v[i].w * inv) << (16 * i + 12); }
#pragma unroll
        for (int i = 0; i < 2; ++i) { w1 |= fp4_code(v[2 + i].x * inv) << (16 * i); w1 |= fp4_code(v[2 + i].y * inv) << (16 * i + 4); w1 |= fp4_code(v[2 + i].z * inv) << (16 * i + 8); w1 |= fp4_code(v[2 + i].w * inv) << (16 * i + 12); }
        *(uint2*)(dst + (size_t)r * 512 + lane * 8) = make_uint2(w0, w1);
        if (lane == 0) scale[r] = sc;
    }
}
__device__ __forceinline__ void ph_peer_cf2(int bid, int nblk, const float* __restrict__ PART, const float* __restrict__ USC, const float* __restrict__ VSC, const int* __restrict__ EID, const float* __restrict__ GATE,
                                            unsigned short* __restrict__ E16, bf16* __restrict__ CFH) {
    const int tid_ = opq((int)threadIdx.x);
    for (size_t i = (size_t)bid * 512 + tid_; i < (size_t)T * 128 / 4; i += (size_t)nblk * 512) {
        float4 s = ((const float4*)PART)[i];
#pragma unroll
        for (int p = 1; p < 8; ++p) { const float4 v = ((const float4*)(PART + (size_t)p * T * 128))[i]; s.x += v.x; s.y += v.y; s.z += v.z; s.w += v.w; }
        const int4 e = ((const int4*)EID)[i]; const float4 g = ((const float4*)GATE)[i];
        const float ox = g.x * VSC[e.x] * gelu_erf(s.x * USC[e.x]), oy = g.y * VSC[e.y] * gelu_erf(s.y * USC[e.y]), oz = g.z * VSC[e.z] * gelu_erf(s.z * USC[e.z]), ow = g.w * VSC[e.w] * gelu_erf(s.w * USC[e.w]);
        ((uint2*)CFH)[i] = make_uint2(pack2(ox, oy), pack2(oz, ow));
        ((uint2*)E16)[i] = make_uint2((unsigned)e.x | ((unsigned)e.y << 16), (unsigned)e.z | ((unsigned)e.w << 16));
    }
}
__device__ __forceinline__ void pv4_issue(uint4 (&r)[4], float (&cc)[4], const u8* vb, const unsigned short* le, const bf16* lc, int k0) {
    const uint2 e8 = *(const uint2*)(le + k0), c8 = *(const uint2*)(lc + k0);
    const unsigned ew[2] = {e8.x, e8.y}, cw[2] = {c8.x, c8.y};
#pragma unroll
    for (int q = 0; q < 2; ++q) { r[2 * q] = *(const uint4*)(vb + (size_t)(ew[q] & 0xFFFFu) * 512); r[2 * q + 1] = *(const uint4*)(vb + (size_t)(ew[q] >> 16) * 512);
        cc[2 * q] = bflo(cw[q]); cc[2 * q + 1] = bfhi(cw[q]); }
}
__device__ __forceinline__ void pv4_fma(float (&acc)[32], const uint4 (&r)[4], const float (&cc)[4]) {
#pragma unroll
    for (int j = 0; j < 4; ++j) {
        const unsigned w[4] = {r[j].x, r[j].y, r[j].z, r[j].w};
#pragma unroll
        for (int q = 0; q < 4; ++q) {
            const auto b0 = __builtin_amdgcn_cvt_scalef32_pk_f32_fp4(w[q], 1.0f, 0), b1 = __builtin_amdgcn_cvt_scalef32_pk_f32_fp4(w[q], 1.0f, 1);
            const auto b2 = __builtin_amdgcn_cvt_scalef32_pk_f32_fp4(w[q], 1.0f, 2), b3 = __builtin_amdgcn_cvt_scalef32_pk_f32_fp4(w[q], 1.0f, 3);
            acc[8 * q] += cc[j] * b0[0]; acc[8 * q + 1] += cc[j] * b0[1]; acc[8 * q + 2] += cc[j] * b1[0]; acc[8 * q + 3] += cc[j] * b1[1];
            acc[8 * q + 4] += cc[j] * b2[0]; acc[8 * q + 5] += cc[j] * b2[1]; acc[8 * q + 6] += cc[j] * b3[0]; acc[8 * q + 7] += cc[j] * b3[1];
        }
        __builtin_amdgcn_sched_barrier(0);
    }
}
__device__ __forceinline__ void ph_peer_v5(unsigned char* shm, const Part pt, const float* X1, float* X2, const u8* __restrict__ V4, const unsigned short* __restrict__ E16, const bf16* __restrict__ CFH, float* __restrict__ SS) {
    const int wv = threadIdx.x >> 6;
    const int rank = pt.rank, nrank = pt.nrank, gstep = nrank * 8;
    for (int p = pt.p0; p < 4; p += pt.pstep) {
        int g = rank * 8 + wv;
        if (g >= T / 8) continue;
        uint4 pe0, pe1, pf0, pf1;
        { const int l0 = threadIdx.x & 63; const size_t o = (size_t)(g * 8 + (l0 >> 3)) * 128 + (l0 & 7) * 16;
          pe0 = *(const uint4*)(E16 + o); pe1 = *(const uint4*)(E16 + o + 8); pf0 = *(const uint4*)(CFH + o); pf1 = *(const uint4*)(CFH + o + 8); }
#pragma unroll 1
        for (; g < T / 8; g += gstep) {
            const int lane = opq((int)threadIdx.x) & 63, tk = lane >> 3, pc = lane & 7;
            unsigned short* le = (unsigned short*)(shm + wv * 4096) + tk * 128; bf16* lc = (bf16*)(shm + wv * 4096 + 2048) + tk * 128;
            const u8* vb = V4 + p * 128 + pc * 16;
            const int t = g * 8 + tk;
            __builtin_amdgcn_wave_barrier();
            *(uint4*)(le + pc * 16) = pe0; *(uint4*)(le + pc * 16 + 8) = pe1; *(uint4*)(lc + pc * 16) = pf0; *(uint4*)(lc + pc * 16 + 8) = pf1;
            asm volatile("s_waitcnt lgkmcnt(0)" ::: "memory"); __builtin_amdgcn_wave_barrier();
            float acc[32];
#pragma unroll
            for (int i = 0; i < 32; ++i) acc[i] = 0.f;
            if (g + gstep < T / 8) { const size_t o = (size_t)((g + gstep) * 8 + tk) * 128 + pc * 16;
                pe0 = *(const uint4*)(E16 + o); pe1 = *(const uint4*)(E16 + o + 8); pf0 = *(const uint4*)(CFH + o); pf1 = *(const uint4*)(CFH + o + 8); }
            uint4 rA[4], rB[4]; float cA[4], cB[4];
            pv4_issue(rA, cA, vb, le, lc, 0);
#pragma unroll 1
            for (int k0 = 0; k0 < 128; k0 += 8) {
                pv4_issue(rB, cB, vb, le, lc, k0 + 4);
                pv4_fma(acc, rA, cA);
                if (k0 + 8 < 128) pv4_issue(rA, cA, vb, le, lc, k0 + 8);
                pv4_fma(acc, rB, cB);
            }
            float ss = 0.f;
            { const float* xr = X1 + (size_t)t * D + p * 256 + pc * 32; float* orow = X2 + (size_t)t * D + p * 256 + pc * 32;
#pragma unroll
              for (int i = 0; i < 8; ++i) { const float4 v = ((const float4*)xr)[i]; const float a = acc[4 * i] + v.x, b = acc[4 * i + 1] + v.y, c = acc[4 * i + 2] + v.z, d = acc[4 * i + 3] + v.w;
                  ss += a * a + b * b + c * c + d * d; ((float4*)orow)[i] = make_float4(a, b, c, d); } }
            ss += __shfl_xor(ss, 1, 64); ss += __shfl_xor(ss, 2, 64); ss += __shfl_xor(ss, 4, 64);
            if (pc == 0) { SS[(size_t)t * 8 + p] = ss; SS[(size_t)t * 8 + 4 + p] = 0.f; }
        }
    }
}

__device__ __forceinline__ unsigned pack4_i8(float a, float b, float c, float d) {
    const int ia = (int)rintf(a), ib = (int)rintf(b), ic = (int)rintf(c), id = (int)rintf(d);
    return (unsigned)(ia & 0xFF) | ((unsigned)(ib & 0xFF) << 8) | ((unsigned)(ic & 0xFF) << 16) | ((unsigned)(id & 0xFF) << 24);
}
__device__ __forceinline__ void ph_cvt_i8(int bid, int nblk, const float* __restrict__ src, u8* __restrict__ dst, float* __restrict__ scale, int rows) {
    const int tid_ = opq((int)threadIdx.x), wave = (bid * 512 + tid_) >> 6, nw = (nblk * 512) >> 6, lane = tid_ & 63;
    float4 nx[4];
    if (wave < rows) {
#pragma unroll
        for (int i = 0; i < 4; ++i) nx[i] = ((const float4*)(src + (size_t)wave * 1024))[lane + 64 * i];
    }
    for (int r = wave; r < rows; r += nw) {
        float4 v[4]; float mx = 0.f;
#pragma unroll
        for (int i = 0; i < 4; ++i) v[i] = nx[i];
        if (r + nw < rows) {
#pragma unroll
            for (int i = 0; i < 4; ++i) nx[i] = ((const float4*)(src + (size_t)(r + nw) * 1024))[lane + 64 * i];
        }
#pragma unroll
        for (int i = 0; i < 4; ++i) mx = fmaxf(mx, fmaxf(fmaxf(fabsf(v[i].x), fabsf(v[i].y)), fmaxf(fabsf(v[i].z), fabsf(v[i].w))));
        mx = wave_max(mx);
        const float sc = fmaxf(mx, 1e-30f) * (1.f / 127.f), inv = 1.f / sc;
#pragma unroll
        for (int i = 0; i < 4; ++i) ((unsigned*)(dst + (size_t)r * 1024))[lane + 64 * i] = pack4_i8(v[i].x * inv, v[i].y * inv, v[i].z * inv, v[i].w * inv);
        if (lane == 0) scale[r] = sc;
    }
}
__device__ __forceinline__ void ph_rowstat(int bid, int nblk, const bf16* __restrict__ x, const float* __restrict__ g, u8* __restrict__ h8, float* __restrict__ hs, float* __restrict__ scl, int rows) {
    const int tid_ = opq((int)threadIdx.x), wave = (bid * 512 + tid_) >> 6, nw = (nblk * 512) >> 6, lane = tid_ & 63;
    float4 gg[4]; uint2 nx[4];
#pragma unroll
    for (int i = 0; i < 4; ++i) gg[i] = ((const float4*)g)[lane + 64 * i];
    if (wave < rows) {
#pragma unroll
        for (int i = 0; i < 4; ++i) nx[i] = ((const uint2*)(x + (size_t)wave * D))[lane + 64 * i];
    }
    for (int r = wave; r < rows; r += nw) {
        float4 v[4]; float ss = 0.f;
#pragma unroll
        for (int i = 0; i < 4; ++i) v[i] = make_float4(bflo(nx[i].x), bfhi(nx[i].x), bflo(nx[i].y), bfhi(nx[i].y));
        if (r + nw < rows) {
#pragma unroll
            for (int i = 0; i < 4; ++i) nx[i] = ((const uint2*)(x + (size_t)(r + nw) * D))[lane + 64 * i];
        }
#pragma unroll
        for (int i = 0; i < 4; ++i) ss += v[i].x * v[i].x + v[i].y * v[i].y + v[i].z * v[i].z + v[i].w * v[i].w;
        const float sc = rsqrtf(wave_sum(ss) * (1.f / D) + 1e-6f);
        float mx = 0.f;
#pragma unroll
        for (int i = 0; i < 4; ++i) {
            v[i].x *= sc * gg[i].x; v[i].y *= sc * gg[i].y; v[i].z *= sc * gg[i].z; v[i].w *= sc * gg[i].w;
            mx = fmaxf(mx, fmaxf(fmaxf(fabsf(v[i].x), fabsf(v[i].y)), fmaxf(fabsf(v[i].z), fabsf(v[i].w)))); }
        mx = wave_max(mx);
        const float hsc = fmaxf(mx, 1e-30f) * (1.f / 119.f), inv = 1.f / hsc;
#pragma unroll
        for (int i = 0; i < 4; ++i) ((unsigned*)(h8 + (size_t)r * D))[lane + 64 * i] = pack4_i8(v[i].x * inv, v[i].y * inv, v[i].z * inv, v[i].w * inv);
        if (lane == 0) { hs[r] = hsc; scl[r] = sc; }
    }
}
__device__ __forceinline__ float pw_dot8_i8(const uint4 (&r)[8], const uint4 hq, int pc) {
    int d[8];
#pragma unroll
    for (int j = 0; j < 8; ++j) {
        int s = __builtin_amdgcn_sdot4((int)r[j].x, (int)hq.x, 0, false);
        s = __builtin_amdgcn_sdot4((int)r[j].y, (int)hq.y, s, false); s = __builtin_amdgcn_sdot4((int)r[j].z, (int)hq.z, s, false); s = __builtin_amdgcn_sdot4((int)r[j].w, (int)hq.w, s, false);
        d[j] = s;
    }
    int e4[4], e2[2];
#pragma unroll
    for (int j = 0; j < 4; ++j) { const int snd = (pc & 4) ? d[j] : d[j + 4], kp = (pc & 4) ? d[j + 4] : d[j]; e4[j] = kp + __shfl_xor(snd, 4, 64); }
#pragma unroll
    for (int j = 0; j < 2; ++j) { const int snd = (pc & 2) ? e4[j] : e4[j + 2], kp = (pc & 2) ? e4[j + 2] : e4[j]; e2[j] = kp + __shfl_xor(snd, 2, 64); }
    { const int snd = (pc & 1) ? e2[0] : e2[1], kp = (pc & 1) ? e2[1] : e2[0]; return (float)(kp + __shfl_xor(snd, 1, 64)); }
}
__device__ __forceinline__ void ph_peer_u6(unsigned char* shm, const Part pt, const u8* __restrict__ H8, const float* __restrict__ HS, const u8* __restrict__ U8, const int* __restrict__ EID, float* __restrict__ PART) {
    const int wv = threadIdx.x >> 6;
    const int rank = pt.rank, nrank = pt.nrank, gstep = nrank * 8;
    for (int p = pt.p0; p < 8; p += pt.pstep) {
        int g = rank * 8 + wv;
        if (g >= T / 8) continue;
        int4 pe0, pe1, pe2, pe3;
        { const int l0 = threadIdx.x & 63; const int* er = EID + (size_t)(g * 8 + (l0 >> 3)) * 128 + (l0 & 7) * 16;
          pe0 = *(const int4*)(er); pe1 = *(const int4*)(er + 4); pe2 = *(const int4*)(er + 8); pe3 = *(const int4*)(er + 12); }
#pragma unroll 1
        for (; g < T / 8; g += gstep) {
            const int lane = opq((int)threadIdx.x) & 63, tk = lane >> 3, pc = lane & 7;
            int* le = (int*)shm + wv * 1024 + tk * 128;
            const u8* ub = U8 + p * 128 + pc * 16;
            const int t = g * 8 + tk;
            __builtin_amdgcn_wave_barrier();
            *(int4*)(le + pc * 16) = pe0; *(int4*)(le + pc * 16 + 4) = pe1; *(int4*)(le + pc * 16 + 8) = pe2; *(int4*)(le + pc * 16 + 12) = pe3;
            asm volatile("s_waitcnt lgkmcnt(0)" ::: "memory"); __builtin_amdgcn_wave_barrier();
            const uint4 hq = *(const uint4*)(H8 + (size_t)t * 1024 + p * 128 + pc * 16);
            const float hsc = HS[t];
            if (g + gstep < T / 8) { const int* er = EID + (size_t)((g + gstep) * 8 + tk) * 128 + pc * 16;
                pe0 = *(const int4*)(er); pe1 = *(const int4*)(er + 4); pe2 = *(const int4*)(er + 8); pe3 = *(const int4*)(er + 12); }
            float* prow = PART + ((size_t)p * T + t) * 128 + pc;
            uint4 rA[8], rB[8];
            pw_issue(rA, ub, le, 0);
#pragma unroll 1
            for (int k0 = 0; k0 < 128; k0 += 16) {
                pw_issue(rB, ub, le, k0 + 8);
                prow[k0] = pw_dot8_i8(rA, hq, pc) * hsc;
                if (k0 + 16 < 128) pw_issue(rA, ub, le, k0 + 16);
                prow[k0 + 8] = pw_dot8_i8(rB, hq, pc) * hsc;
            }
        }
    }
}

__device__ __forceinline__ void ph_peer_cf3(int bid, int nblk, const float* __restrict__ PART, const float* __restrict__ USC, const float* __restrict__ VSC, const int* __restrict__ EID, const float* __restrict__ GATE,
                                            unsigned short* __restrict__ E16, unsigned* __restrict__ CFQ, float* __restrict__ CS, int npart) {
    const int tid_ = opq((int)threadIdx.x);
    for (size_t i = (size_t)bid * 512 + tid_; i < (size_t)T * 128 / 4; i += (size_t)nblk * 512) {
        float4 s = ((const float4*)PART)[i];
#pragma unroll 1
        for (int p = 1; p < npart; ++p) { const float4 v = ((const float4*)(PART + (size_t)p * T * 128))[i]; s.x += v.x; s.y += v.y; s.z += v.z; s.w += v.w; }
        const int4 e = ((const int4*)EID)[i]; const float4 g = ((const float4*)GATE)[i];
        const float ox = g.x * VSC[e.x] * gelu_erf(s.x * USC[e.x]), oy = g.y * VSC[e.y] * gelu_erf(s.y * USC[e.y]), oz = g.z * VSC[e.z] * gelu_erf(s.z * USC[e.z]), ow = g.w * VSC[e.w] * gelu_erf(s.w * USC[e.w]);
        float m = fmaxf(fmaxf(fabsf(ox), fabsf(oy)), fmaxf(fabsf(oz), fabsf(ow)));
#pragma unroll
        for (int o = 1; o < 32; o <<= 1) m = fmaxf(m, __shfl_xor(m, o, 64));
        const float cs = fmaxf(m, 1e-30f) * (1.f / 127.f), inv = 1.f / cs;
        CFQ[i] = pack4_i8(ox * inv, oy * inv, oz * inv, ow * inv);
        ((uint2*)E16)[i] = make_uint2((unsigned)e.x | ((unsigned)e.y << 16), (unsigned)e.z | ((unsigned)e.w << 16));
        if ((i & 31) == 0) CS[i >> 5] = cs;
    }
}
__device__ __forceinline__ void pv6_issue(uint4 (&r)[8], uint2& cq, const u8* vb, const unsigned short* le, const unsigned* lq, int k0) {
    const uint4 e8 = *(const uint4*)(le + k0); cq = *(const uint2*)(lq + (k0 >> 2));
    const unsigned ew[4] = {e8.x, e8.y, e8.z, e8.w};
#pragma unroll
    for (int q = 0; q < 4; ++q) { r[2 * q] = *(const uint4*)(vb + (size_t)(ew[q] & 0xFFFFu) * 1024); r[2 * q + 1] = *(const uint4*)(vb + (size_t)(ew[q] >> 16) * 1024); }
}
__device__ __forceinline__ void pv6_quad(int (&acc)[16], const uint4& a, const uint4& b, const uint4& c, const uint4& d, unsigned cf4) {
    const unsigned aw[4] = {a.x, a.y, a.z, a.w}, bw[4] = {b.x, b.y, b.z, b.w}, cw[4] = {c.x, c.y, c.z, c.w}, dw[4] = {d.x, d.y, d.z, d.w};
#pragma unroll
    for (int q = 0; q < 4; ++q) {
        const unsigned t0 = __builtin_amdgcn_perm(bw[q], aw[q], 0x05010400u), t1 = __builtin_amdgcn_perm(bw[q], aw[q], 0x07030602u);
        const unsigned t2 = __builtin_amdgcn_perm(dw[q], cw[q], 0x05010400u), t3 = __builtin_amdgcn_perm(dw[q], cw[q], 0x07030602u);
        const unsigned c0 = __builtin_amdgcn_perm(t2, t0, 0x05040100u), c1 = __builtin_amdgcn_perm(t2, t0, 0x07060302u);
        const unsigned c2 = __builtin_amdgcn_perm(t3, t1, 0x05040100u), c3 = __builtin_amdgcn_perm(t3, t1, 0x07060302u);
        acc[4 * q] = __builtin_amdgcn_sdot4((int)c0, (int)cf4, acc[4 * q], false); acc[4 * q + 1] = __builtin_amdgcn_sdot4((int)c1, (int)cf4, acc[4 * q + 1], false);
        acc[4 * q + 2] = __builtin_amdgcn_sdot4((int)c2, (int)cf4, acc[4 * q + 2], false); acc[4 * q + 3] = __builtin_amdgcn_sdot4((int)c3, (int)cf4, acc[4 * q + 3], false);
    }
}
typedef int v4i_t __attribute__((ext_vector_type(4)));
__device__ __forceinline__ void pv7_quad(v4i_t (&acc)[4], const uint4& a, const uint4& b, const uint4& c, const uint4& d, unsigned cf4, const unsigned (&sel)[4]) {
    const uint4 rw[4] = {a, b, c, d};
#pragma unroll
    for (int s_ = 0; s_ < 4; ++s_) {
        const int ad = (int)__builtin_amdgcn_perm(cf4, 0u, sel[s_]);
        acc[0] = __builtin_amdgcn_mfma_i32_4x4x4i8(ad, (int)rw[s_].x, acc[0], 0, 0, 0);
        acc[1] = __builtin_amdgcn_mfma_i32_4x4x4i8(ad, (int)rw[s_].y, acc[1], 0, 0, 0);
        acc[2] = __builtin_amdgcn_mfma_i32_4x4x4i8(ad, (int)rw[s_].z, acc[2], 0, 0, 0);
        acc[3] = __builtin_amdgcn_mfma_i32_4x4x4i8(ad, (int)rw[s_].w, acc[3], 0, 0, 0);
    }
}
__device__ __forceinline__ void ph_peer_v6(unsigned char* shm, const Part pt, const bf16* X1, bf16* X2, const u8* __restrict__ V8, const unsigned short* __restrict__ E16, const unsigned* __restrict__ CFQ,
                                           const float* __restrict__ CS, float* __restrict__ SS) {
    const int wv = threadIdx.x >> 6;
    const int rank = pt.rank, nrank = pt.nrank, gstep = nrank * 8;
    for (int p = pt.p0; p < 8; p += pt.pstep) {
        int g = rank * 8 + wv;
        if (g >= T / 8) continue;
        uint4 pe0, pe1, pq0;
        { const int l0 = threadIdx.x & 63; const size_t o = (size_t)(g * 8 + (l0 >> 3)) * 128 + (l0 & 7) * 16;
          pe0 = *(const uint4*)(E16 + o); pe1 = *(const uint4*)(E16 + o + 8); pq0 = *(const uint4*)(CFQ + (o >> 2)); }
#pragma unroll 1
        for (; g < T / 8; g += gstep) {
            const int lane = opq((int)threadIdx.x) & 63, tk = lane >> 3, pc = lane & 7;
            unsigned short* le = (unsigned short*)(shm + wv * 3072) + tk * 128; unsigned* lq = (unsigned*)(shm + wv * 3072 + 2048) + tk * 32;
            const u8* vb = V8 + p * 128 + pc * 16;
            const int t = g * 8 + tk;
            __builtin_amdgcn_wave_barrier();
            *(uint4*)(le + pc * 16) = pe0; *(uint4*)(le + pc * 16 + 8) = pe1; *(uint4*)(lq + pc * 4) = pq0;
            asm volatile("s_waitcnt lgkmcnt(0)" ::: "memory"); __builtin_amdgcn_wave_barrier();
            const float cs = CS[t];
            const uint4 xv0 = *(const uint4*)(X1 + (size_t)t * D + p * 128 + pc * 16), xv1 = *(const uint4*)(X1 + (size_t)t * D + p * 128 + pc * 16 + 8);
            v4i_t acq[4];
#pragma unroll
            for (int i = 0; i < 4; ++i) acq[i] = (v4i_t){0, 0, 0, 0};
            unsigned sel[4];
#pragma unroll
            for (int i = 0; i < 4; ++i) sel[i] = 0x0C0C0C0Cu ^ ((0x0Cu ^ (4u + i)) << (8 * (lane & 3)));
            if (g + gstep < T / 8) { const size_t o = (size_t)((g + gstep) * 8 + tk) * 128 + pc * 16;
                pe0 = *(const uint4*)(E16 + o); pe1 = *(const uint4*)(E16 + o + 8); pq0 = *(const uint4*)(CFQ + (o >> 2)); }
            uint4 rA[8], rB[8]; uint2 qA, qB;
            pv6_issue(rA, qA, vb, le, lq, 0);
#pragma unroll 1
            for (int k0 = 0; k0 < 112; k0 += 16) {
                pv6_issue(rB, qB, vb, le, lq, k0 + 8);
                pv7_quad(acq, rA[0], rA[1], rA[2], rA[3], qA.x, sel); pv7_quad(acq, rA[4], rA[5], rA[6], rA[7], qA.y, sel);
                pv6_issue(rA, qA, vb, le, lq, k0 + 16);
                pv7_quad(acq, rB[0], rB[1], rB[2], rB[3], qB.x, sel); pv7_quad(acq, rB[4], rB[5], rB[6], rB[7], qB.y, sel);
            }
            pv6_issue(rB, qB, vb, le, lq, 120);
            pv7_quad(acq, rA[0], rA[1], rA[2], rA[3], qA.x, sel); pv7_quad(acq, rA[4], rA[5], rA[6], rA[7], qA.y, sel);
            pv7_quad(acq, rB[0], rB[1], rB[2], rB[3], qB.x, sel); pv7_quad(acq, rB[4], rB[5], rB[6], rB[7], qB.y, sel);
            float ss = 0.f;
            { bf16* orow = X2 + (size_t)t * D + p * 128 + pc * 16;
              const unsigned xw[8] = {xv0.x, xv0.y, xv0.z, xv0.w, xv1.x, xv1.y, xv1.z, xv1.w}; unsigned ow[8];
#pragma unroll
              for (int i = 0; i < 8; ++i) { const float a = (float)acq[i >> 1][(2 * i) & 3] * cs + bflo(xw[i]), b = (float)acq[i >> 1][(2 * i + 1) & 3] * cs + bfhi(xw[i]); ss += a * a + b * b; ow[i] = pack2(a, b); }
              *(uint4*)orow = make_uint4(ow[0], ow[1], ow[2], ow[3]); *(uint4*)(orow + 8) = make_uint4(ow[4], ow[5], ow[6], ow[7]); }
            ss += __shfl_xor(ss, 1, 64); ss += __shfl_xor(ss, 2, 64); ss += __shfl_xor(ss, 4, 64);
            if (pc == 0) SS[(size_t)t * 8 + p] = ss;
        }
    }
}

__device__ __forceinline__ void ph_cvt_i4(int bid, int nblk, const float* __restrict__ src, u8* __restrict__ dst, float* __restrict__ scale, int rows) {
    const int tid_ = opq((int)threadIdx.x), wave = (bid * 512 + tid_) >> 6, nw = (nblk * 512) >> 6, lane = tid_ & 63;
    for (int r = wave; r < rows; r += nw) {
        const float4* xr = (const float4*)(src + (size_t)r * 1024 + lane * 16);
        float4 v[4]; float ss = 0.f;
#pragma unroll
        for (int i = 0; i < 4; ++i) { v[i] = xr[i]; ss += v[i].x * v[i].x + v[i].y * v[i].y + v[i].z * v[i].z + v[i].w * v[i].w; }
        ss = wave_sum(ss);
        const float sc = fmaxf(sqrtf(ss * (1.f / 1024.f)), 1e-30f) * 0.3352f, inv = 1.f / sc;
        unsigned w[2] = {0u, 0u};
#pragma unroll
        for (int i = 0; i < 4; ++i) {
            const float f[4] = {v[i].x, v[i].y, v[i].z, v[i].w};
#pragma unroll
            for (int j = 0; j < 4; ++j) { const int q = (int)fminf(fmaxf(rintf(f[j] * inv), -8.f), 7.f) & 15; w[i >> 1] |= (unsigned)q << (4 * ((i & 1) * 4 + j)); }
        }
        *(uint2*)(dst + (size_t)r * 512 + lane * 8) = make_uint2(w[0], w[1]);
        if (lane == 0) scale[r] = sc;
    }
}
__device__ __forceinline__ void pw4_issue(uint4 (&r)[8], const u8* ub, const int* le, int k0) {
#pragma unroll
    for (int q = 0; q < 2; ++q) { const int4 e4 = *(const int4*)(le + k0 + 4 * q);
        r[4 * q] = *(const uint4*)(ub + (size_t)e4.x * 512); r[4 * q + 1] = *(const uint4*)(ub + (size_t)e4.y * 512); r[4 * q + 2] = *(const uint4*)(ub + (size_t)e4.z * 512); r[4 * q + 3] = *(const uint4*)(ub + (size_t)e4.w * 512); }
}
__device__ __forceinline__ float pw_dot8_i4(const uint4 (&r)[8], const unsigned (&he)[4], const unsigned (&ho)[4], int hsum8, int pc) {
    int d[8];
#pragma unroll
    for (int j = 0; j < 8; ++j) {
        const unsigned w[4] = {r[j].x, r[j].y, r[j].z, r[j].w};
        int s = -hsum8;
#pragma unroll
        for (int q = 0; q < 4; ++q) { s = __builtin_amdgcn_sdot4((int)(w[q] & 0x0F0F0F0Fu), (int)he[q], s, false); s = __builtin_amdgcn_sdot4((int)((w[q] >> 4) & 0x0F0F0F0Fu), (int)ho[q], s, false); }
        d[j] = s;
    }
    int e4[4], e2[2];
#pragma unroll
    for (int j = 0; j < 4; ++j) { const int snd = (pc & 4) ? d[j] : d[j + 4], kp = (pc & 4) ? d[j + 4] : d[j]; e4[j] = kp + __shfl_xor(snd, 4, 64); }
#pragma unroll
    for (int j = 0; j < 2; ++j) { const int snd = (pc & 2) ? e4[j] : e4[j + 2], kp = (pc & 2) ? e4[j + 2] : e4[j]; e2[j] = kp + __shfl_xor(snd, 2, 64); }
    { const int snd = (pc & 1) ? e2[0] : e2[1], kp = (pc & 1) ? e2[1] : e2[0]; return (float)(kp + __shfl_xor(snd, 1, 64)); }
}
__device__ __forceinline__ float pw_dot8_n4(const uint4 (&r)[8], const unsigned (&hA)[4], const unsigned (&hB)[4], int pc) {
    int d[8];
#pragma unroll
    for (int j = 0; j < 8; ++j) {
        const unsigned w[4] = {r[j].x, r[j].y, r[j].z, r[j].w};
        int hi = 0, lo = 0;
#pragma unroll
        for (int q = 0; q < 4; ++q) { hi = __builtin_amdgcn_sdot8((int)w[q], (int)hA[q], hi, false); lo = __builtin_amdgcn_sdot8((int)w[q], (int)hB[q], lo, false); }
        d[j] = hi * 16 + lo;
    }
    int e4[4], e2[2];
#pragma unroll
    for (int j = 0; j < 4; ++j) { const int snd = (pc & 4) ? d[j] : d[j + 4], kp = (pc & 4) ? d[j + 4] : d[j]; e4[j] = kp + __shfl_xor(snd, 4, 64); }
#pragma unroll
    for (int j = 0; j < 2; ++j) { const int snd = (pc & 2) ? e4[j] : e4[j + 2], kp = (pc & 2) ? e4[j + 2] : e4[j]; e2[j] = kp + __shfl_xor(snd, 2, 64); }
    { const int snd = (pc & 1) ? e2[0] : e2[1], kp = (pc & 1) ? e2[1] : e2[0]; return (float)(kp + __shfl_xor(snd, 1, 64)); }
}
__device__ __forceinline__ unsigned nib_compact4(unsigned x) { const unsigned y = (x | (x >> 4)) & 0x00FF00FFu; return (y | (y >> 8)) & 0xFFFFu; }
__device__ __forceinline__ void ph_peer_u7(unsigned char* shm, const Part pt, const u8* __restrict__ H8, const float* __restrict__ HS, const u8* __restrict__ U4, const int* __restrict__ EID, float* __restrict__ PART) {
    const int wv = threadIdx.x >> 6;
    const int rank = pt.rank, nrank = pt.nrank, gstep = nrank * 8;
    for (int p = pt.p0; p < 4; p += pt.pstep) {
        int g = rank * 8 + wv;
        if (g >= T / 8) continue;
        int4 pe0, pe1, pe2, pe3;
        { const int l0 = threadIdx.x & 63; const int* er = EID + (size_t)(g * 8 + (l0 >> 3)) * 128 + (l0 & 7) * 16;
          pe0 = *(const int4*)(er); pe1 = *(const int4*)(er + 4); pe2 = *(const int4*)(er + 8); pe3 = *(const int4*)(er + 12); }
#pragma unroll 1
        for (; g < T / 8; g += gstep) {
            const int lane = opq((int)threadIdx.x) & 63, tk = lane >> 3, pc = lane & 7;
            int* le = (int*)shm + wv * 1024 + tk * 128;
            const u8* ub = U4 + p * 128 + pc * 16;
            const int t = g * 8 + tk;
            __builtin_amdgcn_wave_barrier();
            *(int4*)(le + pc * 16) = pe0; *(int4*)(le + pc * 16 + 4) = pe1; *(int4*)(le + pc * 16 + 8) = pe2; *(int4*)(le + pc * 16 + 12) = pe3;
            asm volatile("s_waitcnt lgkmcnt(0)" ::: "memory"); __builtin_amdgcn_wave_barrier();
            const uint4 ha = *(const uint4*)(H8 + (size_t)t * 1024 + p * 256 + pc * 32), hb = *(const uint4*)(H8 + (size_t)t * 1024 + p * 256 + pc * 32 + 16);
            const unsigned hw[8] = {ha.x, ha.y, ha.z, ha.w, hb.x, hb.y, hb.z, hb.w};
            unsigned hA[4], hB[4];
#pragma unroll
            for (int q = 0; q < 4; ++q) {
                unsigned pa[2], pb[2];
#pragma unroll
                for (int e = 0; e < 2; ++e) { const unsigned w = hw[2 * q + e];
                    const unsigned t8 = ((w & 0x7F7F7F7Fu) + 0x08080808u) ^ (w & 0x80808080u);
                    pa[e] = nib_compact4((t8 >> 4) & 0x0F0F0F0Fu); pb[e] = nib_compact4(w & 0x0F0F0F0Fu); }
                hA[q] = pa[0] | (pa[1] << 16); hB[q] = pb[0] | (pb[1] << 16);
            }
            const float hsc = HS[t];
            if (g + gstep < T / 8) { const int* er = EID + (size_t)((g + gstep) * 8 + tk) * 128 + pc * 16;
                pe0 = *(const int4*)(er); pe1 = *(const int4*)(er + 4); pe2 = *(const int4*)(er + 8); pe3 = *(const int4*)(er + 12); }
            float* prow = PART + ((size_t)p * T + t) * 128 + pc;
            uint4 rA[8], rB[8];
            pw4_issue(rA, ub, le, 0);
#pragma unroll 1
            for (int k0 = 0; k0 < 112; k0 += 16) {
                pw4_issue(rB, ub, le, k0 + 8);
                prow[k0] = pw_dot8_n4(rA, hA, hB, pc) * hsc;
                pw4_issue(rA, ub, le, k0 + 16);
                prow[k0 + 8] = pw_dot8_n4(rB, hA, hB, pc) * hsc;
            }
            pw4_issue(rB, ub, le, 120);
            prow[112] = pw_dot8_n4(rA, hA, hB, pc) * hsc;
            prow[120] = pw_dot8_n4(rB, hA, hB, pc) * hsc;
        }
    }
}

constexpr int C2_SLOT = 16384, C2_RING = 8, C2_SBUF = C2_RING * C2_SLOT;
__device__ __forceinline__ void chain2_dma(unsigned char* shm, int slot, const bf16* __restrict__ PHI, const bf16* __restrict__ PSI, size_t item, int w, int lane) {
    const bf16* src[2] = {PHI + item, PSI + item};
#pragma unroll
    for (int m = 0; m < 2; ++m)
#pragma unroll
        for (int i = 0; i < 2; ++i) {
            const int row = (w * 2 + i) * 8 + (lane >> 3), jj = (lane & 7) ^ (row & 7);
            __builtin_amdgcn_global_load_lds((const unsigned*)((const char*)src[m] + row * 128 + jj * 16),
                                             (PG8_LAS unsigned*)(shm + slot * C2_SLOT + m * 8192 + (w * 2 + i) * 1024), 16, 0, 0);
        }
}
__device__ __forceinline__ void ph_chain2(unsigned char* shm, int bh, bf16* __restrict__ PHI, const bf16* __restrict__ PSI) {
    const int b = bh >> 3, h = bh & 7, tid = threadIdx.x, lane = tid & 63, w = __builtin_amdgcn_readfirstlane((tid >> 6) & 3), fr = lane & 15, fq = lane >> 4;
    const size_t ib = ((size_t)(b * 64) * 8 + h) * 4096, istep = (size_t)8 * 4096;
#define CH_BAR() do { asm volatile("s_waitcnt lgkmcnt(0)" ::: "memory"); __builtin_amdgcn_s_barrier(); asm volatile("" ::: "memory"); } while (0)
    if (tid < 256) {
        pg8::bf16x8 sf[2];
#pragma unroll
        for (int j = 0; j < 8; ++j) { sf[0][j] = 0; sf[1][j] = 0; }
#pragma unroll
        for (int c = 0; c < 7; ++c) chain2_dma(shm, c, PHI, PSI, ib + (size_t)c * istep, w, lane);
#pragma unroll 1
        for (int ch = 0; ch < 64; ++ch) {
            asm volatile("s_waitcnt vmcnt(24)" ::: "memory");
            CH_BAR();
            chain2_dma(shm, (ch + 7) & 7, PHI, PSI, ib + (size_t)((ch + 7 < 64) ? ch + 7 : 63) * istep, w, lane);
            const unsigned char* sl = shm + (ch & 7) * C2_SLOT;
            f32x4 sa[4]; pg8::bf16x8 ap[4][2];
#pragma unroll
            for (int mt = 0; mt < 4; ++mt) {
                const int row = w * 16 + fr, sw = (((mt * 2 + (fq >> 1)) ^ (row & 7)) * 16) + (fq & 1) * 8;
                const uint2 ps = *(const uint2*)(sl + 8192 + row * 128 + sw);
                sa[mt][0] = bflo(ps.x); sa[mt][1] = bfhi(ps.x); sa[mt][2] = bflo(ps.y); sa[mt][3] = bfhi(ps.y);
#pragma unroll
                for (int ks = 0; ks < 2; ++ks) { const int ar = mt * 16 + fr; ap[mt][ks] = *(const pg8::bf16x8*)(sl + ar * 128 + (((ks * 4 + fq) ^ (ar & 7)) * 16)); }
            }
#pragma unroll
            for (int ks = 0; ks < 2; ++ks)
#pragma unroll
                for (int mt = 0; mt < 4; ++mt) sa[mt] = __builtin_amdgcn_mfma_f32_16x16x32_bf16(ap[mt][ks], sf[ks], sa[mt], 0, 0, 0);
            uint4 o0, o1;
            o0.x = pack2(sa[0][0], sa[0][1]); o0.y = pack2(sa[0][2], sa[0][3]); o0.z = pack2(sa[1][0], sa[1][1]); o0.w = pack2(sa[1][2], sa[1][3]);
            o1.x = pack2(sa[2][0], sa[2][1]); o1.y = pack2(sa[2][2], sa[2][3]); o1.z = pack2(sa[3][0], sa[3][1]); o1.w = pack2(sa[3][2], sa[3][3]);
            sf[0] = __builtin_bit_cast(pg8::bf16x8, o0); sf[1] = __builtin_bit_cast(pg8::bf16x8, o1);
            unsigned char* sb = shm + C2_SBUF + (ch & 1) * 8192 + w * 2048 + lane * 32;
            *(uint4*)sb = o0; *(uint4*)(sb + 16) = o1;
        }
        asm volatile("s_waitcnt vmcnt(0)" ::: "memory");
        CH_BAR();
    } else {
        CH_BAR();
#pragma unroll 1
        for (int ch = 1; ch < 64; ++ch) {
            CH_BAR();
            const unsigned char* sb = shm + C2_SBUF + ((ch - 1) & 1) * 8192 + w * 2048 + lane * 32;
            const uint4 a = *(const uint4*)sb, c = *(const uint4*)(sb + 16);
            bf16* dst = PHI + ib + (size_t)(ch - 1) * istep + w * 1024 + lane * 16;
            *(uint4*)dst = a; *(uint4*)(dst + 8) = c;
        }
        CH_BAR();
    }
#undef CH_BAR
    __syncthreads();
}

struct YoPre { uint4 s0, s1, a[2][2]; uint2 y0[2]; uint4 vv, gg; float bon; };
__device__ __forceinline__ void yout_load(YoPre& P, int it, const bf16* __restrict__ SPHI, const bf16* __restrict__ OMG, const bf16* __restrict__ Y0, const bf16* __restrict__ V, const bf16* __restrict__ G, const float* __restrict__ BONUS, int tid) {
    const int lane = tid & 63, wv = tid >> 6, vg = wv & 3, mh = wv >> 2, fr = lane & 15, fq = lane >> 4;
    const int ch = (it >> 3) & 63, h = it & 7, b = it >> 9;
    P.s0 = make_uint4(0, 0, 0, 0); P.s1 = make_uint4(0, 0, 0, 0);
    if (ch > 0) { const bf16* sp = SPHI + (size_t)(it - 8) * 4096 + vg * 1024 + lane * 16; P.s0 = *(const uint4*)sp; P.s1 = *(const uint4*)(sp + 8); }
#pragma unroll
    for (int q = 0; q < 2; ++q) { const int mt = mh * 2 + q;
        P.y0[q] = *(const uint2*)(Y0 + (size_t)it * 4096 + (vg * 16 + fr) * 64 + mt * 16 + 4 * fq);
#pragma unroll
        for (int ks = 0; ks < 2; ++ks) P.a[q][ks] = *(const uint4*)(OMG + (size_t)it * 4096 + (mt * 16 + fr) * 64 + ks * 32 + fq * 8); }
    const int et = tid >> 3, eq = tid & 7; const int t = b * SEQ + ch * 64 + et; const size_t o = (size_t)t * 512 + h * 64 + eq * 8;
    P.vv = *(const uint4*)(V + o); P.gg = *(const uint4*)(G + o); P.bon = BONUS[(size_t)t * 8 + h];
}
__device__ __forceinline__ void ph_yout(unsigned char* shm, int bid, int nblk, const bf16* __restrict__ SPHI, const bf16* __restrict__ OMG, const bf16* __restrict__ Y0, const bf16* __restrict__ V, const bf16* __restrict__ G,
                                        const float* __restrict__ BONUS, const float* __restrict__ gng, const float* __restrict__ gnb, bf16* __restrict__ O) {
    if (bid >= 2048) return;
    YoPre P, Q;
    yout_load(P, bid, SPHI, OMG, Y0, V, G, BONUS, threadIdx.x);
    if (bid + nblk < 2048) yout_load(Q, bid + nblk, SPHI, OMG, Y0, V, G, BONUS, threadIdx.x);
    int par = 0;
    for (int it = bid; it < 2048; it += nblk, par ^= 1) {
        const int tid = opq((int)threadIdx.x), lane = tid & 63, wv = tid >> 6, vg = wv & 3, mh = wv >> 2, fr = lane & 15, fq = lane >> 4;
        const int ch = (it >> 3) & 63, h = it & 7, b = it >> 9;
        bf16* yb = (bf16*)(shm + par * (64 * 72 * 2));
        const pg8::bf16x8 sf0 = __builtin_bit_cast(pg8::bf16x8, P.s0), sf1 = __builtin_bit_cast(pg8::bf16x8, P.s1);
#pragma unroll
        for (int q = 0; q < 2; ++q) { const int mt = mh * 2 + q;
            f32x4 ya; ya[0] = bflo(P.y0[q].x); ya[1] = bfhi(P.y0[q].x); ya[2] = bflo(P.y0[q].y); ya[3] = bfhi(P.y0[q].y);
            ya = __builtin_amdgcn_mfma_f32_16x16x32_bf16(__builtin_bit_cast(pg8::bf16x8, P.a[q][0]), sf0, ya, 0, 0, 0);
            ya = __builtin_amdgcn_mfma_f32_16x16x32_bf16(__builtin_bit_cast(pg8::bf16x8, P.a[q][1]), sf1, ya, 0, 0, 0);
#pragma unroll
            for (int r = 0; r < 4; ++r) yb[(mt * 16 + 4 * fq + r) * 72 + vg * 16 + fr] = f2bf(ya[r]); }
        const uint4 cv = P.vv, cg = P.gg; const float cbon = P.bon;
        P = Q;
        if (it + 2 * nblk < 2048) yout_load(Q, it + 2 * nblk, SPHI, OMG, Y0, V, G, BONUS, tid);
        __syncthreads();
        const int et = tid >> 3, eq = tid & 7; const int t = b * SEQ + ch * 64 + et;
        float y[8], s = 0.f;
        unpack8(*(const uint4*)(yb + et * 72 + eq * 8), y);
#pragma unroll
        for (int i = 0; i < 8; ++i) s += y[i];
        s += __shfl_xor(s, 1, 64); s += __shfl_xor(s, 2, 64); s += __shfl_xor(s, 4, 64);
        const float mean = s * (1.f / 64.f);
        float q = 0.f;
#pragma unroll
        for (int i = 0; i < 8; ++i) { y[i] -= mean; q += y[i] * y[i]; }
        q += __shfl_xor(q, 1, 64); q += __shfl_xor(q, 2, 64); q += __shfl_xor(q, 4, 64);
        const float rstd = rsqrtf(q * (1.f / 64.f) + 64e-5f);
        float v8[8], g8[8], o8[8]; unpack8(cv, v8); unpack8(cg, g8);
        const float4 w0 = *(const float4*)(gng + h * 64 + eq * 8), w1 = *(const float4*)(gng + h * 64 + eq * 8 + 4), b0 = *(const float4*)(gnb + h * 64 + eq * 8), b1 = *(const float4*)(gnb + h * 64 + eq * 8 + 4);
        const float gw[8] = {w0.x, w0.y, w0.z, w0.w, w1.x, w1.y, w1.z, w1.w}, gb[8] = {b0.x, b0.y, b0.z, b0.w, b1.x, b1.y, b1.z, b1.w};
#pragma unroll
        for (int i = 0; i < 8; ++i) o8[i] = (y[i] * rstd * gw[i] + gb[i] + cbon * v8[i]) * g8[i];
        *(uint4*)(O + (size_t)t * 512 + h * 64 + eq * 8) = pack8(o8);
    }
}

constexpr int LDS_BYTES = 150528 + 64;
constexpr int N_PHASES = 14;
constexpr size_t WS_BAR = 19 * MiB;
struct MP { const float* in[28]; float* out; unsigned char* ws; int ph_lo, ph_hi; };

__global__ void __launch_bounds__(512, 2) mega(MP p) {
    extern __shared__ __attribute__((aligned(16))) unsigned char lds[];
    const int bid = blockIdx.x, nblk = gridDim.x, tid = threadIdx.x;
    volatile LAS unsigned* st = (volatile LAS unsigned*)(lds + LDS_BYTES - 16);
    if (tid < 4) st[tid] = 0u;
    __syncthreads();
    const int lo = p.ph_lo, hi = p.ph_hi;
    XcdBarrier bar; bar.bar = (unsigned*)(p.ws + WS_BAR); bar.x = 0; bar.st = st;
    if (hi - lo > 1) bar = xcd_barrier_post((unsigned*)(p.ws + WS_BAR), st);
    if (tid == 0) st[2] = (hi - lo > 1) ? xb_add((unsigned*)(p.ws + WS_BAR) + XCD_BAR_WORDS + 64 * bar.x, 1u) : 0u;
#define IN(k) (lo <= (k) && (k) < hi)
#define SEAM(k) do { if (IN(k) && IN((k) + 1)) xcd_barrier(bar); } while (0)
    unsigned char* ws = p.ws; unsigned char* ob = (unsigned char*)p.out;
    const float* x = p.in[0];
    bf16 *WIN_T = (bf16*)(ws + WS_WIN_T), *PW_T = (bf16*)(ws + WS_PW_T), *WO_T = (bf16*)(ws + WS_WO_T), *WOUT_T = (bf16*)(ws + WS_WOUT_T), *WQ_T = (bf16*)(ws + WS_WQ_T), *KEYS = (bf16*)(ws + WS_KEYS);
    bf16 *XN = (bf16*)(ws + WS_XN), *PROJ = (bf16*)(ws + WS_PROJ), *YN = (bf16*)(ws + WS_YN), *G = (bf16*)(ws + WS_G), *M = (bf16*)(ws + WS_M);
    bf16 *Q = (bf16*)(ws + WS_Q);
    u8 *U8 = (u8*)(ws + WS_XN), *V8 = (u8*)(ws + WS_PROJ + 64 * MiB), *H8 = (u8*)(ws + WS_PROJ + 80 * MiB);
    bf16* XN2 = (bf16*)(ws + WS_M);
    float *USC = (float*)(ws + 19 * MiB + 512 * 1024), *VSC = USC + 16384, *HS = USC + 32768, *CF = (float*)(ws + WS_PROJ + 144 * MiB), *SS = (float*)(ws + WS_BONUS), *SCL = USC + 65536, *PARTB = (float*)(ws + WS_Q);
    float *BONUS = (float*)(ws + WS_BONUS), *GATE = (float*)(ws + WS_GATE); int* EID = (int*)(ws + WS_EID);
    bf16 *OMG = (bf16*)(ob), *Y0 = (bf16*)(ob + 16 * MiB), *V = (bf16*)(ob + 32 * MiB), *O = (bf16*)(ob + 48 * MiB);
    bf16 *PHI = (bf16*)(ws + WS_LD), *PSI = (bf16*)(ws + WS_LD + 16 * MiB);
    bf16* X1 = (bf16*)(ws + WS_PROJ + 96 * MiB);

    if (IN(0)) {
        ph_transpose_reg(bid, nblk, 0, p.in[2], WIN_T, 1024, DIN, DINP);
        ph_rmsnorm(bid, nblk, x, p.in[1], XN, T);
        __syncthreads();
    }
    SEAM(0);
    if (IN(1)) ph_gemm(lds, bid, nblk, XN, WIN_T, T, DINP, 1024, EpiGen<FStoreBf16>{FStoreBf16{PROJ, DINP}});
    SEAM(1);
    if (IN(2)) {
        ChunkParams cp{PROJ, p.in[9], p.in[10], p.in[11], p.in[12], p.in[13], p.in[14], p.in[15], p.in[16], p.in[17], V, G, PHI, PSI, OMG, Y0, BONUS};
        ph_chunkprep(lds, bid, nblk, cp);
        __syncthreads();
    }
    SEAM(2);
    if (IN(3)) {
        if (bid < 32) ph_chain2(lds, bid, PHI, PSI);
        else {
            const int ob_ = bid - 32, on_ = nblk - 32;
            int t0 = 0;
            t0 += ph_transpose(lds, ob_, on_, t0, p.in[7], PW_T, 512, 1024, 1024);
            t0 += ph_transpose(lds, ob_, on_, t0, p.in[20], WO_T, 512, 1024, 1024);
            t0 += ph_transpose(lds, ob_, on_, t0, p.in[21], WOUT_T, 1024, 1024, 1024);
            t0 += ph_transpose(lds, ob_, on_, t0, p.in[23], WQ_T, 1024, 2048, 2048, p.in[22]);
            ph_cvt(ob_, on_, p.in[24], KEYS, (size_t)(8 * 2 * 128 * 128 / 4));
            ph_cvt_i4(ob_, on_, p.in[25], U8, USC, 16384);
            __syncthreads();
        }
    }
    SEAM(3);
    if (IN(4)) {
        ph_yout(lds, bid, nblk, PHI, OMG, Y0, V, G, BONUS, p.in[18], p.in[19], O);
        __syncthreads();
        {
            const int ob_ = bid, on_ = nblk;
            ph_conv(lds, ob_, on_, PROJ, p.in[3], p.in[4], p.in[5], p.in[6], YN);
            __syncthreads();
            __syncthreads();
        }
    }
    SEAM(4);
    if (IN(5)) ph_gemm2(lds, bid, nblk, YN, PW_T, O, WO_T, T, 1024, 512, 8, 16, EpiMix{M, PROJ, p.in[8]});
    SEAM(5);
    if (IN(6)) ph_gemm(lds, bid, nblk, M, WOUT_T, T, 1024, 1024, EpiGen2<FResX12B>{FResX12B{x, X1}});
    SEAM(6);
    if (IN(7)) {
        ph_rowstat(bid, nblk, X1, p.in[22], H8, HS, SCL, T);
        ph_cvt_i8(bid, nblk, p.in[26], V8, VSC, 16384);
        __syncthreads();
        ph_gemm(lds, bid, nblk, X1, WQ_T, T, 2048, 1024, EpiGen<FStoreBf16>{FStoreBf16{Q, 2048}});
    }
    SEAM(7);
    if (IN(9)) ph_topk2(lds, bid, nblk, Q, KEYS, SCL, EID, GATE);
    SEAM(9);
    Part part; bool census_ok;
    {
        unsigned n[8], tot = 0; bool ok = (hi - lo > 1);
#pragma unroll
        for (int j = 0; j < 8; ++j) { n[j] = xb_ld(bar.bar + XB_XCNT(j)); tot += n[j]; ok = ok && n[j] > 0; }
        ok = ok && tot == (unsigned)nblk && bar.x < 8u;
        const unsigned myr = st[2];
        census_ok = ok;
        if (ok) { part.p0 = (int)bar.x; part.pstep = 8; part.rank = (int)myr; part.nrank = (int)n[bar.x & 7]; if (part.rank >= part.nrank) { part.rank = 0; part.nrank = 1; part.p0 = 8; } }
        else if ((nblk % 8) == 0) { part.p0 = bid & 7; part.pstep = 8; part.rank = bid >> 3; part.nrank = nblk >> 3; }
        else { part.p0 = 0; part.pstep = 1; part.rank = bid; part.nrank = nblk; }
    }
    Part part4;
    if (census_ok) {
        const unsigned xe = bar.x & 6u, n0 = xb_ld(bar.bar + XB_XCNT(xe)), n1 = xb_ld(bar.bar + XB_XCNT(xe + 1));
        part4.p0 = (int)(bar.x >> 1); part4.pstep = 4; part4.rank = (int)(((bar.x & 1u) ? n0 : 0u) + st[2]); part4.nrank = (int)(n0 + n1);
    } else if ((nblk % 4) == 0) { part4.p0 = bid & 3; part4.pstep = 4; part4.rank = bid >> 2; part4.nrank = nblk >> 2; }
    else { part4.p0 = 0; part4.pstep = 1; part4.rank = bid; part4.nrank = nblk; }
    if (IN(10)) ph_peer_u7(lds, part4, H8, HS, U8, EID, PARTB);
    SEAM(10);
    if (IN(11)) ph_peer_cf3(bid, nblk, PARTB, USC, VSC, EID, GATE, (unsigned short*)CF, (unsigned*)((unsigned short*)CF + (size_t)T * 128), HS + 16384, 4);
    SEAM(11);
    if (IN(12)) ph_peer_v6(lds, part, X1, X1, V8, (const unsigned short*)CF, (const unsigned*)((const unsigned short*)CF + (size_t)T * 128), HS + 16384, SS);
    SEAM(12);
    if (IN(13)) ph_peer_f(bid, nblk, X1, p.out, SS, p.in[27]);
#undef IN
#undef SEAM
}

#ifndef MK_PER_PHASE
#define MK_PER_PHASE 0
#endif
extern "C" void kernel_launch(void* const* d_in, const int* in_sizes, int n_in, void* d_out, int out_size, void* d_ws, size_t ws_size, hipStream_t stream) {
    static int grid = 0;
    if (grid == 0) {
        if (n_in != 28 || ws_size < WS_END) { fprintf(stderr, "kernel_launch: unexpected n_in %d / ws_size %zu\n", n_in, ws_size); grid = -1; return; }
        int dev = 0, cus = 0;
        if (hipGetDevice(&dev) != hipSuccess || hipDeviceGetAttribute(&cus, hipDeviceAttributeMultiprocessorCount, dev) != hipSuccess) { grid = -1; return; }
        if (hipFuncSetAttribute((const void*)mega, hipFuncAttributeMaxDynamicSharedMemorySize, LDS_BYTES) != hipSuccess) { fprintf(stderr, "kernel_launch: hipFuncSetAttribute failed\n"); grid = -1; return; }
        (void)hipGetLastError();
        grid = cus;
    }
    if (grid < 0) return;
    (void)hipMemsetAsync((unsigned char*)d_ws + WS_BAR, 0, XCD_BAR_WORDS * 4 + 16 * 256, stream);
    MP a{};
    for (int i = 0; i < 28; ++i) a.in[i] = (const float*)d_in[i];
    a.out = (float*)d_out; a.ws = (unsigned char*)d_ws;
#if MK_PER_PHASE
    for (int ph = 0; ph < N_PHASES; ++ph) { a.ph_lo = ph; a.ph_hi = ph + 1; hipLaunchKernelGGL(mega, dim3(grid), dim3(512), LDS_BYTES, stream, a); }
#else
    a.ph_lo = 0; a.ph_hi = N_PHASES;
    hipLaunchKernelGGL(mega, dim3(grid), dim3(512), LDS_BYTES, stream, a);
#endif
}
```

```cpp
#include <hip/hip_runtime.h>
#include <stdint.h>
#include <stdio.h>
namespace pg8 {
#define PG8_LAS __attribute__((address_space(3)))
typedef unsigned short bf16_t;
typedef short bf16x8 __attribute__((ext_vector_type(8)));
typedef float f32x4 __attribute__((ext_vector_type(4)));
typedef unsigned u32x4 __attribute__((ext_vector_type(4)));
constexpr int BM = 256, BK = 64, HALF = 128, HTB = HALF * BK * 2  , STAGE_BYTES = 8 * HTB, NXCD = 8, WGM = 8;

__host__ __device__ __forceinline__ int lds_byte(int r, int c) { const int st = (r >> 4) * 2 + (c >> 5), rr = r & 15, cc = c & 31, ob = rr * 64 + cc * 2; return st * 1024 + (ob ^ (((ob >> 9) & 1) << 5)); }
__host__ __device__ __forceinline__ void stage_rc(int b, int& R, int& C) { const int st = b / 1024, sb = b % 1024, swz = sb ^ (((sb >> 9) & 1) << 5); R = (st >> 1) * 16 + swz / 64; C = (st & 1) * 32 + (swz % 64) / 2; }
__host__ __device__ __forceinline__ int perm32(int rho) { const int n = rho >> 4, i = rho & 15; return 8 * (i >> 2) + 4 * n + (i & 3); }

struct Unit { int pm, pn; };
struct Gemm { const bf16_t* A; const bf16_t* Bt; int M, N, K; };

struct StaticOrder {
    int nM, nN, nwg, G, c;
    __host__ __device__ void init(int M, int N, int G_, int c_) { nM = M / BM; nN = N / BM; nwg = nM * nN; G = G_; c = c_; }
    __host__ __device__ bool next(int i, Unit& u) const {
        const long L = (long)i * G + c; if (L >= nwg) return false;
        int wgid = (int)L; { const int q = nwg / NXCD, r = nwg % NXCD, xcd = wgid % NXCD, off = wgid / NXCD; wgid = (xcd < r ? xcd * (q + 1) : r * (q + 1) + (xcd - r) * q) + off; }
        const int nig = WGM * nN, gid = wgid / nig, fm = gid * WGM, gsz = (nM - fm) < WGM ? (nM - fm) : WGM;
        u.pm = fm + ((wgid % nig) % gsz); u.pn = (wgid % nig) / gsz; return true;
    }
    __device__ __forceinline__ void a_ready(const Unit&) const {}
    __device__ __forceinline__ void done(const Unit&) const {}
};
__device__ __forceinline__ unsigned cvt_pk_bf16(float lo, float hi) { unsigned r; asm volatile("v_cvt_pk_bf16_f32 %0, %1, %2" : "=v"(r) : "v"(lo), "v"(hi)); return r; }
struct Gemm2 { const bf16_t* A; const bf16_t* Bt; const bf16_t* A2; const bf16_t* Bt2; int M, N, K, nt1, nt; };
template <class Epi, class Sched, bool STAMP = false>
__device__ __forceinline__ void gemm_phase(PG8_LAS unsigned char* lds, const Gemm g, const Sched& S, const Epi& E, unsigned long long* stamps) {
    const int tid = threadIdx.x, wid = __builtin_amdgcn_readfirstlane(tid >> 6), lane = tid & 63, wr = wid >> 2, wc = wid & 3, fr = lane & 15, fq = lane >> 4;
    const int K = g.K, nt = K / BK;
    int ts_lo = 0, ts_hi = 0, nts = 0; const unsigned long long rt_entry = STAMP ? (unsigned long long)wall_clock64() : 0ull;
#define PG8_STAMP() do { if (STAMP && wid == 0 && nts < 64) { const unsigned long long _c = (unsigned long long)clock64(); \
        ts_lo = (lane == nts) ? (int)(unsigned)_c : ts_lo; ts_hi = (lane == nts) ? (int)(unsigned)(_c >> 32) : ts_hi; ++nts; } } while (0)
    PG8_STAMP();
    unsigned voffA[2], voffB[2];
#pragma unroll
    for (int i = 0; i < 2; ++i) { int R, C; stage_rc(tid * 16 + i * 8192, R, C); const int Rb = Epi::PERM ? ((R & ~31) + perm32(R & 31)) : R;
        voffA[i] = (unsigned)(R * K + C) * 2u; voffB[i] = (unsigned)(Rb * K + C) * 2u; }
    const size_t kstep = (size_t)(BK * 2);
    const size_t hstep = (size_t)HALF * K * 2;
    const size_t tstep = 2 * hstep;
    const unsigned ldsw = (unsigned)wid * 1024u;
    const int aoff = lds_byte(wr * 64 + fr, fq * 8), boff = lds_byte(wc * 32 + fr, fq * 8);
#define PG8_SA(b, h) (((b) * 2 + (h)) * HTB)
#define PG8_SB(b, h) ((4 + (b) * 2 + (h)) * HTB)
#define PG8_STAGE(bufoff, gbase, voff) do { _Pragma("unroll") for (int _i = 0; _i < 2; ++_i) \
        __builtin_amdgcn_global_load_lds((const unsigned*)((const char*)(gbase) + (voff)[_i]), (PG8_LAS unsigned*)(lds + (bufoff) + ldsw + _i * 8192), 16, 0, 0); } while (0)
#define PG8_LDA(dst, b, h) do { _Pragma("unroll") for (int m = 0; m < 4; ++m) _Pragma("unroll") for (int k = 0; k < 2; ++k) dst[m][k] = *(const PG8_LAS bf16x8*)(lds + PG8_SA(b, h) + aoff + m * 2048 + k * 1024); } while (0)
#define PG8_LDB(dst, b, h) do { _Pragma("unroll") for (int n = 0; n < 2; ++n) _Pragma("unroll") for (int k = 0; k < 2; ++k) dst[n][k] = *(const PG8_LAS bf16x8*)(lds + PG8_SB(b, h) + boff + n * 2048 + k * 1024); } while (0)
#define PG8_MMA(ai, bj, At, Bt) do { __builtin_amdgcn_s_setprio(1); _Pragma("unroll") for (int m = 0; m < 4; ++m) _Pragma("unroll") for (int n = 0; n < 2; ++n) _Pragma("unroll") for (int k = 0; k < 2; ++k) \
        acc[ai][bj][m][n] = __builtin_amdgcn_mfma_f32_16x16x32_bf16(Bt[n][k], At[m][k], acc[ai][bj][m][n], 0, 0, 0); __builtin_amdgcn_s_setprio(0); } while (0)
#define PG8_WAIT_V(n) asm volatile("s_waitcnt vmcnt(" #n ")" ::: "memory")
#define PG8_WAIT_L(n) asm volatile("s_waitcnt lgkmcnt(" #n ")" ::: "memory")
#define PG8_BAR __builtin_amdgcn_s_barrier()
#define PG8_SCHED __builtin_amdgcn_sched_barrier(0)
    Unit cur, nxt; int ui = 0;
    if (!S.next(0, cur)) return;
    f32x4 acc[2][2][4][2];
#pragma unroll
    for (int a = 0; a < 2; ++a)
#pragma unroll
        for (int b = 0; b < 2; ++b)
#pragma unroll
            for (int m = 0; m < 4; ++m)
#pragma unroll
                for (int n = 0; n < 2; ++n) acc[a][b][m][n] = (f32x4){0.f, 0.f, 0.f, 0.f};
    bf16x8 At[4][2], B0[2][2], B1[2][2];
    const char* cA = (const char*)g.A + (size_t)cur.pm * tstep; const char* cB = (const char*)g.Bt + (size_t)cur.pn * tstep;
    S.a_ready(cur);
    PG8_STAGE(PG8_SB(0, 0), cB, voffB); PG8_STAGE(PG8_SA(0, 0), cA, voffA); PG8_STAGE(PG8_SB(0, 1), cB + hstep, voffB); PG8_STAGE(PG8_SA(0, 1), cA + hstep, voffA);
    if (wr == 1) PG8_BAR;
    PG8_WAIT_V(4); PG8_BAR;
    PG8_STAGE(PG8_SB(1, 0), cB + kstep, voffB); PG8_STAGE(PG8_SA(1, 0), cA + kstep, voffA); PG8_STAGE(PG8_SB(1, 1), cB + hstep + kstep, voffB);
    PG8_WAIT_V(6); PG8_BAR;
    PG8_STAMP();
    for (;;) {
        const bool has_next = S.next(ui + 1, nxt);
        const char* nA = has_next ? (const char*)g.A + (size_t)nxt.pm * tstep : cA; const char* nB = has_next ? (const char*)g.Bt + (size_t)nxt.pn * tstep : cB;
        for (int t = 0; t < nt; t += 2) {
            const bool last = (t == nt - 2);
            const char* a1 = cA + (size_t)(t + 1) * kstep;
            const char* a2 = last ? nA : cA + (size_t)(t + 2) * kstep; const char* b2 = last ? nB : cB + (size_t)(t + 2) * kstep;
            const char* a3 = a2 + kstep; const char* b3 = b2 + kstep;
            if (last && has_next) S.a_ready(nxt);
            PG8_LDB(B0, 0, 0); PG8_SCHED; PG8_LDA(At, 0, 0); PG8_STAGE(PG8_SA(1, 1), a1 + hstep, voffA);
            PG8_WAIT_L(8); PG8_BAR; PG8_WAIT_L(0); PG8_MMA(0, 0, At, B0); PG8_BAR; PG8_SCHED;
            PG8_LDB(B1, 0, 1); PG8_STAGE(PG8_SB(0, 0), b2, voffB);
            PG8_BAR; PG8_WAIT_L(0); PG8_MMA(0, 1, At, B1); PG8_BAR;
            PG8_LDA(At, 0, 1); PG8_STAGE(PG8_SA(0, 0), a2, voffA);
            PG8_BAR; PG8_WAIT_L(0); PG8_MMA(1, 0, At, B0); PG8_BAR; PG8_SCHED;
            PG8_STAGE(PG8_SB(0, 1), b2 + hstep, voffB);
            PG8_WAIT_V(6); PG8_BAR; PG8_MMA(1, 1, At, B1); PG8_BAR;
            PG8_LDB(B0, 1, 0); PG8_SCHED; PG8_LDA(At, 1, 0); PG8_STAGE(PG8_SA(0, 1), a2 + hstep, voffA);
            PG8_WAIT_L(8); PG8_BAR; PG8_WAIT_L(0); PG8_MMA(0, 0, At, B0); PG8_BAR; PG8_SCHED;
            PG8_LDB(B1, 1, 1); PG8_STAGE(PG8_SB(1, 0), b3, voffB);
            PG8_BAR; PG8_WAIT_L(0); PG8_MMA(0, 1, At, B1); PG8_BAR;
            PG8_LDA(At, 1, 1); PG8_STAGE(PG8_SA(1, 0), a3, voffA);
            PG8_BAR; PG8_WAIT_L(0); PG8_MMA(1, 0, At, B0); PG8_BAR; PG8_SCHED;
            PG8_STAGE(PG8_SB(1, 1), b3 + hstep, voffB);
            PG8_WAIT_V(6); PG8_BAR; PG8_MMA(1, 1, At, B1); PG8_BAR;
        }
        PG8_STAMP();
        if constexpr (!Epi::AFTER_DRAIN) { E(acc, cur, wr, wc, fr, fq); S.done(cur); }
        PG8_STAMP();
        if (!has_next) break;
#pragma unroll
        for (int a = 0; a < 2; ++a)
#pragma unroll
            for (int b = 0; b < 2; ++b)
#pragma unroll
                for (int m = 0; m < 4; ++m)
#pragma unroll
                    for (int n = 0; n < 2; ++n) acc[a][b][m][n] = (f32x4){0.f, 0.f, 0.f, 0.f};
        cur = nxt; cA = nA; cB = nB; ++ui;
    }
    PG8_WAIT_V(0);
    if (wr == 0) PG8_BAR;
    PG8_BAR;
    if constexpr (Epi::AFTER_DRAIN) { E.fused(acc, cur, wr, wc, fr, fq, lds, wid, lane); S.done(cur); }
    PG8_STAMP();
    if (STAMP && wid == 0) { stamps[lane] = lane < nts ? (((unsigned long long)(unsigned)ts_hi << 32) | (unsigned)ts_lo) : 0ull;
        if (lane == 62) stamps[62] = rt_entry; if (lane == 63) stamps[63] = (unsigned long long)wall_clock64(); }
#undef PG8_STAMP
#undef PG8_SA
#undef PG8_SB
#undef PG8_STAGE
#undef PG8_LDA
#undef PG8_LDB
#undef PG8_MMA
#undef PG8_WAIT_V
#undef PG8_WAIT_L
#undef PG8_BAR
#undef PG8_SCHED
}

typedef int i32x8 __attribute__((ext_vector_type(8)));
typedef int i32x4 __attribute__((ext_vector_type(4)));
__device__ __forceinline__ i32x8 cat8(bf16x8 lo, bf16x8 hi) { const i32x4 a = __builtin_bit_cast(i32x4, lo), b = __builtin_bit_cast(i32x4, hi); return __builtin_shufflevector(a, b, 0, 1, 2, 3, 4, 5, 6, 7); }
template <class Epi, class Sched, bool STAMP = false>
__device__ __forceinline__ void gemm_phase_f8(PG8_LAS unsigned char* lds, const Gemm g, const Sched& S, const Epi& E, unsigned long long* stamps) {
    const int tid = threadIdx.x, wid = __builtin_amdgcn_readfirstlane(tid >> 6), lane = tid & 63, wr = wid >> 2, wc = wid & 3, fr = lane & 15, fq = lane >> 4;
    const int K = g.K, nt = K / BK;
    int ts_lo = 0, ts_hi = 0, nts = 0; const unsigned long long rt_entry = STAMP ? (unsigned long long)wall_clock64() : 0ull;
#define PG8_STAMP() do { if (STAMP && wid == 0 && nts < 64) { const unsigned long long _c = (unsigned long long)clock64(); \
        ts_lo = (lane == nts) ? (int)(unsigned)_c : ts_lo; ts_hi = (lane == nts) ? (int)(unsigned)(_c >> 32) : ts_hi; ++nts; } } while (0)
    PG8_STAMP();
    unsigned voffA[2], voffB[2];
#pragma unroll
    for (int i = 0; i < 2; ++i) { int R, C; stage_rc(tid * 16 + i * 8192, R, C); const int Rb = Epi::PERM ? ((R & ~31) + perm32(R & 31)) : R;
        voffA[i] = (unsigned)(R * K + C) * 2u; voffB[i] = (unsigned)(Rb * K + C) * 2u; }
    const size_t kstep = (size_t)(BK * 2);
    const size_t hstep = (size_t)HALF * K * 2;
    const size_t tstep = 2 * hstep;
    const unsigned ldsw = (unsigned)wid * 1024u;
    const int aoff = lds_byte(wr * 64 + fr, fq * 8), boff = lds_byte(wc * 32 + fr, fq * 8);
#define PG8_SA(b, h) (((b) * 2 + (h)) * HTB)
#define PG8_SB(b, h) ((4 + (b) * 2 + (h)) * HTB)
#define PG8_STAGE(bufoff, gbase, voff) do { _Pragma("unroll") for (int _i = 0; _i < 2; ++_i) \
        __builtin_amdgcn_global_load_lds((const unsigned*)((const char*)(gbase) + (voff)[_i]), (PG8_LAS unsigned*)(lds + (bufoff) + ldsw + _i * 8192), 16, 0, 0); } while (0)
#define PG8_LDA(dst, b, h) do { _Pragma("unroll") for (int m = 0; m < 4; ++m) _Pragma("unroll") for (int k = 0; k < 2; ++k) dst[m][k] = *(const PG8_LAS bf16x8*)(lds + PG8_SA(b, h) + aoff + m * 2048 + k * 1024); } while (0)
#define PG8_LDB(dst, b, h) do { _Pragma("unroll") for (int n = 0; n < 2; ++n) _Pragma("unroll") for (int k = 0; k < 2; ++k) dst[n][k] = *(const PG8_LAS bf16x8*)(lds + PG8_SB(b, h) + boff + n * 2048 + k * 1024); } while (0)
#define PG8_MMA(ai, bj, At, Bt) do { __builtin_amdgcn_s_setprio(1); _Pragma("unroll") for (int m = 0; m < 4; ++m) _Pragma("unroll") for (int n = 0; n < 2; ++n) \
        acc[ai][bj][m][n] = __builtin_amdgcn_mfma_scale_f32_16x16x128_f8f6f4(cat8(Bt[n][0], Bt[n][1]), cat8(At[m][0], At[m][1]), acc[ai][bj][m][n], 0, 0, 0, 0, 0, 0); __builtin_amdgcn_s_setprio(0); } while (0)
#define PG8_WAIT_V(n) asm volatile("s_waitcnt vmcnt(" #n ")" ::: "memory")
#define PG8_WAIT_L(n) asm volatile("s_waitcnt lgkmcnt(" #n ")" ::: "memory")
#define PG8_BAR __builtin_amdgcn_s_barrier()
#define PG8_SCHED __builtin_amdgcn_sched_barrier(0)
    Unit cur, nxt; int ui = 0;
    if (!S.next(0, cur)) return;
    f32x4 acc[2][2][4][2];
#pragma unroll
    for (int a = 0; a < 2; ++a)
#pragma unroll
        for (int b = 0; b < 2; ++b)
#pragma unroll
            for (int m = 0; m < 4; ++m)
#pragma unroll
                for (int n = 0; n < 2; ++n) acc[a][b][m][n] = (f32x4){0.f, 0.f, 0.f, 0.f};
    bf16x8 At[4][2], B0[2][2], B1[2][2];
    const char* cA = (const char*)g.A + (size_t)cur.pm * tstep; const char* cB = (const char*)g.Bt + (size_t)cur.pn * tstep;
    S.a_ready(cur);
    PG8_STAGE(PG8_SB(0, 0), cB, voffB); PG8_STAGE(PG8_SA(0, 0), cA, voffA); PG8_STAGE(PG8_SB(0, 1), cB + hstep, voffB); PG8_STAGE(PG8_SA(0, 1), cA + hstep, voffA);
    if (wr == 1) PG8_BAR;
    PG8_WAIT_V(4); PG8_BAR;
    PG8_STAGE(PG8_SB(1, 0), cB + kstep, voffB); PG8_STAGE(PG8_SA(1, 0), cA + kstep, voffA); PG8_STAGE(PG8_SB(1, 1), cB + hstep + kstep, voffB);
    PG8_WAIT_V(6); PG8_BAR;
    PG8_STAMP();
    for (;;) {
        const bool has_next = S.next(ui + 1, nxt);
        const char* nA = has_next ? (const char*)g.A + (size_t)nxt.pm * tstep : cA; const char* nB = has_next ? (const char*)g.Bt + (size_t)nxt.pn * tstep : cB;
        for (int t = 0; t < nt; t += 2) {
            const bool last = (t == nt - 2);
            const char* a1 = cA + (size_t)(t + 1) * kstep;
            const char* a2 = last ? nA : cA + (size_t)(t + 2) * kstep; const char* b2 = last ? nB : cB + (size_t)(t + 2) * kstep;
            const char* a3 = a2 + kstep; const char* b3 = b2 + kstep;
            if (last && has_next) S.a_ready(nxt);
            PG8_LDB(B0, 0, 0); PG8_SCHED; PG8_LDA(At, 0, 0); PG8_STAGE(PG8_SA(1, 1), a1 + hstep, voffA);
            PG8_WAIT_L(8); PG8_BAR; PG8_WAIT_L(0); PG8_MMA(0, 0, At, B0); PG8_BAR; PG8_SCHED;
            PG8_LDB(B1, 0, 1); PG8_STAGE(PG8_SB(0, 0), b2, voffB);
            PG8_BAR; PG8_WAIT_L(0); PG8_MMA(0, 1, At, B1); PG8_BAR;
            PG8_LDA(At, 0, 1); PG8_STAGE(PG8_SA(0, 0), a2, voffA);
            PG8_BAR; PG8_WAIT_L(0); PG8_MMA(1, 0, At, B0); PG8_BAR; PG8_SCHED;
            PG8_STAGE(PG8_SB(0, 1), b2 + hstep, voffB);
            PG8_WAIT_V(6); PG8_BAR; PG8_MMA(1, 1, At, B1); PG8_BAR;
            PG8_LDB(B0, 1, 0); PG8_SCHED; PG8_LDA(At, 1, 0); PG8_STAGE(PG8_SA(0, 1), a2 + hstep, voffA);
            PG8_WAIT_L(8); PG8_BAR; PG8_WAIT_L(0); PG8_MMA(0, 0, At, B0); PG8_BAR; PG8_SCHED;
            PG8_LDB(B1, 1, 1); PG8_STAGE(PG8_SB(1, 0), b3, voffB);
            PG8_BAR; PG8_WAIT_L(0); PG8_MMA(0, 1, At, B1); PG8_BAR;
            PG8_LDA(At, 1, 1); PG8_STAGE(PG8_SA(1, 0), a3, voffA);
            PG8_BAR; PG8_WAIT_L(0); PG8_MMA(1, 0, At, B0); PG8_BAR; PG8_SCHED;
            PG8_STAGE(PG8_SB(1, 1), b3 + hstep, voffB);
            PG8_WAIT_V(6); PG8_BAR; PG8_MMA(1, 1, At, B1); PG8_BAR;
        }
        PG8_STAMP();
        if constexpr (!Epi::AFTER_DRAIN) { E(acc, cur, wr, wc, fr, fq); S.done(cur); }
        PG8_STAMP();
        if (!has_next) break;
#pragma unroll
        for (int a = 0; a < 2; ++a)
#pragma unroll
            for (int b = 0; b < 2; ++b)
#pragma unroll
                for (int m = 0; m < 4; ++m)
#pragma unroll
                    for (int n = 0; n < 2; ++n) acc[a][b][m][n] = (f32x4){0.f, 0.f, 0.f, 0.f};
        cur = nxt; cA = nA; cB = nB; ++ui;
    }
    PG8_WAIT_V(0);
    if (wr == 0) PG8_BAR;
    PG8_BAR;
    if constexpr (Epi::AFTER_DRAIN) { E.fused(acc, cur, wr, wc, fr, fq, lds, wid, lane); S.done(cur); }
    PG8_STAMP();
    if (STAMP && wid == 0) { stamps[lane] = lane < nts ? (((unsigned long long)(unsigned)ts_hi << 32) | (unsigned)ts_lo) : 0ull;
        if (lane == 62) stamps[62] = rt_entry; if (lane == 63) stamps[63] = (unsigned long long)wall_clock64(); }
#undef PG8_STAMP
#undef PG8_SA
#undef PG8_SB
#undef PG8_STAGE
#undef PG8_LDA
#undef PG8_LDB
#undef PG8_MMA
#undef PG8_WAIT_V
#undef PG8_WAIT_L
#undef PG8_BAR
#undef PG8_SCHED
}

template <class Epi, class Sched, bool STAMP = false>
__device__ __forceinline__ void gemm_phase2(PG8_LAS unsigned char* lds, const Gemm2 g, const Sched& S, const Epi& E, unsigned long long* stamps) {
    const int tid = threadIdx.x, wid = __builtin_amdgcn_readfirstlane(tid >> 6), lane = tid & 63, wr = wid >> 2, wc = wid & 3, fr = lane & 15, fq = lane >> 4;
    const int K = g.K, nt1 = g.nt1, nt = g.nt;
    int ts_lo = 0, ts_hi = 0, nts = 0; const unsigned long long rt_entry = STAMP ? (unsigned long long)wall_clock64() : 0ull;
#define PG8_STAMP() do { if (STAMP && wid == 0 && nts < 64) { const unsigned long long _c = (unsigned long long)clock64(); \
        ts_lo = (lane == nts) ? (int)(unsigned)_c : ts_lo; ts_hi = (lane == nts) ? (int)(unsigned)(_c >> 32) : ts_hi; ++nts; } } while (0)
    PG8_STAMP();
    unsigned voffA[2], voffB[2];
#pragma unroll
    for (int i = 0; i < 2; ++i) { int R, C; stage_rc(tid * 16 + i * 8192, R, C); const int Rb = Epi::PERM ? ((R & ~31) + perm32(R & 31)) : R;
        voffA[i] = (unsigned)(R * K + C) * 2u; voffB[i] = (unsigned)(Rb * K + C) * 2u; }
    const size_t kstep = (size_t)(BK * 2);
    const size_t hstep = (size_t)HALF * K * 2;
    const size_t tstep = 2 * hstep;
    const unsigned ldsw = (unsigned)wid * 1024u;
    const int aoff = lds_byte(wr * 64 + fr, fq * 8), boff = lds_byte(wc * 32 + fr, fq * 8);
#define PG8_SA(b, h) (((b) * 2 + (h)) * HTB)
#define PG8_SB(b, h) ((4 + (b) * 2 + (h)) * HTB)
#define PG8_STAGE(bufoff, gbase, voff) do { _Pragma("unroll") for (int _i = 0; _i < 2; ++_i) \
        __builtin_amdgcn_global_load_lds((const unsigned*)((const char*)(gbase) + (voff)[_i]), (PG8_LAS unsigned*)(lds + (bufoff) + ldsw + _i * 8192), 16, 0, 0); } while (0)
#define PG8_LDA(dst, b, h) do { _Pragma("unroll") for (int m = 0; m < 4; ++m) _Pragma("unroll") for (int k = 0; k < 2; ++k) dst[m][k] = *(const PG8_LAS bf16x8*)(lds + PG8_SA(b, h) + aoff + m * 2048 + k * 1024); } while (0)
#define PG8_LDB(dst, b, h) do { _Pragma("unroll") for (int n = 0; n < 2; ++n) _Pragma("unroll") for (int k = 0; k < 2; ++k) dst[n][k] = *(const PG8_LAS bf16x8*)(lds + PG8_SB(b, h) + boff + n * 2048 + k * 1024); } while (0)
#define PG8_MMA(ai, bj, At, Bt) do { __builtin_amdgcn_s_setprio(1); _Pragma("unroll") for (int m = 0; m < 4; ++m) _Pragma("unroll") for (int n = 0; n < 2; ++n) _Pragma("unroll") for (int k = 0; k < 2; ++k) \
        acc[ai][bj][m][n] = __builtin_amdgcn_mfma_f32_16x16x32_bf16(Bt[n][k], At[m][k], acc[ai][bj][m][n], 0, 0, 0); __builtin_amdgcn_s_setprio(0); } while (0)
#define PG8_WAIT_V(n) asm volatile("s_waitcnt vmcnt(" #n ")" ::: "memory")
#define PG8_WAIT_L(n) asm volatile("s_waitcnt lgkmcnt(" #n ")" ::: "memory")
#define PG8_BAR __builtin_amdgcn_s_barrier()
#define PG8_SCHED __builtin_amdgcn_sched_barrier(0)
    Unit cur, nxt; int ui = 0;
    if (!S.next(0, cur)) return;
    f32x4 acc[2][2][4][2];
#pragma unroll
    for (int a = 0; a < 2; ++a)
#pragma unroll
        for (int b = 0; b < 2; ++b)
#pragma unroll
            for (int m = 0; m < 4; ++m)
#pragma unroll
                for (int n = 0; n < 2; ++n) acc[a][b][m][n] = (f32x4){0.f, 0.f, 0.f, 0.f};
    bf16x8 At[4][2], B0[2][2], B1[2][2];
    const char* cA = (const char*)g.A + (size_t)cur.pm * tstep; const char* cB = (const char*)g.Bt + (size_t)cur.pn * tstep;
    const char* dA = (const char*)g.A2 + (size_t)cur.pm * tstep - (size_t)nt1 * kstep; const char* dB = (const char*)g.Bt2 + (size_t)cur.pn * tstep - (size_t)nt1 * kstep;
#define PG8_TA(t_) ((((t_) < nt1) ? cA : dA) + (size_t)(t_) * kstep)
#define PG8_TB(t_) ((((t_) < nt1) ? cB : dB) + (size_t)(t_) * kstep)
    S.a_ready(cur);
    PG8_STAGE(PG8_SB(0, 0), cB, voffB); PG8_STAGE(PG8_SA(0, 0), cA, voffA); PG8_STAGE(PG8_SB(0, 1), cB + hstep, voffB); PG8_STAGE(PG8_SA(0, 1), cA + hstep, voffA);
    if (wr == 1) PG8_BAR;
    PG8_WAIT_V(4); PG8_BAR;
    PG8_STAGE(PG8_SB(1, 0), cB + kstep, voffB); PG8_STAGE(PG8_SA(1, 0), cA + kstep, voffA); PG8_STAGE(PG8_SB(1, 1), cB + hstep + kstep, voffB);
    PG8_WAIT_V(6); PG8_BAR;
    PG8_STAMP();
    for (;;) {
        const bool has_next = S.next(ui + 1, nxt);
        const char* nA = has_next ? (const char*)g.A + (size_t)nxt.pm * tstep : cA; const char* nB = has_next ? (const char*)g.Bt + (size_t)nxt.pn * tstep : cB;
        const char* ndA = has_next ? (const char*)g.A2 + (size_t)nxt.pm * tstep - (size_t)nt1 * kstep : dA; const char* ndB = has_next ? (const char*)g.Bt2 + (size_t)nxt.pn * tstep - (size_t)nt1 * kstep : dB;
        for (int t = 0; t < nt; t += 2) {
            const bool last = (t == nt - 2);
            if (t == nt1) E.mid(acc, cur, wr, wc, fr, fq);
            const char* a1 = PG8_TA(t + 1);
            const char* a2 = last ? nA : PG8_TA(t + 2); const char* b2 = last ? nB : PG8_TB(t + 2);
            const char* a3 = a2 + kstep; const char* b3 = b2 + kstep;
            if (last && has_next) S.a_ready(nxt);
            PG8_LDB(B0, 0, 0); PG8_SCHED; PG8_LDA(At, 0, 0); PG8_STAGE(PG8_SA(1, 1), a1 + hstep, voffA);
            PG8_WAIT_L(8); PG8_BAR; PG8_WAIT_L(0); PG8_MMA(0, 0, At, B0); PG8_BAR; PG8_SCHED;
            PG8_LDB(B1, 0, 1); PG8_STAGE(PG8_SB(0, 0), b2, voffB);
            PG8_BAR; PG8_WAIT_L(0); PG8_MMA(0, 1, At, B1); PG8_BAR;
            PG8_LDA(At, 0, 1); PG8_STAGE(PG8_SA(0, 0), a2, voffA);
            PG8_BAR; PG8_WAIT_L(0); PG8_MMA(1, 0, At, B0); PG8_BAR; PG8_SCHED;
            PG8_STAGE(PG8_SB(0, 1), b2 + hstep, voffB);
            PG8_WAIT_V(6); PG8_BAR; PG8_MMA(1, 1, At, B1); PG8_BAR;
            PG8_LDB(B0, 1, 0); PG8_SCHED; PG8_LDA(At, 1, 0); PG8_STAGE(PG8_SA(0, 1), a2 + hstep, voffA);
            PG8_WAIT_L(8); PG8_BAR; PG8_WAIT_L(0); PG8_MMA(0, 0, At, B0); PG8_BAR; PG8_SCHED;
            PG8_LDB(B1, 1, 1); PG8_STAGE(PG8_SB(1, 0), b3, voffB);
            PG8_BAR; PG8_WAIT_L(0); PG8_MMA(0, 1, At, B1); PG8_BAR;
            PG8_LDA(At, 1, 1); PG8_STAGE(PG8_SA(1, 0), a3, voffA);
            PG8_BAR; PG8_WAIT_L(0); PG8_MMA(1, 0, At, B0); PG8_BAR; PG8_SCHED;
            PG8_STAGE(PG8_SB(1, 1), b3 + hstep, voffB);
            PG8_WAIT_V(6); PG8_BAR; PG8_MMA(1, 1, At, B1); PG8_BAR;
        }
        PG8_STAMP();
        if constexpr (!Epi::AFTER_DRAIN) { E(acc, cur, wr, wc, fr, fq); S.done(cur); }
        PG8_STAMP();
        if (!has_next) break;
#pragma unroll
        for (int a = 0; a < 2; ++a)
#pragma unroll
            for (int b = 0; b < 2; ++b)
#pragma unroll
                for (int m = 0; m < 4; ++m)
#pragma unroll
                    for (int n = 0; n < 2; ++n) acc[a][b][m][n] = (f32x4){0.f, 0.f, 0.f, 0.f};
        cur = nxt; cA = nA; cB = nB; dA = ndA; dB = ndB; ++ui;
    }
    PG8_WAIT_V(0);
    if (wr == 0) PG8_BAR;
    PG8_BAR;
    if constexpr (Epi::AFTER_DRAIN) { E.fused(acc, cur, wr, wc, fr, fq, lds, wid, lane); S.done(cur); }
    PG8_STAMP();
    if (STAMP && wid == 0) { stamps[lane] = lane < nts ? (((unsigned long long)(unsigned)ts_hi << 32) | (unsigned)ts_lo) : 0ull;
        if (lane == 62) stamps[62] = rt_entry; if (lane == 63) stamps[63] = (unsigned long long)wall_clock64(); }
#undef PG8_STAMP
#undef PG8_TA
#undef PG8_TB
#undef PG8_SA
#undef PG8_SB
#undef PG8_STAGE
#undef PG8_LDA
#undef PG8_LDB
#undef PG8_MMA
#undef PG8_WAIT_V
#undef PG8_WAIT_L
#undef PG8_BAR
#undef PG8_SCHED
}
}
#define XB_TMO      128
#define XB_XCNT(j)  (256  + 64 * (j))
#define XB_XSUB(j)  (1280 + 64 * (j))
#define XB_XGEN(j)  (2304 + 64 * (j))
#define XB_TOP      3328
#define XB_TOPGEN   3392
#define XCD_BAR_WORDS 3456
#define XB_SPIN_CAP (1u << 18)
#define LAS __attribute__((address_space(3)))

__device__ __forceinline__ unsigned xb_ld(unsigned* p)              { return __hip_atomic_load(p, __ATOMIC_RELAXED, __HIP_MEMORY_SCOPE_AGENT); }
__device__ __forceinline__ unsigned xb_add(unsigned* p, unsigned v) { return __hip_atomic_fetch_add(p, v, __ATOMIC_RELAXED, __HIP_MEMORY_SCOPE_AGENT); }
__device__ __forceinline__ unsigned xb_xcc_id() { return (unsigned)__builtin_amdgcn_s_getreg((3 << 11) | 20) & 0xFu; }
#define XB_SPIN(cond, bar) do { unsigned _sp = 0; while (cond) { __builtin_amdgcn_s_sleep(1); \
    if ((++_sp & 255u) == 0u) { if (xb_ld(&(bar)[XB_TMO])) break; if (_sp > XB_SPIN_CAP) { atomicAdd(&(bar)[XB_TMO], 1u); break; } } } } while (0)

struct XcdBarrier {
    unsigned* bar; unsigned x;
    volatile LAS unsigned* st;
};

__device__ __forceinline__ XcdBarrier xcd_barrier_post(unsigned* bar, volatile LAS unsigned* st) {
    XcdBarrier b; b.bar = bar; b.x = xb_xcc_id(); b.st = st;
    if (threadIdx.x == 0) (void)xb_add(&bar[XB_XCNT(b.x)], 1u);
    return b;
}
__device__ __forceinline__ void xcd_barrier_complete(unsigned* bar, unsigned x, unsigned& nloc, unsigned& nx) {
    const unsigned G = gridDim.x * gridDim.y * gridDim.z;
    unsigned sum, cnt, mine, sp = 0u;
    for (;;) {
        sum = 0u; cnt = 0u; mine = 0u;
#pragma unroll
        for (unsigned j = 0; j < 16; ++j) { const unsigned c = xb_ld(&bar[XB_XCNT(j)]); sum += c; cnt += (c > 0u) ? 1u : 0u; mine = (j == x) ? c : mine; }
        if (sum == G) break;
        __builtin_amdgcn_s_sleep(1);
        if ((++sp & 255u) == 0u) { if (xb_ld(&bar[XB_TMO])) break; if (sp > XB_SPIN_CAP) { atomicAdd(&bar[XB_TMO], 1u); break; } }
    }
    nloc = mine > 0u ? mine : 1u; nx = cnt > 0u ? cnt : 1u;
}

__device__ __forceinline__ void xcd_barrier(const XcdBarrier& b) {
    asm volatile("s_waitcnt vmcnt(0)" ::: "memory");
    __syncthreads();
    if (threadIdx.x == 0) {
        unsigned* bar = b.bar;
        __builtin_amdgcn_s_waitcnt(0);
        unsigned nloc = b.st[0], nx = b.st[1];
        if (nloc == 0u) { xcd_barrier_complete(bar, b.x, nloc, nx); b.st[0] = nloc; b.st[1] = nx; }
        const unsigned old = xb_add(&bar[XB_XSUB(b.x)], 1u);
        const unsigned gen = old / nloc;
        if (old + 1u == (gen + 1u) * nloc) {
            __builtin_amdgcn_fence(__ATOMIC_RELEASE, "agent");
            asm volatile("s_waitcnt vmcnt(0)" ::: "memory");
            const unsigned og = xb_add(&bar[XB_TOP], 1u);
            const unsigned tg = og / nx;
            if (og + 1u == (tg + 1u) * nx) xb_add(&bar[XB_TOPGEN], 1u);
            else XB_SPIN(xb_ld(&bar[XB_TOPGEN]) == tg, bar);
            __builtin_amdgcn_fence(__ATOMIC_ACQUIRE, "agent");
            xb_add(&bar[XB_XGEN(b.x)], 1u);
            asm volatile("s_waitcnt vmcnt(0)" ::: "memory");
        } else {
            XB_SPIN(xb_ld(&bar[XB_XGEN(b.x)]) == gen, bar);
            __builtin_amdgcn_fence(__ATOMIC_ACQUIRE, "agent");
            asm volatile("s_waitcnt vmcnt(0)" ::: "memory");
        }
    }
    __syncthreads();
}

typedef unsigned short bf16;
using pg8::f32x4;
constexpr int T = 16384, SEQ = 4096, D = 1024, DIN = 4768, DINP = 4864;
constexpr int C_A = 0, C_B = 512, C_R = 1024, C_K = 1536, C_V = 2048, C_LW = 2560, C_LA = 2592, C_LG = 2624, C_GC = 2720, C_GR = 3744;
constexpr size_t MiB = 1u << 20;
constexpr size_t WS_WIN_T = 0, WS_PW_T = 10 * MiB, WS_WO_T = 11 * MiB, WS_WOUT_T = 12 * MiB, WS_WQ_T = 14 * MiB, WS_KEYS = 18 * MiB,
                 WS_BONUS = 18 * MiB + 512 * 1024, WS_XN = 20 * MiB, WS_PROJ = 52 * MiB, WS_LD = 204 * MiB, WS_YN = 236 * MiB, WS_END = 252 * MiB;
constexpr size_t WS_BETA = WS_XN, WS_G = WS_XN + 16 * MiB, WS_M = WS_LD;
constexpr size_t WS_Q = WS_PROJ, WS_UB = WS_PROJ + 64 * MiB, WS_VB = WS_PROJ + 96 * MiB, WS_EID = WS_PROJ + 128 * MiB, WS_GATE = WS_PROJ + 136 * MiB;

__device__ __forceinline__ bf16 f2bf(float f) { return __builtin_bit_cast(unsigned short, (__bf16)f); }
__device__ __forceinline__ float bf2f(bf16 b) { return __uint_as_float(((unsigned)b) << 16); }
__device__ __forceinline__ float bflo(unsigned w) { return __uint_as_float(w << 16); }
__device__ __forceinline__ float bfhi(unsigned w) { return __uint_as_float(w & 0xFFFF0000u); }
typedef __bf16 bf16x2_t __attribute__((ext_vector_type(2)));
__device__ __forceinline__ unsigned pack2(float lo, float hi) { bf16x2_t v; v[0] = (__bf16)lo; v[1] = (__bf16)hi; return __builtin_bit_cast(unsigned, v); }
__device__ __forceinline__ float wave_sum(float v) {
#pragma unroll
    for (int o = 32; o > 0; o >>= 1) v += __shfl_xor(v, o, 64);
    return v;
}
__device__ __forceinline__ float sigmoidf_(float x) { return __builtin_amdgcn_rcpf(1.f + __expf(-x)); }
__device__ __forceinline__ float tanhf_(float x) { return 1.f - 2.f * __builtin_amdgcn_rcpf(1.f + __expf(2.f * x)); }
__device__ __forceinline__ void unpack8(const uint4 v, float (&f)[8]) {
    f[0] = bflo(v.x); f[1] = bfhi(v.x); f[2] = bflo(v.y); f[3] = bfhi(v.y); f[4] = bflo(v.z); f[5] = bfhi(v.z); f[6] = bflo(v.w); f[7] = bfhi(v.w);
}
__device__ __forceinline__ uint4 pack8(const float (&f)[8]) {
    uint4 v; v.x = pack2(f[0], f[1]); v.y = pack2(f[2], f[3]); v.z = pack2(f[4], f[5]); v.w = pack2(f[6], f[7]); return v;
}

__device__ __forceinline__ int ph_transpose(unsigned char* shm, int bid, int nblk, int tile0, const float* __restrict__ src, bf16* __restrict__ dst, int K, int N, int Npad, const float* __restrict__ kscale = nullptr) {
    float (*tile)[65] = (float (*)[65])shm;
    const int ntn = Npad / 64, ntiles = ntn * (K / 64);
    int first = bid - (tile0 % nblk); if (first < 0) first += nblk;
    for (int tl = first; tl < ntiles; tl += nblk) {
        const int n0 = (tl % ntn) * 64, k0 = (tl / ntn) * 64;
        __syncthreads();
        for (int i = threadIdx.x; i < 64 * 64; i += 512) { const int kk = i >> 6, nn = i & 63; float v = 0.f; if (n0 + nn < N) v = src[(size_t)(k0 + kk) * N + n0 + nn]; if (kscale) v *= kscale[k0 + kk]; tile[kk][nn] = v; }
        __syncthreads();
        for (int i = threadIdx.x; i < 64 * 64; i += 512) { const int nn = i >> 6, kk = i & 63; dst[(size_t)(n0 + nn) * K + k0 + kk] = f2bf(tile[kk][nn]); }
    }
    return ntiles;
}
__device__ __forceinline__ int ph_transpose_reg(int bid, int nblk, int tile0, const float* __restrict__ src, bf16* __restrict__ dst, int K, int N, int Npad) {
    const int lane = threadIdx.x & 63, n4 = lane & 7, j = lane >> 3, ntn = Npad / 32, ntiles = ntn * (K / 64);
    int first = bid * 8 + (int)(threadIdx.x >> 6) - (tile0 % (nblk * 8)); if (first < 0) first += nblk * 8;
    for (int tl = first; tl < ntiles; tl += nblk * 8) {
        const int n0 = (tl % ntn) * 32 + 4 * n4, k0 = (tl / ntn) * 64 + 8 * j;
        float4 v[8];
        if (n0 < N) {
#pragma unroll
            for (int i = 0; i < 8; ++i) v[i] = *(const float4*)(src + (size_t)(k0 + i) * N + n0);
        } else {
#pragma unroll
            for (int i = 0; i < 8; ++i) v[i] = make_float4(0.f, 0.f, 0.f, 0.f);
        }
        uint4 o;
        o.x = pack2(v[0].x, v[1].x); o.y = pack2(v[2].x, v[3].x); o.z = pack2(v[4].x, v[5].x); o.w = pack2(v[6].x, v[7].x); *(uint4*)(dst + (size_t)(n0 + 0) * K + k0) = o;
        o.x = pack2(v[0].y, v[1].y); o.y = pack2(v[2].y, v[3].y); o.z = pack2(v[4].y, v[5].y); o.w = pack2(v[6].y, v[7].y); *(uint4*)(dst + (size_t)(n0 + 1) * K + k0) = o;
        o.x = pack2(v[0].z, v[1].z); o.y = pack2(v[2].z, v[3].z); o.z = pack2(v[4].z, v[5].z); o.w = pack2(v[6].z, v[7].z); *(uint4*)(dst + (size_t)(n0 + 2) * K + k0) = o;
        o.x = pack2(v[0].w, v[1].w); o.y = pack2(v[2].w, v[3].w); o.z = pack2(v[4].w, v[5].w); o.w = pack2(v[6].w, v[7].w); *(uint4*)(dst + (size_t)(n0 + 3) * K + k0) = o;
    }
    return ntiles;
}
__device__ __forceinline__ void ph_cvt(int bid, int nblk, const float* __restrict__ src, bf16* __restrict__ dst, size_t n4) {
    for (size_t i = (size_t)bid * 512 + threadIdx.x; i < n4; i += (size_t)nblk * 512) {
        const float4 v = ((const float4*)src)[i]; uint2 o; o.x = pack2(v.x, v.y); o.y = pack2(v.z, v.w); ((uint2*)dst)[i] = o; }
}
__device__ __forceinline__ void ph_rmsnorm(int bid, int nblk, const float* __restrict__ x, const float* __restrict__ g, bf16* __restrict__ out, int rows) {
    const int wave = (bid * 512 + threadIdx.x) >> 6, nw = (nblk * 512) >> 6, lane = threadIdx.x & 63;
    float4 gg[4], nx[4];
#pragma unroll
    for (int i = 0; i < 4; ++i) gg[i] = ((const float4*)g)[lane + 64 * i];
    if (wave < rows) {
#pragma unroll
        for (int i = 0; i < 4; ++i) nx[i] = ((const float4*)(x + (size_t)wave * D))[lane + 64 * i];
    }
    for (int r = wave; r < rows; r += nw) {
        float4 v[4]; float ss = 0.f;
#pragma unroll
        for (int i = 0; i < 4; ++i) v[i] = nx[i];
        if (r + nw < rows) {
#pragma unroll
            for (int i = 0; i < 4; ++i) nx[i] = ((const float4*)(x + (size_t)(r + nw) * D))[lane + 64 * i];
        }
#pragma unroll
        for (int i = 0; i < 4; ++i) ss += v[i].x * v[i].x + v[i].y * v[i].y + v[i].z * v[i].z + v[i].w * v[i].w;
        ss = wave_sum(ss);
        const float sc = rsqrtf(ss * (1.f / D) + 1e-6f);
#pragma unroll
        for (int i = 0; i < 4; ++i) { uint2 o; o.x = pack2(v[i].x * sc * gg[i].x, v[i].y * sc * gg[i].y); o.y = pack2(v[i].z * sc * gg[i].z, v[i].w * sc * gg[i].w);
            ((uint2*)(out + (size_t)r * D))[lane + 64 * i] = o; }
    }
}

template <class F> struct EpiGen {
    static constexpr bool PERM = true, AFTER_DRAIN = false;
    F f;
    __device__ __forceinline__ void operator()(const f32x4 (&acc)[2][2][4][2], const pg8::Unit& u, int wr, int wc, int fr, int fq) const {
        const int row0 = u.pm * 256 + wr * 64 + fr, col0 = u.pn * 256 + wc * 32 + 8 * fq;
#pragma unroll
        for (int ai = 0; ai < 2; ++ai)
#pragma unroll
            for (int m = 0; m < 4; ++m)
#pragma unroll
                for (int bj = 0; bj < 2; ++bj) f(row0 + ai * 128 + m * 16, col0 + bj * 128, acc[ai][bj][m][0], acc[ai][bj][m][1]);
    }
};
struct FStoreBf16 { bf16* O; int ldc;
    __device__ __forceinline__ void operator()(int row, int col, f32x4 a, f32x4 b) const {
        uint4 o; o.x = pack2(a[0], a[1]); o.y = pack2(a[2], a[3]); o.z = pack2(b[0], b[1]); o.w = pack2(b[2], b[3]);
        typedef unsigned nt4 __attribute__((ext_vector_type(4))); nt4 w; w[0] = o.x; w[1] = o.y; w[2] = o.z; w[3] = o.w;
        __builtin_nontemporal_store(w, (nt4*)(O + (size_t)row * ldc + col)); } };
struct FConvM { bf16* M; const bf16* proj; const float* bias;
    __device__ __forceinline__ void operator()(int row, int col, f32x4 a, f32x4 b) const {
        float gl[8]; unpack8(*(const uint4*)(proj + (size_t)row * DINP + C_GC + col), gl);
        const float4 b0 = *(const float4*)(bias + col), b1 = *(const float4*)(bias + col + 4);
        float o[8] = {a[0] + b0.x, a[1] + b0.y, a[2] + b0.z, a[3] + b0.w, b[0] + b1.x, b[1] + b1.y, b[2] + b1.z, b[3] + b1.w};
#pragma unroll
        for (int i = 0; i < 8; ++i) o[i] *= sigmoidf_(gl[i]);
        *(uint4*)(M + (size_t)row * D + col) = pack8(o); } };
struct FRwM { bf16* M; const bf16* proj;
    __device__ __forceinline__ void operator()(int row, int col, f32x4 a, f32x4 b) const {
        float gl[8], mo[8]; unpack8(*(const uint4*)(proj + (size_t)row * DINP + C_GR + col), gl); unpack8(*(const uint4*)(M + (size_t)row * D + col), mo);
        float o[8] = {a[0], a[1], a[2], a[3], b[0], b[1], b[2], b[3]};
#pragma unroll
        for (int i = 0; i < 8; ++i) o[i] = mo[i] + o[i] * sigmoidf_(gl[i]);
        *(uint4*)(M + (size_t)row * D + col) = pack8(o); } };
struct FResX1 { const float* x; float* x1;
    __device__ __forceinline__ void operator()(int row, int col, f32x4 a, f32x4 b) const {
        const float4 x0 = *(const float4*)(x + (size_t)row * D + col), x1v = *(const float4*)(x + (size_t)row * D + col + 4);
        *(float4*)(x1 + (size_t)row * D + col) = make_float4(x0.x + a[0], x0.y + a[1], x0.z + a[2], x0.w + a[3]);
        *(float4*)(x1 + (size_t)row * D + col + 4) = make_float4(x1v.x + b[0], x1v.y + b[1], x1v.z + b[2], x1v.w + b[3]); } };

template <class F> struct EpiGen2 {
    static constexpr bool PERM = true, AFTER_DRAIN = false;
    F f;
    __device__ __forceinline__ void operator()(const f32x4 (&acc)[2][2][4][2], const pg8::Unit& u, int wr, int wc, int fr, int fq) const {
        const int row0 = u.pm * 256 + wr * 64 + fr, col0 = u.pn * 256 + wc * 32 + 8 * fq;
#pragma unroll
        for (int ai = 0; ai < 2; ++ai) {
            typename F::Pre P[4][2];
#pragma unroll
            for (int m = 0; m < 4; ++m)
#pragma unroll
                for (int bj = 0; bj < 2; ++bj) P[m][bj] = f.pre(row0 + ai * 128 + m * 16, col0 + bj * 128);
#pragma unroll
            for (int m = 0; m < 4; ++m)
#pragma unroll
                for (int bj = 0; bj < 2; ++bj) f.post(row0 + ai * 128 + m * 16, col0 + bj * 128, acc[ai][bj][m][0], acc[ai][bj][m][1], P[m][bj]);
        }
    }
};
struct FConvM2 { bf16* M; const bf16* proj; const float* bias;
    struct Pre { uint4 g; };
    __device__ __forceinline__ Pre pre(int row, int col) const { Pre p; p.g = *(const uint4*)(proj + (size_t)row * DINP + C_GC + col); return p; }
    __device__ __forceinline__ void post(int row, int col, f32x4 a, f32x4 b, const Pre& p) const {
        float gl[8]; unpack8(p.g, gl);
        const float4 b0 = *(const float4*)(bias + col), b1 = *(const float4*)(bias + col + 4);
        float o[8] = {a[0] + b0.x, a[1] + b0.y, a[2] + b0.z, a[3] + b0.w, b[0] + b1.x, b[1] + b1.y, b[2] + b1.z, b[3] + b1.w};
#pragma unroll
        for (int i = 0; i < 8; ++i) o[i] *= sigmoidf_(gl[i]);
        *(uint4*)(M + (size_t)row * D + col) = pack8(o); } };
struct FRwM2 { bf16* M; const bf16* proj;
    struct Pre { uint4 g, m; };
    __device__ __forceinline__ Pre pre(int row, int col) const { Pre p; p.g = *(const uint4*)(proj + (size_t)row * DINP + C_GR + col); p.m = *(const uint4*)(M + (size_t)row * D + col); return p; }
    __device__ __forceinline__ void post(int row, int col, f32x4 a, f32x4 b, const Pre& p) const {
        float gl[8], mo[8]; unpack8(p.g, gl); unpack8(p.m, mo);
        float o[8] = {a[0], a[1], a[2], a[3], b[0], b[1], b[2], b[3]};
#pragma unroll
        for (int i = 0; i < 8; ++i) o[i] = mo[i] + o[i] * sigmoidf_(gl[i]);
        *(uint4*)(M + (size_t)row * D + col) = pack8(o); } };
struct FResX12B { const float* x; bf16* x1;
    struct Pre { float4 a, b; };
    __device__ __forceinline__ Pre pre(int row, int col) const { Pre p; p.a = *(const float4*)(x + (size_t)row * D + col); p.b = *(const float4*)(x + (size_t)row * D + col + 4); return p; }
    __device__ __forceinline__ void post(int row, int col, f32x4 a, f32x4 b, const Pre& p) const {
        *(uint4*)(x1 + (size_t)row * D + col) = make_uint4(pack2(p.a.x + a[0], p.a.y + a[1]), pack2(p.a.z + a[2], p.a.w + a[3]), pack2(p.b.x + b[0], p.b.y + b[1]), pack2(p.b.z + b[2], p.b.w + b[3])); } };
struct FResX12 { const float* x; float* x1;
    struct Pre { float4 a, b; };
    __device__ __forceinline__ Pre pre(int row, int col) const { Pre p; p.a = *(const float4*)(x + (size_t)row * D + col); p.b = *(const float4*)(x + (size_t)row * D + col + 4); return p; }
    __device__ __forceinline__ void post(int row, int col, f32x4 a, f32x4 b, const Pre& p) const {
        *(float4*)(x1 + (size_t)row * D + col) = make_float4(p.a.x + a[0], p.a.y + a[1], p.a.z + a[2], p.a.w + a[3]);
        *(float4*)(x1 + (size_t)row * D + col + 4) = make_float4(p.b.x + b[0], p.b.y + b[1], p.b.z + b[2], p.b.w + b[3]); } };

struct EpiMix {
    static constexpr bool PERM = true, AFTER_DRAIN = false;
    bf16* M; const bf16* proj; const float* bias;
    __device__ __forceinline__ void mid(f32x4 (&acc)[2][2][4][2], const pg8::Unit& u, int wr, int wc, int fr_, int fq_) const {
        int fr = fr_, fq = fq_; asm volatile("" : "+v"(fr), "+v"(fq));
        const int row0 = u.pm * 256 + wr * 64 + fr, col0 = u.pn * 256 + wc * 32 + 8 * fq;
#pragma unroll
        for (int ai = 0; ai < 2; ++ai)
#pragma unroll
            for (int mh = 0; mh < 2; ++mh) {
                uint4 gc[2][2], gr[2][2];
#pragma unroll
                for (int mm = 0; mm < 2; ++mm)
#pragma unroll
                    for (int bj = 0; bj < 2; ++bj) { const bf16* pr = proj + (size_t)(row0 + ai * 128 + (mh * 2 + mm) * 16) * DINP + col0 + bj * 128; gc[mm][bj] = *(const uint4*)(pr + C_GC); gr[mm][bj] = *(const uint4*)(pr + C_GR); }
#pragma unroll
                for (int mm = 0; mm < 2; ++mm)
#pragma unroll
                    for (int bj = 0; bj < 2; ++bj) {
                        const int m = mh * 2 + mm;
                        float c8[8], r8[8]; unpack8(gc[mm][bj], c8); unpack8(gr[mm][bj], r8);
                        const float4 b0 = *(const float4*)(bias + col0 + bj * 128), b1 = *(const float4*)(bias + col0 + bj * 128 + 4);
                        const float bb[8] = {b0.x, b0.y, b0.z, b0.w, b1.x, b1.y, b1.z, b1.w};
#pragma unroll
                        for (int i = 0; i < 8; ++i) { const float ratio = (1.f + __expf(-r8[i])) * __builtin_amdgcn_rcpf(1.f + __expf(-c8[i]));
                            if (i < 4) acc[ai][bj][m][0][i] = (acc[ai][bj][m][0][i] + bb[i]) * ratio; else acc[ai][bj][m][1][i - 4] = (acc[ai][bj][m][1][i - 4] + bb[i]) * ratio; }
                    }
                asm volatile("" ::: "memory");
            }
    }
    __device__ __forceinline__ void operator()(const f32x4 (&acc)[2][2][4][2], const pg8::Unit& u, int wr, int wc, int fr, int fq) const {
        const int row0 = u.pm * 256 + wr * 64 + fr, col0 = u.pn * 256 + wc * 32 + 8 * fq;
#pragma unroll
        for (int ai = 0; ai < 2; ++ai) {
            uint4 gr[4][2];
#pragma unroll
            for (int m = 0; m < 4; ++m)
#pragma unroll
                for (int bj = 0; bj < 2; ++bj) gr[m][bj] = *(const uint4*)(proj + (size_t)(row0 + ai * 128 + m * 16) * DINP + C_GR + col0 + bj * 128);
#pragma unroll
            for (int m = 0; m < 4; ++m)
#pragma unroll
                for (int bj = 0; bj < 2; ++bj) {
                    float r8[8], o[8]; unpack8(gr[m][bj], r8);
#pragma unroll
                    for (int i = 0; i < 8; ++i) o[i] = ((i < 4) ? acc[ai][bj][m][0][i] : acc[ai][bj][m][1][i - 4]) * sigmoidf_(r8[i]);
                    *(uint4*)(M + (size_t)(row0 + ai * 128 + m * 16) * D + col0 + bj * 128) = pack8(o);
                }
        }
    }
};
template <class Epi> __device__ __forceinline__ void ph_gemm2(unsigned char* shm, int bid, int nblk, const bf16* A, const bf16* Bt, const bf16* A2, const bf16* Bt2, int M, int N, int K, int nt1, int nt, const Epi& E) {
    pg8::Gemm2 g{A, Bt, A2, Bt2, M, N, K, nt1, nt};
    pg8::StaticOrder S; S.init(M, N, nblk, bid);
    pg8::gemm_phase2<Epi, pg8::StaticOrder, false>((PG8_LAS unsigned char*)shm, g, S, E, nullptr);
}
template <class Epi> __device__ __forceinline__ void ph_gemm(unsigned char* shm, int bid, int nblk, const bf16* A, const bf16* Bt, int M, int N, int K, const Epi& E) {
    pg8::Gemm g{A, Bt, M, N, K};
    pg8::StaticOrder S; S.init(M, N, nblk, bid);
    pg8::gemm_phase<Epi, pg8::StaticOrder, false>((PG8_LAS unsigned char*)shm, g, S, E, nullptr);
}

constexpr int CONV_GLU = 62 * 512 * 2, CONV_LDS = CONV_GLU + 31 * 512 * 4;
__device__ __forceinline__ float fmac1(float a, float b, float c) { asm("v_fmac_f32 %0, %1, %2" : "+v"(c) : "v"(a), "v"(b)); return c; }
__device__ __forceinline__ void ph_conv(unsigned char* shm, int bid, int nblk, const bf16* __restrict__ proj, const float* __restrict__ dw, const float* __restrict__ dwb,
                                              const float* __restrict__ lng, const float* __restrict__ lnb, bf16* __restrict__ yn) {
    bf16* glu = (bf16*)shm;
    float* dws = (float*)(shm + CONV_GLU);
    const int tid = threadIdx.x, lane = tid & 63, wid = tid >> 6;
    if (bid < T / 32) { for (int i = tid; i < 31 * 128; i += 512) ((float4*)dws)[i] = ((const float4*)dw)[i]; }
    const float4 g0 = *(const float4*)(lng + lane * 8), g1 = *(const float4*)(lng + lane * 8 + 4), e0 = *(const float4*)(lnb + lane * 8), e1 = *(const float4*)(lnb + lane * 8 + 4);
    const float4 b0 = *(const float4*)(dwb + lane * 8), b1 = *(const float4*)(dwb + lane * 8 + 4);
    const float gg[8] = {g0.x, g0.y, g0.z, g0.w, g1.x, g1.y, g1.z, g1.w}, ee[8] = {e0.x, e0.y, e0.z, e0.w, e1.x, e1.y, e1.z, e1.w};
    for (int tile = bid; tile < T / 32; tile += nblk) {
        const int t0 = tile * 32, sq0 = t0 & ~(SEQ - 1);
        __syncthreads();
#pragma unroll
        for (int hb = 0; hb < 2; ++hb) {
            uint4 av[4], bv[4];
#pragma unroll
            for (int k = 0; k < 4; ++k) { const int it = tid + 512 * (hb * 4 + k), rr = it >> 6, cg = it & 63, t = t0 - 30 + rr;
                av[k] = make_uint4(0, 0, 0, 0); bv[k] = make_uint4(0, 0, 0, 0);
                if (rr < 62 && t >= sq0) { av[k] = *(const uint4*)(proj + (size_t)t * DINP + C_A + cg * 8); bv[k] = *(const uint4*)(proj + (size_t)t * DINP + C_B + cg * 8); } }
#pragma unroll
            for (int k = 0; k < 4; ++k) { const int it = tid + 512 * (hb * 4 + k), rr = it >> 6, cg = it & 63;
                if (rr < 62) { float a[8], b[8]; unpack8(av[k], a); unpack8(bv[k], b);
#pragma unroll
                    for (int i = 0; i < 8; ++i) a[i] *= sigmoidf_(b[i]);
                    *(uint4*)(glu + rr * 512 + cg * 8) = pack8(a); } }
        }
        __syncthreads();
        float acc[4][8];
#pragma unroll
        for (int i = 0; i < 4; ++i) { acc[i][0] = b0.x; acc[i][1] = b0.y; acc[i][2] = b0.z; acc[i][3] = b0.w; acc[i][4] = b1.x; acc[i][5] = b1.y; acc[i][6] = b1.z; acc[i][7] = b1.w; }
#pragma unroll 4
        for (int j = 0; j < 31; ++j) {
            const float4 w0 = *(const float4*)(dws + j * 512 + lane * 8), w1 = *(const float4*)(dws + j * 512 + lane * 8 + 4);
            const float w[8] = {w0.x, w0.y, w0.z, w0.w, w1.x, w1.y, w1.z, w1.w};
#pragma unroll
            for (int i = 0; i < 4; ++i) { float gv[8]; unpack8(*(const uint4*)(glu + (wid * 4 + i + j) * 512 + lane * 8), gv);
#pragma unroll
                for (int c = 0; c < 8; ++c) acc[i][c] = fmac1(gv[c], w[c], acc[i][c]); }
        }
#pragma unroll
        for (int i = 0; i < 4; ++i) {
            float s = 0.f;
#pragma unroll
            for (int c = 0; c < 8; ++c) s += acc[i][c];
            const float mean = wave_sum(s) * (1.f / 512.f);
            float q = 0.f;
#pragma unroll
            for (int c = 0; c < 8; ++c) { acc[i][c] -= mean; q += acc[i][c] * acc[i][c]; }
            const float rstd = rsqrtf(wave_sum(q) * (1.f / 512.f) + 1e-5f);
            float o[8];
#pragma unroll
            for (int c = 0; c < 8; ++c) { const float z = acc[i][c] * rstd * gg[c] + ee[c]; o[c] = z * sigmoidf_(z); }
            *(uint4*)(yn + (size_t)(t0 + wid * 4 + i) * 512 + lane * 8) = pack8(o);
        }
    }
}


constexpr int CS = 72;
constexpr int SLOT = 64 * CS * 2;
constexpr int CP_SMALL = 15 * SLOT;
struct ChunkParams { const bf16* proj; const float *mu, *w0, *w2, *a0, *a2, *g2, *k_k, *k_a, *r_k; bf16 *V, *G, *PHI, *PSI, *OMG, *Y0; float* BONUS; };

__device__ __forceinline__ f32x4 tile_mm(const bf16* A, const bf16* Bt, int m0, int n0, int fr, int fq, f32x4 acc) {
#pragma unroll
    for (int ks = 0; ks < 2; ++ks) {
        const pg8::bf16x8 a = *(const pg8::bf16x8*)(A + (m0 + fr) * CS + ks * 32 + fq * 8);
        const pg8::bf16x8 b = *(const pg8::bf16x8*)(Bt + (n0 + fr) * CS + ks * 32 + fq * 8);
        acc = __builtin_amdgcn_mfma_f32_16x16x32_bf16(a, b, acc, 0, 0, 0);
    }
    return acc;
}
struct Frag2 { pg8::bf16x8 k0, k1; };
__device__ __forceinline__ Frag2 ld_frag(const bf16* M, int row0, int fr, int fq) {
    Frag2 f; f.k0 = *(const pg8::bf16x8*)(M + (row0 + fr) * CS + fq * 8); f.k1 = *(const pg8::bf16x8*)(M + (row0 + fr) * CS + 32 + fq * 8); return f; }
__device__ __forceinline__ f32x4 mmf(const Frag2& a, const Frag2& b, f32x4 acc) {
    acc = __builtin_amdgcn_mfma_f32_16x16x32_bf16(a.k0, b.k0, acc, 0, 0, 0); acc = __builtin_amdgcn_mfma_f32_16x16x32_bf16(a.k1, b.k1, acc, 0, 0, 0); return acc; }
__device__ __forceinline__ f32x4 tile_mm_sw(const bf16* A, const bf16* Bt, int m0, int n0, int fr, int fq, f32x4 acc) {
#pragma unroll
    for (int ks = 0; ks < 2; ++ks) {
        const pg8::bf16x8 a = *(const pg8::bf16x8*)(A + (m0 + fr) * CS + ks * 32 + fq * 8);
        const pg8::bf16x8 b = *(const pg8::bf16x8*)(Bt + (n0 + fr) * CS + ks * 32 + fq * 8);
        acc = __builtin_amdgcn_mfma_f32_16x16x32_bf16(b, a, acc, 0, 0, 0);
    }
    return acc;
}
__device__ __forceinline__ void tile_mm2(const bf16* A, const bf16* Bt, int m0, int n0, int fr, int fq, f32x4& accN, f32x4& accS) {
#pragma unroll
    for (int ks = 0; ks < 2; ++ks) {
        const pg8::bf16x8 a = *(const pg8::bf16x8*)(A + (m0 + fr) * CS + ks * 32 + fq * 8);
        const pg8::bf16x8 b = *(const pg8::bf16x8*)(Bt + (n0 + fr) * CS + ks * 32 + fq * 8);
        accN = __builtin_amdgcn_mfma_f32_16x16x32_bf16(a, b, accN, 0, 0, 0);
        accS = __builtin_amdgcn_mfma_f32_16x16x32_bf16(b, a, accS, 0, 0, 0);
    }
}
__device__ __forceinline__ void st_rm4(bf16* buf, int m0, int n0, int fr, int fq, f32x4 v) {
    uint2 o; o.x = pack2(v[0], v[1]); o.y = pack2(v[2], v[3]); *(uint2*)(buf + (m0 + fr) * CS + n0 + 4 * fq) = o;
}
__device__ __forceinline__ f32x4 ld_rm4(const bf16* buf, int m0, int n0, int fr, int fq) {
    const uint2 o = *(const uint2*)(buf + (m0 + fr) * CS + n0 + 4 * fq);
    f32x4 v; v[0] = bflo(o.x); v[1] = bfhi(o.x); v[2] = bflo(o.y); v[3] = bfhi(o.y); return v;
}
__device__ __forceinline__ void st_rm(bf16* buf, int m0, int n0, int fr, int fq, f32x4 v) {
#pragma unroll
    for (int r = 0; r < 4; ++r) buf[(m0 + 4 * fq + r) * CS + n0 + fr] = f2bf(v[r]);
}
__device__ __forceinline__ void st_tr(bf16* buf, int m0, int n0, int fr, int fq, f32x4 v) {
    uint2 o; o.x = pack2(v[0], v[1]); o.y = pack2(v[2], v[3]); *(uint2*)(buf + (n0 + fr) * CS + m0 + 4 * fq) = o;
}
__device__ __forceinline__ f32x4 ld_rm(const bf16* buf, int m0, int n0, int fr, int fq) {
    f32x4 v;
#pragma unroll
    for (int r = 0; r < 4; ++r) v[r] = bf2f(buf[(m0 + 4 * fq + r) * CS + n0 + fr]);
    return v;
}
__device__ __forceinline__ f32x4 ld_tr(const bf16* buf, int m0, int n0, int fr, int fq) {
    const uint2 o = *(const uint2*)(buf + (n0 + fr) * CS + m0 + 4 * fq);
    f32x4 v; v[0] = bflo(o.x); v[1] = bfhi(o.x); v[2] = bflo(o.y); v[3] = bfhi(o.y); return v;
}

__device__ __forceinline__ int opq(int v) { asm volatile("" : "+v"(v)); return v; }
template <int CTRL> __device__ __forceinline__ float dppf(float v) { return __int_as_float(__builtin_amdgcn_update_dpp(0, __float_as_int(v), CTRL, 0xF, 0xF, true)); }
__device__ __forceinline__ void wave_sum16(float (&r)[16]) {
    const int l = (int)(threadIdx.x & 63);
    const bool o1 = (l & 1) != 0, o2 = (l & 2) != 0;
    float a[8], b[4];
#pragma unroll
    for (int j = 0; j < 8; ++j) { const float kp = o1 ? r[8 + j] : r[j], sn = o1 ? r[j] : r[8 + j]; a[j] = kp + dppf<0xB1>(sn); }
#pragma unroll
    for (int j = 0; j < 4; ++j) { const float kp = o2 ? a[4 + j] : a[j], sn = o2 ? a[j] : a[4 + j]; b[j] = kp + dppf<0x4E>(sn); }
#pragma unroll
    for (int j = 0; j < 4; ++j) { b[j] += dppf<0x124>(b[j]); b[j] += dppf<0x128>(b[j]); b[j] += __shfl_xor(b[j], 16, 64); b[j] += __shfl_xor(b[j], 32, 64); }
#pragma unroll
    for (int j = 0; j < 4; ++j) { r[j] = dppf<0x00>(b[j]); r[8 + j] = dppf<0x55>(b[j]); r[4 + j] = dppf<0xAA>(b[j]); r[12 + j] = dppf<0xFF>(b[j]); }
}
__device__ __forceinline__ float wave_sum_dpp(float v) {
    v += dppf<0xB1>(v); v += dppf<0x4E>(v); v += dppf<0x141>(v); v += dppf<0x140>(v);
    const float r0 = __int_as_float(__builtin_amdgcn_readlane(__float_as_int(v), 0)), r1 = __int_as_float(__builtin_amdgcn_readlane(__float_as_int(v), 16));
    const float r2 = __int_as_float(__builtin_amdgcn_readlane(__float_as_int(v), 32)), r3 = __int_as_float(__builtin_amdgcn_readlane(__float_as_int(v), 48));
    return (r0 + r1) + (r2 + r3);
}
struct CpPrefetch { uint4 cu[3], pv[3], rw[4]; };
__device__ __forceinline__ void cp_prefetch(CpPrefetch& P, const bf16* __restrict__ proj, int item, int tid) {
    const int h = item & 7, chunk = item >> 3, t0 = chunk * 64, sq0 = t0 & ~(SEQ - 1);
#pragma unroll
    for (int k = 0; k < 3; ++k) { const int idx = tid + 512 * k; P.cu[k] = make_uint4(0, 0, 0, 0); P.pv[k] = make_uint4(0, 0, 0, 0);
        if (idx < 1280) { const int tt = idx / 20, cg = idx % 20, t = t0 + tt;
            P.cu[k] = *(const uint4*)(proj + (size_t)t * DINP + C_LW + cg * 8);
            if (t > sq0) P.pv[k] = *(const uint4*)(proj + (size_t)(t - 1) * DINP + C_LW + cg * 8); } }
#pragma unroll
    for (int k = 0; k < 4; ++k) { const int idx = tid + 512 * k; P.rw[k] = make_uint4(0, 0, 0, 0);
        if (idx < 1560) { const int row = idx / 24, rem = idx % 24, t = t0 - 1 + row;
            if (t >= sq0) P.rw[k] = *(const uint4*)(proj + (size_t)t * DINP + C_R + (rem >> 3) * 512 + h * 64 + (rem & 7) * 8); } }
}
template <bool TOP> __device__ __forceinline__ void g1_panel(const bf16* BK, const bf16* AR, bf16* P0r, bf16* P0t, bf16* T1, bf16* MBT, bf16* LK, bf16* MKT, int mt, int fr, int fq, int nt_lo, int nt_hi) {
    const int q4 = mt & 3, m0 = q4 * 16;
    const Frag2 fa = ld_frag(BK, mt * 16, fr, fq);
    const int dN = 4 * fq - fr;
    const f32x4 zero4 = {0.f, 0.f, 0.f, 0.f};
#pragma unroll
    for (int nt = 0; nt < 8; ++nt) {
        if (nt < nt_lo || nt >= nt_hi) continue;
        const int n4 = nt & 3, n0 = n4 * 16;
        const bool left = (nt < 4);
        if (q4 > n4) {
            if (TOP && left) { st_tr(P0t, m0, n0, fr, fq, zero4); st_rm4(P0r, m0, n0, fr, fq, zero4); st_rm4(T1, m0, n0, fr, fq, zero4); }
            else if (TOP) st_tr(MBT, m0, n0, fr, fq, zero4);
            else if (left) st_rm4(LK, m0, n0, fr, fq, zero4);
            else st_tr(MKT, m0, n0, fr, fq, zero4);
        } else if (q4 < n4) {
            const Frag2 fb = ld_frag(AR, nt * 16, fr, fq);
            if (TOP && left) { f32x4 aN = mmf(fa, fb, zero4), aS = mmf(fb, fa, zero4); st_tr(P0t, m0, n0, fr, fq, aN); st_rm4(P0r, m0, n0, fr, fq, aS); st_rm4(T1, m0, n0, fr, fq, aS); }
            else if (TOP) { f32x4 aN = mmf(fa, fb, zero4); st_tr(MBT, m0, n0, fr, fq, aN); }
            else if (left) { f32x4 aS = mmf(fb, fa, zero4); st_rm4(LK, m0, n0, fr, fq, aS); }
            else { f32x4 aN = mmf(fa, fb, zero4); st_tr(MKT, m0, n0, fr, fq, aN); }
        } else {
            const Frag2 fb = ld_frag(AR, nt * 16, fr, fq);
            if (TOP && left) { f32x4 aN = mmf(fa, fb, zero4), aS = mmf(fb, fa, zero4), t1;
#pragma unroll
                for (int r = 0; r < 4; ++r) { const int d = dN + r; if (!(d < 0)) aN[r] = 0.f; if (!(d > 0)) aS[r] = 0.f; t1[r] = aS[r] + ((d == 0) ? 1.f : 0.f); }
                st_tr(P0t, m0, n0, fr, fq, aN); st_rm4(P0r, m0, n0, fr, fq, aS); st_rm4(T1, m0, n0, fr, fq, t1); }
            else if (TOP) { f32x4 aN = mmf(fa, fb, zero4);
#pragma unroll
                for (int r = 0; r < 4; ++r) if (!(dN + r <= 0)) aN[r] = 0.f;
                st_tr(MBT, m0, n0, fr, fq, aN); }
            else if (left) { f32x4 aS = mmf(fb, fa, zero4);
#pragma unroll
                for (int r = 0; r < 4; ++r) if (!(dN + r > 0)) aS[r] = 0.f;
                st_rm4(LK, m0, n0, fr, fq, aS); }
            else { f32x4 aN = mmf(fa, fb, zero4);
#pragma unroll
                for (int r = 0; r < 4; ++r) if (!(dN + r <= 0)) aN[r] = 0.f;
                st_tr(MKT, m0, n0, fr, fq, aN); }
        }
    }
}
__device__ __forceinline__ void ph_chunkprep(unsigned char* shm, int bid, int nblk, const ChunkParams& p) {
    const int tid = threadIdx.x, lane = tid & 63, wv = tid >> 6, fr = lane & 15, fq = lane >> 4;
    bf16* LWb = (bf16*)shm;
    bf16* LAb = LWb + 64 * 40; bf16* LGb = LAb + 64 * 40;
    float* WLf = (float*)(shm + 24576);
    bf16* RAW = (bf16*)(shm + 8 * SLOT);
    float* segs = (float*)(shm + CP_SMALL);
    float* gC = segs + 512;
#define SL(i) ((bf16*)(shm + (i) * SLOT))
    bf16 *BK = SL(0), *AR = SL(2), *AbT = SL(4), *BhT = SL(5), *KH = SL(6), *Vt = SL(7), *LK = SL(8), *MBT = SL(9), *MKT = SL(10);
    if (bid >= 2048) return;
    int hcur = -1;
    pg8::bf16x8 bw, ba, bg[3];
    float w0n = 0.f, a0n = 0.f, kkc = 0.f, kac = 0.f, rkc = 0.f, mur = 0.f, muk = 0.f, muv = 0.f;
    CpPrefetch P;
    { int it0 = bid; asm volatile("" : "+s"(it0)); cp_prefetch(P, p.proj, it0, tid); }
    for (int item = bid; item < 2048; item += nblk) {
        int itm = item; asm volatile("" : "+s"(itm));
        const int h = itm & 7, chunk = itm >> 3, t0 = chunk * 64;
        if (h != hcur) {
            const int nt = wv & 3, hc = h * 64 + lane;
            hcur = h;
            const int cn = h * 64 + nt * 16 + fr;
            float t8[8];
#pragma unroll
            for (int j = 0; j < 8; ++j) t8[j] = p.w2[(8 * fq + j) * 512 + cn];
            { const uint4 q = pack8(t8); bw = __builtin_bit_cast(pg8::bf16x8, q); }
#pragma unroll
            for (int j = 0; j < 8; ++j) t8[j] = p.a2[(8 * fq + j) * 512 + cn];
            { const uint4 q = pack8(t8); ba = __builtin_bit_cast(pg8::bf16x8, q); }
#pragma unroll
            for (int ks = 0; ks < 3; ++ks) {
#pragma unroll
                for (int j = 0; j < 8; ++j) t8[j] = p.g2[(32 * ks + 8 * fq + j) * 512 + cn];
                const uint4 q = pack8(t8); bg[ks] = __builtin_bit_cast(pg8::bf16x8, q); }
            w0n = p.w0[cn]; a0n = p.a0[cn];
            kkc = p.k_k[hc]; kac = p.k_a[hc]; rkc = p.r_k[hc]; mur = p.mu[hc]; muk = p.mu[512 + hc]; muv = p.mu[1024 + hc];
        }
        __syncthreads();
        {
        const int tid = opq((int)threadIdx.x), lane = tid & 63, wv = tid >> 6, fr = lane & 15, fq = lane >> 4; (void)fr; (void)fq; (void)wv; (void)lane;
#pragma unroll
        for (int k = 0; k < 3; ++k) { const int idx = tid + 512 * k;
            if (idx < 1280) { const int tt = idx / 20, cg = idx % 20;
                float c8[8], p8[8], u[8]; unpack8(P.cu[k], c8); unpack8(P.pv[k], p8);
                const float4 m0 = *(const float4*)(p.mu + 1536 + cg * 8), m1 = *(const float4*)(p.mu + 1536 + cg * 8 + 4);
                const float mm[8] = {m0.x, m0.y, m0.z, m0.w, m1.x, m1.y, m1.z, m1.w};
#pragma unroll
                for (int i = 0; i < 8; ++i) u[i] = c8[i] + (p8[i] - c8[i]) * mm[i];
                const bool isw = cg < 4, isa = (cg >= 4) && (cg < 8);
                const float es = isw ? 2.f : -1.f, ca = isw ? 1.f : 0.f, cb = isw ? -2.f : 1.f;
#pragma unroll
                for (int i = 0; i < 8; ++i) { const float r = __builtin_amdgcn_rcpf(1.f + __expf(es * u[i])); const float act = fmaf(cb, r, ca); u[i] = isa ? u[i] : act; }
                bf16* dst = isw ? (LWb + tt * 40 + cg * 8) : (isa ? (LAb + tt * 40 + (cg - 4) * 8) : (LGb + tt * 104 + (cg - 8) * 8));
                *(uint4*)dst = pack8(u); } }
#pragma unroll
        for (int k = 0; k < 4; ++k) { const int idx = tid + 512 * k; if (idx < 1560) *(uint4*)(RAW + (idx / 24) * 192 + (idx % 24) * 8) = P.rw[k]; }
        }
        __syncthreads();
        {
        const int tid = opq((int)threadIdx.x), lane = tid & 63, wv = tid >> 6, fr = lane & 15, fq = lane >> 4; (void)fr; (void)fq; (void)wv; (void)lane;
        const int nt = wv & 3;
#pragma unroll
        for (int q = 0; q < 2; ++q) {
            const int mt = (wv >> 2) * 2 + q;
            f32x4 cw = {w0n, w0n, w0n, w0n}, ca = {a0n, a0n, a0n, a0n}, cg = {0.f, 0.f, 0.f, 0.f};
            cw = __builtin_amdgcn_mfma_f32_16x16x32_bf16(*(const pg8::bf16x8*)(LWb + (mt * 16 + fr) * 40 + fq * 8), bw, cw, 0, 0, 0);
            ca = __builtin_amdgcn_mfma_f32_16x16x32_bf16(*(const pg8::bf16x8*)(LAb + (mt * 16 + fr) * 40 + fq * 8), ba, ca, 0, 0, 0);
#pragma unroll
            for (int ks = 0; ks < 3; ++ks) cg = __builtin_amdgcn_mfma_f32_16x16x32_bf16(*(const pg8::bf16x8*)(LGb + (mt * 16 + fr) * 104 + ks * 32 + fq * 8), bg[ks], cg, 0, 0, 0);
#pragma unroll
            for (int r = 0; r < 4; ++r) { const int o = (mt * 16 + 4 * fq + r) * 64 + nt * 16 + fr; WLf[o] = cw[r]; WLf[4096 + o] = ca[r]; WLf[8192 + o] = cg[r]; }
        }
        }
        __syncthreads();
        float rr[8], km[8], vv[8], kn[8], be[8], ld[8];
        const int tid1 = opq((int)threadIdx.x), c = tid1 & 63, tg = tid1 >> 6, hc = h * 64 + c;
        {
            const int tb = t0 + tg * 8;
            float red[16], aa[8], kkr[8], gl[8];
#pragma unroll
            for (int i = 0; i < 8; ++i) {
                const float wl = WLf[(tg * 8 + i) * 64 + c], al = WLf[4096 + (tg * 8 + i) * 64 + c]; gl[i] = WLf[8192 + (tg * 8 + i) * 64 + c];
                const bf16* q1 = RAW + (tg * 8 + i + 1) * 192 + c; const bf16* q0 = q1 - 192;
                const float cr1 = bf2f(q1[0]), cr0 = bf2f(q0[0]), ck1 = bf2f(q1[64]), ck0 = bf2f(q0[64]), cv1 = bf2f(q1[128]), cv0 = bf2f(q0[128]);
                rr[i] = cr1 + (cr0 - cr1) * mur; const float kraw = ck1 + (ck0 - ck1) * muk; vv[i] = cv1 + (cv0 - cv1) * muv;
                const float xw = -wl;
                const float sp = fmaxf(xw, 0.f) + __logf(1.f + __expf(-fabsf(xw)));
                ld[i] = -__expf(-sp - 0.5f);
                aa[i] = sigmoidf_(al);
                kkr[i] = kraw * kkc; km[i] = kraw * (1.f + (aa[i] - 1.f) * kac);
                red[i] = kkr[i] * kkr[i]; red[8 + i] = rr[i] * km[i] * rkc;
            }
            { int nxt = item + nblk; asm volatile("" : "+s"(nxt)); if (nxt < 2048) cp_prefetch(P, p.proj, nxt, tid); }
            wave_sum16(red);
#pragma unroll
            for (int i = 0; i < 8; ++i) {
                kn[i] = kkr[i] * __builtin_amdgcn_rsqf(fmaxf(red[i], 1e-24f)); be[i] = kn[i] * aa[i];
                const size_t o = (size_t)(tb + i) * 512 + hc;
                p.V[o] = f2bf(vv[i]); p.G[o] = f2bf(gl[i]);
                if (c == 0) p.BONUS[(size_t)(tb + i) * 8 + h] = red[8 + i];
            }
        }
        float cl[8];
        { float s = 0.f;
#pragma unroll
          for (int i = 0; i < 8; ++i) { s += ld[i]; cl[i] = s; }
          segs[tg * 64 + c] = s; }
        __syncthreads();
        float off = 0.f, clC = 0.f;
#pragma unroll
        for (int g = 0; g < 8; ++g) { const float sg = segs[g * 64 + c]; clC += sg; if (g < tg) off += sg; }
        if (tg == 0) gC[c] = __expf(clC);
        {
            float ab8[8], bh8[8], v8[8], kh8[8];
#pragma unroll
            for (int i = 0; i < 8; ++i) {
                const float x = off + cl[i]; const int tt = tg * 8 + i;
                const float em = __expf(-x), ep = __expf(x), epm = __expf(x - ld[i]), eh = __expf(clC - x);
                const float ab = -kn[i] * epm;
                ab8[i] = ab; bh8[i] = be[i] * eh; v8[i] = vv[i];
                BK[tt * CS + c] = f2bf(be[i] * em); BK[(64 + tt) * CS + c] = f2bf(km[i] * em);
                AR[tt * CS + c] = f2bf(ab); AR[(64 + tt) * CS + c] = f2bf(rr[i] * ep);
                kh8[i] = km[i] * eh;
            }
            *(uint4*)(AbT + c * CS + tg * 8) = pack8(ab8); *(uint4*)(BhT + c * CS + tg * 8) = pack8(bh8); *(uint4*)(Vt + c * CS + tg * 8) = pack8(v8); *(uint4*)(KH + c * CS + tg * 8) = pack8(kh8);
        }
        __syncthreads();
        {
            const int tid = opq((int)threadIdx.x), lane = tid & 63, wv = tid >> 6, fr = lane & 15, fq = lane >> 4; (void)fr; (void)fq; (void)wv; (void)lane;
            const int mt = __builtin_amdgcn_readfirstlane(wv), q4 = mt & 3;
            const int hi0 = (q4 == 0) ? 5 : (q4 == 1) ? 7 : 8;
            const int mt2 = (q4 == 3) ? mt - 3 : mt - 1, lo2 = (q4 == 3) ? 5 : 7;
            if (mt < 4) { g1_panel<true>(BK, AR, SL(11), SL(12), SL(13), MBT, LK, MKT, mt, fr, fq, 0, hi0); if (q4 >= 2) g1_panel<true>(BK, AR, SL(11), SL(12), SL(13), MBT, LK, MKT, mt2, fr, fq, lo2, 8); }
            else { g1_panel<false>(BK, AR, SL(11), SL(12), SL(13), MBT, LK, MKT, mt, fr, fq, 0, hi0); if (q4 >= 2) g1_panel<false>(BK, AR, SL(11), SL(12), SL(13), MBT, LK, MKT, mt2, fr, fq, lo2, 8); }
        }
        __syncthreads();
#pragma unroll
        for (int s = 0; s < 6; ++s) {
            const int tid = opq((int)threadIdx.x), lane = tid & 63, wv = tid >> 6, fr = lane & 15, fq = lane >> 4; (void)fr; (void)fq; (void)wv; (void)lane;
            const bf16* Pr = (s & 1) ? SL(0) : SL(11); const bf16* Pt = (s & 1) ? SL(1) : SL(12);
            bf16* Pnr = (s & 1) ? SL(11) : SL(0); bf16* Pnt = (s & 1) ? SL(12) : SL(1);
            const bf16* Tc = (s & 1) ? SL(13) : SL(14); bf16* Tn = (s & 1) ? SL(14) : SL(13);
            const int m0 = (wv >> 1) * 16, nb = (wv & 1) * 32;
            Frag2 fp, ft;
            if (s < 5) fp = ld_frag(Pr, m0, fr, fq);
            if (s > 0) ft = ld_frag(Tc, m0, fr, fq);
#pragma unroll
            for (int q = 0; q < 2; ++q) {
                const int n0 = nb + q * 16;
                const Frag2 fb = ld_frag(Pt, n0, fr, fq);
                if (s < 5) { f32x4 aN = {0.f, 0.f, 0.f, 0.f}, aS = {0.f, 0.f, 0.f, 0.f}; aN = mmf(fp, fb, aN); aS = mmf(fb, fp, aS); st_rm4(Pnr, m0, n0, fr, fq, aS); st_tr(Pnt, m0, n0, fr, fq, aN); }
                if (s > 0 && s < 5) { f32x4 acc = ld_rm4(Tc, m0, n0, fr, fq); acc = mmf(fb, ft, acc); st_rm4(Tn, m0, n0, fr, fq, acc); }
                if (s == 5) { f32x4 acc = ld_rm(Tc, m0, n0, fr, fq); acc = mmf(ft, fb, acc); st_tr(SL(2), m0, n0, fr, fq, acc); }
            }
            __syncthreads();
        }
        {
            const int tid = opq((int)threadIdx.x), lane = tid & 63, wv = tid >> 6, fr = lane & 15, fq = lane >> 4; (void)fr; (void)fq; (void)wv; (void)lane;
            const bf16* TT = SL(2); bf16 *X = SL(11), *W = SL(12);
            const int m0 = (wv >> 1) * 16, nb = (wv & 1) * 32;
            const Frag2 fl = ld_frag(LK, m0, fr, fq), fa = ld_frag(AbT, m0, fr, fq);
#pragma unroll
            for (int q = 0; q < 2; ++q) {
                const int n0 = nb + q * 16;
                const Frag2 fb = ld_frag(TT, n0, fr, fq);
                f32x4 a0 = {0.f, 0.f, 0.f, 0.f}, a1 = {0.f, 0.f, 0.f, 0.f};
                a0 = mmf(fb, fl, a0); a1 = mmf(fb, fa, a1);
                st_rm4(X, m0, n0, fr, fq, a0); st_rm4(W, m0, n0, fr, fq, a1);
            }
        }
        __syncthreads();
        {
            const int tid = opq((int)threadIdx.x), lane = tid & 63, wv = tid >> 6, fr = lane & 15, fq = lane >> 4; (void)fr; (void)fq; (void)wv; (void)lane;
            const bf16 *X = SL(11), *W = SL(12), *RB = SL(3); bf16 *ZT = SL(13), *Q2T = SL(14);
            bf16* PHI = p.PHI + (size_t)item * 4096; bf16* OMG = p.OMG + (size_t)item * 4096;
            const int mt = wv >> 1, m0 = mt * 16, nb = (wv & 1) * 32;
            const Frag2 fx = ld_frag(X, m0, fr, fq), fw = ld_frag(W, m0, fr, fq);
#pragma unroll
            for (int q = 0; q < 2; ++q) {
                const int n0 = nb + q * 16;
                const Frag2 fbh = ld_frag(BhT, n0, fr, fq), fmb = ld_frag(MBT, n0, fr, fq);
                f32x4 z = ld_tr(KH, m0, n0, fr, fq); z = mmf(fx, fbh, z); st_tr(ZT, m0, n0, fr, fq, z);
                f32x4 q2 = ld_tr(MKT, m0, n0, fr, fq); q2 = mmf(fx, fmb, q2); st_tr(Q2T, m0, n0, fr, fq, q2);
                f32x4 ph = {0.f, 0.f, 0.f, 0.f}; ph = mmf(fw, fbh, ph);
#pragma unroll
                for (int r = 0; r < 4; ++r) if (m0 + 4 * fq + r == n0 + fr) ph[r] += gC[n0 + fr];
                const int slot = (mt >> 1) * 32 + fq * 8 + (mt & 1) * 4;
                { uint2 o; o.x = pack2(ph[0], ph[1]); o.y = pack2(ph[2], ph[3]); *(uint2*)(PHI + (n0 + fr) * 64 + slot) = o; }
                f32x4 om = ld_tr(RB, m0, n0, fr, fq); om = mmf(fw, fmb, om);
                { uint2 o; o.x = pack2(om[0], om[1]); o.y = pack2(om[2], om[3]); *(uint2*)(OMG + (n0 + fr) * 64 + slot) = o; }
            }
        }
        __syncthreads();
        {
            const int tid = opq((int)threadIdx.x), lane = tid & 63, wv = tid >> 6, fr = lane & 15, fq = lane >> 4; (void)fr; (void)fq; (void)wv; (void)lane;
            const bf16 *ZT = SL(13), *Q2T = SL(14);
            bf16* PSI = p.PSI + (size_t)item * 4096; bf16* Y0 = p.Y0 + (size_t)item * 4096;
            const int m0 = (wv >> 1) * 16, nb = (wv & 1) * 32;
            const Frag2 fz = ld_frag(ZT, m0, fr, fq), fq2 = ld_frag(Q2T, m0, fr, fq);
#pragma unroll
            for (int q = 0; q < 2; ++q) {
                const int n0 = nb + q * 16;
                const Frag2 fv = ld_frag(Vt, n0, fr, fq);
                f32x4 a0 = {0.f, 0.f, 0.f, 0.f}, a1 = {0.f, 0.f, 0.f, 0.f};
                a0 = mmf(fz, fv, a0); a1 = mmf(fq2, fv, a1);
                { uint2 o; o.x = pack2(a0[0], a0[1]); o.y = pack2(a0[2], a0[3]); *(uint2*)(PSI + (n0 + fr) * 64 + m0 + 4 * fq) = o; }
                { uint2 o; o.x = pack2(a1[0], a1[1]); o.y = pack2(a1[2], a1[3]); *(uint2*)(Y0 + (n0 + fr) * 64 + m0 + 4 * fq) = o; }
            }
        }
    }
#undef SL
}

constexpr int CH_SLOT = 32768, CH_RING = 4, CH_YB = CH_RING * CH_SLOT, CH_YBSZ = 64 * 72 * 2;
__device__ __forceinline__ void chain_dma(unsigned char* shm, int slot, const bf16* __restrict__ PHI, const bf16* __restrict__ PSI, const bf16* __restrict__ OMG, const bf16* __restrict__ Y0, size_t item, int w, int lane) {
    const bf16* src[4] = {PHI + item, OMG + item, PSI + item, Y0 + item};
#pragma unroll
    for (int m = 0; m < 4; ++m)
#pragma unroll
        for (int i = 0; i < 2; ++i) {
            const int row = (w * 2 + i) * 8 + (lane >> 3), jj = (lane & 7) ^ (row & 7);
            __builtin_amdgcn_global_load_lds((const unsigned*)((const char*)src[m] + row * 128 + jj * 16),
                                             (PG8_LAS unsigned*)(shm + slot * CH_SLOT + m * 8192 + (w * 2 + i) * 1024), 16, 0, 0);
        }
}
__device__ __forceinline__ void ph_chain(unsigned char* shm, int bh, const bf16* __restrict__ PHI, const bf16* __restrict__ PSI, const bf16* __restrict__ OMG, const bf16* __restrict__ Y0,
                                         const bf16* __restrict__ V, const bf16* __restrict__ G, const float* __restrict__ BONUS, const float* __restrict__ gng, const float* __restrict__ gnb, bf16* __restrict__ O) {
    const int b = bh >> 3, h = bh & 7, tid = threadIdx.x, lane = tid & 63, w = __builtin_amdgcn_readfirstlane((tid >> 6) & 3), fr = lane & 15, fq = lane >> 4;
    const size_t ib = ((size_t)(b * 64) * 8 + h) * 4096, istep = (size_t)8 * 4096;
#define CH_BAR() do { asm volatile("s_waitcnt lgkmcnt(0)" ::: "memory"); __builtin_amdgcn_s_barrier(); asm volatile("" ::: "memory"); } while (0)
    if (tid < 256) {
        pg8::bf16x8 sf[2];
#pragma unroll
        for (int j = 0; j < 8; ++j) { sf[0][j] = 0; sf[1][j] = 0; }
        chain_dma(shm, 0, PHI, PSI, OMG, Y0, ib, w, lane);
        chain_dma(shm, 1, PHI, PSI, OMG, Y0, ib + istep, w, lane);
        chain_dma(shm, 2, PHI, PSI, OMG, Y0, ib + 2 * istep, w, lane);
#pragma unroll 1
        for (int ch = 0; ch < 64; ++ch) {
            asm volatile("s_waitcnt vmcnt(16)" ::: "memory");
            CH_BAR();
            chain_dma(shm, (ch + 3) & 3, PHI, PSI, OMG, Y0, ib + (size_t)((ch + 3 < 64) ? ch + 3 : 63) * istep, w, lane);
            const unsigned char* sl = shm + (ch & 3) * CH_SLOT;
            f32x4 ya[4], sa[4]; pg8::bf16x8 ap[4][2], ao[4][2];
#pragma unroll
            for (int mt = 0; mt < 4; ++mt) {
                const int row = w * 16 + fr, sw = (((mt * 2 + (fq >> 1)) ^ (row & 7)) * 16) + (fq & 1) * 8;
                const uint2 ps = *(const uint2*)(sl + 16384 + row * 128 + sw), y0 = *(const uint2*)(sl + 24576 + row * 128 + sw);
                ya[mt][0] = bflo(y0.x); ya[mt][1] = bfhi(y0.x); ya[mt][2] = bflo(y0.y); ya[mt][3] = bfhi(y0.y);
                sa[mt][0] = bflo(ps.x); sa[mt][1] = bfhi(ps.x); sa[mt][2] = bflo(ps.y); sa[mt][3] = bfhi(ps.y);
#pragma unroll
                for (int ks = 0; ks < 2; ++ks) { const int ar = mt * 16 + fr, off = ar * 128 + (((ks * 4 + fq) ^ (ar & 7)) * 16);
                    ap[mt][ks] = *(const pg8::bf16x8*)(sl + off); ao[mt][ks] = *(const pg8::bf16x8*)(sl + 8192 + off); }
            }
#pragma unroll
            for (int ks = 0; ks < 2; ++ks)
#pragma unroll
                for (int mt = 0; mt < 4; ++mt) sa[mt] = __builtin_amdgcn_mfma_f32_16x16x32_bf16(ap[mt][ks], sf[ks], sa[mt], 0, 0, 0);
#pragma unroll
            for (int ks = 0; ks < 2; ++ks)
#pragma unroll
                for (int mt = 0; mt < 4; ++mt) ya[mt] = __builtin_amdgcn_mfma_f32_16x16x32_bf16(ao[mt][ks], sf[ks], ya[mt], 0, 0, 0);
#pragma unroll
            for (int ks = 0; ks < 2; ++ks) {
                const unsigned w0 = pack2(sa[2 * ks][0], sa[2 * ks][1]), w1 = pack2(sa[2 * ks][2], sa[2 * ks][3]), w2 = pack2(sa[2 * ks + 1][0], sa[2 * ks + 1][1]), w3 = pack2(sa[2 * ks + 1][2], sa[2 * ks + 1][3]);
                sf[ks][0] = (short)(w0 & 0xFFFF); sf[ks][1] = (short)(w0 >> 16); sf[ks][2] = (short)(w1 & 0xFFFF); sf[ks][3] = (short)(w1 >> 16);
                sf[ks][4] = (short)(w2 & 0xFFFF); sf[ks][5] = (short)(w2 >> 16); sf[ks][6] = (short)(w3 & 0xFFFF); sf[ks][7] = (short)(w3 >> 16);
            }
            bf16* yb = (bf16*)(shm + CH_YB + (ch & 1) * CH_YBSZ);
#pragma unroll
            for (int mt = 0; mt < 4; ++mt)
#pragma unroll
                for (int r = 0; r < 4; ++r) yb[(mt * 16 + 4 * fq + r) * 72 + w * 16 + fr] = f2bf(ya[mt][r]);
        }
        asm volatile("s_waitcnt vmcnt(0)" ::: "memory");
        CH_BAR();
    } else {
        const int et = (tid & 255) >> 2, eq = tid & 3;
        float gw[16], gb[16];
#pragma unroll
        for (int i = 0; i < 16; ++i) { gw[i] = gng[h * 64 + eq * 16 + i]; gb[i] = gnb[h * 64 + eq * 16 + i]; }
        uint4 nv0, nv1, ng0, ng1; float nbon;
        { const int t = b * SEQ + et; const size_t o = (size_t)t * 512 + h * 64 + eq * 16;
          nv0 = *(const uint4*)(V + o); nv1 = *(const uint4*)(V + o + 8); ng0 = *(const uint4*)(G + o); ng1 = *(const uint4*)(G + o + 8); nbon = BONUS[(size_t)t * 8 + h]; }
        CH_BAR();
#pragma unroll 1
        for (int ch = 0; ch < 64; ++ch) {
            const int t = b * SEQ + ch * 64 + et;
            const size_t o = (size_t)t * 512 + h * 64 + eq * 16;
            const uint4 cv0 = nv0, cv1 = nv1, cg0 = ng0, cg1 = ng1; const float cbon = nbon;
            CH_BAR();
            if (ch + 1 < 64) { const size_t o2 = o + (size_t)64 * 512;
                nv0 = *(const uint4*)(V + o2); nv1 = *(const uint4*)(V + o2 + 8); ng0 = *(const uint4*)(G + o2); ng1 = *(const uint4*)(G + o2 + 8); nbon = BONUS[(size_t)(t + 64) * 8 + h]; }
            const bf16* yb = (const bf16*)(shm + CH_YB + (ch & 1) * CH_YBSZ);
            float y[16], s = 0.f;
            { float a8[8], b8[8]; unpack8(*(const uint4*)(yb + et * 72 + eq * 16), a8); unpack8(*(const uint4*)(yb + et * 72 + eq * 16 + 8), b8);
#pragma unroll
              for (int i = 0; i < 8; ++i) { y[i] = a8[i]; y[8 + i] = b8[i]; } }
#pragma unroll
            for (int i = 0; i < 16; ++i) s += y[i];
            s += __shfl_xor(s, 1, 64); s += __shfl_xor(s, 2, 64);
            const float mean = s * (1.f / 64.f);
            float q = 0.f;
#pragma unroll
            for (int i = 0; i < 16; ++i) { y[i] -= mean; q += y[i] * y[i]; }
            q += __shfl_xor(q, 1, 64); q += __shfl_xor(q, 2, 64);
            const float rstd = rsqrtf(q * (1.f / 64.f) + 64e-5f);
            float v0[8], v1[8], g0[8], g1[8], o0[8], o1[8];
            unpack8(cv0, v0); unpack8(cv1, v1); unpack8(cg0, g0); unpack8(cg1, g1);
#pragma unroll
            for (int i = 0; i < 8; ++i) { o0[i] = (y[i] * rstd * gw[i] + gb[i] + cbon * v0[i]) * g0[i]; o1[i] = (y[8 + i] * rstd * gw[8 + i] + gb[8 + i] + cbon * v1[i]) * g1[i]; }
            *(uint4*)(O + o) = pack8(o0); *(uint4*)(O + o + 8) = pack8(o1);
        }
    }
#undef CH_BAR
    __syncthreads();
}

#define CE_DESC(a, b) { const float _mx = fmaxf(a, b), _mn = fminf(a, b); a = _mx; b = _mn; }
__device__ __forceinline__ void sort16_desc(float (&a)[16]) {
#pragma unroll
    for (int k = 2; k <= 16; k <<= 1)
#pragma unroll
        for (int j = k >> 1; j > 0; j >>= 1)
#pragma unroll
            for (int i = 0; i < 16; ++i) { const int l = i ^ j; if (l > i) { if ((i & k) == 0) { CE_DESC(a[i], a[l]); } else { CE_DESC(a[l], a[i]); } } }
}
__device__ __forceinline__ void merge16_desc(float (&run)[16], const float (&grp)[16]) {
#pragma unroll
    for (int i = 0; i < 16; ++i) run[i] = fmaxf(run[i], grp[15 - i]);
#pragma unroll
    for (int j = 8; j > 0; j >>= 1)
#pragma unroll
        for (int i = 0; i < 16; ++i) { const int l = i ^ j; if (l > i) { CE_DESC(run[i], run[l]); } }
}
struct CandTab { int i[64], j[64]; };
constexpr CandTab make_cand_tab() { CandTab t{}; int n = 0; for (int i = 0; i < 16; ++i) for (int j = 0; j < 16; ++j) if ((i + 1) * (j + 1) <= 16) { t.i[n] = i; t.j[n] = j; ++n; }
    for (; n < 64; ++n) { t.i[n] = 0; t.j[n] = 0; } return t; }
constexpr CandTab CT = make_cand_tab();
constexpr int TOPK_LDS = 8 * (16 * 256 * 4 + 16 * 2 * 16 * 4);
__device__ __forceinline__ void ph_topk(unsigned char* shm, int bid, int nblk, const bf16* __restrict__ Q, const bf16* __restrict__ keys, int* __restrict__ EID, float* __restrict__ GATE) {
    const int tid = threadIdx.x, lane = tid & 63, h = tid >> 6, fr = lane & 15, fq = lane >> 4;
    float* sc = (float*)shm + h * (16 * 256 + 512);
    float* top = sc + 16 * 256;
    for (int item = bid; item < T / 16; item += nblk) {
        const int t0 = item * 16;
        int koff = 0; asm volatile("" : "+v"(koff));
#pragma unroll
        for (int p = 0; p < 2; ++p) {
            pg8::bf16x8 a[4];
#pragma unroll
            for (int ks = 0; ks < 4; ++ks) a[ks] = *(const pg8::bf16x8*)(Q + (size_t)(t0 + fr) * 2048 + h * 256 + p * 128 + ks * 32 + fq * 8);
#pragma unroll
            for (int nt = 0; nt < 8; ++nt) {
                f32x4 acc = {0.f, 0.f, 0.f, 0.f};
#pragma unroll
                for (int ks = 0; ks < 4; ++ks) { const pg8::bf16x8 bfr = *(const pg8::bf16x8*)(keys + koff + ((size_t)(h * 2 + p) * 128 + nt * 16 + fr) * 128 + ks * 32 + fq * 8);
                    acc = __builtin_amdgcn_mfma_f32_16x16x32_bf16(a[ks], bfr, acc, 0, 0, 0); }
#pragma unroll
                for (int r = 0; r < 4; ++r) sc[(4 * fq + r) * 256 + p * 128 + nt * 16 + fr] = acc[r];
            }
        }
        __builtin_amdgcn_s_waitcnt(0);
        __builtin_amdgcn_wave_barrier();
        if (lane < 32) {
            const int tok = lane & 15, half = lane >> 4;
            const float* s = sc + tok * 256 + half * 128;
            float run[16], grp[16];
#pragma unroll
            for (int i = 0; i < 16; ++i) run[i] = __uint_as_float((__float_as_uint(s[i]) & ~0x7Fu) | (unsigned)i);
            sort16_desc(run);
            for (int g = 1; g < 8; ++g) {
#pragma unroll
                for (int i = 0; i < 16; ++i) grp[i] = __uint_as_float((__float_as_uint(s[g * 16 + i]) & ~0x7Fu) | (unsigned)(g * 16 + i));
                sort16_desc(grp);
                merge16_desc(run, grp);
            }
#pragma unroll
            for (int i = 0; i < 16; ++i) top[(tok * 2 + half) * 16 + i] = run[i];
        }
        __builtin_amdgcn_s_waitcnt(0);
        __builtin_amdgcn_wave_barrier();
        if (lane < 16) {
            const float* t1 = top + (lane * 2) * 16; const float* t2 = t1 + 16;
            float v1[16], v2[16];
#pragma unroll
            for (int i = 0; i < 16; ++i) { v1[i] = __uint_as_float(__float_as_uint(t1[i]) & ~0x7Fu); v2[i] = __uint_as_float(__float_as_uint(t2[i]) & ~0x7Fu); }
            float run[16], grp[16];
#pragma unroll
            for (int i = 0; i < 16; ++i) run[i] = __uint_as_float((__float_as_uint(v1[CT.i[i]] + v2[CT.j[i]]) & ~0xFFu) | (unsigned)(CT.i[i] * 16 + CT.j[i]));
            sort16_desc(run);
#pragma unroll
            for (int g = 1; g < 4; ++g) {
#pragma unroll
                for (int i = 0; i < 16; ++i) { const int n = g * 16 + i; grp[i] = (n < 50) ? __uint_as_float((__float_as_uint(v1[CT.i[n]] + v2[CT.j[n]]) & ~0xFFu) | (unsigned)(CT.i[n] * 16 + CT.j[n])) : -3.0e38f; }
                sort16_desc(grp); merge16_desc(run, grp);
            }
            float e[16], sum = 0.f; const float mx = __uint_as_float(__float_as_uint(run[0]) & ~0xFFu);
#pragma unroll
            for (int i = 0; i < 16; ++i) { e[i] = __expf(__uint_as_float(__float_as_uint(run[i]) & ~0xFFu) - mx); sum += e[i]; }
            const float inv = 1.f / sum;
            const size_t ob = (size_t)(t0 + lane) * 128 + h * 16;
#pragma unroll
            for (int i = 0; i < 16; ++i) { const unsigned ij = __float_as_uint(run[i]) & 0xFFu; const unsigned e1 = __float_as_uint(t1[ij >> 4]) & 0x7Fu, e2 = __float_as_uint(t2[ij & 15]) & 0x7Fu;
                EID[ob + i] = (int)(e1 * 128 + e2); GATE[ob + i] = e[i] * inv; }
        }
        __builtin_amdgcn_wave_barrier();
    }
}

__device__ __forceinline__ void ph_peer(unsigned char* shm, int bid, int nblk, const bf16* __restrict__ XN2, float* __restrict__ X1  , const bf16* __restrict__ UB, const bf16* __restrict__ VB,
                                              const int* __restrict__ EID, const float* __restrict__ GATE, const float* __restrict__ gf) {
    float (*cfs)[128] = (float (*)[128])shm;
    int (*eids)[128] = (int (*)[128])(shm + 8 * 128 * 4);
    const int wv = threadIdx.x >> 6, lane = threadIdx.x & 63;
    const int wave = (bid * 512 + threadIdx.x) >> 6, nw = (nblk * 512) >> 6;
    for (int t = wave; t < T; t += nw) {
        float hv[16];
        { float a[8], b[8]; unpack8(*(const uint4*)(XN2 + (size_t)t * D + lane * 16), a); unpack8(*(const uint4*)(XN2 + (size_t)t * D + lane * 16 + 8), b);
#pragma unroll
          for (int i = 0; i < 8; ++i) { hv[i] = a[i]; hv[8 + i] = b[i]; } }
        eids[wv][lane] = EID[(size_t)t * 128 + lane]; eids[wv][lane + 64] = EID[(size_t)t * 128 + 64 + lane];
        __builtin_amdgcn_s_waitcnt(0); __builtin_amdgcn_wave_barrier();
        for (int k0 = 0; k0 < 128; k0 += 4) {
            float dp[4];
#pragma unroll
            for (int q = 0; q < 4; ++q) { const int e = eids[wv][k0 + q];
                float a[8], b[8]; unpack8(*(const uint4*)(UB + (size_t)e * D + lane * 16), a); unpack8(*(const uint4*)(UB + (size_t)e * D + lane * 16 + 8), b);
                float s = 0.f;
#pragma unroll
                for (int i = 0; i < 8; ++i) s += a[i] * hv[i] + b[i] * hv[8 + i];
                dp[q] = s; }
#pragma unroll
            for (int q = 0; q < 4; ++q) { const float z = wave_sum(dp[q]); const float act = 0.5f * z * (1.f + erff(z * 0.70710678118f));
                if (lane == 0) cfs[wv][k0 + q] = act * GATE[(size_t)t * 128 + k0 + q]; }
        }
        __builtin_amdgcn_s_waitcnt(0); __builtin_amdgcn_wave_barrier();
        float acc[16];
#pragma unroll
        for (int i = 0; i < 16; ++i) acc[i] = 0.f;
        for (int k0 = 0; k0 < 128; k0 += 4) {
#pragma unroll
            for (int q = 0; q < 4; ++q) { const int e = eids[wv][k0 + q]; const float cf = cfs[wv][k0 + q];
                float a[8], b[8]; unpack8(*(const uint4*)(VB + (size_t)e * D + lane * 16), a); unpack8(*(const uint4*)(VB + (size_t)e * D + lane * 16 + 8), b);
#pragma unroll
                for (int i = 0; i < 8; ++i) { acc[i] += cf * a[i]; acc[8 + i] += cf * b[i]; } }
        }
        float* xr = X1 + (size_t)t * D + lane * 16; float ss = 0.f;
#pragma unroll
        for (int i = 0; i < 4; ++i) { const float4 v = ((const float4*)xr)[i]; acc[4 * i] += v.x; acc[4 * i + 1] += v.y; acc[4 * i + 2] += v.z; acc[4 * i + 3] += v.w; }
#pragma unroll
        for (int i = 0; i < 16; ++i) ss += acc[i] * acc[i];
        const float sc = rsqrtf(wave_sum(ss) * (1.f / D) + 1e-6f);
#pragma unroll
        for (int i = 0; i < 4; ++i) { const float4 g = ((const float4*)(gf + lane * 16))[i];
            ((float4*)xr)[i] = make_float4(acc[4 * i] * sc * g.x, acc[4 * i + 1] * sc * g.y, acc[4 * i + 2] * sc * g.z, acc[4 * i + 3] * sc * g.w); }
        __builtin_amdgcn_wave_barrier();
    }
}


typedef unsigned char u8;
constexpr float H8_SCALE = 16.f;
__device__ __forceinline__ unsigned pack4_fp8(float a, float b, float c, float d) {
    int w = 0; w = __builtin_amdgcn_cvt_pk_fp8_f32(a, b, w, false); w = __builtin_amdgcn_cvt_pk_fp8_f32(c, d, w, true); return (unsigned)w; }
__device__ __forceinline__ float wave_max(float v) {
#pragma unroll
    for (int o = 32; o > 0; o >>= 1) v = fmaxf(v, __shfl_xor(v, o, 64));
    return v;
}
__device__ __forceinline__ void ph_cvt_fp8(int bid, int nblk, const float* __restrict__ src, u8* __restrict__ dst, float* __restrict__ scale, int rows) {
    const int tid_ = opq((int)threadIdx.x), wave = (bid * 512 + tid_) >> 6, nw = (nblk * 512) >> 6, lane = tid_ & 63;
    for (int r = wave; r < rows; r += nw) {
        const float4* xr = (const float4*)(src + (size_t)r * 1024 + lane * 16);
        float4 v[4]; float mx = 0.f;
#pragma unroll
        for (int i = 0; i < 4; ++i) { v[i] = xr[i]; mx = fmaxf(mx, fmaxf(fmaxf(fabsf(v[i].x), fabsf(v[i].y)), fmaxf(fabsf(v[i].z), fabsf(v[i].w)))); }
        mx = wave_max(mx);
        const float sc = fmaxf(mx, 1e-30f) * (1.f / 440.f), inv = 1.f / sc;
        uint4 o; o.x = pack4_fp8(v[0].x * inv, v[0].y * inv, v[0].z * inv, v[0].w * inv); o.y = pack4_fp8(v[1].x * inv, v[1].y * inv, v[1].z * inv, v[1].w * inv);
        o.z = pack4_fp8(v[2].x * inv, v[2].y * inv, v[2].z * inv, v[2].w * inv); o.w = pack4_fp8(v[3].x * inv, v[3].y * inv, v[3].z * inv, v[3].w * inv);
        *(uint4*)(dst + (size_t)r * 1024 + lane * 16) = o;
        if (lane == 0) scale[r] = sc;
    }
}
__device__ __forceinline__ void ph_rmsnorm2(int bid, int nblk, const float* __restrict__ x, const float* __restrict__ g, bf16* __restrict__ out, u8* __restrict__ h8, int rows) {
    const int tid_ = opq((int)threadIdx.x), wave = (bid * 512 + tid_) >> 6, nw = (nblk * 512) >> 6, lane = tid_ & 63;
    for (int r = wave; r < rows; r += nw) {
        const float4* xr = (const float4*)(x + (size_t)r * D + lane * 16);
        float4 v[4]; float ss = 0.f;
#pragma unroll
        for (int i = 0; i < 4; ++i) { v[i] = xr[i]; ss += v[i].x * v[i].x + v[i].y * v[i].y + v[i].z * v[i].z + v[i].w * v[i].w; }
        const float sc = rsqrtf(wave_sum(ss) * (1.f / D) + 1e-6f);
        uint4 q; unsigned qq[4]; uint2 ob[4];
#pragma unroll
        for (int i = 0; i < 4; ++i) { const float4 gg = ((const float4*)(g + lane * 16))[i];
            const float a = v[i].x * sc * gg.x, b = v[i].y * sc * gg.y, c = v[i].z * sc * gg.z, d = v[i].w * sc * gg.w;
            ob[i].x = pack2(a, b); ob[i].y = pack2(c, d); qq[i] = pack4_fp8(a * H8_SCALE, b * H8_SCALE, c * H8_SCALE, d * H8_SCALE); }
        q.x = qq[0]; q.y = qq[1]; q.z = qq[2]; q.w = qq[3];
        *(uint4*)(out + (size_t)r * D + lane * 16) = make_uint4(ob[0].x, ob[0].y, ob[1].x, ob[1].y);
        *(uint4*)(out + (size_t)r * D + lane * 16 + 8) = make_uint4(ob[2].x, ob[2].y, ob[3].x, ob[3].y);
        *(uint4*)(h8 + (size_t)r * D + lane * 16) = q;
    }
}

__device__ __forceinline__ void ph_peer2(unsigned char* shm, int bid, int nblk, const u8* __restrict__ H8, const float* X1, float* OUT, const u8* __restrict__ U8, const u8* __restrict__ V8,
                                         const float* __restrict__ USC, const float* __restrict__ VSC, const int* __restrict__ EID, const float* __restrict__ GATE, const float* __restrict__ gf) {
    const int wv = threadIdx.x >> 6, lane = threadIdx.x & 63, fr = lane & 15, fq = lane >> 4;
    float* zb = (float*)shm + wv * 128;
    const int wave = (bid * 512 + threadIdx.x) >> 6, nw = (nblk * 512) >> 6;
    for (int t = wave; t < T; t += nw) {
        uint4 hq[16];
#pragma unroll
        for (int s = 0; s < 16; ++s) hq[s] = *(const uint4*)(H8 + (size_t)t * 1024 + 64 * s + 16 * fq);
        const int e0 = EID[(size_t)t * 128 + lane], e1 = EID[(size_t)t * 128 + 64 + lane];
        const float g0 = GATE[(size_t)t * 128 + lane], g1 = GATE[(size_t)t * 128 + 64 + lane];
        const float us0 = USC[e0], us1 = USC[e1], vs0 = VSC[e0], vs1 = VSC[e1];
#pragma unroll 1
        for (int tile = 0; tile < 8; ++tile) {
            const int er = __shfl((tile < 4) ? e0 : e1, (tile & 3) * 16 + fr, 64);
            const u8* rowp = U8 + (size_t)er * 1024 + 16 * fq;
            uint4 a[16];
#pragma unroll
            for (int s = 0; s < 16; ++s) a[s] = *(const uint4*)(rowp + 64 * s);
            f32x4 acc = {0.f, 0.f, 0.f, 0.f};
#pragma unroll
            for (int s = 0; s < 16; ++s) {
                const long alo = (long)(((unsigned long long)a[s].y << 32) | a[s].x), ahi = (long)(((unsigned long long)a[s].w << 32) | a[s].z);
                const long blo = (long)(((unsigned long long)hq[s].y << 32) | hq[s].x), bhi = (long)(((unsigned long long)hq[s].w << 32) | hq[s].z);
                acc = __builtin_amdgcn_mfma_f32_16x16x32_fp8_fp8(alo, blo, acc, 0, 0, 0);
                acc = __builtin_amdgcn_mfma_f32_16x16x32_fp8_fp8(ahi, bhi, acc, 0, 0, 0);
            }
            if (fr == 0) { *(float4*)(zb + tile * 16 + 4 * fq) = make_float4(acc[0], acc[1], acc[2], acc[3]); }
        }
        __builtin_amdgcn_s_waitcnt(0); __builtin_amdgcn_wave_barrier();
        float cf0, cf1;
        { const float z0 = zb[lane] * us0 * (1.f / H8_SCALE), z1 = zb[64 + lane] * us1 * (1.f / H8_SCALE);
          cf0 = g0 * vs0 * 0.5f * z0 * (1.f + erff(z0 * 0.70710678118f)); cf1 = g1 * vs1 * 0.5f * z1 * (1.f + erff(z1 * 0.70710678118f)); }
        __builtin_amdgcn_wave_barrier();
        float acc[16];
#pragma unroll
        for (int i = 0; i < 16; ++i) acc[i] = 0.f;
#pragma unroll 1
        for (int k0 = 0; k0 < 128; k0 += 16) {
            uint4 r[16]; float cc[16];
#pragma unroll
            for (int j = 0; j < 16; ++j) {
                const int k = k0 + j;
                const int e = __builtin_amdgcn_readlane((k < 64) ? e0 : e1, k & 63);
                cc[j] = __int_as_float(__builtin_amdgcn_readlane(__float_as_int((k < 64) ? cf0 : cf1), k & 63));
                r[j] = *(const uint4*)(V8 + (size_t)e * 1024 + lane * 16);
            }
#pragma unroll
            for (int j = 0; j < 16; ++j) {
                const unsigned w[4] = {r[j].x, r[j].y, r[j].z, r[j].w};
#pragma unroll
                for (int q = 0; q < 4; ++q) {
                    const auto lo = __builtin_amdgcn_cvt_pk_f32_fp8((int)w[q], false), hi = __builtin_amdgcn_cvt_pk_f32_fp8((int)w[q], true);
                    acc[4 * q] += cc[j] * lo[0]; acc[4 * q + 1] += cc[j] * lo[1]; acc[4 * q + 2] += cc[j] * hi[0]; acc[4 * q + 3] += cc[j] * hi[1];
                }
            }
        }
        const float* xr = X1 + (size_t)t * D + lane * 16; float* orow = OUT + (size_t)t * D + lane * 16; float ss = 0.f;
#pragma unroll
        for (int i = 0; i < 4; ++i) { const float4 v = ((const float4*)xr)[i]; acc[4 * i] += v.x; acc[4 * i + 1] += v.y; acc[4 * i + 2] += v.z; acc[4 * i + 3] += v.w; }
#pragma unroll
        for (int i = 0; i < 16; ++i) ss += acc[i] * acc[i];
        const float sc = rsqrtf(wave_sum(ss) * (1.f / D) + 1e-6f);
#pragma unroll
        for (int i = 0; i < 4; ++i) { const float4 g = ((const float4*)(gf + lane * 16))[i];
            ((float4*)orow)[i] = make_float4(acc[4 * i] * sc * g.x, acc[4 * i + 1] * sc * g.y, acc[4 * i + 2] * sc * g.z, acc[4 * i + 3] * sc * g.w); }
    }
}

constexpr int TK_KPITCH = 136;
constexpr int TK_KEYS = 2 * 128 * TK_KPITCH * 2;
constexpr int TK_TAB = TK_KEYS, TK_XCH = TK_TAB + 64;
__device__ __forceinline__ void xmerge16(float (&run)[16], int xm) {
    float oth[16];
#pragma unroll
    for (int i = 0; i < 16; ++i) oth[i] = __shfl_xor(run[i], xm, 64);
    merge16_desc(run, oth);
}
__device__ __forceinline__ void ph_topk2(unsigned char* shm, int bid, int nblk, const bf16* __restrict__ Q, const bf16* __restrict__ keys, const float* __restrict__ SCL, int* __restrict__ EID, float* __restrict__ GATE) {
    const int tid = threadIdx.x, lane = tid & 63, wv = tid >> 6, fr = lane & 15, fq = lane >> 4;
    bf16* KL = (bf16*)shm;
    unsigned char* tab = shm + TK_TAB;
    float* xch = (float*)(shm + TK_XCH) + wv * 512;
    const bool par = (nblk % 8) == 0;
    const int rank = par ? (bid >> 3) : bid, nrank = par ? (nblk >> 3) : nblk;
    if (tid == 0) {
#pragma unroll
        for (int n = 0; n < 50; ++n) tab[n] = (unsigned char)(CT.i[n] * 16 + CT.j[n]);
    }
    for (int h = par ? (bid & 7) : 0; h < 8; h += par ? 8 : 1) {
        __syncthreads();
        for (int i = tid; i < 2 * 128 * 16; i += 512) { const int row = i >> 4, ch = i & 15;
            *(uint4*)(KL + row * TK_KPITCH + ch * 8) = *(const uint4*)(keys + ((size_t)h * 256 + row) * 128 + ch * 8); }
        __syncthreads();
        for (int g = rank * 8 + wv; g < T / 16; g += nrank * 8) {
            const int t0 = g * 16;
            float tops[2][16];
#pragma unroll
            for (int p = 0; p < 2; ++p) {
                pg8::bf16x8 bq[4];
#pragma unroll
                for (int ks = 0; ks < 4; ++ks) bq[ks] = *(const pg8::bf16x8*)(Q + (size_t)(t0 + fr) * 2048 + h * 256 + p * 128 + ks * 32 + fq * 8);
                float sc[32];
#pragma unroll
                for (int mt = 0; mt < 8; ++mt) {
                    f32x4 acc = {0.f, 0.f, 0.f, 0.f};
#pragma unroll
                    for (int ks = 0; ks < 4; ++ks) acc = __builtin_amdgcn_mfma_f32_16x16x32_bf16(*(const pg8::bf16x8*)(KL + (p * 128 + mt * 16 + fr) * TK_KPITCH + ks * 32 + fq * 8), bq[ks], acc, 0, 0, 0);
#pragma unroll
                    for (int r = 0; r < 4; ++r) sc[mt * 4 + r] = __uint_as_float((__float_as_uint(acc[r]) & ~0x7Fu) | (unsigned)(mt * 16 + 4 * fq + r));
                }
                float run[16], grp[16];
#pragma unroll
                for (int i = 0; i < 16; ++i) { run[i] = sc[i]; grp[i] = sc[16 + i]; }
                sort16_desc(run); sort16_desc(grp); merge16_desc(run, grp);
                xmerge16(run, 16); xmerge16(run, 32);
#pragma unroll
                for (int i = 0; i < 16; ++i) tops[p][i] = run[i];
            }
            if (fq == 0) {
#pragma unroll
                for (int i = 0; i < 16; ++i) { xch[(fr * 2) * 16 + i] = tops[0][i]; xch[(fr * 2 + 1) * 16 + i] = tops[1][i]; }
            }
            __builtin_amdgcn_s_waitcnt(0); __builtin_amdgcn_wave_barrier();
            const float* t1 = xch + (fr * 2) * 16; const float* t2 = t1 + 16;
            float run[16];
#pragma unroll
            for (int m = 0; m < 16; ++m) {
                const int n = fq * 13 + m;
                float v = -3.0e38f;
                if (m < 13 && n < 50) { const unsigned ij = tab[n];
                    const float a = __uint_as_float(__float_as_uint(t1[ij >> 4]) & ~0x7Fu), b = __uint_as_float(__float_as_uint(t2[ij & 15]) & ~0x7Fu);
                    v = __uint_as_float((__float_as_uint(a + b) & ~0xFFu) | ij); }
                run[m] = v;
            }
            sort16_desc(run);
            xmerge16(run, 16); xmerge16(run, 32);
            if (fq == 0) {
                float e[16], sum = 0.f; const float mx = __uint_as_float(__float_as_uint(run[0]) & ~0xFFu), sct = SCL[t0 + fr];
#pragma unroll
                for (int i = 0; i < 16; ++i) { e[i] = __expf((__uint_as_float(__float_as_uint(run[i]) & ~0xFFu) - mx) * sct); sum += e[i]; }
                const float inv = 1.f / sum;
                const size_t ob = (size_t)(t0 + fr) * 128 + h * 16;
                int eo[16]; float go[16];
#pragma unroll
                for (int i = 0; i < 16; ++i) { const unsigned ij = __float_as_uint(run[i]) & 0xFFu; const unsigned e1 = __float_as_uint(t1[ij >> 4]) & 0x7Fu, e2 = __float_as_uint(t2[ij & 15]) & 0x7Fu;
                    eo[i] = (int)(e1 * 128 + e2); go[i] = e[i] * inv; }
#pragma unroll
                for (int i = 0; i < 4; ++i) { *(int4*)(EID + ob + 4 * i) = make_int4(eo[4 * i], eo[4 * i + 1], eo[4 * i + 2], eo[4 * i + 3]); *(float4*)(GATE + ob + 4 * i) = make_float4(go[4 * i], go[4 * i + 1], go[4 * i + 2], go[4 * i + 3]); }
            }
            __builtin_amdgcn_wave_barrier();
        }
    }
}

__device__ __forceinline__ void ph_peer_u(unsigned char* shm, int bid, int nblk, const u8* __restrict__ H8, const u8* __restrict__ U8, const float* __restrict__ USC, const float* __restrict__ VSC,
                                          const int* __restrict__ EID, const float* __restrict__ GATE, float* __restrict__ CF) {
    const int wv = threadIdx.x >> 6, lane = threadIdx.x & 63, fr = lane & 15, fq = lane >> 4;
    int* lst_e = (int*)shm + wv * 256; int* lst_s = lst_e + 128;
    const bool par = (nblk % 8) == 0;
    const int rank = par ? (bid >> 3) : bid, nrank = par ? (nblk >> 3) : nblk;
    for (int p = par ? (bid & 7) : 0; p < 8; p += par ? 8 : 1) {
        for (int t = rank * 8 + wv; t < T; t += nrank * 8) {
            const int e0 = EID[(size_t)t * 128 + lane], e1 = EID[(size_t)t * 128 + 64 + lane];
            const bool f0 = (e0 >> 11) == p, f1 = (e1 >> 11) == p;
            const unsigned long long m0 = __ballot(f0), m1 = __ballot(f1);
            const int c0 = __popcll(m0), cnt = c0 + __popcll(m1);
            if (cnt == 0) continue;
            const int below = __builtin_amdgcn_mbcnt_hi((unsigned)(m0 >> 32), __builtin_amdgcn_mbcnt_lo((unsigned)m0, 0));
            const int below1 = __builtin_amdgcn_mbcnt_hi((unsigned)(m1 >> 32), __builtin_amdgcn_mbcnt_lo((unsigned)m1, 0));
            if (f0) { lst_e[below] = e0; lst_s[below] = lane; }
            if (f1) { lst_e[c0 + below1] = e1; lst_s[c0 + below1] = 64 + lane; }
            uint4 hq[16];
#pragma unroll
            for (int s = 0; s < 16; ++s) hq[s] = *(const uint4*)(H8 + (size_t)t * 1024 + 64 * s + 16 * fq);
            __builtin_amdgcn_s_waitcnt(0); __builtin_amdgcn_wave_barrier();
            const int ntile = (cnt + 15) >> 4;
#pragma unroll 1
            for (int tile = 0; tile < ntile; ++tile) {
                const int j = tile * 16 + fr;
                const int er = lst_e[(j < cnt) ? j : 0];
                const u8* rowp = U8 + (size_t)er * 1024 + 16 * fq;
                uint4 a[16];
#pragma unroll
                for (int s = 0; s < 16; ++s) a[s] = *(const uint4*)(rowp + 64 * s);
                f32x4 acc = {0.f, 0.f, 0.f, 0.f};
#pragma unroll
                for (int s = 0; s < 16; ++s) {
                    const long alo = (long)(((unsigned long long)a[s].y << 32) | a[s].x), ahi = (long)(((unsigned long long)a[s].w << 32) | a[s].z);
                    const long blo = (long)(((unsigned long long)hq[s].y << 32) | hq[s].x), bhi = (long)(((unsigned long long)hq[s].w << 32) | hq[s].z);
                    acc = __builtin_amdgcn_mfma_f32_16x16x32_fp8_fp8(alo, blo, acc, 0, 0, 0);
                    acc = __builtin_amdgcn_mfma_f32_16x16x32_fp8_fp8(ahi, bhi, acc, 0, 0, 0);
                }
                const int jo = tile * 16 + 4 * fq + fr;
                if (fr < 4 && jo < cnt) {
                    const float d = (fr == 0) ? acc[0] : (fr == 1) ? acc[1] : (fr == 2) ? acc[2] : acc[3];
                    const int e = lst_e[jo], sl = lst_s[jo];
                    const float z = d * USC[e] * (1.f / H8_SCALE);
                    CF[(size_t)t * 128 + sl] = GATE[(size_t)t * 128 + sl] * VSC[e] * 0.5f * z * (1.f + erff(z * 0.70710678118f));
                }
            }
            __builtin_amdgcn_wave_barrier();
        }
    }
}

__device__ __forceinline__ void ph_peer_v(unsigned char* shm, int bid, int nblk, const float* X1, float* X2, const u8* __restrict__ V8, const int* __restrict__ EID, const float* __restrict__ CF, float* __restrict__ SS) {
    const int wv = threadIdx.x >> 6, lane = threadIdx.x & 63, tk = lane >> 3, pc = lane & 7;
    int* le = (int*)shm + wv * 2048;
    float* lc = (float*)(le + 1024);
    const bool par = (nblk % 8) == 0;
    const int rank = par ? (bid >> 3) : bid, nrank = par ? (nblk >> 3) : nblk;
    for (int p = par ? (bid & 7) : 0; p < 8; p += par ? 8 : 1) {
        for (int g = rank * 8 + wv; g < T / 8; g += nrank * 8) {
            const int t = g * 8 + tk;
            __builtin_amdgcn_wave_barrier();
#pragma unroll
            for (int i = 0; i < 4; ++i) { *(int4*)(le + tk * 128 + pc * 16 + 4 * i) = *(const int4*)(EID + (size_t)t * 128 + pc * 16 + 4 * i);
                                          *(float4*)(lc + tk * 128 + pc * 16 + 4 * i) = *(const float4*)(CF + (size_t)t * 128 + pc * 16 + 4 * i); }
            float acc[16];
            { const float* xr = X1 + (size_t)t * D + p * 128 + pc * 16;
#pragma unroll
              for (int i = 0; i < 4; ++i) { const float4 v = ((const float4*)xr)[i]; acc[4 * i] = v.x; acc[4 * i + 1] = v.y; acc[4 * i + 2] = v.z; acc[4 * i + 3] = v.w; } }
            __builtin_amdgcn_s_waitcnt(0); __builtin_amdgcn_wave_barrier();
            const u8* vb = V8 + p * 128 + pc * 16;
#pragma unroll 1
            for (int k0 = 0; k0 < 128; k0 += 16) {
                uint4 r[16]; float cc[16];
#pragma unroll
                for (int q = 0; q < 4; ++q) { const int4 e4 = *(const int4*)(le + tk * 128 + k0 + 4 * q); const float4 c4 = *(const float4*)(lc + tk * 128 + k0 + 4 * q);
                    r[4 * q] = *(const uint4*)(vb + (size_t)e4.x * 1024); r[4 * q + 1] = *(const uint4*)(vb + (size_t)e4.y * 1024); r[4 * q + 2] = *(const uint4*)(vb + (size_t)e4.z * 1024); r[4 * q + 3] = *(const uint4*)(vb + (size_t)e4.w * 1024);
                    cc[4 * q] = c4.x; cc[4 * q + 1] = c4.y; cc[4 * q + 2] = c4.z; cc[4 * q + 3] = c4.w; }
#pragma unroll
                for (int j = 0; j < 16; ++j) {
                    const unsigned w[4] = {r[j].x, r[j].y, r[j].z, r[j].w};
#pragma unroll
                    for (int q = 0; q < 4; ++q) {
                        const auto lo = __builtin_amdgcn_cvt_pk_f32_fp8((int)w[q], false), hi = __builtin_amdgcn_cvt_pk_f32_fp8((int)w[q], true);
                        acc[4 * q] += cc[j] * lo[0]; acc[4 * q + 1] += cc[j] * lo[1]; acc[4 * q + 2] += cc[j] * hi[0]; acc[4 * q + 3] += cc[j] * hi[1];
                    }
                }
            }
            float ss = 0.f;
#pragma unroll
            for (int i = 0; i < 16; ++i) ss += acc[i] * acc[i];
            { float* orow = X2 + (size_t)t * D + p * 128 + pc * 16;
#pragma unroll
              for (int i = 0; i < 4; ++i) ((float4*)orow)[i] = make_float4(acc[4 * i], acc[4 * i + 1], acc[4 * i + 2], acc[4 * i + 3]); }
            ss += __shfl_xor(ss, 1, 64); ss += __shfl_xor(ss, 2, 64); ss += __shfl_xor(ss, 4, 64);
            if (pc == 0) SS[(size_t)t * 8 + p] = ss;
        }
    }
}

__device__ __forceinline__ void ph_peer_f(int bid, int nblk, const bf16* __restrict__ X2, float* __restrict__ OUT, const float* __restrict__ SS, const float* __restrict__ gf) {
    const int tid_ = opq((int)threadIdx.x), wave = (bid * 512 + tid_) >> 6, nw = (nblk * 512) >> 6, lane = tid_ & 63;
    float4 g[4], ns0, ns1; uint2 nx[4];
#pragma unroll
    for (int i = 0; i < 4; ++i) g[i] = ((const float4*)gf)[lane + 64 * i];
    if (wave < T) {
        ns0 = *(const float4*)(SS + (size_t)wave * 8); ns1 = *(const float4*)(SS + (size_t)wave * 8 + 4);
#pragma unroll
        for (int i = 0; i < 4; ++i) nx[i] = ((const uint2*)(X2 + (size_t)wave * D))[lane + 64 * i];
    }
    for (int t = wave; t < T; t += nw) {
        float4 v[4]; const float4 s0 = ns0, s1 = ns1;
#pragma unroll
        for (int i = 0; i < 4; ++i) v[i] = make_float4(bflo(nx[i].x), bfhi(nx[i].x), bflo(nx[i].y), bfhi(nx[i].y));
        if (t + nw < T) {
            ns0 = *(const float4*)(SS + (size_t)(t + nw) * 8); ns1 = *(const float4*)(SS + (size_t)(t + nw) * 8 + 4);
#pragma unroll
            for (int i = 0; i < 4; ++i) nx[i] = ((const uint2*)(X2 + (size_t)(t + nw) * D))[lane + 64 * i];
        }
        const float sc = rsqrtf(((s0.x + s0.y) + (s0.z + s0.w) + (s1.x + s1.y) + (s1.z + s1.w)) * (1.f / D) + 1e-6f);
#pragma unroll
        for (int i = 0; i < 4; ++i) ((float4*)(OUT + (size_t)t * D))[lane + 64 * i] = make_float4(v[i].x * sc * g[i].x, v[i].y * sc * g[i].y, v[i].z * sc * g[i].z, v[i].w * sc * g[i].w);
    }
}

struct Part { int p0, pstep, rank, nrank; };
__device__ __forceinline__ long u4lo(const uint4& v) { return (long)(((unsigned long long)v.y << 32) | v.x); }
__device__ __forceinline__ long u4hi(const uint4& v) { return (long)(((unsigned long long)v.w << 32) | v.z); }
__device__ __forceinline__ int pu_compact(int e0, int e1, int p, int lane, int* lst) {
    const bool f0 = (e0 >> 11) == p, f1 = (e1 >> 11) == p;
    const unsigned long long m0 = __ballot(f0), m1 = __ballot(f1);
    const int c0 = __popcll(m0), cnt = c0 + __popcll(m1);
    const int b0 = __builtin_amdgcn_mbcnt_hi((unsigned)(m0 >> 32), __builtin_amdgcn_mbcnt_lo((unsigned)m0, 0));
    const int b1 = __builtin_amdgcn_mbcnt_hi((unsigned)(m1 >> 32), __builtin_amdgcn_mbcnt_lo((unsigned)m1, 0));
    __builtin_amdgcn_wave_barrier();
    if (f0) { lst[b0] = e0; lst[128 + b0] = lane; }
    if (f1) { lst[c0 + b1] = e1; lst[128 + c0 + b1] = 64 + lane; }
    asm volatile("s_waitcnt lgkmcnt(0)" ::: "memory"); __builtin_amdgcn_wave_barrier();
    return cnt;
}
struct PuScal { float us[2], vs[2], gt[2]; int sl[2]; };
__device__ __forceinline__ void pu_scalars(PuScal& S, int t, int cnt, const int* lst, int fr, int fq, const float* __restrict__ USC, const float* __restrict__ VSC, const float* __restrict__ GATE) {
#pragma unroll
    for (int rt = 0; rt < 2; ++rt) { const int jo = rt * 16 + 4 * fq + fr; S.us[rt] = 0.f; S.vs[rt] = 0.f; S.gt[rt] = 0.f; S.sl[rt] = 0;
        if (fr < 4 && jo < cnt) { const int e = lst[jo], sl = lst[128 + jo]; S.sl[rt] = sl; S.us[rt] = USC[e]; S.vs[rt] = VSC[e]; S.gt[rt] = GATE[(size_t)t * 128 + sl]; } }
}
template <int HALF> __device__ __forceinline__ void pu_rows(uint4 (&a)[8], const u8* __restrict__ U8, const int* lst, int cnt, int j0, int fr, int fq, int pad_row) {
    const int j = j0 + fr; const int er = (j < cnt) ? lst[j] : pad_row;
    const u8* r0 = U8 + (size_t)er * 1024 + 16 * fq + HALF * 512;
#pragma unroll
    for (int s = 0; s < 8; ++s) a[s] = *(const uint4*)(r0 + 64 * s);
}
template <int HALF> __device__ __forceinline__ void pu_mma(const uint4 (&a)[8], const unsigned char* hbuf, int fq, f32x4& acc) {
#pragma unroll
    for (int s = 0; s < 8; ++s) {
        const uint4 hv = *(const uint4*)(hbuf + HALF * 512 + 64 * s + 16 * fq);
        acc = __builtin_amdgcn_mfma_f32_16x16x32_fp8_fp8(u4lo(a[s]), u4lo(hv), acc, 0, 0, 0);
        acc = __builtin_amdgcn_mfma_f32_16x16x32_fp8_fp8(u4hi(a[s]), u4hi(hv), acc, 0, 0, 0);
    }
}
__device__ __forceinline__ float gelu_erf(float v) {
    const float av = fabsf(v), tt = __builtin_amdgcn_rcpf(av * 0.2316418882f + 1.0f);
    float q = tt * 0.5307027145f + (-0.7265760135f); q = q * tt + 0.7107068705f; q = q * tt + (-0.142248368f); q = q * tt + 0.127414796f; q = q * tt;
    const float e = __builtin_amdgcn_exp2f((v * v) * (-0.72134752044f));
    const float m = v * (q * e);
    return v < 0.f ? m : v - m;
}
__device__ __forceinline__ void pu_tile_mma(const uint4 (&aA)[8], const uint4 (&aB)[8], const unsigned char* hbuf, int fq, f32x4& acc) { pu_mma<0>(aA, hbuf, fq, acc); pu_mma<1>(aB, hbuf, fq, acc); }
__device__ __forceinline__ void ph_peer_u2(unsigned char* shm, const Part pt, const u8* __restrict__ H8, const u8* __restrict__ U8, const float* __restrict__ USC, const float* __restrict__ VSC,
                                           const int* __restrict__ EID, const float* __restrict__ GATE, float* __restrict__ CF) {
    const int wv = threadIdx.x >> 6;
    const int rank = pt.rank, nrank = pt.nrank, tstep = nrank * 8;
    for (int p = pt.p0; p < 8; p += pt.pstep) {
        int tn = rank * 8 + wv;
        if (tn >= T) continue;
        const int pad = p * 2048;
        int cb = 1, cnt = 0, t = 0;
        bool has_cur = false;
        uint4 hreg = make_uint4(0, 0, 0, 0);
        PuScal S;
        uint4 a0A[8], a0B[8], a1A[8], a1B[8];
        int ne0, ne1;
        { const int lane0 = threadIdx.x & 63; ne0 = EID[(size_t)tn * 128 + lane0]; ne1 = EID[(size_t)tn * 128 + 64 + lane0]; }
#pragma unroll 1
        for (;;) {
            const int lane = opq((int)threadIdx.x) & 63, fr = lane & 15, fq = lane >> 4;
            int* lstb = (int*)shm + (opq((int)threadIdx.x) >> 6) * 512;
            unsigned char* hbuf = shm + 16384 + (opq((int)threadIdx.x) >> 6) * 1024;
            int* lcur = lstb + cb * 256; int* lnxt = lstb + (cb ^ 1) * 256;
            if (has_cur) {
                __builtin_amdgcn_wave_barrier();
                *(uint4*)(hbuf + lane * 16) = hreg;
                asm volatile("s_waitcnt lgkmcnt(0)" ::: "memory"); __builtin_amdgcn_wave_barrier();
                f32x4 acc0 = {0.f, 0.f, 0.f, 0.f}, acc1 = {0.f, 0.f, 0.f, 0.f};
                pu_tile_mma(a0A, a0B, hbuf, fq, acc0);
                if (cnt > 16) pu_tile_mma(a1A, a1B, hbuf, fq, acc1);
                for (int tile = 2; tile * 16 < cnt; ++tile) {
                    pu_rows<0>(a1A, U8, lcur, cnt, tile * 16, fr, fq, pad); pu_rows<1>(a1B, U8, lcur, cnt, tile * 16, fr, fq, pad);
                    f32x4 acc = {0.f, 0.f, 0.f, 0.f}; pu_tile_mma(a1A, a1B, hbuf, fq, acc);
                    const int jo = tile * 16 + 4 * fq + fr;
                    if (fr < 4 && jo < cnt) { const float d = (fr == 0) ? acc[0] : (fr == 1) ? acc[1] : (fr == 2) ? acc[2] : acc[3];
                        const int e = lcur[jo], sl = lcur[128 + jo];
                        CF[(size_t)t * 128 + sl] = GATE[(size_t)t * 128 + sl] * VSC[e] * gelu_erf(d * USC[e] * (1.f / H8_SCALE)); }
                }
                if (fr < 4) {
                    const int jo = 4 * fq + fr;
                    if (jo < cnt) { const float d = (fr == 0) ? acc0[0] : (fr == 1) ? acc0[1] : (fr == 2) ? acc0[2] : acc0[3];
                        CF[(size_t)t * 128 + S.sl[0]] = S.gt[0] * S.vs[0] * gelu_erf(d * S.us[0] * (1.f / H8_SCALE)); }
                    if (16 + jo < cnt) { const float d = (fr == 0) ? acc1[0] : (fr == 1) ? acc1[1] : (fr == 2) ? acc1[2] : acc1[3];
                        CF[(size_t)t * 128 + S.sl[1]] = S.gt[1] * S.vs[1] * gelu_erf(d * S.us[1] * (1.f / H8_SCALE)); }
                }
            }
            if (tn >= T) break;
            const int ncnt = pu_compact(ne0, ne1, p, lane, lnxt);
            pu_rows<0>(a0A, U8, lnxt, ncnt, 0, fr, fq, pad); pu_rows<1>(a0B, U8, lnxt, ncnt, 0, fr, fq, pad);
            if (ncnt > 16) { pu_rows<0>(a1A, U8, lnxt, ncnt, 16, fr, fq, pad); pu_rows<1>(a1B, U8, lnxt, ncnt, 16, fr, fq, pad); }
            hreg = *(const uint4*)(H8 + (size_t)tn * 1024 + lane * 16);
            pu_scalars(S, tn, ncnt, lnxt, fr, fq, USC, VSC, GATE);
            if (tn + tstep < T) { ne0 = EID[(size_t)(tn + tstep) * 128 + lane]; ne1 = EID[(size_t)(tn + tstep) * 128 + 64 + lane]; }
            t = tn; tn += tstep; cnt = ncnt; cb ^= 1; has_cur = true;
        }
    }
}

__device__ __forceinline__ void pv_issue(uint4 (&r)[8], float (&cc)[8], const u8* vb, const int* le, const float* lc, int k0) {
#pragma unroll
    for (int q = 0; q < 2; ++q) { const int4 e4 = *(const int4*)(le + k0 + 4 * q); const float4 c4 = *(const float4*)(lc + k0 + 4 * q);
        r[4 * q] = *(const uint4*)(vb + (size_t)e4.x * 1024); r[4 * q + 1] = *(const uint4*)(vb + (size_t)e4.y * 1024); r[4 * q + 2] = *(const uint4*)(vb + (size_t)e4.z * 1024); r[4 * q + 3] = *(const uint4*)(vb + (size_t)e4.w * 1024);
        cc[4 * q] = c4.x; cc[4 * q + 1] = c4.y; cc[4 * q + 2] = c4.z; cc[4 * q + 3] = c4.w; }
}
__device__ __forceinline__ void pv_fma(float (&acc)[16], const uint4 (&r)[8], const float (&cc)[8]) {
#pragma unroll
    for (int j = 0; j < 8; ++j) {
        const unsigned w[4] = {r[j].x, r[j].y, r[j].z, r[j].w};
#pragma unroll
        for (int q = 0; q < 4; ++q) {
            const auto lo = __builtin_amdgcn_cvt_pk_f32_fp8((int)w[q], false), hi = __builtin_amdgcn_cvt_pk_f32_fp8((int)w[q], true);
            acc[4 * q] += cc[j] * lo[0]; acc[4 * q + 1] += cc[j] * lo[1]; acc[4 * q + 2] += cc[j] * hi[0]; acc[4 * q + 3] += cc[j] * hi[1];
        }
        if (j & 1) __builtin_amdgcn_sched_barrier(0);
    }
}
__device__ __forceinline__ void ph_peer_v2(unsigned char* shm, const Part pt, const float* X1, float* X2, const u8* __restrict__ V8, const int* __restrict__ EID, const float* __restrict__ CF, float* __restrict__ SS) {
    const int wv = threadIdx.x >> 6, lane = threadIdx.x & 63, tk = lane >> 3, pc = lane & 7;
    int* le = (int*)shm + wv * 2048 + tk * 128;
    float* lc = (float*)((int*)shm + wv * 2048 + 1024) + tk * 128;
    const int rank = pt.rank, nrank = pt.nrank, gstep = nrank * 8;
    for (int p = pt.p0; p < 8; p += pt.pstep) {
        int g = rank * 8 + wv;
        if (g >= T / 8) continue;
        int4 pe0, pe1, pe2, pe3; float4 pf0, pf1, pf2, pf3;
        { const int* er = EID + (size_t)(g * 8 + tk) * 128 + pc * 16; const float* cr = CF + (size_t)(g * 8 + tk) * 128 + pc * 16;
          pe0 = *(const int4*)(er); pe1 = *(const int4*)(er + 4); pe2 = *(const int4*)(er + 8); pe3 = *(const int4*)(er + 12);
          pf0 = *(const float4*)(cr); pf1 = *(const float4*)(cr + 4); pf2 = *(const float4*)(cr + 8); pf3 = *(const float4*)(cr + 12); }
        const u8* vb = V8 + p * 128 + pc * 16;
#pragma unroll 1
        for (; g < T / 8; g += gstep) {
            const int lane = opq((int)threadIdx.x) & 63, tk = lane >> 3, pc = lane & 7;
            int* le = (int*)shm + wv * 2048 + tk * 128; float* lc = (float*)((int*)shm + wv * 2048 + 1024) + tk * 128;
            const u8* vb = V8 + p * 128 + pc * 16;
            const int t = g * 8 + tk;
            __builtin_amdgcn_wave_barrier();
            *(int4*)(le + pc * 16) = pe0; *(int4*)(le + pc * 16 + 4) = pe1; *(int4*)(le + pc * 16 + 8) = pe2; *(int4*)(le + pc * 16 + 12) = pe3;
            *(float4*)(lc + pc * 16) = pf0; *(float4*)(lc + pc * 16 + 4) = pf1; *(float4*)(lc + pc * 16 + 8) = pf2; *(float4*)(lc + pc * 16 + 12) = pf3;
            asm volatile("s_waitcnt lgkmcnt(0)" ::: "memory"); __builtin_amdgcn_wave_barrier();
            float acc[16];
#pragma unroll
            for (int i = 0; i < 16; ++i) acc[i] = 0.f;
            if (g + gstep < T / 8) { const int* er = EID + (size_t)((g + gstep) * 8 + tk) * 128 + pc * 16; const float* cr = CF + (size_t)((g + gstep) * 8 + tk) * 128 + pc * 16;
                pe0 = *(const int4*)(er); pe1 = *(const int4*)(er + 4); pe2 = *(const int4*)(er + 8); pe3 = *(const int4*)(er + 12);
                pf0 = *(const float4*)(cr); pf1 = *(const float4*)(cr + 4); pf2 = *(const float4*)(cr + 8); pf3 = *(const float4*)(cr + 12); }
            uint4 rA[8], rB[8]; float cA[8], cB[8];
            pv_issue(rA, cA, vb, le, lc, 0);
#pragma unroll 1
            for (int k0 = 0; k0 < 128; k0 += 16) {
                pv_issue(rB, cB, vb, le, lc, k0 + 8);
                pv_fma(acc, rA, cA);
                if (k0 + 16 < 128) pv_issue(rA, cA, vb, le, lc, k0 + 16);
                pv_fma(acc, rB, cB);
            }
            { const float* xr = X1 + (size_t)t * D + p * 128 + pc * 16;
#pragma unroll
              for (int i = 0; i < 4; ++i) { const float4 v = ((const float4*)xr)[i]; acc[4 * i] += v.x; acc[4 * i + 1] += v.y; acc[4 * i + 2] += v.z; acc[4 * i + 3] += v.w; } }
            float ss = 0.f;
#pragma unroll
            for (int i = 0; i < 16; ++i) ss += acc[i] * acc[i];
            { float* orow = X2 + (size_t)t * D + p * 128 + pc * 16;
#pragma unroll
              for (int i = 0; i < 4; ++i) ((float4*)orow)[i] = make_float4(acc[4 * i], acc[4 * i + 1], acc[4 * i + 2], acc[4 * i + 3]); }
            ss += __shfl_xor(ss, 1, 64); ss += __shfl_xor(ss, 2, 64); ss += __shfl_xor(ss, 4, 64);
            if (pc == 0) SS[(size_t)t * 8 + p] = ss;
        }
    }
}

__device__ __forceinline__ void pw_issue(uint4 (&r)[8], const u8* ub, const int* le, int k0) {
#pragma unroll
    for (int q = 0; q < 2; ++q) { const int4 e4 = *(const int4*)(le + k0 + 4 * q);
        r[4 * q] = *(const uint4*)(ub + (size_t)e4.x * 1024); r[4 * q + 1] = *(const uint4*)(ub + (size_t)e4.y * 1024); r[4 * q + 2] = *(const uint4*)(ub + (size_t)e4.z * 1024); r[4 * q + 3] = *(const uint4*)(ub + (size_t)e4.w * 1024); }
}
__device__ __forceinline__ float pw_dot8(const uint4 (&r)[8], const float (&h)[16], int pc) {
    float d[8];
#pragma unroll
    for (int j = 0; j < 8; ++j) {
        const unsigned w[4] = {r[j].x, r[j].y, r[j].z, r[j].w};
        typedef float f2v __attribute__((ext_vector_type(2)));
        f2v s2 = {0.f, 0.f};
#pragma unroll
        for (int q = 0; q < 4; ++q) {
            const f2v lo = __builtin_amdgcn_cvt_pk_f32_fp8((int)w[q], false), hi = __builtin_amdgcn_cvt_pk_f32_fp8((int)w[q], true);
            const f2v ha = {h[4 * q], h[4 * q + 1]}, hb = {h[4 * q + 2], h[4 * q + 3]};
            s2 = __builtin_elementwise_fma(ha, lo, s2); s2 = __builtin_elementwise_fma(hb, hi, s2);
        }
        d[j] = s2[0] + s2[1];
        if (j & 1) __builtin_amdgcn_sched_barrier(0);
    }
    float e4[4], e2[2];
#pragma unroll
    for (int j = 0; j < 4; ++j) { const float snd = (pc & 4) ? d[j] : d[j + 4], kp = (pc & 4) ? d[j + 4] : d[j]; e4[j] = kp + __shfl_xor(snd, 4, 64); }
#pragma unroll
    for (int j = 0; j < 2; ++j) { const float snd = (pc & 2) ? e4[j] : e4[j + 2], kp = (pc & 2) ? e4[j + 2] : e4[j]; e2[j] = kp + __shfl_xor(snd, 2, 64); }
    { const float snd = (pc & 1) ? e2[0] : e2[1], kp = (pc & 1) ? e2[1] : e2[0]; return kp + __shfl_xor(snd, 1, 64); }
}
__device__ __forceinline__ void ph_peer_u3(unsigned char* shm, const Part pt, const u8* __restrict__ H8, const u8* __restrict__ U8, const int* __restrict__ EID, float* __restrict__ PART) {
    const int wv = threadIdx.x >> 6;
    const int rank = pt.rank, nrank = pt.nrank, gstep = nrank * 8;
    for (int p = pt.p0; p < 8; p += pt.pstep) {
        int g = rank * 8 + wv;
        if (g >= T / 8) continue;
        int4 pe0, pe1, pe2, pe3;
        { const int l0 = threadIdx.x & 63; const int* er = EID + (size_t)(g * 8 + (l0 >> 3)) * 128 + (l0 & 7) * 16;
          pe0 = *(const int4*)(er); pe1 = *(const int4*)(er + 4); pe2 = *(const int4*)(er + 8); pe3 = *(const int4*)(er + 12); }
#pragma unroll 1
        for (; g < T / 8; g += gstep) {
            const int lane = opq((int)threadIdx.x) & 63, tk = lane >> 3, pc = lane & 7;
            int* le = (int*)shm + wv * 1024 + tk * 128;
            const u8* ub = U8 + p * 128 + pc * 16;
            const int t = g * 8 + tk;
            __builtin_amdgcn_wave_barrier();
            *(int4*)(le + pc * 16) = pe0; *(int4*)(le + pc * 16 + 4) = pe1; *(int4*)(le + pc * 16 + 8) = pe2; *(int4*)(le + pc * 16 + 12) = pe3;
            asm volatile("s_waitcnt lgkmcnt(0)" ::: "memory"); __builtin_amdgcn_wave_barrier();
            float h[16];
            { const uint4 hq = *(const uint4*)(H8 + (size_t)t * 1024 + p * 128 + pc * 16); const unsigned w[4] = {hq.x, hq.y, hq.z, hq.w};
#pragma unroll
              for (int q = 0; q < 4; ++q) { const auto lo = __builtin_amdgcn_cvt_pk_f32_fp8((int)w[q], false), hi = __builtin_amdgcn_cvt_pk_f32_fp8((int)w[q], true);
                  h[4 * q] = lo[0] * (1.f / H8_SCALE); h[4 * q + 1] = lo[1] * (1.f / H8_SCALE); h[4 * q + 2] = hi[0] * (1.f / H8_SCALE); h[4 * q + 3] = hi[1] * (1.f / H8_SCALE); } }
            if (g + gstep < T / 8) { const int* er = EID + (size_t)((g + gstep) * 8 + tk) * 128 + pc * 16;
                pe0 = *(const int4*)(er); pe1 = *(const int4*)(er + 4); pe2 = *(const int4*)(er + 8); pe3 = *(const int4*)(er + 12); }
            float* prow = PART + ((size_t)p * T + t) * 128 + pc;
            uint4 rA[8], rB[8];
            pw_issue(rA, ub, le, 0);
#pragma unroll 1
            for (int k0 = 0; k0 < 128; k0 += 16) {
                pw_issue(rB, ub, le, k0 + 8);
                prow[k0] = pw_dot8(rA, h, pc);
                if (k0 + 16 < 128) pw_issue(rA, ub, le, k0 + 16);
                prow[k0 + 8] = pw_dot8(rB, h, pc);
            }
        }
    }
}
__device__ __forceinline__ void ph_peer_cf(int bid, int nblk, const float* __restrict__ PART, const float* __restrict__ USC, const float* __restrict__ VSC, const int* __restrict__ EID, const float* __restrict__ GATE, float* __restrict__ CF) {
    const int tid_ = opq((int)threadIdx.x);
    for (size_t i = (size_t)bid * 512 + tid_; i < (size_t)T * 128 / 4; i += (size_t)nblk * 512) {
        float4 s = ((const float4*)PART)[i];
#pragma unroll
        for (int p = 1; p < 8; ++p) { const float4 v = ((const float4*)(PART + (size_t)p * T * 128))[i]; s.x += v.x; s.y += v.y; s.z += v.z; s.w += v.w; }
        const int4 e = ((const int4*)EID)[i]; const float4 g = ((const float4*)GATE)[i];
        float4 o;
        o.x = g.x * VSC[e.x] * gelu_erf(s.x * USC[e.x]); o.y = g.y * VSC[e.y] * gelu_erf(s.y * USC[e.y]); o.z = g.z * VSC[e.z] * gelu_erf(s.z * USC[e.z]); o.w = g.w * VSC[e.w] * gelu_erf(s.w * USC[e.w]);
        ((float4*)CF)[i] = o;
    }
}

__device__ __forceinline__ unsigned fp4_code(float q) {
    const float a = fabsf(q);
    unsigned c = (a >= 0.25f) + (a >= 0.75f) + (a >= 1.25f) + (a >= 1.75f) + (a >= 2.5f) + (a >= 3.5f) + (a >= 5.0f);
    return c | ((q < 0.f) ? 8u : 0u);
}
__device__ __forceinline__ void ph_cvt_fp4(int bid, int nblk, const float* __restrict__ src, u8* __restrict__ dst, float* __restrict__ scale, int rows) {
    const int tid_ = opq((int)threadIdx.x), wave = (bid * 512 + tid_) >> 6, nw = (nblk * 512) >> 6, lane = tid_ & 63;
    for (int r = wave; r < rows; r += nw) {
        const float4* xr = (const float4*)(src + (size_t)r * 1024 + lane * 16);
        float4 v[4]; float mx = 0.f;
#pragma unroll
        for (int i = 0; i < 4; ++i) { v[i] = xr[i]; mx = fmaxf(mx, fmaxf(fmaxf(fabsf(v[i].x), fabsf(v[i].y)), fmaxf(fabsf(v[i].z), fabsf(v[i].w)))); }
        mx = wave_max(mx);
        const float sc = fmaxf(mx, 1e-30f) * (1.f / 6.f), inv = 1.f / sc;
        unsigned w0 = 0, w1 = 0;
#pragma unroll
        for (int i = 0; i < 2; ++i) { w0 |= fp4_code(v[i].x * inv) << (16 * i); w0 |= fp4_code(v[i].y * inv) << (16 * i + 4); w0 |= fp4_code(v[i].z * inv) << (16 * i + 8); w0 |= fp4_code(v[i].w * inv) << (16 * i + 12); }
#pragma unroll
        for (int i = 0; i < 2; ++i) { w1 |= fp4_code(v[2 + i].x * inv) << (16 * i); w1 |= fp4_code(v[2 + i].y * inv) << (16 * i + 4); w1 |= fp4_code(v[2 + i].z * inv) << (16 * i + 8); w1 |= fp4_code(v[2 + i].w * inv) << (16 * i + 12); }
        *(uint2*)(dst + (size_t)r * 512 + lane * 8) = make_uint2(w0, w1);
        if (lane == 0) scale[r] = sc;
    }
}
__device__ __forceinline__ void ph_peer_cf2(int bid, int nblk, const float* __restrict__ PART, const float* __restrict__ USC, const float* __restrict__ VSC, const int* __restrict__ EID, const float* __restrict__ GATE,
                                            unsigned short* __restrict__ E16, bf16* __restrict__ CFH) {
    const int tid_ = opq((int)threadIdx.x);
    for (size_t i = (size_t)bid * 512 + tid_; i < (size_t)T * 128 / 4; i += (size_t)nblk * 512) {
        float4 s = ((const float4*)PART)[i];
#pragma unroll
        for (int p = 1; p < 8; ++p) { const float4 v = ((const float4*)(PART + (size_t)p * T * 128))[i]; s.x += v.x; s.y += v.y; s.z += v.z; s.w += v.w; }
        const int4 e = ((const int4*)EID)[i]; const float4 g = ((const float4*)GATE)[i];
        const float ox = g.x * VSC[e.x] * gelu_erf(s.x * USC[e.x]), oy = g.y * VSC[e.y] * gelu_erf(s.y * USC[e.y]), oz = g.z * VSC[e.z] * gelu_erf(s.z * USC[e.z]), ow = g.w * VSC[e.w] * gelu_erf(s.w * USC[e.w]);
        ((uint2*)CFH)[i] = make_uint2(pack2(ox, oy), pack2(oz, ow));
        ((uint2*)E16)[i] = make_uint2((unsigned)e.x | ((unsigned)e.y << 16), (unsigned)e.z | ((unsigned)e.w << 16));
    }
}
__device__ __forceinline__ void pv4_issue(uint4 (&r)[4], float (&cc)[4], const u8* vb, const unsigned short* le, const bf16* lc, int k0) {
    const uint2 e8 = *(const uint2*)(le + k0), c8 = *(const uint2*)(lc + k0);
    const unsigned ew[2] = {e8.x, e8.y}, cw[2] = {c8.x, c8.y};
#pragma unroll
    for (int q = 0; q < 2; ++q) { r[2 * q] = *(const uint4*)(vb + (size_t)(ew[q] & 0xFFFFu) * 512); r[2 * q + 1] = *(const uint4*)(vb + (size_t)(ew[q] >> 16) * 512);
        cc[2 * q] = bflo(cw[q]); cc[2 * q + 1] = bfhi(cw[q]); }
}
__device__ __forceinline__ void pv4_fma(float (&acc)[32], const uint4 (&r)[4], const float (&cc)[4]) {
#pragma unroll
    for (int j = 0; j < 4; ++j) {
        const unsigned w[4] = {r[j].x, r[j].y, r[j].z, r[j].w};
#pragma unroll
        for (int q = 0; q < 4; ++q) {
            const auto b0 = __builtin_amdgcn_cvt_scalef32_pk_f32_fp4(w[q], 1.0f, 0), b1 = __builtin_amdgcn_cvt_scalef32_pk_f32_fp4(w[q], 1.0f, 1);
            const auto b2 = __builtin_amdgcn_cvt_scalef32_pk_f32_fp4(w[q], 1.0f, 2), b3 = __builtin_amdgcn_cvt_scalef32_pk_f32_fp4(w[q], 1.0f, 3);
            acc[8 * q] += cc[j] * b0[0]; acc[8 * q + 1] += cc[j] * b0[1]; acc[8 * q + 2] += cc[j] * b1[0]; acc[8 * q + 3] += cc[j] * b1[1];
            acc[8 * q + 4] += cc[j] * b2[0]; acc[8 * q + 5] += cc[j] * b2[1]; acc[8 * q + 6] += cc[j] * b3[0]; acc[8 * q + 7] += cc[j] * b3[1];
        }
        __builtin_amdgcn_sched_barrier(0);
    }
}
__device__ __forceinline__ void ph_peer_v5(unsigned char* shm, const Part pt, const float* X1, float* X2, const u8* __restrict__ V4, const unsigned short* __restrict__ E16, const bf16* __restrict__ CFH, float* __restrict__ SS) {
    const int wv = threadIdx.x >> 6;
    const int rank = pt.rank, nrank = pt.nrank, gstep = nrank * 8;
    for (int p = pt.p0; p < 4; p += pt.pstep) {
        int g = rank * 8 + wv;
        if (g >= T / 8) continue;
        uint4 pe0, pe1, pf0, pf1;
        { const int l0 = threadIdx.x & 63; const size_t o = (size_t)(g * 8 + (l0 >> 3)) * 128 + (l0 & 7) * 16;
          pe0 = *(const uint4*)(E16 + o); pe1 = *(const uint4*)(E16 + o + 8); pf0 = *(const uint4*)(CFH + o); pf1 = *(const uint4*)(CFH + o + 8); }
#pragma unroll 1
        for (; g < T / 8; g += gstep) {
            const int lane = opq((int)threadIdx.x) & 63, tk = lane >> 3, pc = lane & 7;
            unsigned short* le = (unsigned short*)(shm + wv * 4096) + tk * 128; bf16* lc = (bf16*)(shm + wv * 4096 + 2048) + tk * 128;
            const u8* vb = V4 + p * 128 + pc * 16;
            const int t = g * 8 + tk;
            __builtin_amdgcn_wave_barrier();
            *(uint4*)(le + pc * 16) = pe0; *(uint4*)(le + pc * 16 + 8) = pe1; *(uint4*)(lc + pc * 16) = pf0; *(uint4*)(lc + pc * 16 + 8) = pf1;
            asm volatile("s_waitcnt lgkmcnt(0)" ::: "memory"); __builtin_amdgcn_wave_barrier();
            float acc[32];
#pragma unroll
            for (int i = 0; i < 32; ++i) acc[i] = 0.f;
            if (g + gstep < T / 8) { const size_t o = (size_t)((g + gstep) * 8 + tk) * 128 + pc * 16;
                pe0 = *(const uint4*)(E16 + o); pe1 = *(const uint4*)(E16 + o + 8); pf0 = *(const uint4*)(CFH + o); pf1 = *(const uint4*)(CFH + o + 8); }
            uint4 rA[4], rB[4]; float cA[4], cB[4];
            pv4_issue(rA, cA, vb, le, lc, 0);
#pragma unroll 1
            for (int k0 = 0; k0 < 128; k0 += 8) {
                pv4_issue(rB, cB, vb, le, lc, k0 + 4);
                pv4_fma(acc, rA, cA);
                if (k0 + 8 < 128) pv4_issue(rA, cA, vb, le, lc, k0 + 8);
                pv4_fma(acc, rB, cB);
            }
            float ss = 0.f;
            { const float* xr = X1 + (size_t)t * D + p * 256 + pc * 32; float* orow = X2 + (size_t)t * D + p * 256 + pc * 32;
#pragma unroll
              for (int i = 0; i < 8; ++i) { const float4 v = ((const float4*)xr)[i]; const float a = acc[4 * i] + v.x, b = acc[4 * i + 1] + v.y, c = acc[4 * i + 2] + v.z, d = acc[4 * i + 3] + v.w;
                  ss += a * a + b * b + c * c + d * d; ((float4*)orow)[i] = make_float4(a, b, c, d); } }
            ss += __shfl_xor(ss, 1, 64); ss += __shfl_xor(ss, 2, 64); ss += __shfl_xor(ss, 4, 64);
            if (pc == 0) { SS[(size_t)t * 8 + p] = ss; SS[(size_t)t * 8 + 4 + p] = 0.f; }
        }
    }
}

__device__ __forceinline__ unsigned pack4_i8(float a, float b, float c, float d) {
    const int ia = (int)rintf(a), ib = (int)rintf(b), ic = (int)rintf(c), id = (int)rintf(d);
    return (unsigned)(ia & 0xFF) | ((unsigned)(ib & 0xFF) << 8) | ((unsigned)(ic & 0xFF) << 16) | ((unsigned)(id & 0xFF) << 24);
}
__device__ __forceinline__ void ph_cvt_i8(int bid, int nblk, const float* __restrict__ src, u8* __restrict__ dst, float* __restrict__ scale, int rows) {
    const int tid_ = opq((int)threadIdx.x), wave = (bid * 512 + tid_) >> 6, nw = (nblk * 512) >> 6, lane = tid_ & 63;
    float4 nx[4];
    if (wave < rows) {
#pragma unroll
        for (int i = 0; i < 4; ++i) nx[i] = ((const float4*)(src + (size_t)wave * 1024))[lane + 64 * i];
    }
    for (int r = wave; r < rows; r += nw) {
        float4 v[4]; float mx = 0.f;
#pragma unroll
        for (int i = 0; i < 4; ++i) v[i] = nx[i];
        if (r + nw < rows) {
#pragma unroll
            for (int i = 0; i < 4; ++i) nx[i] = ((const float4*)(src + (size_t)(r + nw) * 1024))[lane + 64 * i];
        }
#pragma unroll
        for (int i = 0; i < 4; ++i) mx = fmaxf(mx, fmaxf(fmaxf(fabsf(v[i].x), fabsf(v[i].y)), fmaxf(fabsf(v[i].z), fabsf(v[i].w))));
        mx = wave_max(mx);
        const float sc = fmaxf(mx, 1e-30f) * (1.f / 127.f), inv = 1.f / sc;
#pragma unroll
        for (int i = 0; i < 4; ++i) ((unsigned*)(dst + (size_t)r * 1024))[lane + 64 * i] = pack4_i8(v[i].x * inv, v[i].y * inv, v[i].z * inv, v[i].w * inv);
        if (lane == 0) scale[r] = sc;
    }
}
__device__ __forceinline__ void ph_rowstat(int bid, int nblk, const bf16* __restrict__ x, const float* __restrict__ g, u8* __restrict__ h8, float* __restrict__ hs, float* __restrict__ scl, int rows) {
    const int tid_ = opq((int)threadIdx.x), wave = (bid * 512 + tid_) >> 6, nw = (nblk * 512) >> 6, lane = tid_ & 63;
    float4 gg[4]; uint2 nx[4];
#pragma unroll
    for (int i = 0; i < 4; ++i) gg[i] = ((const float4*)g)[lane + 64 * i];
    if (wave < rows) {
#pragma unroll
        for (int i = 0; i < 4; ++i) nx[i] = ((const uint2*)(x + (size_t)wave * D))[lane + 64 * i];
    }
    for (int r = wave; r < rows; r += nw) {
        float4 v[4]; float ss = 0.f;
#pragma unroll
        for (int i = 0; i < 4; ++i) v[i] = make_float4(bflo(nx[i].x), bfhi(nx[i].x), bflo(nx[i].y), bfhi(nx[i].y));
        if (r + nw < rows) {
#pragma unroll
            for (int i = 0; i < 4; ++i) nx[i] = ((const uint2*)(x + (size_t)(r + nw) * D))[lane + 64 * i];
        }
#pragma unroll
        for (int i = 0; i < 4; ++i) ss += v[i].x * v[i].x + v[i].y * v[i].y + v[i].z * v[i].z + v[i].w * v[i].w;
        const float sc = rsqrtf(wave_sum(ss) * (1.f / D) + 1e-6f);
        float mx = 0.f;
#pragma unroll
        for (int i = 0; i < 4; ++i) {
            v[i].x *= sc * gg[i].x; v[i].y *= sc * gg[i].y; v[i].z *= sc * gg[i].z; v[i].w *= sc * gg[i].w;
            mx = fmaxf(mx, fmaxf(fmaxf(fabsf(v[i].x), fabsf(v[i].y)), fmaxf(fabsf(v[i].z), fabsf(v[i].w)))); }
        mx = wave_max(mx);
        const float hsc = fmaxf(mx, 1e-30f) * (1.f / 119.f), inv = 1.f / hsc;
#pragma unroll
        for (int i = 0; i < 4; ++i) ((unsigned*)(h8 + (size_t)r * D))[lane + 64 * i] = pack4_i8(v[i].x * inv, v[i].y * inv, v[i].z * inv, v[i].w * inv);
        if (lane == 0) { hs[r] = hsc; scl[r] = sc; }
    }
}
__device__ __forceinline__ float pw_dot8_i8(const uint4 (&r)[8], const uint4 hq, int pc) {
    int d[8];
#pragma unroll
    for (int j = 0; j < 8; ++j) {
        int s = __builtin_amdgcn_sdot4((int)r[j].x, (int)hq.x, 0, false);
        s = __builtin_amdgcn_sdot4((int)r[j].y, (int)hq.y, s, false); s = __builtin_amdgcn_sdot4((int)r[j].z, (int)hq.z, s, false); s = __builtin_amdgcn_sdot4((int)r[j].w, (int)hq.w, s, false);
        d[j] = s;
    }
    int e4[4], e2[2];
#pragma unroll
    for (int j = 0; j < 4; ++j) { const int snd = (pc & 4) ? d[j] : d[j + 4], kp = (pc & 4) ? d[j + 4] : d[j]; e4[j] = kp + __shfl_xor(snd, 4, 64); }
#pragma unroll
    for (int j = 0; j < 2; ++j) { const int snd = (pc & 2) ? e4[j] : e4[j + 2], kp = (pc & 2) ? e4[j + 2] : e4[j]; e2[j] = kp + __shfl_xor(snd, 2, 64); }
    { const int snd = (pc & 1) ? e2[0] : e2[1], kp = (pc & 1) ? e2[1] : e2[0]; return (float)(kp + __shfl_xor(snd, 1, 64)); }
}
__device__ __forceinline__ void ph_peer_u6(unsigned char* shm, const Part pt, const u8* __restrict__ H8, const float* __restrict__ HS, const u8* __restrict__ U8, const int* __restrict__ EID, float* __restrict__ PART) {
    const int wv = threadIdx.x >> 6;
    const int rank = pt.rank, nrank = pt.nrank, gstep = nrank * 8;
    for (int p = pt.p0; p < 8; p += pt.pstep) {
        int g = rank * 8 + wv;
        if (g >= T / 8) continue;
        int4 pe0, pe1, pe2, pe3;
        { const int l0 = threadIdx.x & 63; const int* er = EID + (size_t)(g * 8 + (l0 >> 3)) * 128 + (l0 & 7) * 16;
          pe0 = *(const int4*)(er); pe1 = *(const int4*)(er + 4); pe2 = *(const int4*)(er + 8); pe3 = *(const int4*)(er + 12); }
#pragma unroll 1
        for (; g < T / 8; g += gstep) {
            const int lane = opq((int)threadIdx.x) & 63, tk = lane >> 3, pc = lane & 7;
            int* le = (int*)shm + wv * 1024 + tk * 128;
            const u8* ub = U8 + p * 128 + pc * 16;
            const int t = g * 8 + tk;
            __builtin_amdgcn_wave_barrier();
            *(int4*)(le + pc * 16) = pe0; *(int4*)(le + pc * 16 + 4) = pe1; *(int4*)(le + pc * 16 + 8) = pe2; *(int4*)(le + pc * 16 + 12) = pe3;
            asm volatile("s_waitcnt lgkmcnt(0)" ::: "memory"); __builtin_amdgcn_wave_barrier();
            const uint4 hq = *(const uint4*)(H8 + (size_t)t * 1024 + p * 128 + pc * 16);
            const float hsc = HS[t];
            if (g + gstep < T / 8) { const int* er = EID + (size_t)((g + gstep) * 8 + tk) * 128 + pc * 16;
                pe0 = *(const int4*)(er); pe1 = *(const int4*)(er + 4); pe2 = *(const int4*)(er + 8); pe3 = *(const int4*)(er + 12); }
            float* prow = PART + ((size_t)p * T + t) * 128 + pc;
            uint4 rA[8], rB[8];
            pw_issue(rA, ub, le, 0);
#pragma unroll 1
            for (int k0 = 0; k0 < 128; k0 += 16) {
                pw_issue(rB, ub, le, k0 + 8);
                prow[k0] = pw_dot8_i8(rA, hq, pc) * hsc;
                if (k0 + 16 < 128) pw_issue(rA, ub, le, k0 + 16);
                prow[k0 + 8] = pw_dot8_i8(rB, hq, pc) * hsc;
            }
        }
    }
}

__device__ __forceinline__ void ph_peer_cf3(int bid, int nblk, const float* __restrict__ PART, const float* __restrict__ USC, const float* __restrict__ VSC, const int* __restrict__ EID, const float* __restrict__ GATE,
                                            unsigned short* __restrict__ E16, unsigned* __restrict__ CFQ, float* __restrict__ CS, int npart) {
    const int tid_ = opq((int)threadIdx.x);
    for (size_t i = (size_t)bid * 512 + tid_; i < (size_t)T * 128 / 4; i += (size_t)nblk * 512) {
        float4 s = ((const float4*)PART)[i];
#pragma unroll 1
        for (int p = 1; p < npart; ++p) { const float4 v = ((const float4*)(PART + (size_t)p * T * 128))[i]; s.x += v.x; s.y += v.y; s.z += v.z; s.w += v.w; }
        const int4 e = ((const int4*)EID)[i]; const float4 g = ((const float4*)GATE)[i];
        const float ox = g.x * VSC[e.x] * gelu_erf(s.x * USC[e.x]), oy = g.y * VSC[e.y] * gelu_erf(s.y * USC[e.y]), oz = g.z * VSC[e.z] * gelu_erf(s.z * USC[e.z]), ow = g.w * VSC[e.w] * gelu_erf(s.w * USC[e.w]);
        float m = fmaxf(fmaxf(fabsf(ox), fabsf(oy)), fmaxf(fabsf(oz), fabsf(ow)));
#pragma unroll
        for (int o = 1; o < 32; o <<= 1) m = fmaxf(m, __shfl_xor(m, o, 64));
        const float cs = fmaxf(m, 1e-30f) * (1.f / 127.f), inv = 1.f / cs;
        CFQ[i] = pack4_i8(ox * inv, oy * inv, oz * inv, ow * inv);
        ((uint2*)E16)[i] = make_uint2((unsigned)e.x | ((unsigned)e.y << 16), (unsigned)e.z | ((unsigned)e.w << 16));
        if ((i & 31) == 0) CS[i >> 5] = cs;
    }
}
__device__ __forceinline__ void pv6_issue(uint4 (&r)[8], uint2& cq, const u8* vb, const unsigned short* le, const unsigned* lq, int k0) {
    const uint4 e8 = *(const uint4*)(le + k0); cq = *(const uint2*)(lq + (k0 >> 2));
    const unsigned ew[4] = {e8.x, e8.y, e8.z, e8.w};
#pragma unroll
    for (int q = 0; q < 4; ++q) { r[2 * q] = *(const uint4*)(vb + (size_t)(ew[q] & 0xFFFFu) * 1024); r[2 * q + 1] = *(const uint4*)(vb + (size_t)(ew[q] >> 16) * 1024); }
}
__device__ __forceinline__ void pv6_quad(int (&acc)[16], const uint4& a, const uint4& b, const uint4& c, const uint4& d, unsigned cf4) {
    const unsigned aw[4] = {a.x, a.y, a.z, a.w}, bw[4] = {b.x, b.y, b.z, b.w}, cw[4] = {c.x, c.y, c.z, c.w}, dw[4] = {d.x, d.y, d.z, d.w};
#pragma unroll
    for (int q = 0; q < 4; ++q) {
        const unsigned t0 = __builtin_amdgcn_perm(bw[q], aw[q], 0x05010400u), t1 = __builtin_amdgcn_perm(bw[q], aw[q], 0x07030602u);
        const unsigned t2 = __builtin_amdgcn_perm(dw[q], cw[q], 0x05010400u), t3 = __builtin_amdgcn_perm(dw[q], cw[q], 0x07030602u);
        const unsigned c0 = __builtin_amdgcn_perm(t2, t0, 0x05040100u), c1 = __builtin_amdgcn_perm(t2, t0, 0x07060302u);
        const unsigned c2 = __builtin_amdgcn_perm(t3, t1, 0x05040100u), c3 = __builtin_amdgcn_perm(t3, t1, 0x07060302u);
        acc[4 * q] = __builtin_amdgcn_sdot4((int)c0, (int)cf4, acc[4 * q], false); acc[4 * q + 1] = __builtin_amdgcn_sdot4((int)c1, (int)cf4, acc[4 * q + 1], false);
        acc[4 * q + 2] = __builtin_amdgcn_sdot4((int)c2, (int)cf4, acc[4 * q + 2], false); acc[4 * q + 3] = __builtin_amdgcn_sdot4((int)c3, (int)cf4, acc[4 * q + 3], false);
    }
}
typedef int v4i_t __attribute__((ext_vector_type(4)));
__device__ __forceinline__ void pv7_quad(v4i_t (&acc)[4], const uint4& a, const uint4& b, const uint4& c, const uint4& d, unsigned cf4, const unsigned (&sel)[4]) {
    const uint4 rw[4] = {a, b, c, d};
#pragma unroll
    for (int s_ = 0; s_ < 4; ++s_) {
        const int ad = (int)__builtin_amdgcn_perm(cf4, 0u, sel[s_]);
        acc[0] = __builtin_amdgcn_mfma_i32_4x4x4i8(ad, (int)rw[s_].x, acc[0], 0, 0, 0);
        acc[1] = __builtin_amdgcn_mfma_i32_4x4x4i8(ad, (int)rw[s_].y, acc[1], 0, 0, 0);
        acc[2] = __builtin_amdgcn_mfma_i32_4x4x4i8(ad, (int)rw[s_].z, acc[2], 0, 0, 0);
        acc[3] = __builtin_amdgcn_mfma_i32_4x4x4i8(ad, (int)rw[s_].w, acc[3], 0, 0, 0);
    }
}
__device__ __forceinline__ void pv8_issue(uint4 (&r)[8], uint2& cq, const u8* vb, const unsigned short* le, const unsigned* lq, int k0) {
    const uint4 e8 = *(const uint4*)(le + k0); cq = *(const uint2*)(lq + (k0 >> 2));
    const unsigned ew[4] = {e8.x, e8.y, e8.z, e8.w};
#pragma unroll
    for (int q = 0; q < 4; ++q) { r[2 * q] = *(const uint4*)(vb + (size_t)(ew[q] & 0xFFFFu) * 512); r[2 * q + 1] = *(const uint4*)(vb + (size_t)(ew[q] >> 16) * 512); }
}
__device__ __forceinline__ void pv8_quad(v4i_t (&aL)[4], v4i_t (&aH)[4], const uint4& a, const uint4& b, const uint4& c, const uint4& d, unsigned cf4, const unsigned (&sel)[4]) {
    const uint4 rw[4] = {a, b, c, d};
#pragma unroll
    for (int s_ = 0; s_ < 4; ++s_) {
        const int ad = (int)__builtin_amdgcn_perm(cf4, 0u, sel[s_]);
        const unsigned w[4] = {rw[s_].x, rw[s_].y, rw[s_].z, rw[s_].w};
#pragma unroll
        for (int q = 0; q < 4; ++q) {
            aL[q] = __builtin_amdgcn_mfma_i32_4x4x4i8(ad, (int)(w[q] & 0x0F0F0F0Fu), aL[q], 0, 0, 0);
            aH[q] = __builtin_amdgcn_mfma_i32_4x4x4i8(ad, (int)w[q], aH[q], 0, 0, 0);
        }
    }
}
__device__ __forceinline__ void ph_peer_v8(unsigned char* shm, const Part pt, const bf16* X1, bf16* X2, const u8* __restrict__ V4, const unsigned short* __restrict__ E16, const unsigned* __restrict__ CFQ,
                                           const float* __restrict__ CS, float* __restrict__ SS) {
    const int wv = threadIdx.x >> 6;
    const int rank = pt.rank, nrank = pt.nrank, gstep = nrank * 8;
    for (int p = pt.p0; p < 4; p += pt.pstep) {
        int g = rank * 8 + wv;
        if (g >= T / 8) continue;
        uint4 pe0, pe1, pq0;
        { const int l0 = threadIdx.x & 63; const size_t o = (size_t)(g * 8 + (l0 >> 3)) * 128 + (l0 & 7) * 16;
          pe0 = *(const uint4*)(E16 + o); pe1 = *(const uint4*)(E16 + o + 8); pq0 = *(const uint4*)(CFQ + (o >> 2)); }
#pragma unroll 1
        for (; g < T / 8; g += gstep) {
            const int lane = opq((int)threadIdx.x) & 63, tk = lane >> 3, pc = lane & 7;
            unsigned short* le = (unsigned short*)(shm + wv * 3072) + tk * 128; unsigned* lq = (unsigned*)(shm + wv * 3072 + 2048) + tk * 32;
            const u8* vb = V4 + p * 128 + pc * 16;
            const int t = g * 8 + tk;
            __builtin_amdgcn_wave_barrier();
            *(uint4*)(le + pc * 16) = pe0; *(uint4*)(le + pc * 16 + 8) = pe1; *(uint4*)(lq + pc * 4) = pq0;
            asm volatile("s_waitcnt lgkmcnt(0)" ::: "memory"); __builtin_amdgcn_wave_barrier();
            const float cs = CS[t];
            const bf16* xrow = X1 + (size_t)t * D + p * 256 + pc * 32;
            const uint4 xv0 = *(const uint4*)xrow, xv1 = *(const uint4*)(xrow + 8), xv2 = *(const uint4*)(xrow + 16), xv3 = *(const uint4*)(xrow + 24);
            int csum = __builtin_amdgcn_sdot4((int)pq0.x, 0x01010101, 0, false);
            csum = __builtin_amdgcn_sdot4((int)pq0.y, 0x01010101, csum, false); csum = __builtin_amdgcn_sdot4((int)pq0.z, 0x01010101, csum, false); csum = __builtin_amdgcn_sdot4((int)pq0.w, 0x01010101, csum, false);
            csum += __shfl_xor(csum, 1, 64); csum += __shfl_xor(csum, 2, 64); csum += __shfl_xor(csum, 4, 64);
            v4i_t aL[4], aH[4];
#pragma unroll
            for (int i = 0; i < 4; ++i) { aL[i] = (v4i_t){0, 0, 0, 0}; aH[i] = (v4i_t){0, 0, 0, 0}; }
            unsigned sel[4];
#pragma unroll
            for (int i = 0; i < 4; ++i) sel[i] = 0x0C0C0C0Cu ^ ((0x0Cu ^ (4u + i)) << (8 * (lane & 3)));
            if (g + gstep < T / 8) { const size_t o = (size_t)((g + gstep) * 8 + tk) * 128 + pc * 16;
                pe0 = *(const uint4*)(E16 + o); pe1 = *(const uint4*)(E16 + o + 8); pq0 = *(const uint4*)(CFQ + (o >> 2)); }
            uint4 rA[8], rB[8]; uint2 qA, qB;
            pv8_issue(rA, qA, vb, le, lq, 0);
#pragma unroll 1
            for (int k0 = 0; k0 < 112; k0 += 16) {
                pv8_issue(rB, qB, vb, le, lq, k0 + 8);
                pv8_quad(aL, aH, rA[0], rA[1], rA[2], rA[3], qA.x, sel); pv8_quad(aL, aH, rA[4], rA[5], rA[6], rA[7], qA.y, sel);
                pv8_issue(rA, qA, vb, le, lq, k0 + 16);
                pv8_quad(aL, aH, rB[0], rB[1], rB[2], rB[3], qB.x, sel); pv8_quad(aL, aH, rB[4], rB[5], rB[6], rB[7], qB.y, sel);
            }
            pv8_issue(rB, qB, vb, le, lq, 120);
            pv8_quad(aL, aH, rA[0], rA[1], rA[2], rA[3], qA.x, sel); pv8_quad(aL, aH, rA[4], rA[5], rA[6], rA[7], qA.y, sel);
            pv8_quad(aL, aH, rB[0], rB[1], rB[2], rB[3], qB.x, sel); pv8_quad(aL, aH, rB[4], rB[5], rB[6], rB[7], qB.y, sel);
            float ss = 0.f;
            { bf16* orow = X2 + (size_t)t * D + p * 256 + pc * 32;
              const unsigned xw[16] = {xv0.x, xv0.y, xv0.z, xv0.w, xv1.x, xv1.y, xv1.z, xv1.w, xv2.x, xv2.y, xv2.z, xv2.w, xv3.x, xv3.y, xv3.z, xv3.w}; unsigned ow[16];
              const int off8 = 8 * csum;
#pragma unroll
              for (int dw = 0; dw < 16; ++dw) {
                  const int lo_ = aL[dw >> 2][dw & 3], raw_ = aH[dw >> 2][dw & 3];
                  const float a = (float)(lo_ - off8) * cs + bflo(xw[dw]), b = (float)((raw_ - lo_) >> 4) * cs + bfhi(xw[dw]); ss += a * a + b * b; ow[dw] = pack2(a, b); }
              *(uint4*)orow = make_uint4(ow[0], ow[1], ow[2], ow[3]); *(uint4*)(orow + 8) = make_uint4(ow[4], ow[5], ow[6], ow[7]);
              *(uint4*)(orow + 16) = make_uint4(ow[8], ow[9], ow[10], ow[11]); *(uint4*)(orow + 24) = make_uint4(ow[12], ow[13], ow[14], ow[15]); }
            ss += __shfl_xor(ss, 1, 64); ss += __shfl_xor(ss, 2, 64); ss += __shfl_xor(ss, 4, 64);
            if (pc == 0) SS[(size_t)t * 8 + p] = ss;
            if (pc == 1) SS[(size_t)t * 8 + 4 + p] = 0.f;
        }
    }
}
__device__ __forceinline__ void ph_peer_v6(unsigned char* shm, const Part pt, const bf16* X1, bf16* X2, const u8* __restrict__ V8, const unsigned short* __restrict__ E16, const unsigned* __restrict__ CFQ,
                                           const float* __restrict__ CS, float* __restrict__ SS) {
    const int wv = threadIdx.x >> 6;
    const int rank = pt.rank, nrank = pt.nrank, gstep = nrank * 8;
    for (int p = pt.p0; p < 8; p += pt.pstep) {
        int g = rank * 8 + wv;
        if (g >= T / 8) continue;
        uint4 pe0, pe1, pq0;
        { const int l0 = threadIdx.x & 63; const size_t o = (size_t)(g * 8 + (l0 >> 3)) * 128 + (l0 & 7) * 16;
          pe0 = *(const uint4*)(E16 + o); pe1 = *(const uint4*)(E16 + o + 8); pq0 = *(const uint4*)(CFQ + (o >> 2)); }
#pragma unroll 1
        for (; g < T / 8; g += gstep) {
            const int lane = opq((int)threadIdx.x) & 63, tk = lane >> 3, pc = lane & 7;
            unsigned short* le = (unsigned short*)(shm + wv * 3072) + tk * 128; unsigned* lq = (unsigned*)(shm + wv * 3072 + 2048) + tk * 32;
            const u8* vb = V8 + p * 128 + pc * 16;
            const int t = g * 8 + tk;
            __builtin_amdgcn_wave_barrier();
            *(uint4*)(le + pc * 16) = pe0; *(uint4*)(le + pc * 16 + 8) = pe1; *(uint4*)(lq + pc * 4) = pq0;
            asm volatile("s_waitcnt lgkmcnt(0)" ::: "memory"); __builtin_amdgcn_wave_barrier();
            const float cs = CS[t];
            const uint4 xv0 = *(const uint4*)(X1 + (size_t)t * D + p * 128 + pc * 16), xv1 = *(const uint4*)(X1 + (size_t)t * D + p * 128 + pc * 16 + 8);
            v4i_t acq[4];
#pragma unroll
            for (int i = 0; i < 4; ++i) acq[i] = (v4i_t){0, 0, 0, 0};
            unsigned sel[4];
#pragma unroll
            for (int i = 0; i < 4; ++i) sel[i] = 0x0C0C0C0Cu ^ ((0x0Cu ^ (4u + i)) << (8 * (lane & 3)));
            if (g + gstep < T / 8) { const size_t o = (size_t)((g + gstep) * 8 + tk) * 128 + pc * 16;
                pe0 = *(const uint4*)(E16 + o); pe1 = *(const uint4*)(E16 + o + 8); pq0 = *(const uint4*)(CFQ + (o >> 2)); }
            uint4 rA[8], rB[8]; uint2 qA, qB;
            pv6_issue(rA, qA, vb, le, lq, 0);
#pragma unroll 1
            for (int k0 = 0; k0 < 112; k0 += 16) {
                pv6_issue(rB, qB, vb, le, lq, k0 + 8);
                pv7_quad(acq, rA[0], rA[1], rA[2], rA[3], qA.x, sel); pv7_quad(acq, rA[4], rA[5], rA[6], rA[7], qA.y, sel);
                pv6_issue(rA, qA, vb, le, lq, k0 + 16);
                pv7_quad(acq, rB[0], rB[1], rB[2], rB[3], qB.x, sel); pv7_quad(acq, rB[4], rB[5], rB[6], rB[7], qB.y, sel);
            }
            pv6_issue(rB, qB, vb, le, lq, 120);
            pv7_quad(acq, rA[0], rA[1], rA[2], rA[3], qA.x, sel); pv7_quad(acq, rA[4], rA[5], rA[6], rA[7], qA.y, sel);
            pv7_quad(acq, rB[0], rB[1], rB[2], rB[3], qB.x, sel); pv7_quad(acq, rB[4], rB[5], rB[6], rB[7], qB.y, sel);
            float ss = 0.f;
            { bf16* orow = X2 + (size_t)t * D + p * 128 + pc * 16;
              const unsigned xw[8] = {xv0.x, xv0.y, xv0.z, xv0.w, xv1.x, xv1.y, xv1.z, xv1.w}; unsigned ow[8];
#pragma unroll
              for (int i = 0; i < 8; ++i) { const float a = (float)acq[i >> 1][(2 * i) & 3] * cs + bflo(xw[i]), b = (float)acq[i >> 1][(2 * i + 1) & 3] * cs + bfhi(xw[i]); ss += a * a + b * b; ow[i] = pack2(a, b); }
              *(uint4*)orow = make_uint4(ow[0], ow[1], ow[2], ow[3]); *(uint4*)(orow + 8) = make_uint4(ow[4], ow[5], ow[6], ow[7]); }
            ss += __shfl_xor(ss, 1, 64); ss += __shfl_xor(ss, 2, 64); ss += __shfl_xor(ss, 4, 64);
            if (pc == 0) SS[(size_t)t * 8 + p] = ss;
        }
    }
}

template <bool OFFS> __device__ __forceinline__ void ph_cvt_i4(int bid, int nblk, const float* __restrict__ src, u8* __restrict__ dst, float* __restrict__ scale, int rows) {
    const int tid_ = opq((int)threadIdx.x), wave = (bid * 512 + tid_) >> 6, nw = (nblk * 512) >> 6, lane = tid_ & 63;
    for (int r = wave; r < rows; r += nw) {
        const float4* xr = (const float4*)(src + (size_t)r * 1024 + lane * 16);
        float4 v[4]; float ss = 0.f;
#pragma unroll
        for (int i = 0; i < 4; ++i) { v[i] = xr[i]; ss += v[i].x * v[i].x + v[i].y * v[i].y + v[i].z * v[i].z + v[i].w * v[i].w; }
        ss = wave_sum(ss);
        const float sc = fmaxf(sqrtf(ss * (1.f / 1024.f)), 1e-30f) * 0.3352f, inv = 1.f / sc;
        unsigned w[2] = {0u, 0u};
#pragma unroll
        for (int i = 0; i < 4; ++i) {
            const float f[4] = {v[i].x, v[i].y, v[i].z, v[i].w};
#pragma unroll
            for (int j = 0; j < 4; ++j) { const int q0 = (int)fminf(fmaxf(rintf(f[j] * inv), -8.f), 7.f); const int q = (OFFS && !(j & 1)) ? (q0 + 8) : (q0 & 15); w[i >> 1] |= (unsigned)q << (4 * ((i & 1) * 4 + j)); }
        }
        *(uint2*)(dst + (size_t)r * 512 + lane * 8) = make_uint2(w[0], w[1]);
        if (lane == 0) scale[r] = sc;
    }
}
__device__ __forceinline__ void pw4_issue(uint4 (&r)[8], const u8* ub, const int* le, int k0) {
#pragma unroll
    for (int q = 0; q < 2; ++q) { const int4 e4 = *(const int4*)(le + k0 + 4 * q);
        r[4 * q] = *(const uint4*)(ub + (size_t)e4.x * 512); r[4 * q + 1] = *(const uint4*)(ub + (size_t)e4.y * 512); r[4 * q + 2] = *(const uint4*)(ub + (size_t)e4.z * 512); r[4 * q + 3] = *(const uint4*)(ub + (size_t)e4.w * 512); }
}
__device__ __forceinline__ float pw_dot8_i4(const uint4 (&r)[8], const unsigned (&he)[4], const unsigned (&ho)[4], int hsum8, int pc) {
    int d[8];
#pragma unroll
    for (int j = 0; j < 8; ++j) {
        const unsigned w[4] = {r[j].x, r[j].y, r[j].z, r[j].w};
        int s = -hsum8;
#pragma unroll
        for (int q = 0; q < 4; ++q) { s = __builtin_amdgcn_sdot4((int)(w[q] & 0x0F0F0F0Fu), (int)he[q], s, false); s = __builtin_amdgcn_sdot4((int)((w[q] >> 4) & 0x0F0F0F0Fu), (int)ho[q], s, false); }
        d[j] = s;
    }
    int e4[4], e2[2];
#pragma unroll
    for (int j = 0; j < 4; ++j) { const int snd = (pc & 4) ? d[j] : d[j + 4], kp = (pc & 4) ? d[j + 4] : d[j]; e4[j] = kp + __shfl_xor(snd, 4, 64); }
#pragma unroll
    for (int j = 0; j < 2; ++j) { const int snd = (pc & 2) ? e4[j] : e4[j + 2], kp = (pc & 2) ? e4[j + 2] : e4[j]; e2[j] = kp + __shfl_xor(snd, 2, 64); }
    { const int snd = (pc & 1) ? e2[0] : e2[1], kp = (pc & 1) ? e2[1] : e2[0]; return (float)(kp + __shfl_xor(snd, 1, 64)); }
}
__device__ __forceinline__ float pw_dot8_n4(const uint4 (&r)[8], const unsigned (&hA)[4], const unsigned (&hB)[4], int pc) {
    int d[8];
#pragma unroll
    for (int j = 0; j < 8; ++j) {
        const unsigned w[4] = {r[j].x, r[j].y, r[j].z, r[j].w};
        int hi = 0, lo = 0;
#pragma unroll
        for (int q = 0; q < 4; ++q) { hi = __builtin_amdgcn_sdot8((int)w[q], (int)hA[q], hi, false); lo = __builtin_amdgcn_sdot8((int)w[q], (int)hB[q], lo, false); }
        d[j] = hi * 16 + lo;
    }
    int e4[4], e2[2];
#pragma unroll
    for (int j = 0; j < 4; ++j) { const int snd = (pc & 4) ? d[j] : d[j + 4], kp = (pc & 4) ? d[j + 4] : d[j]; e4[j] = kp + __shfl_xor(snd, 4, 64); }
#pragma unroll
    for (int j = 0; j < 2; ++j) { const int snd = (pc & 2) ? e4[j] : e4[j + 2], kp = (pc & 2) ? e4[j + 2] : e4[j]; e2[j] = kp + __shfl_xor(snd, 2, 64); }
    { const int snd = (pc & 1) ? e2[0] : e2[1], kp = (pc & 1) ? e2[1] : e2[0]; return (float)(kp + __shfl_xor(snd, 1, 64)); }
}
__device__ __forceinline__ unsigned nib_compact4(unsigned x) { const unsigned y = (x | (x >> 4)) & 0x00FF00FFu; return (y | (y >> 8)) & 0xFFFFu; }
__device__ __forceinline__ void ph_peer_u7(unsigned char* shm, const Part pt, const u8* __restrict__ H8, const float* __restrict__ HS, const u8* __restrict__ U4, const int* __restrict__ EID, float* __restrict__ PART) {
    const int wv = threadIdx.x >> 6;
    const int rank = pt.rank, nrank = pt.nrank, gstep = nrank * 8;
    for (int p = pt.p0; p < 4; p += pt.pstep) {
        int g = rank * 8 + wv;
        if (g >= T / 8) continue;
        int4 pe0, pe1, pe2, pe3;
        { const int l0 = threadIdx.x & 63; const int* er = EID + (size_t)(g * 8 + (l0 >> 3)) * 128 + (l0 & 7) * 16;
          pe0 = *(const int4*)(er); pe1 = *(const int4*)(er + 4); pe2 = *(const int4*)(er + 8); pe3 = *(const int4*)(er + 12); }
#pragma unroll 1
        for (; g < T / 8; g += gstep) {
            const int lane = opq((int)threadIdx.x) & 63, tk = lane >> 3, pc = lane & 7;
            int* le = (int*)shm + wv * 1024 + tk * 128;
            const u8* ub = U4 + p * 128 + pc * 16;
            const int t = g * 8 + tk;
            __builtin_amdgcn_wave_barrier();
            *(int4*)(le + pc * 16) = pe0; *(int4*)(le + pc * 16 + 4) = pe1; *(int4*)(le + pc * 16 + 8) = pe2; *(int4*)(le + pc * 16 + 12) = pe3;
            asm volatile("s_waitcnt lgkmcnt(0)" ::: "memory"); __builtin_amdgcn_wave_barrier();
            const uint4 ha = *(const uint4*)(H8 + (size_t)t * 1024 + p * 256 + pc * 32), hb = *(const uint4*)(H8 + (size_t)t * 1024 + p * 256 + pc * 32 + 16);
            const unsigned hw[8] = {ha.x, ha.y, ha.z, ha.w, hb.x, hb.y, hb.z, hb.w};
            unsigned hA[4], hB[4];
#pragma unroll
            for (int q = 0; q < 4; ++q) {
                unsigned pa[2], pb[2];
#pragma unroll
                for (int e = 0; e < 2; ++e) { const unsigned w = hw[2 * q + e];
                    const unsigned t8 = ((w & 0x7F7F7F7Fu) + 0x08080808u) ^ (w & 0x80808080u);
                    pa[e] = nib_compact4((t8 >> 4) & 0x0F0F0F0Fu); pb[e] = nib_compact4(w & 0x0F0F0F0Fu); }
                hA[q] = pa[0] | (pa[1] << 16); hB[q] = pb[0] | (pb[1] << 16);
            }
            const float hsc = HS[t];
            if (g + gstep < T / 8) { const int* er = EID + (size_t)((g + gstep) * 8 + tk) * 128 + pc * 16;
                pe0 = *(const int4*)(er); pe1 = *(const int4*)(er + 4); pe2 = *(const int4*)(er + 8); pe3 = *(const int4*)(er + 12); }
            float* prow = PART + ((size_t)p * T + t) * 128 + pc;
            uint4 rA[8], rB[8];
            pw4_issue(rA, ub, le, 0);
#pragma unroll 1
            for (int k0 = 0; k0 < 112; k0 += 16) {
                pw4_issue(rB, ub, le, k0 + 8);
                prow[k0] = pw_dot8_n4(rA, hA, hB, pc) * hsc;
                pw4_issue(rA, ub, le, k0 + 16);
                prow[k0 + 8] = pw_dot8_n4(rB, hA, hB, pc) * hsc;
            }
            pw4_issue(rB, ub, le, 120);
            prow[112] = pw_dot8_n4(rA, hA, hB, pc) * hsc;
            prow[120] = pw_dot8_n4(rB, hA, hB, pc) * hsc;
        }
    }
}

constexpr int C2_SLOT = 16384, C2_RING = 8, C2_SBUF = C2_RING * C2_SLOT;
__device__ __forceinline__ void chain2_dma(unsigned char* shm, int slot, const bf16* __restrict__ PHI, const bf16* __restrict__ PSI, size_t item, int w, int lane) {
    const bf16* src[2] = {PHI + item, PSI + item};
#pragma unroll
    for (int m = 0; m < 2; ++m)
#pragma unroll
        for (int i = 0; i < 2; ++i) {
            const int row = (w * 2 + i) * 8 + (lane >> 3), jj = (lane & 7) ^ (row & 7);
            __builtin_amdgcn_global_load_lds((const unsigned*)((const char*)src[m] + row * 128 + jj * 16),
                                             (PG8_LAS unsigned*)(shm + slot * C2_SLOT + m * 8192 + (w * 2 + i) * 1024), 16, 0, 0);
        }
}
__device__ __forceinline__ void ph_chain2(unsigned char* shm, int bh, bf16* __restrict__ PHI, const bf16* __restrict__ PSI) {
    const int b = bh >> 3, h = bh & 7, tid = threadIdx.x, lane = tid & 63, w = __builtin_amdgcn_readfirstlane((tid >> 6) & 3), fr = lane & 15, fq = lane >> 4;
    const size_t ib = ((size_t)(b * 64) * 8 + h) * 4096, istep = (size_t)8 * 4096;
#define CH_BAR() do { asm volatile("s_waitcnt lgkmcnt(0)" ::: "memory"); __builtin_amdgcn_s_barrier(); asm volatile("" ::: "memory"); } while (0)
    if (tid < 256) {
        pg8::bf16x8 sf[2];
#pragma unroll
        for (int j = 0; j < 8; ++j) { sf[0][j] = 0; sf[1][j] = 0; }
#pragma unroll
        for (int c = 0; c < 7; ++c) chain2_dma(shm, c, PHI, PSI, ib + (size_t)c * istep, w, lane);
#pragma unroll 1
        for (int ch = 0; ch < 64; ++ch) {
            asm volatile("s_waitcnt vmcnt(24)" ::: "memory");
            CH_BAR();
            chain2_dma(shm, (ch + 7) & 7, PHI, PSI, ib + (size_t)((ch + 7 < 64) ? ch + 7 : 63) * istep, w, lane);
            const unsigned char* sl = shm + (ch & 7) * C2_SLOT;
            f32x4 sa[4]; pg8::bf16x8 ap[4][2];
#pragma unroll
            for (int mt = 0; mt < 4; ++mt) {
                const int row = w * 16 + fr, sw = (((mt * 2 + (fq >> 1)) ^ (row & 7)) * 16) + (fq & 1) * 8;
                const uint2 ps = *(const uint2*)(sl + 8192 + row * 128 + sw);
                sa[mt][0] = bflo(ps.x); sa[mt][1] = bfhi(ps.x); sa[mt][2] = bflo(ps.y); sa[mt][3] = bfhi(ps.y);
#pragma unroll
                for (int ks = 0; ks < 2; ++ks) { const int ar = mt * 16 + fr; ap[mt][ks] = *(const pg8::bf16x8*)(sl + ar * 128 + (((ks * 4 + fq) ^ (ar & 7)) * 16)); }
            }
#pragma unroll
            for (int ks = 0; ks < 2; ++ks)
#pragma unroll
                for (int mt = 0; mt < 4; ++mt) sa[mt] = __builtin_amdgcn_mfma_f32_16x16x32_bf16(ap[mt][ks], sf[ks], sa[mt], 0, 0, 0);
            uint4 o0, o1;
            o0.x = pack2(sa[0][0], sa[0][1]); o0.y = pack2(sa[0][2], sa[0][3]); o0.z = pack2(sa[1][0], sa[1][1]); o0.w = pack2(sa[1][2], sa[1][3]);
            o1.x = pack2(sa[2][0], sa[2][1]); o1.y = pack2(sa[2][2], sa[2][3]); o1.z = pack2(sa[3][0], sa[3][1]); o1.w = pack2(sa[3][2], sa[3][3]);
            sf[0] = __builtin_bit_cast(pg8::bf16x8, o0); sf[1] = __builtin_bit_cast(pg8::bf16x8, o1);
            unsigned char* sb = shm + C2_SBUF + (ch & 1) * 8192 + w * 2048 + lane * 32;
            *(uint4*)sb = o0; *(uint4*)(sb + 16) = o1;
        }
        asm volatile("s_waitcnt vmcnt(0)" ::: "memory");
        CH_BAR();
    } else {
        CH_BAR();
#pragma unroll 1
        for (int ch = 1; ch < 64; ++ch) {
            CH_BAR();
            const unsigned char* sb = shm + C2_SBUF + ((ch - 1) & 1) * 8192 + w * 2048 + lane * 32;
            const uint4 a = *(const uint4*)sb, c = *(const uint4*)(sb + 16);
            bf16* dst = PHI + ib + (size_t)(ch - 1) * istep + w * 1024 + lane * 16;
            *(uint4*)dst = a; *(uint4*)(dst + 8) = c;
        }
        CH_BAR();
    }
#undef CH_BAR
    __syncthreads();
}

struct YoPre { uint4 s0, s1, a[2][2]; uint2 y0[2]; uint4 vv, gg; float bon; };
__device__ __forceinline__ void yout_load(YoPre& P, int it, const bf16* __restrict__ SPHI, const bf16* __restrict__ OMG, const bf16* __restrict__ Y0, const bf16* __restrict__ V, const bf16* __restrict__ G, const float* __restrict__ BONUS, int tid) {
    const int lane = tid & 63, wv = tid >> 6, vg = wv & 3, mh = wv >> 2, fr = lane & 15, fq = lane >> 4;
    const int ch = (it >> 3) & 63, h = it & 7, b = it >> 9;
    P.s0 = make_uint4(0, 0, 0, 0); P.s1 = make_uint4(0, 0, 0, 0);
    if (ch > 0) { const bf16* sp = SPHI + (size_t)(it - 8) * 4096 + vg * 1024 + lane * 16; P.s0 = *(const uint4*)sp; P.s1 = *(const uint4*)(sp + 8); }
#pragma unroll
    for (int q = 0; q < 2; ++q) { const int mt = mh * 2 + q;
        P.y0[q] = *(const uint2*)(Y0 + (size_t)it * 4096 + (vg * 16 + fr) * 64 + mt * 16 + 4 * fq);
#pragma unroll
        for (int ks = 0; ks < 2; ++ks) P.a[q][ks] = *(const uint4*)(OMG + (size_t)it * 4096 + (mt * 16 + fr) * 64 + ks * 32 + fq * 8); }
    const int et = tid >> 3, eq = tid & 7; const int t = b * SEQ + ch * 64 + et; const size_t o = (size_t)t * 512 + h * 64 + eq * 8;
    P.vv = *(const uint4*)(V + o); P.gg = *(const uint4*)(G + o); P.bon = BONUS[(size_t)t * 8 + h];
}
__device__ __forceinline__ void ph_yout(unsigned char* shm, int bid, int nblk, const bf16* __restrict__ SPHI, const bf16* __restrict__ OMG, const bf16* __restrict__ Y0, const bf16* __restrict__ V, const bf16* __restrict__ G,
                                        const float* __restrict__ BONUS, const float* __restrict__ gng, const float* __restrict__ gnb, bf16* __restrict__ O) {
    if (bid >= 2048) return;
    YoPre P, Q;
    yout_load(P, bid, SPHI, OMG, Y0, V, G, BONUS, threadIdx.x);
    if (bid + nblk < 2048) yout_load(Q, bid + nblk, SPHI, OMG, Y0, V, G, BONUS, threadIdx.x);
    int par = 0;
    for (int it = bid; it < 2048; it += nblk, par ^= 1) {
        const int tid = opq((int)threadIdx.x), lane = tid & 63, wv = tid >> 6, vg = wv & 3, mh = wv >> 2, fr = lane & 15, fq = lane >> 4;
        const int ch = (it >> 3) & 63, h = it & 7, b = it >> 9;
        bf16* yb = (bf16*)(shm + par * (64 * 72 * 2));
        const pg8::bf16x8 sf0 = __builtin_bit_cast(pg8::bf16x8, P.s0), sf1 = __builtin_bit_cast(pg8::bf16x8, P.s1);
#pragma unroll
        for (int q = 0; q < 2; ++q) { const int mt = mh * 2 + q;
            f32x4 ya; ya[0] = bflo(P.y0[q].x); ya[1] = bfhi(P.y0[q].x); ya[2] = bflo(P.y0[q].y); ya[3] = bfhi(P.y0[q].y);
            ya = __builtin_amdgcn_mfma_f32_16x16x32_bf16(__builtin_bit_cast(pg8::bf16x8, P.a[q][0]), sf0, ya, 0, 0, 0);
            ya = __builtin_amdgcn_mfma_f32_16x16x32_bf16(__builtin_bit_cast(pg8::bf16x8, P.a[q][1]), sf1, ya, 0, 0, 0);
#pragma unroll
            for (int r = 0; r < 4; ++r) yb[(mt * 16 + 4 * fq + r) * 72 + vg * 16 + fr] = f2bf(ya[r]); }
        const uint4 cv = P.vv, cg = P.gg; const float cbon = P.bon;
        P = Q;
        if (it + 2 * nblk < 2048) yout_load(Q, it + 2 * nblk, SPHI, OMG, Y0, V, G, BONUS, tid);
        __syncthreads();
        const int et = tid >> 3, eq = tid & 7; const int t = b * SEQ + ch * 64 + et;
        float y[8], s = 0.f;
        unpack8(*(const uint4*)(yb + et * 72 + eq * 8), y);
#pragma unroll
        for (int i = 0; i < 8; ++i) s += y[i];
        s += __shfl_xor(s, 1, 64); s += __shfl_xor(s, 2, 64); s += __shfl_xor(s, 4, 64);
        const float mean = s * (1.f / 64.f);
        float q = 0.f;
#pragma unroll
        for (int i = 0; i < 8; ++i) { y[i] -= mean; q += y[i] * y[i]; }
        q += __shfl_xor(q, 1, 64); q += __shfl_xor(q, 2, 64); q += __shfl_xor(q, 4, 64);
        const float rstd = rsqrtf(q * (1.f / 64.f) + 64e-5f);
        float v8[8], g8[8], o8[8]; unpack8(cv, v8); unpack8(cg, g8);
        const float4 w0 = *(const float4*)(gng + h * 64 + eq * 8), w1 = *(const float4*)(gng + h * 64 + eq * 8 + 4), b0 = *(const float4*)(gnb + h * 64 + eq * 8), b1 = *(const float4*)(gnb + h * 64 + eq * 8 + 4);
        const float gw[8] = {w0.x, w0.y, w0.z, w0.w, w1.x, w1.y, w1.z, w1.w}, gb[8] = {b0.x, b0.y, b0.z, b0.w, b1.x, b1.y, b1.z, b1.w};
#pragma unroll
        for (int i = 0; i < 8; ++i) o8[i] = (y[i] * rstd * gw[i] + gb[i] + cbon * v8[i]) * g8[i];
        *(uint4*)(O + (size_t)t * 512 + h * 64 + eq * 8) = pack8(o8);
    }
}

constexpr int LDS_BYTES = 150528 + 64;
constexpr int N_PHASES = 14;
constexpr size_t WS_BAR = 19 * MiB;
struct MP { const float* in[28]; float* out; unsigned char* ws; int ph_lo, ph_hi; };

__global__ void __launch_bounds__(512, 2) mega(MP p) {
    extern __shared__ __attribute__((aligned(16))) unsigned char lds[];
    const int bid = blockIdx.x, nblk = gridDim.x, tid = threadIdx.x;
    volatile LAS unsigned* st = (volatile LAS unsigned*)(lds + LDS_BYTES - 16);
    if (tid < 4) st[tid] = 0u;
    __syncthreads();
    const int lo = p.ph_lo, hi = p.ph_hi;
    XcdBarrier bar; bar.bar = (unsigned*)(p.ws + WS_BAR); bar.x = 0; bar.st = st;
    if (hi - lo > 1) bar = xcd_barrier_post((unsigned*)(p.ws + WS_BAR), st);
    if (tid == 0) st[2] = (hi - lo > 1) ? xb_add((unsigned*)(p.ws + WS_BAR) + XCD_BAR_WORDS + 64 * bar.x, 1u) : 0u;
#define IN(k) (lo <= (k) && (k) < hi)
#define SEAM(k) do { if (IN(k) && IN((k) + 1)) xcd_barrier(bar); } while (0)
    unsigned char* ws = p.ws; unsigned char* ob = (unsigned char*)p.out;
    const float* x = p.in[0];
    bf16 *WIN_T = (bf16*)(ws + WS_WIN_T), *PW_T = (bf16*)(ws + WS_PW_T), *WO_T = (bf16*)(ws + WS_WO_T), *WOUT_T = (bf16*)(ws + WS_WOUT_T), *WQ_T = (bf16*)(ws + WS_WQ_T), *KEYS = (bf16*)(ws + WS_KEYS);
    bf16 *XN = (bf16*)(ws + WS_XN), *PROJ = (bf16*)(ws + WS_PROJ), *YN = (bf16*)(ws + WS_YN), *G = (bf16*)(ws + WS_G), *M = (bf16*)(ws + WS_M);
    bf16 *Q = (bf16*)(ws + WS_Q);
    u8 *U8 = (u8*)(ws + WS_XN), *V8 = (u8*)(ws + WS_PROJ + 64 * MiB), *H8 = (u8*)(ws + WS_PROJ + 80 * MiB);
    bf16* XN2 = (bf16*)(ws + WS_M);
    float *USC = (float*)(ws + 19 * MiB + 512 * 1024), *VSC = USC + 16384, *HS = USC + 32768, *CF = (float*)(ws + WS_PROJ + 144 * MiB), *SS = (float*)(ws + WS_BONUS), *SCL = USC + 65536, *PARTB = (float*)(ws + WS_Q);
    float *BONUS = (float*)(ws + WS_BONUS), *GATE = (float*)(ws + WS_GATE); int* EID = (int*)(ws + WS_EID);
    bf16 *OMG = (bf16*)(ob), *Y0 = (bf16*)(ob + 16 * MiB), *V = (bf16*)(ob + 32 * MiB), *O = (bf16*)(ob + 48 * MiB);
    bf16 *PHI = (bf16*)(ws + WS_LD), *PSI = (bf16*)(ws + WS_LD + 16 * MiB);
    bf16* X1 = (bf16*)(ws + WS_PROJ + 96 * MiB);

    if (IN(0)) {
        ph_transpose_reg(bid, nblk, 0, p.in[2], WIN_T, 1024, DIN, DINP);
        ph_rmsnorm(bid, nblk, x, p.in[1], XN, T);
        __syncthreads();
    }
    SEAM(0);
    if (IN(1)) ph_gemm(lds, bid, nblk, XN, WIN_T, T, DINP, 1024, EpiGen<FStoreBf16>{FStoreBf16{PROJ, DINP}});
    SEAM(1);
    if (IN(2)) {
        ChunkParams cp{PROJ, p.in[9], p.in[10], p.in[11], p.in[12], p.in[13], p.in[14], p.in[15], p.in[16], p.in[17], V, G, PHI, PSI, OMG, Y0, BONUS};
        ph_chunkprep(lds, bid, nblk, cp);
        __syncthreads();
    }
    SEAM(2);
    if (IN(3)) {
        if (bid < 32) ph_chain2(lds, bid, PHI, PSI);
        else {
            const int ob_ = bid - 32, on_ = nblk - 32;
            int t0 = 0;
            t0 += ph_transpose(lds, ob_, on_, t0, p.in[7], PW_T, 512, 1024, 1024);
            t0 += ph_transpose(lds, ob_, on_, t0, p.in[20], WO_T, 512, 1024, 1024);
            t0 += ph_transpose(lds, ob_, on_, t0, p.in[21], WOUT_T, 1024, 1024, 1024);
            t0 += ph_transpose(lds, ob_, on_, t0, p.in[23], WQ_T, 1024, 2048, 2048, p.in[22]);
            ph_cvt(ob_, on_, p.in[24], KEYS, (size_t)(8 * 2 * 128 * 128 / 4));
            ph_cvt_i4<false>(ob_, on_, p.in[25], U8, USC, 16384);
            __syncthreads();
        }
    }
    SEAM(3);
    if (IN(4)) {
        ph_yout(lds, bid, nblk, PHI, OMG, Y0, V, G, BONUS, p.in[18], p.in[19], O);
        __syncthreads();
        {
            const int ob_ = bid, on_ = nblk;
            ph_conv(lds, ob_, on_, PROJ, p.in[3], p.in[4], p.in[5], p.in[6], YN);
            __syncthreads();
            __syncthreads();
        }
    }
    SEAM(4);
    if (IN(5)) ph_gemm2(lds, bid, nblk, YN, PW_T, O, WO_T, T, 1024, 512, 8, 16, EpiMix{M, PROJ, p.in[8]});
    SEAM(5);
    if (IN(6)) ph_gemm(lds, bid, nblk, M, WOUT_T, T, 1024, 1024, EpiGen2<FResX12B>{FResX12B{x, X1}});
    SEAM(6);
    if (IN(7)) {
        ph_rowstat(bid, nblk, X1, p.in[22], H8, HS, SCL, T);
        ph_cvt_i4<true>(bid, nblk, p.in[26], V8, VSC, 16384);
        __syncthreads();
        ph_gemm(lds, bid, nblk, X1, WQ_T, T, 2048, 1024, EpiGen<FStoreBf16>{FStoreBf16{Q, 2048}});
    }
    SEAM(7);
    if (IN(9)) ph_topk2(lds, bid, nblk, Q, KEYS, SCL, EID, GATE);
    SEAM(9);
    Part part; bool census_ok;
    {
        unsigned n[8], tot = 0; bool ok = (hi - lo > 1);
#pragma unroll
        for (int j = 0; j < 8; ++j) { n[j] = xb_ld(bar.bar + XB_XCNT(j)); tot += n[j]; ok = ok && n[j] > 0; }
        ok = ok && tot == (unsigned)nblk && bar.x < 8u;
        const unsigned myr = st[2];
        census_ok = ok;
        if (ok) { part.p0 = (int)bar.x; part.pstep = 8; part.rank = (int)myr; part.nrank = (int)n[bar.x & 7]; if (part.rank >= part.nrank) { part.rank = 0; part.nrank = 1; part.p0 = 8; } }
        else if ((nblk % 8) == 0) { part.p0 = bid & 7; part.pstep = 8; part.rank = bid >> 3; part.nrank = nblk >> 3; }
        else { part.p0 = 0; part.pstep = 1; part.rank = bid; part.nrank = nblk; }
    }
    Part part4;
    if (census_ok) {
        const unsigned xe = bar.x & 6u, n0 = xb_ld(bar.bar + XB_XCNT(xe)), n1 = xb_ld(bar.bar + XB_XCNT(xe + 1));
        part4.p0 = (int)(bar.x >> 1); part4.pstep = 4; part4.rank = (int)(((bar.x & 1u) ? n0 : 0u) + st[2]); part4.nrank = (int)(n0 + n1);
    } else if ((nblk % 4) == 0) { part4.p0 = bid & 3; part4.pstep = 4; part4.rank = bid >> 2; part4.nrank = nblk >> 2; }
    else { part4.p0 = 0; part4.pstep = 1; part4.rank = bid; part4.nrank = nblk; }
    if (IN(10)) ph_peer_u7(lds, part4, H8, HS, U8, EID, PARTB);
    SEAM(10);
    if (IN(11)) ph_peer_cf3(bid, nblk, PARTB, USC, VSC, EID, GATE, (unsigned short*)CF, (unsigned*)((unsigned short*)CF + (size_t)T * 128), HS + 16384, 4);
    SEAM(11);
    if (IN(12)) ph_peer_v8(lds, part4, X1, X1, V8, (const unsigned short*)CF, (const unsigned*)((const unsigned short*)CF + (size_t)T * 128), HS + 16384, SS);
    SEAM(12);
    if (IN(13)) ph_peer_f(bid, nblk, X1, p.out, SS, p.in[27]);
#undef IN
#undef SEAM
}

#ifndef MK_PER_PHASE
#define MK_PER_PHASE 0
#endif
extern "C" void kernel_launch(void* const* d_in, const int* in_sizes, int n_in, void* d_out, int out_size, void* d_ws, size_t ws_size, hipStream_t stream) {
    static int grid = 0;
    if (grid == 0) {
        if (n_in != 28 || ws_size < WS_END) { fprintf(stderr, "kernel_launch: unexpected n_in %d / ws_size %zu\n", n_in, ws_size); grid = -1; return; }
        int dev = 0, cus = 0;
        if (hipGetDevice(&dev) != hipSuccess || hipDeviceGetAttribute(&cus, hipDeviceAttributeMultiprocessorCount, dev) != hipSuccess) { grid = -1; return; }
        if (hipFuncSetAttribute((const void*)mega, hipFuncAttributeMaxDynamicSharedMemorySize, LDS_BYTES) != hipSuccess) { fprintf(stderr, "kernel_launch: hipFuncSetAttribute failed\n"); grid = -1; return; }
        (void)hipGetLastError();
        grid = cus;
    }
    if (grid < 0) return;
    (void)hipMemsetAsync((unsigned char*)d_ws + WS_BAR, 0, XCD_BAR_WORDS * 4 + 16 * 256, stream);
    MP a{};
    for (int i = 0; i < 28; ++i) a.in[i] = (const float*)d_in[i];
    a.out = (float*)d_out; a.ws = (unsigned char*)d_ws;
#if MK_PER_PHASE
    for (int ph = 0; ph < N_PHASES; ++ph) { a.ph_lo = ph; a.ph_hi = ph + 1; hipLaunchKernelGGL(mega, dim3(grid), dim3(512), LDS_BYTES, stream, a); }
#else
    a.ph_lo = 0; a.ph_hi = N_PHASES;
    hipLaunchKernelGGL(mega, dim3(grid), dim3(512), LDS_BYTES, stream, a);
#endif
}
```

```cpp
#include <hip/hip_runtime.h>
#include <stdint.h>
#include <stdio.h>
namespace pg8 {
#define PG8_LAS __attribute__((address_space(3)))
typedef unsigned short bf16_t;
typedef short bf16x8 __attribute__((ext_vector_type(8)));
typedef float f32x4 __attribute__((ext_vector_type(4)));
typedef unsigned u32x4 __attribute__((ext_vector_type(4)));
constexpr int BM = 256, BK = 64, HALF = 128, HTB = HALF * BK * 2  , STAGE_BYTES = 8 * HTB, NXCD = 8, WGM = 8;

__host__ __device__ __forceinline__ int lds_byte(int r, int c) { const int st = (r >> 4) * 2 + (c >> 5), rr = r & 15, cc = c & 31, ob = rr * 64 + cc * 2; return st * 1024 + (ob ^ (((ob >> 9) & 1) << 5)); }
__host__ __device__ __forceinline__ void stage_rc(int b, int& R, int& C) { const int st = b / 1024, sb = b % 1024, swz = sb ^ (((sb >> 9) & 1) << 5); R = (st >> 1) * 16 + swz / 64; C = (st & 1) * 32 + (swz % 64) / 2; }
__host__ __device__ __forceinline__ int perm32(int rho) { const int n = rho >> 4, i = rho & 15; return 8 * (i >> 2) + 4 * n + (i & 3); }

struct Unit { int pm, pn; };
struct Gemm { const bf16_t* A; const bf16_t* Bt; int M, N, K; };

struct StaticOrder {
    int nM, nN, nwg, G, c;
    __host__ __device__ void init(int M, int N, int G_, int c_) { nM = M / BM; nN = N / BM; nwg = nM * nN; G = G_; c = c_; }
    __host__ __device__ bool next(int i, Unit& u) const {
        const long L = (long)i * G + c; if (L >= nwg) return false;
        int wgid = (int)L; { const int q = nwg / NXCD, r = nwg % NXCD, xcd = wgid % NXCD, off = wgid / NXCD; wgid = (xcd < r ? xcd * (q + 1) : r * (q + 1) + (xcd - r) * q) + off; }
        const int nig = WGM * nN, gid = wgid / nig, fm = gid * WGM, gsz = (nM - fm) < WGM ? (nM - fm) : WGM;
        u.pm = fm + ((wgid % nig) % gsz); u.pn = (wgid % nig) / gsz; return true;
    }
    __device__ __forceinline__ void a_ready(const Unit&) const {}
    __device__ __forceinline__ void done(const Unit&) const {}
};
__device__ __forceinline__ unsigned cvt_pk_bf16(float lo, float hi) { unsigned r; asm volatile("v_cvt_pk_bf16_f32 %0, %1, %2" : "=v"(r) : "v"(lo), "v"(hi)); return r; }
struct Gemm2 { const bf16_t* A; const bf16_t* Bt; const bf16_t* A2; const bf16_t* Bt2; int M, N, K, nt1, nt; };
template <class Epi, class Sched, bool STAMP = false>
__device__ __forceinline__ void gemm_phase(PG8_LAS unsigned char* lds, const Gemm g, const Sched& S, const Epi& E, unsigned long long* stamps) {
    const int tid = threadIdx.x, wid = __builtin_amdgcn_readfirstlane(tid >> 6), lane = tid & 63, wr = wid >> 2, wc = wid & 3, fr = lane & 15, fq = lane >> 4;
    const int K = g.K, nt = K / BK;
    int ts_lo = 0, ts_hi = 0, nts = 0; const unsigned long long rt_entry = STAMP ? (unsigned long long)wall_clock64() : 0ull;
#define PG8_STAMP() do { if (STAMP && wid == 0 && nts < 64) { const unsigned long long _c = (unsigned long long)clock64(); \
        ts_lo = (lane == nts) ? (int)(unsigned)_c : ts_lo; ts_hi = (lane == nts) ? (int)(unsigned)(_c >> 32) : ts_hi; ++nts; } } while (0)
    PG8_STAMP();
    unsigned voffA[2], voffB[2];
#pragma unroll
    for (int i = 0; i < 2; ++i) { int R, C; stage_rc(tid * 16 + i * 8192, R, C); const int Rb = Epi::PERM ? ((R & ~31) + perm32(R & 31)) : R;
        voffA[i] = (unsigned)(R * K + C) * 2u; voffB[i] = (unsigned)(Rb * K + C) * 2u; }
    const size_t kstep = (size_t)(BK * 2);
    const size_t hstep = (size_t)HALF * K * 2;
    const size_t tstep = 2 * hstep;
    const unsigned ldsw = (unsigned)wid * 1024u;
    const int aoff = lds_byte(wr * 64 + fr, fq * 8), boff = lds_byte(wc * 32 + fr, fq * 8);
#define PG8_SA(b, h) (((b) * 2 + (h)) * HTB)
#define PG8_SB(b, h) ((4 + (b) * 2 + (h)) * HTB)
#define PG8_STAGE(bufoff, gbase, voff) do { _Pragma("unroll") for (int _i = 0; _i < 2; ++_i) \
        __builtin_amdgcn_global_load_lds((const unsigned*)((const char*)(gbase) + (voff)[_i]), (PG8_LAS unsigned*)(lds + (bufoff) + ldsw + _i * 8192), 16, 0, 0); } while (0)
#define PG8_LDA(dst, b, h) do { _Pragma("unroll") for (int m = 0; m < 4; ++m) _Pragma("unroll") for (int k = 0; k < 2; ++k) dst[m][k] = *(const PG8_LAS bf16x8*)(lds + PG8_SA(b, h) + aoff + m * 2048 + k * 1024); } while (0)
#define PG8_LDB(dst, b, h) do { _Pragma("unroll") for (int n = 0; n < 2; ++n) _Pragma("unroll") for (int k = 0; k < 2; ++k) dst[n][k] = *(const PG8_LAS bf16x8*)(lds + PG8_SB(b, h) + boff + n * 2048 + k * 1024); } while (0)
#define PG8_MMA(ai, bj, At, Bt) do { __builtin_amdgcn_s_setprio(1); _Pragma("unroll") for (int m = 0; m < 4; ++m) _Pragma("unroll") for (int n = 0; n < 2; ++n) _Pragma("unroll") for (int k = 0; k < 2; ++k) \
        acc[ai][bj][m][n] = __builtin_amdgcn_mfma_f32_16x16x32_bf16(Bt[n][k], At[m][k], acc[ai][bj][m][n], 0, 0, 0); __builtin_amdgcn_s_setprio(0); } while (0)
#define PG8_WAIT_V(n) asm volatile("s_waitcnt vmcnt(" #n ")" ::: "memory")
#define PG8_WAIT_L(n) asm volatile("s_waitcnt lgkmcnt(" #n ")" ::: "memory")
#define PG8_BAR __builtin_amdgcn_s_barrier()
#define PG8_SCHED __builtin_amdgcn_sched_barrier(0)
    Unit cur, nxt; int ui = 0;
    if (!S.next(0, cur)) return;
    f32x4 acc[2][2][4][2];
#pragma unroll
    for (int a = 0; a < 2; ++a)
#pragma unroll
        for (int b = 0; b < 2; ++b)
#pragma unroll
            for (int m = 0; m < 4; ++m)
#pragma unroll
                for (int n = 0; n < 2; ++n) acc[a][b][m][n] = (f32x4){0.f, 0.f, 0.f, 0.f};
    bf16x8 At[4][2], B0[2][2], B1[2][2];
    const char* cA = (const char*)g.A + (size_t)cur.pm * tstep; const char* cB = (const char*)g.Bt + (size_t)cur.pn * tstep;
    S.a_ready(cur);
    PG8_STAGE(PG8_SB(0, 0), cB, voffB); PG8_STAGE(PG8_SA(0, 0), cA, voffA); PG8_STAGE(PG8_SB(0, 1), cB + hstep, voffB); PG8_STAGE(PG8_SA(0, 1), cA + hstep, voffA);
    if (wr == 1) PG8_BAR;
    PG8_WAIT_V(4); PG8_BAR;
    PG8_STAGE(PG8_SB(1, 0), cB + kstep, voffB); PG8_STAGE(PG8_SA(1, 0), cA + kstep, voffA); PG8_STAGE(PG8_SB(1, 1), cB + hstep + kstep, voffB);
    PG8_WAIT_V(6); PG8_BAR;
    PG8_STAMP();
    for (;;) {
        const bool has_next = S.next(ui + 1, nxt);
        const char* nA = has_next ? (const char*)g.A + (size_t)nxt.pm * tstep : cA; const char* nB = has_next ? (const char*)g.Bt + (size_t)nxt.pn * tstep : cB;
        for (int t = 0; t < nt; t += 2) {
            const bool last = (t == nt - 2);
            const char* a1 = cA + (size_t)(t + 1) * kstep;
            const char* a2 = last ? nA : cA + (size_t)(t + 2) * kstep; const char* b2 = last ? nB : cB + (size_t)(t + 2) * kstep;
            const char* a3 = a2 + kstep; const char* b3 = b2 + kstep;
            if (last && has_next) S.a_ready(nxt);
            PG8_LDB(B0, 0, 0); PG8_SCHED; PG8_LDA(At, 0, 0); PG8_STAGE(PG8_SA(1, 1), a1 + hstep, voffA);
            PG8_WAIT_L(8); PG8_BAR; PG8_WAIT_L(0); PG8_MMA(0, 0, At, B0); PG8_BAR; PG8_SCHED;
            PG8_LDB(B1, 0, 1); PG8_STAGE(PG8_SB(0, 0), b2, voffB);
            PG8_BAR; PG8_WAIT_L(0); PG8_MMA(0, 1, At, B1); PG8_BAR;
            PG8_LDA(At, 0, 1); PG8_STAGE(PG8_SA(0, 0), a2, voffA);
            PG8_BAR; PG8_WAIT_L(0); PG8_MMA(1, 0, At, B0); PG8_BAR; PG8_SCHED;
            PG8_STAGE(PG8_SB(0, 1), b2 + hstep, voffB);
            PG8_WAIT_V(6); PG8_BAR; PG8_MMA(1, 1, At, B1); PG8_BAR;
            PG8_LDB(B0, 1, 0); PG8_SCHED; PG8_LDA(At, 1, 0); PG8_STAGE(PG8_SA(0, 1), a2 + hstep, voffA);
            PG8_WAIT_L(8); PG8_BAR; PG8_WAIT_L(0); PG8_MMA(0, 0, At, B0); PG8_BAR; PG8_SCHED;
            PG8_LDB(B1, 1, 1); PG8_STAGE(PG8_SB(1, 0), b3, voffB);
            PG8_BAR; PG8_WAIT_L(0); PG8_MMA(0, 1, At, B1); PG8_BAR;
            PG8_LDA(At, 1, 1); PG8_STAGE(PG8_SA(1, 0), a3, voffA);
            PG8_BAR; PG8_WAIT_L(0); PG8_MMA(1, 0, At, B0); PG8_BAR; PG8_SCHED;
            PG8_STAGE(PG8_SB(1, 1), b3 + hstep, voffB);
            PG8_WAIT_V(6); PG8_BAR; PG8_MMA(1, 1, At, B1); PG8_BAR;
        }
        PG8_STAMP();
        if constexpr (!Epi::AFTER_DRAIN) { E(acc, cur, wr, wc, fr, fq); S.done(cur); }
        PG8_STAMP();
        if (!has_next) break;
#pragma unroll
        for (int a = 0; a < 2; ++a)
#pragma unroll
            for (int b = 0; b < 2; ++b)
#pragma unroll
                for (int m = 0; m < 4; ++m)
#pragma unroll
                    for (int n = 0; n < 2; ++n) acc[a][b][m][n] = (f32x4){0.f, 0.f, 0.f, 0.f};
        cur = nxt; cA = nA; cB = nB; ++ui;
    }
    PG8_WAIT_V(0);
    if (wr == 0) PG8_BAR;
    PG8_BAR;
    if constexpr (Epi::AFTER_DRAIN) { E.fused(acc, cur, wr, wc, fr, fq, lds, wid, lane); S.done(cur); }
    PG8_STAMP();
    if (STAMP && wid == 0) { stamps[lane] = lane < nts ? (((unsigned long long)(unsigned)ts_hi << 32) | (unsigned)ts_lo) : 0ull;
        if (lane == 62) stamps[62] = rt_entry; if (lane == 63) stamps[63] = (unsigned long long)wall_clock64(); }
#undef PG8_STAMP
#undef PG8_SA
#undef PG8_SB
#undef PG8_STAGE
#undef PG8_LDA
#undef PG8_LDB
#undef PG8_MMA
#undef PG8_WAIT_V
#undef PG8_WAIT_L
#undef PG8_BAR
#undef PG8_SCHED
}

typedef int i32x8 __attribute__((ext_vector_type(8)));
typedef int i32x4 __attribute__((ext_vector_type(4)));
__device__ __forceinline__ i32x8 cat8(bf16x8 lo, bf16x8 hi) { const i32x4 a = __builtin_bit_cast(i32x4, lo), b = __builtin_bit_cast(i32x4, hi); return __builtin_shufflevector(a, b, 0, 1, 2, 3, 4, 5, 6, 7); }
template <class Epi, class Sched, bool STAMP = false>
__device__ __forceinline__ void gemm_phase_f8(PG8_LAS unsigned char* lds, const Gemm g, const Sched& S, const Epi& E, unsigned long long* stamps) {
    const int tid = threadIdx.x, wid = __builtin_amdgcn_readfirstlane(tid >> 6), lane = tid & 63, wr = wid >> 2, wc = wid & 3, fr = lane & 15, fq = lane >> 4;
    const int K = g.K, nt = K / BK;
    int ts_lo = 0, ts_hi = 0, nts = 0; const unsigned long long rt_entry = STAMP ? (unsigned long long)wall_clock64() : 0ull;
#define PG8_STAMP() do { if (STAMP && wid == 0 && nts < 64) { const unsigned long long _c = (unsigned long long)clock64(); \
        ts_lo = (lane == nts) ? (int)(unsigned)_c : ts_lo; ts_hi = (lane == nts) ? (int)(unsigned)(_c >> 32) : ts_hi; ++nts; } } while (0)
    PG8_STAMP();
    unsigned voffA[2], voffB[2];
#pragma unroll
    for (int i = 0; i < 2; ++i) { int R, C; stage_rc(tid * 16 + i * 8192, R, C); const int Rb = Epi::PERM ? ((R & ~31) + perm32(R & 31)) : R;
        voffA[i] = (unsigned)(R * K + C) * 2u; voffB[i] = (unsigned)(Rb * K + C) * 2u; }
    const size_t kstep = (size_t)(BK * 2);
    const size_t hstep = (size_t)HALF * K * 2;
    const size_t tstep = 2 * hstep;
    const unsigned ldsw = (unsigned)wid * 1024u;
    const int aoff = lds_byte(wr * 64 + fr, fq * 8), boff = lds_byte(wc * 32 + fr, fq * 8);
#define PG8_SA(b, h) (((b) * 2 + (h)) * HTB)
#define PG8_SB(b, h) ((4 + (b) * 2 + (h)) * HTB)
#define PG8_STAGE(bufoff, gbase, voff) do { _Pragma("unroll") for (int _i = 0; _i < 2; ++_i) \
        __builtin_amdgcn_global_load_lds((const unsigned*)((const char*)(gbase) + (voff)[_i]), (PG8_LAS unsigned*)(lds + (bufoff) + ldsw + _i * 8192), 16, 0, 0); } while (0)
#define PG8_LDA(dst, b, h) do { _Pragma("unroll") for (int m = 0; m < 4; ++m) _Pragma("unroll") for (int k = 0; k < 2; ++k) dst[m][k] = *(const PG8_LAS bf16x8*)(lds + PG8_SA(b, h) + aoff + m * 2048 + k * 1024); } while (0)
#define PG8_LDB(dst, b, h) do { _Pragma("unroll") for (int n = 0; n < 2; ++n) _Pragma("unroll") for (int k = 0; k < 2; ++k) dst[n][k] = *(const PG8_LAS bf16x8*)(lds + PG8_SB(b, h) + boff + n * 2048 + k * 1024); } while (0)
#define PG8_MMA(ai, bj, At, Bt) do { __builtin_amdgcn_s_setprio(1); _Pragma("unroll") for (int m = 0; m < 4; ++m) _Pragma("unroll") for (int n = 0; n < 2; ++n) \
        acc[ai][bj][m][n] = __builtin_amdgcn_mfma_scale_f32_16x16x128_f8f6f4(cat8(Bt[n][0], Bt[n][1]), cat8(At[m][0], At[m][1]), acc[ai][bj][m][n], 0, 0, 0, 0, 0, 0); __builtin_amdgcn_s_setprio(0); } while (0)
#define PG8_WAIT_V(n) asm volatile("s_waitcnt vmcnt(" #n ")" ::: "memory")
#define PG8_WAIT_L(n) asm volatile("s_waitcnt lgkmcnt(" #n ")" ::: "memory")
#define PG8_BAR __builtin_amdgcn_s_barrier()
#define PG8_SCHED __builtin_amdgcn_sched_barrier(0)
    Unit cur, nxt; int ui = 0;
    if (!S.next(0, cur)) return;
    f32x4 acc[2][2][4][2];
#pragma unroll
    for (int a = 0; a < 2; ++a)
#pragma unroll
        for (int b = 0; b < 2; ++b)
#pragma unroll
            for (int m = 0; m < 4; ++m)
#pragma unroll
                for (int n = 0; n < 2; ++n) acc[a][b][m][n] = (f32x4){0.f, 0.f, 0.f, 0.f};
    bf16x8 At[4][2], B0[2][2], B1[2][2];
    const char* cA = (const char*)g.A + (size_t)cur.pm * tstep; const char* cB = (const char*)g.Bt + (size_t)cur.pn * tstep;
    S.a_ready(cur);
    PG8_STAGE(PG8_SB(0, 0), cB, voffB); PG8_STAGE(PG8_SA(0, 0), cA, voffA); PG8_STAGE(PG8_SB(0, 1), cB + hstep, voffB); PG8_STAGE(PG8_SA(0, 1), cA + hstep, voffA);
    if (wr == 1) PG8_BAR;
    PG8_WAIT_V(4); PG8_BAR;
    PG8_STAGE(PG8_SB(1, 0), cB + kstep, voffB); PG8_STAGE(PG8_SA(1, 0), cA + kstep, voffA); PG8_STAGE(PG8_SB(1, 1), cB + hstep + kstep, voffB);
    PG8_WAIT_V(6); PG8_BAR;
    PG8_STAMP();
    for (;;) {
        const bool has_next = S.next(ui + 1, nxt);
        const char* nA = has_next ? (const char*)g.A + (size_t)nxt.pm * tstep : cA; const char* nB = has_next ? (const char*)g.Bt + (size_t)nxt.pn * tstep : cB;
        for (int t = 0; t < nt; t += 2) {
            const bool last = (t == nt - 2);
            const char* a1 = cA + (size_t)(t + 1) * kstep;
            const char* a2 = last ? nA : cA + (size_t)(t + 2) * kstep; const char* b2 = last ? nB : cB + (size_t)(t + 2) * kstep;
            const char* a3 = a2 + kstep; const char* b3 = b2 + kstep;
            if (last && has_next) S.a_ready(nxt);
            PG8_LDB(B0, 0, 0); PG8_SCHED; PG8_LDA(At, 0, 0); PG8_STAGE(PG8_SA(1, 1), a1 + hstep, voffA);
            PG8_WAIT_L(8); PG8_BAR; PG8_WAIT_L(0); PG8_MMA(0, 0, At, B0); PG8_BAR; PG8_SCHED;
            PG8_LDB(B1, 0, 1); PG8_STAGE(PG8_SB(0, 0), b2, voffB);
            PG8_BAR; PG8_WAIT_L(0); PG8_MMA(0, 1, At, B1); PG8_BAR;
            PG8_LDA(At, 0, 1); PG8_STAGE(PG8_SA(0, 0), a2, voffA);
            PG8_BAR; PG8_WAIT_L(0); PG8_MMA(1, 0, At, B0); PG8_BAR; PG8_SCHED;
            PG8_STAGE(PG8_SB(0, 1), b2 + hstep, voffB);
            PG8_WAIT_V(6); PG8_BAR; PG8_MMA(1, 1, At, B1); PG8_BAR;
            PG8_LDB(B0, 1, 0); PG8_SCHED; PG8_LDA(At, 1, 0); PG8_STAGE(PG8_SA(0, 1), a2 + hstep, voffA);
            PG8_WAIT_L(8); PG8_BAR; PG8_WAIT_L(0); PG8_MMA(0, 0, At, B0); PG8_BAR; PG8_SCHED;
            PG8_LDB(B1, 1, 1); PG8_STAGE(PG8_SB(1, 0), b3, voffB);
            PG8_BAR; PG8_WAIT_L(0); PG8_MMA(0, 1, At, B1); PG8_BAR;
            PG8_LDA(At, 1, 1); PG8_STAGE(PG8_SA(1, 0), a3, voffA);
            PG8_BAR; PG8_WAIT_L(0); PG8_MMA(1, 0, At, B0); PG8_BAR; PG8_SCHED;
            PG8_STAGE(PG8_SB(1, 1), b3 + hstep, voffB);
            PG8_WAIT_V(6); PG8_BAR; PG8_MMA(1, 1, At, B1); PG8_BAR;
        }
        PG8_STAMP();
        if constexpr (!Epi::AFTER_DRAIN) { E(acc, cur, wr, wc, fr, fq); S.done(cur); }
        PG8_STAMP();
        if (!has_next) break;
#pragma unroll
        for (int a = 0; a < 2; ++a)
#pragma unroll
            for (int b = 0; b < 2; ++b)
#pragma unroll
                for (int m = 0; m < 4; ++m)
#pragma unroll
                    for (int n = 0; n < 2; ++n) acc[a][b][m][n] = (f32x4){0.f, 0.f, 0.f, 0.f};
        cur = nxt; cA = nA; cB = nB; ++ui;
    }
    PG8_WAIT_V(0);
    if (wr == 0) PG8_BAR;
    PG8_BAR;
    if constexpr (Epi::AFTER_DRAIN) { E.fused(acc, cur, wr, wc, fr, fq, lds, wid, lane); S.done(cur); }
    PG8_STAMP();
    if (STAMP && wid == 0) { stamps[lane] = lane < nts ? (((unsigned long long)(unsigned)ts_hi << 32) | (unsigned)ts_lo) : 0ull;
        if (lane == 62) stamps[62] = rt_entry; if (lane == 63) stamps[63] = (unsigned long long)wall_clock64(); }
#undef PG8_STAMP
#undef PG8_SA
#undef PG8_SB
#undef PG8_STAGE
#undef PG8_LDA
#undef PG8_LDB
#undef PG8_MMA
#undef PG8_WAIT_V
#undef PG8_WAIT_L
#undef PG8_BAR
#undef PG8_SCHED
}

template <class Epi, class Sched, bool STAMP = false>
__device__ __forceinline__ void gemm_phase2(PG8_LAS unsigned char* lds, const Gemm2 g, const Sched& S, const Epi& E, unsigned long long* stamps) {
    const int tid = threadIdx.x, wid = __builtin_amdgcn_readfirstlane(tid >> 6), lane = tid & 63, wr = wid >> 2, wc = wid & 3, fr = lane & 15, fq = lane >> 4;
    const int K = g.K, nt1 = g.nt1, nt = g.nt;
    int ts_lo = 0, ts_hi = 0, nts = 0; const unsigned long long rt_entry = STAMP ? (unsigned long long)wall_clock64() : 0ull;
#define PG8_STAMP() do { if (STAMP && wid == 0 && nts < 64) { const unsigned long long _c = (unsigned long long)clock64(); \
        ts_lo = (lane == nts) ? (int)(unsigned)_c : ts_lo; ts_hi = (lane == nts) ? (int)(unsigned)(_c >> 32) : ts_hi; ++nts; } } while (0)
    PG8_STAMP();
    unsigned voffA[2], voffB[2];
#pragma unroll
    for (int i = 0; i < 2; ++i) { int R, C; stage_rc(tid * 16 + i * 8192, R, C); const int Rb = Epi::PERM ? ((R & ~31) + perm32(R & 31)) : R;
        voffA[i] = (unsigned)(R * K + C) * 2u; voffB[i] = (unsigned)(Rb * K + C) * 2u; }
    const size_t kstep = (size_t)(BK * 2);
    const size_t hstep = (size_t)HALF * K * 2;
    const size_t tstep = 2 * hstep;
    const unsigned ldsw = (unsigned)wid * 1024u;
    const int aoff = lds_byte(wr * 64 + fr, fq * 8), boff = lds_byte(wc * 32 + fr, fq * 8);
#define PG8_SA(b, h) (((b) * 2 + (h)) * HTB)
#define PG8_SB(b, h) ((4 + (b) * 2 + (h)) * HTB)
#define PG8_STAGE(bufoff, gbase, voff) do { _Pragma("unroll") for (int _i = 0; _i < 2; ++_i) \
        __builtin_amdgcn_global_load_lds((const unsigned*)((const char*)(gbase) + (voff)[_i]), (PG8_LAS unsigned*)(lds + (bufoff) + ldsw + _i * 8192), 16, 0, 0); } while (0)
#define PG8_LDA(dst, b, h) do { _Pragma("unroll") for (int m = 0; m < 4; ++m) _Pragma("unroll") for (int k = 0; k < 2; ++k) dst[m][k] = *(const PG8_LAS bf16x8*)(lds + PG8_SA(b, h) + aoff + m * 2048 + k * 1024); } while (0)
#define PG8_LDB(dst, b, h) do { _Pragma("unroll") for (int n = 0; n < 2; ++n) _Pragma("unroll") for (int k = 0; k < 2; ++k) dst[n][k] = *(const PG8_LAS bf16x8*)(lds + PG8_SB(b, h) + boff + n * 2048 + k * 1024); } while (0)
#define PG8_MMA(ai, bj, At, Bt) do { __builtin_amdgcn_s_setprio(1); _Pragma("unroll") for (int m = 0; m < 4; ++m) _Pragma("unroll") for (int n = 0; n < 2; ++n) _Pragma("unroll") for (int k = 0; k < 2; ++k) \
        acc[ai][bj][m][n] = __builtin_amdgcn_mfma_f32_16x16x32_bf16(Bt[n][k], At[m][k], acc[ai][bj][m][n], 0, 0, 0); __builtin_amdgcn_s_setprio(0); } while (0)
#define PG8_WAIT_V(n) asm volatile("s_waitcnt vmcnt(" #n ")" ::: "memory")
#define PG8_WAIT_L(n) asm volatile("s_waitcnt lgkmcnt(" #n ")" ::: "memory")
#define PG8_BAR __builtin_amdgcn_s_barrier()
#define PG8_SCHED __builtin_amdgcn_sched_barrier(0)
    Unit cur, nxt; int ui = 0;
    if (!S.next(0, cur)) return;
    f32x4 acc[2][2][4][2];
#pragma unroll
    for (int a = 0; a < 2; ++a)
#pragma unroll
        for (int b = 0; b < 2; ++b)
#pragma unroll
            for (int m = 0; m < 4; ++m)
#pragma unroll
                for (int n = 0; n < 2; ++n) acc[a][b][m][n] = (f32x4){0.f, 0.f, 0.f, 0.f};
    bf16x8 At[4][2], B0[2][2], B1[2][2];
    const char* cA = (const char*)g.A + (size_t)cur.pm * tstep; const char* cB = (const char*)g.Bt + (size_t)cur.pn * tstep;
    const char* dA = (const char*)g.A2 + (size_t)cur.pm * tstep - (size_t)nt1 * kstep; const char* dB = (const char*)g.Bt2 + (size_t)cur.pn * tstep - (size_t)nt1 * kstep;
#define PG8_TA(t_) ((((t_) < nt1) ? cA : dA) + (size_t)(t_) * kstep)
#define PG8_TB(t_) ((((t_) < nt1) ? cB : dB) + (size_t)(t_) * kstep)
    S.a_ready(cur);
    PG8_STAGE(PG8_SB(0, 0), cB, voffB); PG8_STAGE(PG8_SA(0, 0), cA, voffA); PG8_STAGE(PG8_SB(0, 1), cB + hstep, voffB); PG8_STAGE(PG8_SA(0, 1), cA + hstep, voffA);
    if (wr == 1) PG8_BAR;
    PG8_WAIT_V(4); PG8_BAR;
    PG8_STAGE(PG8_SB(1, 0), cB + kstep, voffB); PG8_STAGE(PG8_SA(1, 0), cA + kstep, voffA); PG8_STAGE(PG8_SB(1, 1), cB + hstep + kstep, voffB);
    PG8_WAIT_V(6); PG8_BAR;
    PG8_STAMP();
    for (;;) {
        const bool has_next = S.next(ui + 1, nxt);
        const char* nA = has_next ? (const char*)g.A + (size_t)nxt.pm * tstep : cA; const char* nB = has_next ? (const char*)g.Bt + (size_t)nxt.pn * tstep : cB;
        const char* ndA = has_next ? (const char*)g.A2 + (size_t)nxt.pm * tstep - (size_t)nt1 * kstep : dA; const char* ndB = has_next ? (const char*)g.Bt2 + (size_t)nxt.pn * tstep - (size_t)nt1 * kstep : dB;
        for (int t = 0; t < nt; t += 2) {
            const bool last = (t == nt - 2);
            if (t == nt1) E.mid(acc, cur, wr, wc, fr, fq);
            const char* a1 = PG8_TA(t + 1);
            const char* a2 = last ? nA : PG8_TA(t + 2); const char* b2 = last ? nB : PG8_TB(t + 2);
            const char* a3 = a2 + kstep; const char* b3 = b2 + kstep;
            if (last && has_next) S.a_ready(nxt);
            PG8_LDB(B0, 0, 0); PG8_SCHED; PG8_LDA(At, 0, 0); PG8_STAGE(PG8_SA(1, 1), a1 + hstep, voffA);
            PG8_WAIT_L(8); PG8_BAR; PG8_WAIT_L(0); PG8_MMA(0, 0, At, B0); PG8_BAR; PG8_SCHED;
            PG8_LDB(B1, 0, 1); PG8_STAGE(PG8_SB(0, 0), b2, voffB);
            PG8_BAR; PG8_WAIT_L(0); PG8_MMA(0, 1, At, B1); PG8_BAR;
            PG8_LDA(At, 0, 1); PG8_STAGE(PG8_SA(0, 0), a2, voffA);
            PG8_BAR; PG8_WAIT_L(0); PG8_MMA(1, 0, At, B0); PG8_BAR; PG8_SCHED;
            PG8_STAGE(PG8_SB(0, 1), b2 + hstep, voffB);
            PG8_WAIT_V(6); PG8_BAR; PG8_MMA(1, 1, At, B1); PG8_BAR;
            PG8_LDB(B0, 1, 0); PG8_SCHED; PG8_LDA(At, 1, 0); PG8_STAGE(PG8_SA(0, 1), a2 + hstep, voffA);
            PG8_WAIT_L(8); PG8_BAR; PG8_WAIT_L(0); PG8_MMA(0, 0, At, B0); PG8_BAR; PG8_SCHED;
            PG8_LDB(B1, 1, 1); PG8_STAGE(PG8_SB(1, 0), b3, voffB);
            PG8_BAR; PG8_WAIT_L(0); PG8_MMA(0, 1, At, B1); PG8_BAR;
            PG8_LDA(At, 1, 1); PG8_STAGE(PG8_SA(1, 0), a3, voffA);
            PG8_BAR; PG8_WAIT_L(0); PG8_MMA(1, 0, At, B0); PG8_BAR; PG8_SCHED;
            PG8_STAGE(PG8_SB(1, 1), b3 + hstep, voffB);
            PG8_WAIT_V(6); PG8_BAR; PG8_MMA(1, 1, At, B1); PG8_BAR;
        }
        PG8_STAMP();
        if constexpr (!Epi::AFTER_DRAIN) { E(acc, cur, wr, wc, fr, fq); S.done(cur); }
        PG8_STAMP();
        if (!has_next) break;
#pragma unroll
        for (int a = 0; a < 2; ++a)
#pragma unroll
            for (int b = 0; b < 2; ++b)
#pragma unroll
                for (int m = 0; m < 4; ++m)
#pragma unroll
                    for (int n = 0; n < 2; ++n) acc[a][b][m][n] = (f32x4){0.f, 0.f, 0.f, 0.f};
        cur = nxt; cA = nA; cB = nB; dA = ndA; dB = ndB; ++ui;
    }
    PG8_WAIT_V(0);
    if (wr == 0) PG8_BAR;
    PG8_BAR;
    if constexpr (Epi::AFTER_DRAIN) { E.fused(acc, cur, wr, wc, fr, fq, lds, wid, lane); S.done(cur); }
    PG8_STAMP();
    if (STAMP && wid == 0) { stamps[lane] = lane < nts ? (((unsigned long long)(unsigned)ts_hi << 32) | (unsigned)ts_lo) : 0ull;
        if (lane == 62) stamps[62] = rt_entry; if (lane == 63) stamps[63] = (unsigned long long)wall_clock64(); }
#undef PG8_STAMP
#undef PG8_TA
#undef PG8_TB
#undef PG8_SA
#undef PG8_SB
#undef PG8_STAGE
#undef PG8_LDA
#undef PG8_LDB
#undef PG8_MMA
#undef PG8_WAIT_V
#undef PG8_WAIT_L
#undef PG8_BAR
#undef PG8_SCHED
}
}
#define XB_TMO      128
#define XB_XCNT(j)  (256  + 64 * (j))
#define XB_XSUB(j)  (1280 + 64 * (j))
#define XB_XGEN(j)  (2304 + 64 * (j))
#define XB_TOP      3328
#define XB_TOPGEN   3392
#define XCD_BAR_WORDS 3456
#define XB_SPIN_CAP (1u << 18)
#define LAS __attribute__((address_space(3)))

__device__ __forceinline__ unsigned xb_ld(unsigned* p)              { return __hip_atomic_load(p, __ATOMIC_RELAXED, __HIP_MEMORY_SCOPE_AGENT); }
__device__ __forceinline__ unsigned xb_add(unsigned* p, unsigned v) { return __hip_atomic_fetch_add(p, v, __ATOMIC_RELAXED, __HIP_MEMORY_SCOPE_AGENT); }
__device__ __forceinline__ unsigned xb_xcc_id() { return (unsigned)__builtin_amdgcn_s_getreg((3 << 11) | 20) & 0xFu; }
#define XB_SPIN(cond, bar) do { unsigned _sp = 0; while (cond) { __builtin_amdgcn_s_sleep(1); \
    if ((++_sp & 255u) == 0u) { if (xb_ld(&(bar)[XB_TMO])) break; if (_sp > XB_SPIN_CAP) { atomicAdd(&(bar)[XB_TMO], 1u); break; } } } } while (0)

__device__ __forceinline__ void xb_wait_ge(unsigned* p, unsigned target) {
    unsigned t; unsigned n = 0u;
    asm volatile(
        "s_nop 4\n\t"
        "global_load_dword v250, %2, %3 sc1\n\t"
        "s_sleep 2\n\t"
        "global_load_dword v251, %2, %3 sc1\n"
        ".Lxbw_top%=:\n\t"
        "s_sleep 2\n\t"
        "global_load_dword v252, %2, %3 sc1\n\t"
        "s_waitcnt vmcnt(2)\n\t"
        "v_sub_u32_e32 %0, v250, %4\n\t"
        "v_cmp_le_i32_e32 vcc, 0, %0\n\t"
        "s_cbranch_vccnz .Lxbw_out%=\n\t"
        "s_sleep 2\n\t"
        "global_load_dword v250, %2, %3 sc1\n\t"
        "s_waitcnt vmcnt(2)\n\t"
        "v_sub_u32_e32 %0, v251, %4\n\t"
        "v_cmp_le_i32_e32 vcc, 0, %0\n\t"
        "s_cbranch_vccnz .Lxbw_out%=\n\t"
        "s_sleep 2\n\t"
        "global_load_dword v251, %2, %3 sc1\n\t"
        "s_waitcnt vmcnt(2)\n\t"
        "v_sub_u32_e32 %0, v252, %4\n\t"
        "v_cmp_le_i32_e32 vcc, 0, %0\n\t"
        "s_cbranch_vccnz .Lxbw_out%=\n\t"
        "s_add_u32 %1, %1, 1\n\t"
        "s_cmp_lt_u32 %1, 0x40000\n\t"
        "s_cbranch_scc1 .Lxbw_top%=\n"
        ".Lxbw_out%=:"
        : "=&v"(t), "+s"(n) : "v"(0u), "s"(p), "v"(target) : "v250", "v251", "v252", "vcc", "scc", "memory");
}

struct XcdBarrier {
    unsigned* bar; unsigned x;
    volatile LAS unsigned* st;
};

__device__ __forceinline__ XcdBarrier xcd_barrier_post(unsigned* bar, volatile LAS unsigned* st) {
    XcdBarrier b; b.bar = bar; b.x = xb_xcc_id(); b.st = st;
    if (threadIdx.x == 0) (void)xb_add(&bar[XB_XCNT(b.x)], 1u);
    return b;
}
__device__ __forceinline__ void xcd_barrier_complete(unsigned* bar, unsigned x, unsigned& nloc, unsigned& nx, unsigned& pr0, unsigned& pr1, unsigned& reg) {
    const unsigned G = gridDim.x * gridDim.y * gridDim.z;
    unsigned sum, cnt, mine, sp = 0u, s8, a8, q0, q1;
    for (;;) {
        sum = 0u; cnt = 0u; mine = 0u; s8 = 0u; a8 = 1u; q0 = 0u; q1 = 0u;
#pragma unroll
        for (unsigned j = 0; j < 16; ++j) { const unsigned c = xb_ld(&bar[XB_XCNT(j)]); sum += c; cnt += (c > 0u) ? 1u : 0u; mine = (j == x) ? c : mine;
            if (j < 8u) { s8 += c; a8 &= (c > 0u) ? 1u : 0u; }
            q0 = (j == (x & 6u)) ? c : q0; q1 = (j == ((x & 6u) | 1u)) ? c : q1; }
        pr0 = q0; pr1 = q1; reg = (sum == G && s8 == G && a8 != 0u && x < 8u) ? 1u : 0u;
        if (sum == G) break;
        __builtin_amdgcn_s_sleep(1);
        if ((++sp & 255u) == 0u) { if (xb_ld(&bar[XB_TMO])) break; if (sp > XB_SPIN_CAP) { atomicAdd(&bar[XB_TMO], 1u); break; } }
    }
    nloc = mine > 0u ? mine : 1u; nx = cnt > 0u ? cnt : 1u;
}

template <bool ACQ = true> __device__ __forceinline__ void xcd_barrier(const XcdBarrier& b, const unsigned gen) {
    asm volatile("s_waitcnt vmcnt(0)" ::: "memory");
    __syncthreads();
    if (threadIdx.x == 64) {
        if (ACQ) { __builtin_amdgcn_fence(__ATOMIC_ACQUIRE, "agent");
            asm volatile("s_waitcnt vmcnt(0)" ::: "memory"); }
        b.st[3] = b.st[3] + 1u;
    }
    if (threadIdx.x == 0) {
        unsigned* bar = b.bar;
        __builtin_amdgcn_s_waitcnt(0);
        const unsigned old = xb_add(&bar[XB_XSUB(b.x)], 1u);
        unsigned nloc = b.st[0], nx = b.st[1];
        if (nloc == 0u) { unsigned q0_, q1_, rg_; xcd_barrier_complete(bar, b.x, nloc, nx, q0_, q1_, rg_); b.st[0] = nloc; b.st[1] = nx; b.st[-1] = q0_; b.st[-2] = q1_; b.st[-3] = rg_; }
        if (old + 1u == (gen + 1u) * nloc) {
            __builtin_amdgcn_fence(__ATOMIC_RELEASE, "agent");
            asm volatile("s_waitcnt vmcnt(0)" ::: "memory");
            const unsigned og = xb_add(&bar[XB_TOP], 1u);
            const unsigned tg = gen;
            if (og + 1u != (tg + 1u) * nx) xb_wait_ge(&bar[XB_TOP], (tg + 1u) * nx);
            { unsigned sp_ = 0u; while (b.st[3] != gen + 1u) { __builtin_amdgcn_s_sleep(1); if (++sp_ > XB_SPIN_CAP) break; } }
            xb_add(&bar[XB_XGEN(b.x)], 1u);
        } else {
            xb_wait_ge(&bar[XB_XGEN(b.x)], gen + 1u);
        }
        asm volatile("s_waitcnt vmcnt(0)" ::: "memory");
    }
    __syncthreads();
}

typedef unsigned short bf16;
using pg8::f32x4;
constexpr int T = 16384, SEQ = 4096, D = 1024, DIN = 4768, DINP = 4864;
constexpr int C_A = 0, C_B = 512, C_R = 1024, C_K = 1536, C_V = 2048, C_LW = 2560, C_LA = 2592, C_LG = 2624, C_GC = 2720, C_GR = 3744;
constexpr size_t MiB = 1u << 20;
constexpr size_t WS_WIN_T = 0, WS_PW_T = 10 * MiB, WS_WO_T = 11 * MiB, WS_WOUT_T = 12 * MiB, WS_WQ_T = 14 * MiB, WS_KEYS = 18 * MiB,
                 WS_BONUS = 18 * MiB + 512 * 1024, WS_XN = 20 * MiB, WS_PROJ = 52 * MiB, WS_LD = 204 * MiB, WS_YN = 236 * MiB, WS_END = 252 * MiB;
constexpr size_t WS_BETA = WS_XN, WS_G = WS_XN + 16 * MiB, WS_M = WS_LD;
constexpr size_t WS_Q = WS_PROJ, WS_UB = WS_PROJ + 64 * MiB, WS_VB = WS_PROJ + 96 * MiB, WS_EID = WS_PROJ + 128 * MiB, WS_GATE = WS_PROJ + 136 * MiB;

__device__ __forceinline__ bf16 f2bf(float f) { return __builtin_bit_cast(unsigned short, (__bf16)f); }
__device__ __forceinline__ float bf2f(bf16 b) { return __uint_as_float(((unsigned)b) << 16); }
__device__ __forceinline__ float bflo(unsigned w) { return __uint_as_float(w << 16); }
__device__ __forceinline__ float bfhi(unsigned w) { return __uint_as_float(w & 0xFFFF0000u); }
typedef __bf16 bf16x2_t __attribute__((ext_vector_type(2)));
__device__ __forceinline__ unsigned pack2(float lo, float hi) { bf16x2_t v; v[0] = (__bf16)lo; v[1] = (__bf16)hi; return __builtin_bit_cast(unsigned, v); }
__device__ __forceinline__ float wave_sum(float v) {
#pragma unroll
    for (int o = 32; o > 0; o >>= 1) v += __shfl_xor(v, o, 64);
    return v;
}
__device__ __forceinline__ float sigmoidf_(float x) { return __builtin_amdgcn_rcpf(1.f + __expf(-x)); }
__device__ __forceinline__ float tanhf_(float x) { return 1.f - 2.f * __builtin_amdgcn_rcpf(1.f + __expf(2.f * x)); }
__device__ __forceinline__ void unpack8(const uint4 v, float (&f)[8]) {
    f[0] = bflo(v.x); f[1] = bfhi(v.x); f[2] = bflo(v.y); f[3] = bfhi(v.y); f[4] = bflo(v.z); f[5] = bfhi(v.z); f[6] = bflo(v.w); f[7] = bfhi(v.w);
}
__device__ __forceinline__ uint4 pack8(const float (&f)[8]) {
    uint4 v; v.x = pack2(f[0], f[1]); v.y = pack2(f[2], f[3]); v.z = pack2(f[4], f[5]); v.w = pack2(f[6], f[7]); return v;
}

__device__ __forceinline__ int ph_transpose(unsigned char* shm, int bid, int nblk, int tile0, const float* __restrict__ src, bf16* __restrict__ dst, int K, int N, int Npad, const float* __restrict__ kscale = nullptr) {
    float (*tile)[65] = (float (*)[65])shm;
    const int ntn = Npad / 64, ntiles = ntn * (K / 64);
    int first = bid - (tile0 % nblk); if (first < 0) first += nblk;
    for (int tl = first; tl < ntiles; tl += nblk) {
        const int n0 = (tl % ntn) * 64, k0 = (tl / ntn) * 64;
        __syncthreads();
        for (int i = threadIdx.x; i < 64 * 64; i += 512) { const int kk = i >> 6, nn = i & 63; float v = 0.f; if (n0 + nn < N) v = src[(size_t)(k0 + kk) * N + n0 + nn]; if (kscale) v *= kscale[k0 + kk]; tile[kk][nn] = v; }
        __syncthreads();
        for (int i = threadIdx.x; i < 64 * 64; i += 512) { const int nn = i >> 6, kk = i & 63; dst[(size_t)(n0 + nn) * K + k0 + kk] = f2bf(tile[kk][nn]); }
    }
    return ntiles;
}
__device__ __forceinline__ int ph_transpose_reg(int bid, int nblk, int tile0, const float* __restrict__ src, bf16* __restrict__ dst, int K, int N, int Npad) {
    const int lane = threadIdx.x & 63, n4 = lane & 7, j = lane >> 3, ntn = Npad / 32, ntiles = ntn * (K / 64);
    int first = bid * 8 + (int)(threadIdx.x >> 6) - (tile0 % (nblk * 8)); if (first < 0) first += nblk * 8;
    for (int tl = first; tl < ntiles; tl += nblk * 8) {
        const int n0 = (tl % ntn) * 32 + 4 * n4, k0 = (tl / ntn) * 64 + 8 * j;
        float4 v[8];
        if (n0 < N) {
#pragma unroll
            for (int i = 0; i < 8; ++i) v[i] = *(const float4*)(src + (size_t)(k0 + i) * N + n0);
        } else {
#pragma unroll
            for (int i = 0; i < 8; ++i) v[i] = make_float4(0.f, 0.f, 0.f, 0.f);
        }
        uint4 o;
        o.x = pack2(v[0].x, v[1].x); o.y = pack2(v[2].x, v[3].x); o.z = pack2(v[4].x, v[5].x); o.w = pack2(v[6].x, v[7].x); *(uint4*)(dst + (size_t)(n0 + 0) * K + k0) = o;
        o.x = pack2(v[0].y, v[1].y); o.y = pack2(v[2].y, v[3].y); o.z = pack2(v[4].y, v[5].y); o.w = pack2(v[6].y, v[7].y); *(uint4*)(dst + (size_t)(n0 + 1) * K + k0) = o;
        o.x = pack2(v[0].z, v[1].z); o.y = pack2(v[2].z, v[3].z); o.z = pack2(v[4].z, v[5].z); o.w = pack2(v[6].z, v[7].z); *(uint4*)(dst + (size_t)(n0 + 2) * K + k0) = o;
        o.x = pack2(v[0].w, v[1].w); o.y = pack2(v[2].w, v[3].w); o.z = pack2(v[4].w, v[5].w); o.w = pack2(v[6].w, v[7].w); *(uint4*)(dst + (size_t)(n0 + 3) * K + k0) = o;
    }
    return ntiles;
}
__device__ __forceinline__ void ph_cvt(int bid, int nblk, const float* __restrict__ src, bf16* __restrict__ dst, size_t n4) {
    for (size_t i = (size_t)bid * 512 + threadIdx.x; i < n4; i += (size_t)nblk * 512) {
        const float4 v = ((const float4*)src)[i]; uint2 o; o.x = pack2(v.x, v.y); o.y = pack2(v.z, v.w); ((uint2*)dst)[i] = o; }
}
__device__ __forceinline__ void ph_rmsnorm(int bid, int nblk, const float* __restrict__ x, const float* __restrict__ g, bf16* __restrict__ out, int rows) {
    const int wave = (bid * 512 + threadIdx.x) >> 6, nw = (nblk * 512) >> 6, lane = threadIdx.x & 63;
    float4 gg[4], nx[4];
#pragma unroll
    for (int i = 0; i < 4; ++i) gg[i] = ((const float4*)g)[lane + 64 * i];
    if (wave < rows) {
#pragma unroll
        for (int i = 0; i < 4; ++i) nx[i] = ((const float4*)(x + (size_t)wave * D))[lane + 64 * i];
    }
    for (int r = wave; r < rows; r += nw) {
        float4 v[4]; float ss = 0.f;
#pragma unroll
        for (int i = 0; i < 4; ++i) v[i] = nx[i];
        if (r + nw < rows) {
#pragma unroll
            for (int i = 0; i < 4; ++i) nx[i] = ((const float4*)(x + (size_t)(r + nw) * D))[lane + 64 * i];
        }
#pragma unroll
        for (int i = 0; i < 4; ++i) ss += v[i].x * v[i].x + v[i].y * v[i].y + v[i].z * v[i].z + v[i].w * v[i].w;
        ss = wave_sum(ss);
        const float sc = rsqrtf(ss * (1.f / D) + 1e-6f);
#pragma unroll
        for (int i = 0; i < 4; ++i) { uint2 o; o.x = pack2(v[i].x * sc * gg[i].x, v[i].y * sc * gg[i].y); o.y = pack2(v[i].z * sc * gg[i].z, v[i].w * sc * gg[i].w);
            ((uint2*)(out + (size_t)r * D))[lane + 64 * i] = o; }
    }
}

template <class F> struct EpiGen {
    static constexpr bool PERM = true, AFTER_DRAIN = false;
    F f;
    __device__ __forceinline__ void operator()(const f32x4 (&acc)[2][2][4][2], const pg8::Unit& u, int wr, int wc, int fr, int fq) const {
        const int row0 = u.pm * 256 + wr * 64 + fr, col0 = u.pn * 256 + wc * 32 + 8 * fq;
#pragma unroll
        for (int ai = 0; ai < 2; ++ai)
#pragma unroll
            for (int m = 0; m < 4; ++m)
#pragma unroll
                for (int bj = 0; bj < 2; ++bj) f(row0 + ai * 128 + m * 16, col0 + bj * 128, acc[ai][bj][m][0], acc[ai][bj][m][1]);
    }
};
struct FStoreBf16 { bf16* O; int ldc;
    __device__ __forceinline__ void operator()(int row, int col, f32x4 a, f32x4 b) const {
        uint4 o; o.x = pack2(a[0], a[1]); o.y = pack2(a[2], a[3]); o.z = pack2(b[0], b[1]); o.w = pack2(b[2], b[3]);
        typedef unsigned nt4 __attribute__((ext_vector_type(4))); nt4 w; w[0] = o.x; w[1] = o.y; w[2] = o.z; w[3] = o.w;
        __builtin_nontemporal_store(w, (nt4*)(O + (size_t)row * ldc + col)); } };
struct FConvM { bf16* M; const bf16* proj; const float* bias;
    __device__ __forceinline__ void operator()(int row, int col, f32x4 a, f32x4 b) const {
        float gl[8]; unpack8(*(const uint4*)(proj + (size_t)row * DINP + C_GC + col), gl);
        const float4 b0 = *(const float4*)(bias + col), b1 = *(const float4*)(bias + col + 4);
        float o[8] = {a[0] + b0.x, a[1] + b0.y, a[2] + b0.z, a[3] + b0.w, b[0] + b1.x, b[1] + b1.y, b[2] + b1.z, b[3] + b1.w};
#pragma unroll
        for (int i = 0; i < 8; ++i) o[i] *= sigmoidf_(gl[i]);
        *(uint4*)(M + (size_t)row * D + col) = pack8(o); } };
struct FRwM { bf16* M; const bf16* proj;
    __device__ __forceinline__ void operator()(int row, int col, f32x4 a, f32x4 b) const {
        float gl[8], mo[8]; unpack8(*(const uint4*)(proj + (size_t)row * DINP + C_GR + col), gl); unpack8(*(const uint4*)(M + (size_t)row * D + col), mo);
        float o[8] = {a[0], a[1], a[2], a[3], b[0], b[1], b[2], b[3]};
#pragma unroll
        for (int i = 0; i < 8; ++i) o[i] = mo[i] + o[i] * sigmoidf_(gl[i]);
        *(uint4*)(M + (size_t)row * D + col) = pack8(o); } };
struct FResX1 { const float* x; float* x1;
    __device__ __forceinline__ void operator()(int row, int col, f32x4 a, f32x4 b) const {
        const float4 x0 = *(const float4*)(x + (size_t)row * D + col), x1v = *(const float4*)(x + (size_t)row * D + col + 4);
        *(float4*)(x1 + (size_t)row * D + col) = make_float4(x0.x + a[0], x0.y + a[1], x0.z + a[2], x0.w + a[3]);
        *(float4*)(x1 + (size_t)row * D + col + 4) = make_float4(x1v.x + b[0], x1v.y + b[1], x1v.z + b[2], x1v.w + b[3]); } };

template <class F> struct EpiGen2 {
    static constexpr bool PERM = true, AFTER_DRAIN = false;
    F f;
    __device__ __forceinline__ void operator()(const f32x4 (&acc)[2][2][4][2], const pg8::Unit& u, int wr, int wc, int fr, int fq) const {
        const int row0 = u.pm * 256 + wr * 64 + fr, col0 = u.pn * 256 + wc * 32 + 8 * fq;
#pragma unroll
        for (int ai = 0; ai < 2; ++ai) {
            typename F::Pre P[4][2];
#pragma unroll
            for (int m = 0; m < 4; ++m)
#pragma unroll
                for (int bj = 0; bj < 2; ++bj) P[m][bj] = f.pre(row0 + ai * 128 + m * 16, col0 + bj * 128);
#pragma unroll
            for (int m = 0; m < 4; ++m)
#pragma unroll
                for (int bj = 0; bj < 2; ++bj) f.post(row0 + ai * 128 + m * 16, col0 + bj * 128, acc[ai][bj][m][0], acc[ai][bj][m][1], P[m][bj]);
        }
    }
};
struct FConvM2 { bf16* M; const bf16* proj; const float* bias;
    struct Pre { uint4 g; };
    __device__ __forceinline__ Pre pre(int row, int col) const { Pre p; p.g = *(const uint4*)(proj + (size_t)row * DINP + C_GC + col); return p; }
    __device__ __forceinline__ void post(int row, int col, f32x4 a, f32x4 b, const Pre& p) const {
        float gl[8]; unpack8(p.g, gl);
        const float4 b0 = *(const float4*)(bias + col), b1 = *(const float4*)(bias + col + 4);
        float o[8] = {a[0] + b0.x, a[1] + b0.y, a[2] + b0.z, a[3] + b0.w, b[0] + b1.x, b[1] + b1.y, b[2] + b1.z, b[3] + b1.w};
#pragma unroll
        for (int i = 0; i < 8; ++i) o[i] *= sigmoidf_(gl[i]);
        *(uint4*)(M + (size_t)row * D + col) = pack8(o); } };
struct FRwM2 { bf16* M; const bf16* proj;
    struct Pre { uint4 g, m; };
    __device__ __forceinline__ Pre pre(int row, int col) const { Pre p; p.g = *(const uint4*)(proj + (size_t)row * DINP + C_GR + col); p.m = *(const uint4*)(M + (size_t)row * D + col); return p; }
    __device__ __forceinline__ void post(int row, int col, f32x4 a, f32x4 b, const Pre& p) const {
        float gl[8], mo[8]; unpack8(p.g, gl); unpack8(p.m, mo);
        float o[8] = {a[0], a[1], a[2], a[3], b[0], b[1], b[2], b[3]};
#pragma unroll
        for (int i = 0; i < 8; ++i) o[i] = mo[i] + o[i] * sigmoidf_(gl[i]);
        *(uint4*)(M + (size_t)row * D + col) = pack8(o); } };
struct FResX12B { const float* x; bf16* x1;
    struct Pre { float4 a, b; };
    __device__ __forceinline__ Pre pre(int row, int col) const { Pre p; p.a = *(const float4*)(x + (size_t)row * D + col); p.b = *(const float4*)(x + (size_t)row * D + col + 4); return p; }
    __device__ __forceinline__ void post(int row, int col, f32x4 a, f32x4 b, const Pre& p) const {
        *(uint4*)(x1 + (size_t)row * D + col) = make_uint4(pack2(p.a.x + a[0], p.a.y + a[1]), pack2(p.a.z + a[2], p.a.w + a[3]), pack2(p.b.x + b[0], p.b.y + b[1]), pack2(p.b.z + b[2], p.b.w + b[3])); } };
struct FResX12 { const float* x; float* x1;
    struct Pre { float4 a, b; };
    __device__ __forceinline__ Pre pre(int row, int col) const { Pre p; p.a = *(const float4*)(x + (size_t)row * D + col); p.b = *(const float4*)(x + (size_t)row * D + col + 4); return p; }
    __device__ __forceinline__ void post(int row, int col, f32x4 a, f32x4 b, const Pre& p) const {
        *(float4*)(x1 + (size_t)row * D + col) = make_float4(p.a.x + a[0], p.a.y + a[1], p.a.z + a[2], p.a.w + a[3]);
        *(float4*)(x1 + (size_t)row * D + col + 4) = make_float4(p.b.x + b[0], p.b.y + b[1], p.b.z + b[2], p.b.w + b[3]); } };

struct EpiMix {
    static constexpr bool PERM = true, AFTER_DRAIN = false;
    bf16* M; const bf16* proj; const float* bias;
    __device__ __forceinline__ void mid(f32x4 (&acc)[2][2][4][2], const pg8::Unit& u, int wr, int wc, int fr_, int fq_) const {
        int fr = fr_, fq = fq_; asm volatile("" : "+v"(fr), "+v"(fq));
        const int row0 = u.pm * 256 + wr * 64 + fr, col0 = u.pn * 256 + wc * 32 + 8 * fq;
#pragma unroll
        for (int ai = 0; ai < 2; ++ai)
#pragma unroll
            for (int mh = 0; mh < 2; ++mh) {
                uint4 gc[2][2], gr[2][2];
#pragma unroll
                for (int mm = 0; mm < 2; ++mm)
#pragma unroll
                    for (int bj = 0; bj < 2; ++bj) { const bf16* pr = proj + (size_t)(row0 + ai * 128 + (mh * 2 + mm) * 16) * DINP + col0 + bj * 128; gc[mm][bj] = *(const uint4*)(pr + C_GC); gr[mm][bj] = *(const uint4*)(pr + C_GR); }
#pragma unroll
                for (int mm = 0; mm < 2; ++mm)
#pragma unroll
                    for (int bj = 0; bj < 2; ++bj) {
                        const int m = mh * 2 + mm;
                        float c8[8], r8[8]; unpack8(gc[mm][bj], c8); unpack8(gr[mm][bj], r8);
                        const float4 b0 = *(const float4*)(bias + col0 + bj * 128), b1 = *(const float4*)(bias + col0 + bj * 128 + 4);
                        const float bb[8] = {b0.x, b0.y, b0.z, b0.w, b1.x, b1.y, b1.z, b1.w};
#pragma unroll
                        for (int i = 0; i < 8; ++i) { const float ratio = (1.f + __expf(-r8[i])) * __builtin_amdgcn_rcpf(1.f + __expf(-c8[i]));
                            if (i < 4) acc[ai][bj][m][0][i] = (acc[ai][bj][m][0][i] + bb[i]) * ratio; else acc[ai][bj][m][1][i - 4] = (acc[ai][bj][m][1][i - 4] + bb[i]) * ratio; }
                    }
                asm volatile("" ::: "memory");
            }
    }
    __device__ __forceinline__ void operator()(const f32x4 (&acc)[2][2][4][2], const pg8::Unit& u, int wr, int wc, int fr, int fq) const {
        const int row0 = u.pm * 256 + wr * 64 + fr, col0 = u.pn * 256 + wc * 32 + 8 * fq;
#pragma unroll
        for (int ai = 0; ai < 2; ++ai) {
            uint4 gr[4][2];
#pragma unroll
            for (int m = 0; m < 4; ++m)
#pragma unroll
                for (int bj = 0; bj < 2; ++bj) gr[m][bj] = *(const uint4*)(proj + (size_t)(row0 + ai * 128 + m * 16) * DINP + C_GR + col0 + bj * 128);
#pragma unroll
            for (int m = 0; m < 4; ++m)
#pragma unroll
                for (int bj = 0; bj < 2; ++bj) {
                    float r8[8], o[8]; unpack8(gr[m][bj], r8);
#pragma unroll
                    for (int i = 0; i < 8; ++i) o[i] = ((i < 4) ? acc[ai][bj][m][0][i] : acc[ai][bj][m][1][i - 4]) * sigmoidf_(r8[i]);
                    *(uint4*)(M + (size_t)(row0 + ai * 128 + m * 16) * D + col0 + bj * 128) = pack8(o);
                }
        }
    }
};
template <class Epi> __device__ __forceinline__ void ph_gemm2(unsigned char* shm, int bid, int nblk, const bf16* A, const bf16* Bt, const bf16* A2, const bf16* Bt2, int M, int N, int K, int nt1, int nt, const Epi& E) {
    pg8::Gemm2 g{A, Bt, A2, Bt2, M, N, K, nt1, nt};
    pg8::StaticOrder S; S.init(M, N, nblk, bid);
    pg8::gemm_phase2<Epi, pg8::StaticOrder, false>((PG8_LAS unsigned char*)shm, g, S, E, nullptr);
}
template <class Epi> __device__ __forceinline__ void ph_gemm(unsigned char* shm, int bid, int nblk, const bf16* A, const bf16* Bt, int M, int N, int K, const Epi& E) {
    pg8::Gemm g{A, Bt, M, N, K};
    pg8::StaticOrder S; S.init(M, N, nblk, bid);
    pg8::gemm_phase<Epi, pg8::StaticOrder, false>((PG8_LAS unsigned char*)shm, g, S, E, nullptr);
}

constexpr int CONV_GLU = 62 * 512 * 2, CONV_LDS = CONV_GLU + 31 * 512 * 4;
__device__ __forceinline__ float fmac1(float a, float b, float c) { asm("v_fmac_f32 %0, %1, %2" : "+v"(c) : "v"(a), "v"(b)); return c; }
__device__ __forceinline__ void ph_conv(unsigned char* shm, int bid, int nblk, const bf16* __restrict__ proj, const float* __restrict__ dw, const float* __restrict__ dwb,
                                              const float* __restrict__ lng, const float* __restrict__ lnb, bf16* __restrict__ yn) {
    bf16* glu = (bf16*)shm;
    float* dws = (float*)(shm + CONV_GLU);
    const int tid = threadIdx.x, lane = tid & 63, wid = tid >> 6;
    if (bid < T / 32) { for (int i = tid; i < 31 * 128; i += 512) ((float4*)dws)[i] = ((const float4*)dw)[i]; }
    const float4 g0 = *(const float4*)(lng + lane * 8), g1 = *(const float4*)(lng + lane * 8 + 4), e0 = *(const float4*)(lnb + lane * 8), e1 = *(const float4*)(lnb + lane * 8 + 4);
    const float4 b0 = *(const float4*)(dwb + lane * 8), b1 = *(const float4*)(dwb + lane * 8 + 4);
    const float gg[8] = {g0.x, g0.y, g0.z, g0.w, g1.x, g1.y, g1.z, g1.w}, ee[8] = {e0.x, e0.y, e0.z, e0.w, e1.x, e1.y, e1.z, e1.w};
    for (int tile = bid; tile < T / 32; tile += nblk) {
        const int t0 = tile * 32, sq0 = t0 & ~(SEQ - 1);
        __syncthreads();
#pragma unroll
        for (int hb = 0; hb < 2; ++hb) {
            uint4 av[4], bv[4];
#pragma unroll
            for (int k = 0; k < 4; ++k) { const int it = tid + 512 * (hb * 4 + k), rr = it >> 6, cg = it & 63, t = t0 - 30 + rr;
                av[k] = make_uint4(0, 0, 0, 0); bv[k] = make_uint4(0, 0, 0, 0);
                if (rr < 62 && t >= sq0) { av[k] = *(const uint4*)(proj + (size_t)t * DINP + C_A + cg * 8); bv[k] = *(const uint4*)(proj + (size_t)t * DINP + C_B + cg * 8); } }
#pragma unroll
            for (int k = 0; k < 4; ++k) { const int it = tid + 512 * (hb * 4 + k), rr = it >> 6, cg = it & 63;
                if (rr < 62) { float a[8], b[8]; unpack8(av[k], a); unpack8(bv[k], b);
#pragma unroll
                    for (int i = 0; i < 8; ++i) a[i] *= sigmoidf_(b[i]);
                    *(uint4*)(glu + rr * 512 + cg * 8) = pack8(a); } }
        }
        __syncthreads();
        float acc[4][8];
#pragma unroll
        for (int i = 0; i < 4; ++i) { acc[i][0] = b0.x; acc[i][1] = b0.y; acc[i][2] = b0.z; acc[i][3] = b0.w; acc[i][4] = b1.x; acc[i][5] = b1.y; acc[i][6] = b1.z; acc[i][7] = b1.w; }
#pragma unroll 8
        for (int j = 0; j < 31; ++j) {
            const float4 w0 = *(const float4*)(dws + j * 512 + lane * 8), w1 = *(const float4*)(dws + j * 512 + lane * 8 + 4);
            const float w[8] = {w0.x, w0.y, w0.z, w0.w, w1.x, w1.y, w1.z, w1.w};
#pragma unroll
            for (int i = 0; i < 4; ++i) { float gv[8]; unpack8(*(const uint4*)(glu + (wid * 4 + i + j) * 512 + lane * 8), gv);
#pragma unroll
                for (int c = 0; c < 8; ++c) acc[i][c] = fmac1(gv[c], w[c], acc[i][c]); }
        }
#pragma unroll
        for (int i = 0; i < 4; ++i) {
            float s = 0.f;
#pragma unroll
            for (int c = 0; c < 8; ++c) s += acc[i][c];
            const float mean = wave_sum(s) * (1.f / 512.f);
            float q = 0.f;
#pragma unroll
            for (int c = 0; c < 8; ++c) { acc[i][c] -= mean; q += acc[i][c] * acc[i][c]; }
            const float rstd = rsqrtf(wave_sum(q) * (1.f / 512.f) + 1e-5f);
            float o[8];
#pragma unroll
            for (int c = 0; c < 8; ++c) { const float z = acc[i][c] * rstd * gg[c] + ee[c]; o[c] = z * sigmoidf_(z); }
            *(uint4*)(yn + (size_t)(t0 + wid * 4 + i) * 512 + lane * 8) = pack8(o);
        }
    }
}


constexpr int CS = 72;
constexpr int SLOT = 64 * CS * 2;
constexpr int CP_SMALL = 15 * SLOT;
struct ChunkParams { const bf16* proj; const float *mu, *w0, *w2, *a0, *a2, *g2, *k_k, *k_a, *r_k; bf16 *V, *G, *PHI, *PSI, *OMG, *Y0; float* BONUS; };

__device__ __forceinline__ f32x4 tile_mm(const bf16* A, const bf16* Bt, int m0, int n0, int fr, int fq, f32x4 acc) {
#pragma unroll
    for (int ks = 0; ks < 2; ++ks) {
        const pg8::bf16x8 a = *(const pg8::bf16x8*)(A + (m0 + fr) * CS + ks * 32 + fq * 8);
        const pg8::bf16x8 b = *(const pg8::bf16x8*)(Bt + (n0 + fr) * CS + ks * 32 + fq * 8);
        acc = __builtin_amdgcn_mfma_f32_16x16x32_bf16(a, b, acc, 0, 0, 0);
    }
    return acc;
}
struct Frag2 { pg8::bf16x8 k0, k1; };
__device__ __forceinline__ Frag2 ld_frag(const bf16* M, int row0, int fr, int fq) {
    Frag2 f; f.k0 = *(const pg8::bf16x8*)(M + (row0 + fr) * CS + fq * 8); f.k1 = *(const pg8::bf16x8*)(M + (row0 + fr) * CS + 32 + fq * 8); return f; }
__device__ __forceinline__ f32x4 mmf(const Frag2& a, const Frag2& b, f32x4 acc) {
    acc = __builtin_amdgcn_mfma_f32_16x16x32_bf16(a.k0, b.k0, acc, 0, 0, 0); acc = __builtin_amdgcn_mfma_f32_16x16x32_bf16(a.k1, b.k1, acc, 0, 0, 0); return acc; }
__device__ __forceinline__ f32x4 tile_mm_sw(const bf16* A, const bf16* Bt, int m0, int n0, int fr, int fq, f32x4 acc) {
#pragma unroll
    for (int ks = 0; ks < 2; ++ks) {
        const pg8::bf16x8 a = *(const pg8::bf16x8*)(A + (m0 + fr) * CS + ks * 32 + fq * 8);
        const pg8::bf16x8 b = *(const pg8::bf16x8*)(Bt + (n0 + fr) * CS + ks * 32 + fq * 8);
        acc = __builtin_amdgcn_mfma_f32_16x16x32_bf16(b, a, acc, 0, 0, 0);
    }
    return acc;
}
__device__ __forceinline__ void tile_mm2(const bf16* A, const bf16* Bt, int m0, int n0, int fr, int fq, f32x4& accN, f32x4& accS) {
#pragma unroll
    for (int ks = 0; ks < 2; ++ks) {
        const pg8::bf16x8 a = *(const pg8::bf16x8*)(A + (m0 + fr) * CS + ks * 32 + fq * 8);
        const pg8::bf16x8 b = *(const pg8::bf16x8*)(Bt + (n0 + fr) * CS + ks * 32 + fq * 8);
        accN = __builtin_amdgcn_mfma_f32_16x16x32_bf16(a, b, accN, 0, 0, 0);
        accS = __builtin_amdgcn_mfma_f32_16x16x32_bf16(b, a, accS, 0, 0, 0);
    }
}
__device__ __forceinline__ void st_rm4(bf16* buf, int m0, int n0, int fr, int fq, f32x4 v) {
    uint2 o; o.x = pack2(v[0], v[1]); o.y = pack2(v[2], v[3]); *(uint2*)(buf + (m0 + fr) * CS + n0 + 4 * fq) = o;
}
__device__ __forceinline__ f32x4 ld_rm4(const bf16* buf, int m0, int n0, int fr, int fq) {
    const uint2 o = *(const uint2*)(buf + (m0 + fr) * CS + n0 + 4 * fq);
    f32x4 v; v[0] = bflo(o.x); v[1] = bfhi(o.x); v[2] = bflo(o.y); v[3] = bfhi(o.y); return v;
}
__device__ __forceinline__ void st_rm(bf16* buf, int m0, int n0, int fr, int fq, f32x4 v) {
#pragma unroll
    for (int r = 0; r < 4; ++r) buf[(m0 + 4 * fq + r) * CS + n0 + fr] = f2bf(v[r]);
}
__device__ __forceinline__ void st_tr(bf16* buf, int m0, int n0, int fr, int fq, f32x4 v) {
    uint2 o; o.x = pack2(v[0], v[1]); o.y = pack2(v[2], v[3]); *(uint2*)(buf + (n0 + fr) * CS + m0 + 4 * fq) = o;
}
__device__ __forceinline__ f32x4 ld_rm(const bf16* buf, int m0, int n0, int fr, int fq) {
    f32x4 v;
#pragma unroll
    for (int r = 0; r < 4; ++r) v[r] = bf2f(buf[(m0 + 4 * fq + r) * CS + n0 + fr]);
    return v;
}
__device__ __forceinline__ f32x4 ld_tr(const bf16* buf, int m0, int n0, int fr, int fq) {
    const uint2 o = *(const uint2*)(buf + (n0 + fr) * CS + m0 + 4 * fq);
    f32x4 v; v[0] = bflo(o.x); v[1] = bfhi(o.x); v[2] = bflo(o.y); v[3] = bfhi(o.y); return v;
}

__device__ __forceinline__ int opq(int v) { asm volatile("" : "+v"(v)); return v & 1023; }
template <int CTRL> __device__ __forceinline__ float dppf(float v) { return __int_as_float(__builtin_amdgcn_update_dpp(0, __float_as_int(v), CTRL, 0xF, 0xF, true)); }
__device__ __forceinline__ void wave_sum16(float (&r)[16]) {
    const int l = (int)(threadIdx.x & 63);
    const bool o1 = (l & 1) != 0, o2 = (l & 2) != 0;
    float a[8], b[4];
#pragma unroll
    for (int j = 0; j < 8; ++j) { const float kp = o1 ? r[8 + j] : r[j], sn = o1 ? r[j] : r[8 + j]; a[j] = kp + dppf<0xB1>(sn); }
#pragma unroll
    for (int j = 0; j < 4; ++j) { const float kp = o2 ? a[4 + j] : a[j], sn = o2 ? a[j] : a[4 + j]; b[j] = kp + dppf<0x4E>(sn); }
#pragma unroll
    for (int j = 0; j < 4; ++j) { b[j] += dppf<0x124>(b[j]); b[j] += dppf<0x128>(b[j]); b[j] += __shfl_xor(b[j], 16, 64); b[j] += __shfl_xor(b[j], 32, 64); }
#pragma unroll
    for (int j = 0; j < 4; ++j) { r[j] = dppf<0x00>(b[j]); r[8 + j] = dppf<0x55>(b[j]); r[4 + j] = dppf<0xAA>(b[j]); r[12 + j] = dppf<0xFF>(b[j]); }
}
__device__ __forceinline__ float wave_sum_dpp(float v) {
    v += dppf<0xB1>(v); v += dppf<0x4E>(v); v += dppf<0x141>(v); v += dppf<0x140>(v);
    const float r0 = __int_as_float(__builtin_amdgcn_readlane(__float_as_int(v), 0)), r1 = __int_as_float(__builtin_amdgcn_readlane(__float_as_int(v), 16));
    const float r2 = __int_as_float(__builtin_amdgcn_readlane(__float_as_int(v), 32)), r3 = __int_as_float(__builtin_amdgcn_readlane(__float_as_int(v), 48));
    return (r0 + r1) + (r2 + r3);
}
struct CpPrefetch { uint4 cu[3], pv[3], rw[4]; };
__device__ __forceinline__ void cp_prefetch(CpPrefetch& P, const bf16* __restrict__ proj, int item, int tid) {
    const int h = item & 7, chunk = item >> 3, t0 = chunk * 64, sq0 = t0 & ~(SEQ - 1);
#pragma unroll
    for (int k = 0; k < 3; ++k) { const int idx = tid + 512 * k; P.cu[k] = make_uint4(0, 0, 0, 0); P.pv[k] = make_uint4(0, 0, 0, 0);
        if (idx < 1280) { const int tt = idx / 20, cg = idx % 20, t = t0 + tt;
            P.cu[k] = *(const uint4*)(proj + (size_t)t * DINP + C_LW + cg * 8);
            if (t > sq0) P.pv[k] = *(const uint4*)(proj + (size_t)(t - 1) * DINP + C_LW + cg * 8); } }
#pragma unroll
    for (int k = 0; k < 4; ++k) { const int idx = tid + 512 * k; P.rw[k] = make_uint4(0, 0, 0, 0);
        if (idx < 1560) { const int row = idx / 24, rem = idx % 24, t = t0 - 1 + row;
            if (t >= sq0) P.rw[k] = *(const uint4*)(proj + (size_t)t * DINP + C_R + (rem >> 3) * 512 + h * 64 + (rem & 7) * 8); } }
}
template <bool TOP> __device__ __forceinline__ void g1_panel(const bf16* BK, const bf16* AR, bf16* P0r, bf16* P0t, bf16* T1, bf16* MBT, bf16* LK, bf16* MKT, int mt, int fr, int fq, int nt_lo, int nt_hi) {
    const int q4 = mt & 3, m0 = q4 * 16;
    const Frag2 fa = ld_frag(BK, mt * 16, fr, fq);
    const int dN = 4 * fq - fr;
    const f32x4 zero4 = {0.f, 0.f, 0.f, 0.f};
#pragma unroll
    for (int nt = 0; nt < 8; ++nt) {
        if (nt < nt_lo || nt >= nt_hi) continue;
        const int n4 = nt & 3, n0 = n4 * 16;
        const bool left = (nt < 4);
        if (q4 > n4) {
            if (TOP && left) { st_tr(P0t, m0, n0, fr, fq, zero4); st_rm4(P0r, m0, n0, fr, fq, zero4); st_rm4(T1, m0, n0, fr, fq, zero4); }
            else if (TOP) st_tr(MBT, m0, n0, fr, fq, zero4);
            else if (left) st_rm4(LK, m0, n0, fr, fq, zero4);
            else st_tr(MKT, m0, n0, fr, fq, zero4);
        } else if (q4 < n4) {
            const Frag2 fb = ld_frag(AR, nt * 16, fr, fq);
            if (TOP && left) { f32x4 aN = mmf(fa, fb, zero4), aS = mmf(fb, fa, zero4); st_tr(P0t, m0, n0, fr, fq, aN); st_rm4(P0r, m0, n0, fr, fq, aS); st_rm4(T1, m0, n0, fr, fq, aS); }
            else if (TOP) { f32x4 aN = mmf(fa, fb, zero4); st_tr(MBT, m0, n0, fr, fq, aN); }
            else if (left) { f32x4 aS = mmf(fb, fa, zero4); st_rm4(LK, m0, n0, fr, fq, aS); }
            else { f32x4 aN = mmf(fa, fb, zero4); st_tr(MKT, m0, n0, fr, fq, aN); }
        } else {
            const Frag2 fb = ld_frag(AR, nt * 16, fr, fq);
            if (TOP && left) { f32x4 aN = mmf(fa, fb, zero4), aS = mmf(fb, fa, zero4), t1;
#pragma unroll
                for (int r = 0; r < 4; ++r) { const int d = dN + r; if (!(d < 0)) aN[r] = 0.f; if (!(d > 0)) aS[r] = 0.f; t1[r] = aS[r] + ((d == 0) ? 1.f : 0.f); }
                st_tr(P0t, m0, n0, fr, fq, aN); st_rm4(P0r, m0, n0, fr, fq, aS); st_rm4(T1, m0, n0, fr, fq, t1); }
            else if (TOP) { f32x4 aN = mmf(fa, fb, zero4);
#pragma unroll
                for (int r = 0; r < 4; ++r) if (!(dN + r <= 0)) aN[r] = 0.f;
                st_tr(MBT, m0, n0, fr, fq, aN); }
            else if (left) { f32x4 aS = mmf(fb, fa, zero4);
#pragma unroll
                for (int r = 0; r < 4; ++r) if (!(dN + r > 0)) aS[r] = 0.f;
                st_rm4(LK, m0, n0, fr, fq, aS); }
            else { f32x4 aN = mmf(fa, fb, zero4);
#pragma unroll
                for (int r = 0; r < 4; ++r) if (!(dN + r <= 0)) aN[r] = 0.f;
                st_tr(MKT, m0, n0, fr, fq, aN); }
        }
    }
}
__device__ __forceinline__ void ph_chunkprep(unsigned char* shm, int bid, int nblk, const ChunkParams& p) {
    const int tid = threadIdx.x, lane = tid & 63, wv = tid >> 6, fr = lane & 15, fq = lane >> 4;
    bf16* LWb = (bf16*)shm;
    bf16* LAb = LWb + 64 * 40; bf16* LGb = LAb + 64 * 40;
    float* WLf = (float*)(shm + 24576);
    bf16* RAW = (bf16*)(shm + 8 * SLOT);
    float* segs = (float*)(shm + CP_SMALL);
    float* gC = segs + 512;
    float* muL = gC + 64;
#define SL(i) ((bf16*)(shm + (i) * SLOT))
    bf16 *BK = SL(0), *AR = SL(2), *AbT = SL(4), *BhT = SL(5), *KH = SL(6), *Vt = SL(7), *LK = SL(8), *MBT = SL(9), *MKT = SL(10);
    if (bid >= 2048) return;
    int hcur = -1;
    pg8::bf16x8 bw, ba, bg[3];
    float w0n = 0.f, a0n = 0.f, kkc = 0.f, kac = 0.f, rkc = 0.f, mur = 0.f, muk = 0.f, muv = 0.f;
    for (int i = tid; i < 160; i += 512) muL[i] = p.mu[1536 + i];
    CpPrefetch P;
    { int it0 = bid; asm volatile("" : "+s"(it0)); cp_prefetch(P, p.proj, it0, tid); }
    asm volatile("" :: "v"(P.cu[0].x), "v"(P.cu[0].y), "v"(P.cu[0].z), "v"(P.cu[0].w), "v"(P.cu[1].x), "v"(P.cu[1].y), "v"(P.cu[1].z), "v"(P.cu[1].w), "v"(P.cu[2].x), "v"(P.cu[2].y), "v"(P.cu[2].z), "v"(P.cu[2].w));
    asm volatile("" :: "v"(P.pv[0].x), "v"(P.pv[0].y), "v"(P.pv[0].z), "v"(P.pv[0].w), "v"(P.pv[1].x), "v"(P.pv[1].y), "v"(P.pv[1].z), "v"(P.pv[1].w), "v"(P.pv[2].x), "v"(P.pv[2].y), "v"(P.pv[2].z), "v"(P.pv[2].w));
    asm volatile("" :: "v"(P.rw[0].x), "v"(P.rw[0].y), "v"(P.rw[0].z), "v"(P.rw[0].w), "v"(P.rw[1].x), "v"(P.rw[1].y), "v"(P.rw[1].z), "v"(P.rw[1].w), "v"(P.rw[2].x), "v"(P.rw[2].y), "v"(P.rw[2].z), "v"(P.rw[2].w), "v"(P.rw[3].x), "v"(P.rw[3].y), "v"(P.rw[3].z), "v"(P.rw[3].w));
    for (int item = bid; item < 2048; item += nblk) {
        int itm = item; asm volatile("" : "+s"(itm));
        const int h = itm & 7, chunk = itm >> 3, t0 = chunk * 64;
        if (h != hcur) {
            const int nt = wv & 3, hc = h * 64 + lane;
            hcur = h;
            const int cn = h * 64 + nt * 16 + fr;
            float t8[8];
#pragma unroll
            for (int j = 0; j < 8; ++j) t8[j] = p.w2[(8 * fq + j) * 512 + cn];
            { const uint4 q = pack8(t8); bw = __builtin_bit_cast(pg8::bf16x8, q); }
#pragma unroll
            for (int j = 0; j < 8; ++j) t8[j] = p.a2[(8 * fq + j) * 512 + cn];
            { const uint4 q = pack8(t8); ba = __builtin_bit_cast(pg8::bf16x8, q); }
#pragma unroll
            for (int ks = 0; ks < 3; ++ks) {
#pragma unroll
                for (int j = 0; j < 8; ++j) t8[j] = p.g2[(32 * ks + 8 * fq + j) * 512 + cn];
                const uint4 q = pack8(t8); bg[ks] = __builtin_bit_cast(pg8::bf16x8, q); }
            w0n = p.w0[cn]; a0n = p.a0[cn];
            kkc = p.k_k[hc]; kac = p.k_a[hc]; rkc = p.r_k[hc]; mur = p.mu[hc]; muk = p.mu[512 + hc]; muv = p.mu[1024 + hc];
            asm volatile("" :: "v"(w0n), "v"(a0n), "v"(kkc), "v"(kac), "v"(rkc), "v"(mur), "v"(muk), "v"(muv));
        }
        __syncthreads();
        {
        const int tid = opq((int)threadIdx.x), lane = tid & 63, wv = tid >> 6, fr = lane & 15, fq = lane >> 4; (void)fr; (void)fq; (void)wv; (void)lane;
#pragma unroll
        for (int k = 0; k < 3; ++k) { const int idx = tid + 512 * k;
            if (idx < 1280) { const int tt = (int)(__umul24((unsigned)idx, 3277u) >> 16), cg = idx - __mul24(tt, 20);
                float c8[8], p8[8], u[8]; unpack8(P.cu[k], c8); unpack8(P.pv[k], p8);
                const float4 m0 = *(const float4*)(muL + cg * 8), m1 = *(const float4*)(muL + cg * 8 + 4);
                const float mm[8] = {m0.x, m0.y, m0.z, m0.w, m1.x, m1.y, m1.z, m1.w};
#pragma unroll
                for (int i = 0; i < 8; ++i) u[i] = c8[i] + (p8[i] - c8[i]) * mm[i];
                const bool isw = cg < 4, isa = (cg >= 4) && (cg < 8);
                const float es = isw ? 2.f : -1.f, ca = isw ? 1.f : 0.f, cb = isw ? -2.f : 1.f;
#pragma unroll
                for (int i = 0; i < 8; ++i) { const float r = __builtin_amdgcn_rcpf(1.f + __expf(es * u[i])); const float act = fmaf(cb, r, ca); u[i] = isa ? u[i] : act; }
                bf16* dst = isw ? (LWb + __mul24(tt, 40) + cg * 8) : (isa ? (LAb + __mul24(tt, 40) + (cg - 4) * 8) : (LGb + __mul24(tt, 104) + (cg - 8) * 8));
                *(uint4*)dst = pack8(u); } }
#pragma unroll
        for (int k = 0; k < 4; ++k) { const int idx = tid + 512 * k; if (idx < 1560) { const int q24 = (int)(__umul24((unsigned)idx >> 3, 21846u) >> 16), r24 = idx - __mul24(q24, 24); *(uint4*)(RAW + __mul24(q24, 192) + r24 * 8) = P.rw[k]; } }
        }
        __syncthreads();
        {
        const int tid = opq((int)threadIdx.x), lane = tid & 63, wv = tid >> 6, fr = lane & 15, fq = lane >> 4; (void)fr; (void)fq; (void)wv; (void)lane;
        const int nt = wv & 3;
#pragma unroll
        for (int q = 0; q < 2; ++q) {
            const int mt = (wv >> 2) * 2 + q;
            f32x4 cw = {w0n, w0n, w0n, w0n}, ca = {a0n, a0n, a0n, a0n}, cg = {0.f, 0.f, 0.f, 0.f};
            cw = __builtin_amdgcn_mfma_f32_16x16x32_bf16(*(const pg8::bf16x8*)(LWb + (mt * 16 + fr) * 40 + fq * 8), bw, cw, 0, 0, 0);
            ca = __builtin_amdgcn_mfma_f32_16x16x32_bf16(*(const pg8::bf16x8*)(LAb + (mt * 16 + fr) * 40 + fq * 8), ba, ca, 0, 0, 0);
#pragma unroll
            for (int ks = 0; ks < 3; ++ks) cg = __builtin_amdgcn_mfma_f32_16x16x32_bf16(*(const pg8::bf16x8*)(LGb + (mt * 16 + fr) * 104 + ks * 32 + fq * 8), bg[ks], cg, 0, 0, 0);
#pragma unroll
            for (int r = 0; r < 4; ++r) { const int o = (mt * 16 + 4 * fq + r) * 64 + nt * 16 + fr; WLf[o] = cw[r]; WLf[4096 + o] = ca[r]; WLf[8192 + o] = cg[r]; }
        }
        }
        __syncthreads();
        float rr[8], km[8], vv[8], kn[8], be[8], ld[8];
        const int tid1 = opq((int)threadIdx.x), c = tid1 & 63, tg = tid1 >> 6, hc = h * 64 + c;
        {
            const int tb = t0 + tg * 8;
            float red[16], aa[8], kkr[8], gl[8];
#pragma unroll
            for (int i = 0; i < 8; ++i) {
                const float wl = WLf[(tg * 8 + i) * 64 + c], al = WLf[4096 + (tg * 8 + i) * 64 + c]; gl[i] = WLf[8192 + (tg * 8 + i) * 64 + c];
                const bf16* q1 = RAW + (tg * 8 + i + 1) * 192 + c; const bf16* q0 = q1 - 192;
                const float cr1 = bf2f(q1[0]), cr0 = bf2f(q0[0]), ck1 = bf2f(q1[64]), ck0 = bf2f(q0[64]), cv1 = bf2f(q1[128]), cv0 = bf2f(q0[128]);
                rr[i] = cr1 + (cr0 - cr1) * mur; const float kraw = ck1 + (ck0 - ck1) * muk; vv[i] = cv1 + (cv0 - cv1) * muv;
                const float xw = -wl;
                const float sp = fmaxf(xw, 0.f) + __logf(1.f + __expf(-fabsf(xw)));
                ld[i] = -__expf(-sp - 0.5f);
                aa[i] = sigmoidf_(al);
                kkr[i] = kraw * kkc; km[i] = kraw * (1.f + (aa[i] - 1.f) * kac);
                red[i] = kkr[i] * kkr[i]; red[8 + i] = rr[i] * km[i] * rkc;
            }
            { int nxt = item + nblk; asm volatile("" : "+s"(nxt)); if (nxt < 2048) cp_prefetch(P, p.proj, nxt, tid); }
            wave_sum16(red);
#pragma unroll
            for (int i = 0; i < 8; ++i) {
                kn[i] = kkr[i] * __builtin_amdgcn_rsqf(fmaxf(red[i], 1e-24f)); be[i] = kn[i] * aa[i];
                const size_t o = (size_t)(tb + i) * 512 + hc;
                p.V[o] = f2bf(vv[i]); p.G[o] = f2bf(gl[i]);
                if (c == 0) p.BONUS[(size_t)(tb + i) * 8 + h] = red[8 + i];
            }
        }
        float cl[8];
        { float s = 0.f;
#pragma unroll
          for (int i = 0; i < 8; ++i) { s += ld[i]; cl[i] = s; }
          segs[tg * 64 + c] = s; }
        __syncthreads();
        float off = 0.f, clC = 0.f;
#pragma unroll
        for (int g = 0; g < 8; ++g) { const float sg = segs[g * 64 + c]; clC += sg; if (g < tg) off += sg; }
        if (tg == 0) gC[c] = __expf(clC);
        {
            float ab8[8], bh8[8], v8[8], kh8[8];
#pragma unroll
            for (int i = 0; i < 8; ++i) {
                const float x = off + cl[i]; const int tt = tg * 8 + i;
                const float em = __expf(-x), ep = __expf(x), epm = __expf(x - ld[i]), eh = __expf(clC - x);
                const float ab = -kn[i] * epm;
                ab8[i] = ab; bh8[i] = be[i] * eh; v8[i] = vv[i];
                BK[tt * CS + c] = f2bf(be[i] * em); BK[(64 + tt) * CS + c] = f2bf(km[i] * em);
                AR[tt * CS + c] = f2bf(ab); AR[(64 + tt) * CS + c] = f2bf(rr[i] * ep);
                kh8[i] = km[i] * eh;
            }
            *(uint4*)(AbT + c * CS + tg * 8) = pack8(ab8); *(uint4*)(BhT + c * CS + tg * 8) = pack8(bh8); *(uint4*)(Vt + c * CS + tg * 8) = pack8(v8); *(uint4*)(KH + c * CS + tg * 8) = pack8(kh8);
        }
        __syncthreads();
        {
            const int tid = opq((int)threadIdx.x), lane = tid & 63, wv = tid >> 6, fr = lane & 15, fq = lane >> 4; (void)fr; (void)fq; (void)wv; (void)lane;
            const int mt = __builtin_amdgcn_readfirstlane(wv), q4 = mt & 3;
            const int hi0 = (q4 == 0) ? 5 : (q4 == 1) ? 7 : 8;
            const int mt2 = (q4 == 3) ? mt - 3 : mt - 1, lo2 = (q4 == 3) ? 5 : 7;
            if (mt < 4) { g1_panel<true>(BK, AR, SL(11), SL(12), SL(13), MBT, LK, MKT, mt, fr, fq, 0, hi0); if (q4 >= 2) g1_panel<true>(BK, AR, SL(11), SL(12), SL(13), MBT, LK, MKT, mt2, fr, fq, lo2, 8); }
            else { g1_panel<false>(BK, AR, SL(11), SL(12), SL(13), MBT, LK, MKT, mt, fr, fq, 0, hi0); if (q4 >= 2) g1_panel<false>(BK, AR, SL(11), SL(12), SL(13), MBT, LK, MKT, mt2, fr, fq, lo2, 8); }
        }
        __syncthreads();
#pragma unroll
        for (int s = 0; s < 6; ++s) {
            const int tid = opq((int)threadIdx.x), lane = tid & 63, wv = tid >> 6, fr = lane & 15, fq = lane >> 4; (void)fr; (void)fq; (void)wv; (void)lane;
            const bf16* Pr = (s & 1) ? SL(0) : SL(11); const bf16* Pt = (s & 1) ? SL(1) : SL(12);
            bf16* Pnr = (s & 1) ? SL(11) : SL(0); bf16* Pnt = (s & 1) ? SL(12) : SL(1);
            const bf16* Tc = (s & 1) ? SL(13) : SL(14); bf16* Tn = (s & 1) ? SL(14) : SL(13);
            const int m0 = (wv >> 1) * 16, nb = (wv & 1) * 32;
            Frag2 fp, ft;
            if (s < 5) fp = ld_frag(Pr, m0, fr, fq);
            if (s > 0) ft = ld_frag(Tc, m0, fr, fq);
#pragma unroll
            for (int q = 0; q < 2; ++q) {
                const int n0 = nb + q * 16;
                const Frag2 fb = ld_frag(Pt, n0, fr, fq);
                if (s < 5) { f32x4 aN = {0.f, 0.f, 0.f, 0.f}, aS = {0.f, 0.f, 0.f, 0.f}; aN = mmf(fp, fb, aN); aS = mmf(fb, fp, aS); st_rm4(Pnr, m0, n0, fr, fq, aS); st_tr(Pnt, m0, n0, fr, fq, aN); }
                if (s > 0 && s < 5) { f32x4 acc = ld_rm4(Tc, m0, n0, fr, fq); acc = mmf(fb, ft, acc); st_rm4(Tn, m0, n0, fr, fq, acc); }
                if (s == 5) { f32x4 acc = ld_rm(Tc, m0, n0, fr, fq); acc = mmf(ft, fb, acc); st_tr(SL(2), m0, n0, fr, fq, acc); }
            }
            __syncthreads();
        }
        {
            const int tid = opq((int)threadIdx.x), lane = tid & 63, wv = tid >> 6, fr = lane & 15, fq = lane >> 4; (void)fr; (void)fq; (void)wv; (void)lane;
            const bf16* TT = SL(2); bf16 *X = SL(11), *W = SL(12);
            const int m0 = (wv >> 1) * 16, nb = (wv & 1) * 32;
            const Frag2 fl = ld_frag(LK, m0, fr, fq), fa = ld_frag(AbT, m0, fr, fq);
#pragma unroll
            for (int q = 0; q < 2; ++q) {
                const int n0 = nb + q * 16;
                const Frag2 fb = ld_frag(TT, n0, fr, fq);
                f32x4 a0 = {0.f, 0.f, 0.f, 0.f}, a1 = {0.f, 0.f, 0.f, 0.f};
                a0 = mmf(fb, fl, a0); a1 = mmf(fb, fa, a1);
                st_rm4(X, m0, n0, fr, fq, a0); st_rm4(W, m0, n0, fr, fq, a1);
            }
        }
        __syncthreads();
        asm volatile("" :: "v"(P.cu[0].x), "v"(P.cu[0].y), "v"(P.cu[0].z), "v"(P.cu[0].w), "v"(P.cu[1].x), "v"(P.cu[1].y), "v"(P.cu[1].z), "v"(P.cu[1].w), "v"(P.cu[2].x), "v"(P.cu[2].y), "v"(P.cu[2].z), "v"(P.cu[2].w));
        asm volatile("" :: "v"(P.pv[0].x), "v"(P.pv[0].y), "v"(P.pv[0].z), "v"(P.pv[0].w), "v"(P.pv[1].x), "v"(P.pv[1].y), "v"(P.pv[1].z), "v"(P.pv[1].w), "v"(P.pv[2].x), "v"(P.pv[2].y), "v"(P.pv[2].z), "v"(P.pv[2].w));
        asm volatile("" :: "v"(P.rw[0].x), "v"(P.rw[0].y), "v"(P.rw[0].z), "v"(P.rw[0].w), "v"(P.rw[1].x), "v"(P.rw[1].y), "v"(P.rw[1].z), "v"(P.rw[1].w), "v"(P.rw[2].x), "v"(P.rw[2].y), "v"(P.rw[2].z), "v"(P.rw[2].w), "v"(P.rw[3].x), "v"(P.rw[3].y), "v"(P.rw[3].z), "v"(P.rw[3].w));
        {
            const int tid = opq((int)threadIdx.x), lane = tid & 63, wv = tid >> 6, fr = lane & 15, fq = lane >> 4; (void)fr; (void)fq; (void)wv; (void)lane;
            const bf16 *X = SL(11), *W = SL(12), *RB = SL(3); bf16 *ZT = SL(13), *Q2T = SL(14);
            bf16* PHI = p.PHI + (size_t)item * 4096; bf16* OMG = p.OMG + (size_t)item * 4096;
            const int mt = wv >> 1, m0 = mt * 16, nb = (wv & 1) * 32;
            const Frag2 fx = ld_frag(X, m0, fr, fq), fw = ld_frag(W, m0, fr, fq);
#pragma unroll
            for (int q = 0; q < 2; ++q) {
                const int n0 = nb + q * 16;
                const Frag2 fbh = ld_frag(BhT, n0, fr, fq), fmb = ld_frag(MBT, n0, fr, fq);
                f32x4 z = ld_tr(KH, m0, n0, fr, fq); z = mmf(fx, fbh, z); st_tr(ZT, m0, n0, fr, fq, z);
                f32x4 q2 = ld_tr(MKT, m0, n0, fr, fq); q2 = mmf(fx, fmb, q2); st_tr(Q2T, m0, n0, fr, fq, q2);
                f32x4 ph = {0.f, 0.f, 0.f, 0.f}; ph = mmf(fw, fbh, ph);
#pragma unroll
                for (int r = 0; r < 4; ++r) if (m0 + 4 * fq + r == n0 + fr) ph[r] += gC[n0 + fr];
                const int slot = (mt >> 1) * 32 + fq * 8 + (mt & 1) * 4;
                { uint2 o; o.x = pack2(ph[0], ph[1]); o.y = pack2(ph[2], ph[3]); *(uint2*)(PHI + (n0 + fr) * 64 + slot) = o; }
                f32x4 om = ld_tr(RB, m0, n0, fr, fq); om = mmf(fw, fmb, om);
                { uint2 o; o.x = pack2(om[0], om[1]); o.y = pack2(om[2], om[3]); *(uint2*)(OMG + (n0 + fr) * 64 + slot) = o; }
            }
        }
        __syncthreads();
        {
            const int tid = opq((int)threadIdx.x), lane = tid & 63, wv = tid >> 6, fr = lane & 15, fq = lane >> 4; (void)fr; (void)fq; (void)wv; (void)lane;
            const bf16 *ZT = SL(13), *Q2T = SL(14);
            bf16* PSI = p.PSI + (size_t)item * 4096; bf16* Y0 = p.Y0 + (size_t)item * 4096;
            const int m0 = (wv >> 1) * 16, nb = (wv & 1) * 32;
            const Frag2 fz = ld_frag(ZT, m0, fr, fq), fq2 = ld_frag(Q2T, m0, fr, fq);
#pragma unroll
            for (int q = 0; q < 2; ++q) {
                const int n0 = nb + q * 16;
                const Frag2 fv = ld_frag(Vt, n0, fr, fq);
                f32x4 a0 = {0.f, 0.f, 0.f, 0.f}, a1 = {0.f, 0.f, 0.f, 0.f};
                a0 = mmf(fz, fv, a0); a1 = mmf(fq2, fv, a1);
                { uint2 o; o.x = pack2(a0[0], a0[1]); o.y = pack2(a0[2], a0[3]); *(uint2*)(PSI + (n0 + fr) * 64 + m0 + 4 * fq) = o; }
                { uint2 o; o.x = pack2(a1[0], a1[1]); o.y = pack2(a1[2], a1[3]); *(uint2*)(Y0 + (n0 + fr) * 64 + m0 + 4 * fq) = o; }
            }
        }
    }
#undef SL
}

constexpr int CH_SLOT = 32768, CH_RING = 4, CH_YB = CH_RING * CH_SLOT, CH_YBSZ = 64 * 72 * 2;
__device__ __forceinline__ void chain_dma(unsigned char* shm, int slot, const bf16* __restrict__ PHI, const bf16* __restrict__ PSI, const bf16* __restrict__ OMG, const bf16* __restrict__ Y0, size_t item, int w, int lane) {
    const bf16* src[4] = {PHI + item, OMG + item, PSI + item, Y0 + item};
#pragma unroll
    for (int m = 0; m < 4; ++m)
#pragma unroll
        for (int i = 0; i < 2; ++i) {
            const int row = (w * 2 + i) * 8 + (lane >> 3), jj = (lane & 7) ^ (row & 7);
            __builtin_amdgcn_global_load_lds((const unsigned*)((const char*)src[m] + row * 128 + jj * 16),
                                             (PG8_LAS unsigned*)(shm + slot * CH_SLOT + m * 8192 + (w * 2 + i) * 1024), 16, 0, 0);
        }
}
__device__ __forceinline__ void ph_chain(unsigned char* shm, int bh, const bf16* __restrict__ PHI, const bf16* __restrict__ PSI, const bf16* __restrict__ OMG, const bf16* __restrict__ Y0,
                                         const bf16* __restrict__ V, const bf16* __restrict__ G, const float* __restrict__ BONUS, const float* __restrict__ gng, const float* __restrict__ gnb, bf16* __restrict__ O) {
    const int b = bh >> 3, h = bh & 7, tid = threadIdx.x, lane = tid & 63, w = __builtin_amdgcn_readfirstlane((tid >> 6) & 3), fr = lane & 15, fq = lane >> 4;
    const size_t ib = ((size_t)(b * 64) * 8 + h) * 4096, istep = (size_t)8 * 4096;
#define CH_BAR() do { asm volatile("s_waitcnt lgkmcnt(0)" ::: "memory"); __builtin_amdgcn_s_barrier(); asm volatile("" ::: "memory"); } while (0)
    if (tid < 256) {
        pg8::bf16x8 sf[2];
#pragma unroll
        for (int j = 0; j < 8; ++j) { sf[0][j] = 0; sf[1][j] = 0; }
        chain_dma(shm, 0, PHI, PSI, OMG, Y0, ib, w, lane);
        chain_dma(shm, 1, PHI, PSI, OMG, Y0, ib + istep, w, lane);
        chain_dma(shm, 2, PHI, PSI, OMG, Y0, ib + 2 * istep, w, lane);
#pragma unroll 1
        for (int ch = 0; ch < 64; ++ch) {
            asm volatile("s_waitcnt vmcnt(16)" ::: "memory");
            CH_BAR();
            chain_dma(shm, (ch + 3) & 3, PHI, PSI, OMG, Y0, ib + (size_t)((ch + 3 < 64) ? ch + 3 : 63) * istep, w, lane);
            const unsigned char* sl = shm + (ch & 3) * CH_SLOT;
            f32x4 ya[4], sa[4]; pg8::bf16x8 ap[4][2], ao[4][2];
#pragma unroll
            for (int mt = 0; mt < 4; ++mt) {
                const int row = w * 16 + fr, sw = (((mt * 2 + (fq >> 1)) ^ (row & 7)) * 16) + (fq & 1) * 8;
                const uint2 ps = *(const uint2*)(sl + 16384 + row * 128 + sw), y0 = *(const uint2*)(sl + 24576 + row * 128 + sw);
                ya[mt][0] = bflo(y0.x); ya[mt][1] = bfhi(y0.x); ya[mt][2] = bflo(y0.y); ya[mt][3] = bfhi(y0.y);
                sa[mt][0] = bflo(ps.x); sa[mt][1] = bfhi(ps.x); sa[mt][2] = bflo(ps.y); sa[mt][3] = bfhi(ps.y);
#pragma unroll
                for (int ks = 0; ks < 2; ++ks) { const int ar = mt * 16 + fr, off = ar * 128 + (((ks * 4 + fq) ^ (ar & 7)) * 16);
                    ap[mt][ks] = *(const pg8::bf16x8*)(sl + off); ao[mt][ks] = *(const pg8::bf16x8*)(sl + 8192 + off); }
            }
#pragma unroll
            for (int ks = 0; ks < 2; ++ks)
#pragma unroll
                for (int mt = 0; mt < 4; ++mt) sa[mt] = __builtin_amdgcn_mfma_f32_16x16x32_bf16(ap[mt][ks], sf[ks], sa[mt], 0, 0, 0);
#pragma unroll
            for (int ks = 0; ks < 2; ++ks)
#pragma unroll
                for (int mt = 0; mt < 4; ++mt) ya[mt] = __builtin_amdgcn_mfma_f32_16x16x32_bf16(ao[mt][ks], sf[ks], ya[mt], 0, 0, 0);
#pragma unroll
            for (int ks = 0; ks < 2; ++ks) {
                const unsigned w0 = pack2(sa[2 * ks][0], sa[2 * ks][1]), w1 = pack2(sa[2 * ks][2], sa[2 * ks][3]), w2 = pack2(sa[2 * ks + 1][0], sa[2 * ks + 1][1]), w3 = pack2(sa[2 * ks + 1][2], sa[2 * ks + 1][3]);
                sf[ks][0] = (short)(w0 & 0xFFFF); sf[ks][1] = (short)(w0 >> 16); sf[ks][2] = (short)(w1 & 0xFFFF); sf[ks][3] = (short)(w1 >> 16);
                sf[ks][4] = (short)(w2 & 0xFFFF); sf[ks][5] = (short)(w2 >> 16); sf[ks][6] = (short)(w3 & 0xFFFF); sf[ks][7] = (short)(w3 >> 16);
            }
            bf16* yb = (bf16*)(shm + CH_YB + (ch & 1) * CH_YBSZ);
#pragma unroll
            for (int mt = 0; mt < 4; ++mt)
#pragma unroll
                for (int r = 0; r < 4; ++r) yb[(mt * 16 + 4 * fq + r) * 72 + w * 16 + fr] = f2bf(ya[mt][r]);
        }
        asm volatile("s_waitcnt vmcnt(0)" ::: "memory");
        CH_BAR();
    } else {
        const int et = (tid & 255) >> 2, eq = tid & 3;
        float gw[16], gb[16];
#pragma unroll
        for (int i = 0; i < 16; ++i) { gw[i] = gng[h * 64 + eq * 16 + i]; gb[i] = gnb[h * 64 + eq * 16 + i]; }
        uint4 nv0, nv1, ng0, ng1; float nbon;
        { const int t = b * SEQ + et; const size_t o = (size_t)t * 512 + h * 64 + eq * 16;
          nv0 = *(const uint4*)(V + o); nv1 = *(const uint4*)(V + o + 8); ng0 = *(const uint4*)(G + o); ng1 = *(const uint4*)(G + o + 8); nbon = BONUS[(size_t)t * 8 + h]; }
        CH_BAR();
#pragma unroll 1
        for (int ch = 0; ch < 64; ++ch) {
            const int t = b * SEQ + ch * 64 + et;
            const size_t o = (size_t)t * 512 + h * 64 + eq * 16;
            const uint4 cv0 = nv0, cv1 = nv1, cg0 = ng0, cg1 = ng1; const float cbon = nbon;
            CH_BAR();
            if (ch + 1 < 64) { const size_t o2 = o + (size_t)64 * 512;
                nv0 = *(const uint4*)(V + o2); nv1 = *(const uint4*)(V + o2 + 8); ng0 = *(const uint4*)(G + o2); ng1 = *(const uint4*)(G + o2 + 8); nbon = BONUS[(size_t)(t + 64) * 8 + h]; }
            const bf16* yb = (const bf16*)(shm + CH_YB + (ch & 1) * CH_YBSZ);
            float y[16], s = 0.f;
            { float a8[8], b8[8]; unpack8(*(const uint4*)(yb + et * 72 + eq * 16), a8); unpack8(*(const uint4*)(yb + et * 72 + eq * 16 + 8), b8);
#pragma unroll
              for (int i = 0; i < 8; ++i) { y[i] = a8[i]; y[8 + i] = b8[i]; } }
#pragma unroll
            for (int i = 0; i < 16; ++i) s += y[i];
            s += __shfl_xor(s, 1, 64); s += __shfl_xor(s, 2, 64);
            const float mean = s * (1.f / 64.f);
            float q = 0.f;
#pragma unroll
            for (int i = 0; i < 16; ++i) { y[i] -= mean; q += y[i] * y[i]; }
            q += __shfl_xor(q, 1, 64); q += __shfl_xor(q, 2, 64);
            const float rstd = rsqrtf(q * (1.f / 64.f) + 64e-5f);
            float v0[8], v1[8], g0[8], g1[8], o0[8], o1[8];
            unpack8(cv0, v0); unpack8(cv1, v1); unpack8(cg0, g0); unpack8(cg1, g1);
#pragma unroll
            for (int i = 0; i < 8; ++i) { o0[i] = (y[i] * rstd * gw[i] + gb[i] + cbon * v0[i]) * g0[i]; o1[i] = (y[8 + i] * rstd * gw[8 + i] + gb[8 + i] + cbon * v1[i]) * g1[i]; }
            *(uint4*)(O + o) = pack8(o0); *(uint4*)(O + o + 8) = pack8(o1);
        }
    }
#undef CH_BAR
    __syncthreads();
}

#define CE_DESC(a, b) { const float _mx = fmaxf(a, b), _mn = fminf(a, b); a = _mx; b = _mn; }
__device__ __forceinline__ void sort16_desc(float (&a)[16]) {
    CE_DESC(a[0], a[13]); CE_DESC(a[1], a[12]); CE_DESC(a[2], a[15]); CE_DESC(a[3], a[14]); CE_DESC(a[4], a[8]); CE_DESC(a[5], a[6]); CE_DESC(a[7], a[11]); CE_DESC(a[9], a[10]);
    CE_DESC(a[0], a[5]); CE_DESC(a[1], a[7]); CE_DESC(a[2], a[9]); CE_DESC(a[3], a[4]); CE_DESC(a[6], a[13]); CE_DESC(a[8], a[14]); CE_DESC(a[10], a[15]); CE_DESC(a[11], a[12]);
    CE_DESC(a[0], a[1]); CE_DESC(a[2], a[3]); CE_DESC(a[4], a[5]); CE_DESC(a[6], a[8]); CE_DESC(a[7], a[9]); CE_DESC(a[10], a[11]); CE_DESC(a[12], a[13]); CE_DESC(a[14], a[15]);
    CE_DESC(a[0], a[2]); CE_DESC(a[1], a[3]); CE_DESC(a[4], a[10]); CE_DESC(a[5], a[11]); CE_DESC(a[6], a[7]); CE_DESC(a[8], a[9]); CE_DESC(a[12], a[14]); CE_DESC(a[13], a[15]);
    CE_DESC(a[1], a[2]); CE_DESC(a[3], a[12]); CE_DESC(a[4], a[6]); CE_DESC(a[5], a[7]); CE_DESC(a[8], a[10]); CE_DESC(a[9], a[11]); CE_DESC(a[13], a[14]); CE_DESC(a[1], a[4]);
    CE_DESC(a[2], a[6]); CE_DESC(a[5], a[8]); CE_DESC(a[7], a[10]); CE_DESC(a[9], a[13]); CE_DESC(a[11], a[14]); CE_DESC(a[2], a[4]); CE_DESC(a[3], a[6]); CE_DESC(a[9], a[12]);
    CE_DESC(a[11], a[13]); CE_DESC(a[3], a[5]); CE_DESC(a[6], a[8]); CE_DESC(a[7], a[9]); CE_DESC(a[10], a[12]); CE_DESC(a[3], a[4]); CE_DESC(a[5], a[6]); CE_DESC(a[7], a[8]);
    CE_DESC(a[9], a[10]); CE_DESC(a[11], a[12]); CE_DESC(a[6], a[7]); CE_DESC(a[8], a[9]);
}
__device__ __forceinline__ void sort13_desc(float (&a)[16]) {
    CE_DESC(a[1], a[12]); CE_DESC(a[4], a[8]); CE_DESC(a[5], a[6]); CE_DESC(a[7], a[11]); CE_DESC(a[9], a[10]); CE_DESC(a[0], a[5]); CE_DESC(a[1], a[7]); CE_DESC(a[2], a[9]);
    CE_DESC(a[3], a[4]); CE_DESC(a[11], a[12]); CE_DESC(a[0], a[1]); CE_DESC(a[2], a[3]); CE_DESC(a[4], a[5]); CE_DESC(a[6], a[8]); CE_DESC(a[7], a[9]); CE_DESC(a[10], a[11]);
    CE_DESC(a[0], a[2]); CE_DESC(a[1], a[3]); CE_DESC(a[4], a[10]); CE_DESC(a[5], a[11]); CE_DESC(a[6], a[7]); CE_DESC(a[8], a[9]); CE_DESC(a[1], a[2]); CE_DESC(a[3], a[12]);
    CE_DESC(a[4], a[6]); CE_DESC(a[5], a[7]); CE_DESC(a[8], a[10]); CE_DESC(a[9], a[11]); CE_DESC(a[1], a[4]); CE_DESC(a[2], a[6]); CE_DESC(a[5], a[8]); CE_DESC(a[7], a[10]);
    CE_DESC(a[2], a[4]); CE_DESC(a[3], a[6]); CE_DESC(a[9], a[12]); CE_DESC(a[3], a[5]); CE_DESC(a[6], a[8]); CE_DESC(a[7], a[9]); CE_DESC(a[10], a[12]); CE_DESC(a[3], a[4]);
    CE_DESC(a[5], a[6]); CE_DESC(a[7], a[8]); CE_DESC(a[9], a[10]); CE_DESC(a[11], a[12]); CE_DESC(a[6], a[7]); CE_DESC(a[8], a[9]);
}
__device__ __forceinline__ void merge16_desc(float (&run)[16], const float (&grp)[16]) {
#pragma unroll
    for (int i = 0; i < 16; ++i) run[i] = fmaxf(run[i], grp[15 - i]);
#pragma unroll
    for (int j = 8; j > 0; j >>= 1)
#pragma unroll
        for (int i = 0; i < 16; ++i) { const int l = i ^ j; if (l > i) { CE_DESC(run[i], run[l]); } }
}
struct CandTab { int i[64], j[64]; };
constexpr CandTab make_cand_tab() { CandTab t{}; int n = 0; for (int i = 0; i < 16; ++i) for (int j = 0; j < 16; ++j) if ((i + 1) * (j + 1) <= 16) { t.i[n] = i; t.j[n] = j; ++n; }
    for (; n < 64; ++n) { t.i[n] = 0; t.j[n] = 0; } return t; }
constexpr CandTab CT = make_cand_tab();
constexpr int TOPK_LDS = 8 * (16 * 256 * 4 + 16 * 2 * 16 * 4);
__device__ __forceinline__ void ph_topk(unsigned char* shm, int bid, int nblk, const bf16* __restrict__ Q, const bf16* __restrict__ keys, int* __restrict__ EID, float* __restrict__ GATE) {
    const int tid = threadIdx.x, lane = tid & 63, h = tid >> 6, fr = lane & 15, fq = lane >> 4;
    float* sc = (float*)shm + h * (16 * 256 + 512);
    float* top = sc + 16 * 256;
    for (int item = bid; item < T / 16; item += nblk) {
        const int t0 = item * 16;
        int koff = 0; asm volatile("" : "+v"(koff));
#pragma unroll
        for (int p = 0; p < 2; ++p) {
            pg8::bf16x8 a[4];
#pragma unroll
            for (int ks = 0; ks < 4; ++ks) a[ks] = *(const pg8::bf16x8*)(Q + (size_t)(t0 + fr) * 2048 + h * 256 + p * 128 + ks * 32 + fq * 8);
#pragma unroll
            for (int nt = 0; nt < 8; ++nt) {
                f32x4 acc = {0.f, 0.f, 0.f, 0.f};
#pragma unroll
                for (int ks = 0; ks < 4; ++ks) { const pg8::bf16x8 bfr = *(const pg8::bf16x8*)(keys + koff + ((size_t)(h * 2 + p) * 128 + nt * 16 + fr) * 128 + ks * 32 + fq * 8);
                    acc = __builtin_amdgcn_mfma_f32_16x16x32_bf16(a[ks], bfr, acc, 0, 0, 0); }
#pragma unroll
                for (int r = 0; r < 4; ++r) sc[(4 * fq + r) * 256 + p * 128 + nt * 16 + fr] = acc[r];
            }
        }
        __builtin_amdgcn_s_waitcnt(0);
        __builtin_amdgcn_wave_barrier();
        if (lane < 32) {
            const int tok = lane & 15, half = lane >> 4;
            const float* s = sc + tok * 256 + half * 128;
            float run[16], grp[16];
#pragma unroll
            for (int i = 0; i < 16; ++i) run[i] = __uint_as_float((__float_as_uint(s[i]) & ~0x7Fu) | (unsigned)i);
            sort16_desc(run);
            for (int g = 1; g < 8; ++g) {
#pragma unroll
                for (int i = 0; i < 16; ++i) grp[i] = __uint_as_float((__float_as_uint(s[g * 16 + i]) & ~0x7Fu) | (unsigned)(g * 16 + i));
                sort16_desc(grp);
                merge16_desc(run, grp);
            }
#pragma unroll
            for (int i = 0; i < 16; ++i) top[(tok * 2 + half) * 16 + i] = run[i];
        }
        __builtin_amdgcn_s_waitcnt(0);
        __builtin_amdgcn_wave_barrier();
        if (lane < 16) {
            const float* t1 = top + (lane * 2) * 16; const float* t2 = t1 + 16;
            float v1[16], v2[16];
#pragma unroll
            for (int i = 0; i < 16; ++i) { v1[i] = __uint_as_float(__float_as_uint(t1[i]) & ~0x7Fu); v2[i] = __uint_as_float(__float_as_uint(t2[i]) & ~0x7Fu); }
            float run[16], grp[16];
#pragma unroll
            for (int i = 0; i < 16; ++i) run[i] = __uint_as_float((__float_as_uint(v1[CT.i[i]] + v2[CT.j[i]]) & ~0xFFu) | (unsigned)(CT.i[i] * 16 + CT.j[i]));
            sort16_desc(run);
#pragma unroll
            for (int g = 1; g < 4; ++g) {
#pragma unroll
                for (int i = 0; i < 16; ++i) { const int n = g * 16 + i; grp[i] = (n < 50) ? __uint_as_float((__float_as_uint(v1[CT.i[n]] + v2[CT.j[n]]) & ~0xFFu) | (unsigned)(CT.i[n] * 16 + CT.j[n])) : -3.0e38f; }
                sort16_desc(grp); merge16_desc(run, grp);
            }
            float e[16], sum = 0.f; const float mx = __uint_as_float(__float_as_uint(run[0]) & ~0xFFu);
#pragma unroll
            for (int i = 0; i < 16; ++i) { e[i] = __expf(__uint_as_float(__float_as_uint(run[i]) & ~0xFFu) - mx); sum += e[i]; }
            const float inv = 1.f / sum;
            const size_t ob = (size_t)(t0 + lane) * 128 + h * 16;
#pragma unroll
            for (int i = 0; i < 16; ++i) { const unsigned ij = __float_as_uint(run[i]) & 0xFFu; const unsigned e1 = __float_as_uint(t1[ij >> 4]) & 0x7Fu, e2 = __float_as_uint(t2[ij & 15]) & 0x7Fu;
                EID[ob + i] = (int)(e1 * 128 + e2); GATE[ob + i] = e[i] * inv; }
        }
        __builtin_amdgcn_wave_barrier();
    }
}

__device__ __forceinline__ void ph_peer(unsigned char* shm, int bid, int nblk, const bf16* __restrict__ XN2, float* __restrict__ X1  , const bf16* __restrict__ UB, const bf16* __restrict__ VB,
                                              const int* __restrict__ EID, const float* __restrict__ GATE, const float* __restrict__ gf) {
    float (*cfs)[128] = (float (*)[128])shm;
    int (*eids)[128] = (int (*)[128])(shm + 8 * 128 * 4);
    const int wv = threadIdx.x >> 6, lane = threadIdx.x & 63;
    const int wave = (bid * 512 + threadIdx.x) >> 6, nw = (nblk * 512) >> 6;
    for (int t = wave; t < T; t += nw) {
        float hv[16];
        { float a[8], b[8]; unpack8(*(const uint4*)(XN2 + (size_t)t * D + lane * 16), a); unpack8(*(const uint4*)(XN2 + (size_t)t * D + lane * 16 + 8), b);
#pragma unroll
          for (int i = 0; i < 8; ++i) { hv[i] = a[i]; hv[8 + i] = b[i]; } }
        eids[wv][lane] = EID[(size_t)t * 128 + lane]; eids[wv][lane + 64] = EID[(size_t)t * 128 + 64 + lane];
        __builtin_amdgcn_s_waitcnt(0); __builtin_amdgcn_wave_barrier();
        for (int k0 = 0; k0 < 128; k0 += 4) {
            float dp[4];
#pragma unroll
            for (int q = 0; q < 4; ++q) { const int e = eids[wv][k0 + q];
                float a[8], b[8]; unpack8(*(const uint4*)(UB + (size_t)e * D + lane * 16), a); unpack8(*(const uint4*)(UB + (size_t)e * D + lane * 16 + 8), b);
                float s = 0.f;
#pragma unroll
                for (int i = 0; i < 8; ++i) s += a[i] * hv[i] + b[i] * hv[8 + i];
                dp[q] = s; }
#pragma unroll
            for (int q = 0; q < 4; ++q) { const float z = wave_sum(dp[q]); const float act = 0.5f * z * (1.f + erff(z * 0.70710678118f));
                if (lane == 0) cfs[wv][k0 + q] = act * GATE[(size_t)t * 128 + k0 + q]; }
        }
        __builtin_amdgcn_s_waitcnt(0); __builtin_amdgcn_wave_barrier();
        float acc[16];
#pragma unroll
        for (int i = 0; i < 16; ++i) acc[i] = 0.f;
        for (int k0 = 0; k0 < 128; k0 += 4) {
#pragma unroll
            for (int q = 0; q < 4; ++q) { const int e = eids[wv][k0 + q]; const float cf = cfs[wv][k0 + q];
                float a[8], b[8]; unpack8(*(const uint4*)(VB + (size_t)e * D + lane * 16), a); unpack8(*(const uint4*)(VB + (size_t)e * D + lane * 16 + 8), b);
#pragma unroll
                for (int i = 0; i < 8; ++i) { acc[i] += cf * a[i]; acc[8 + i] += cf * b[i]; } }
        }
        float* xr = X1 + (size_t)t * D + lane * 16; float ss = 0.f;
#pragma unroll
        for (int i = 0; i < 4; ++i) { const float4 v = ((const float4*)xr)[i]; acc[4 * i] += v.x; acc[4 * i + 1] += v.y; acc[4 * i + 2] += v.z; acc[4 * i + 3] += v.w; }
#pragma unroll
        for (int i = 0; i < 16; ++i) ss += acc[i] * acc[i];
        const float sc = rsqrtf(wave_sum(ss) * (1.f / D) + 1e-6f);
#pragma unroll
        for (int i = 0; i < 4; ++i) { const float4 g = ((const float4*)(gf + lane * 16))[i];
            ((float4*)xr)[i] = make_float4(acc[4 * i] * sc * g.x, acc[4 * i + 1] * sc * g.y, acc[4 * i + 2] * sc * g.z, acc[4 * i + 3] * sc * g.w); }
        __builtin_amdgcn_wave_barrier();
    }
}


typedef unsigned char u8;
constexpr float H8_SCALE = 16.f;
__device__ __forceinline__ unsigned pack4_fp8(float a, float b, float c, float d) {
    int w = 0; w = __builtin_amdgcn_cvt_pk_fp8_f32(a, b, w, false); w = __builtin_amdgcn_cvt_pk_fp8_f32(c, d, w, true); return (unsigned)w; }
__device__ __forceinline__ float wave_max(float v) {
#pragma unroll
    for (int o = 32; o > 0; o >>= 1) v = fmaxf(v, __shfl_xor(v, o, 64));
    return v;
}
__device__ __forceinline__ void ph_cvt_fp8(int bid, int nblk, const float* __restrict__ src, u8* __restrict__ dst, float* __restrict__ scale, int rows) {
    const int tid_ = opq((int)threadIdx.x), wave = (bid * 512 + tid_) >> 6, nw = (nblk * 512) >> 6, lane = tid_ & 63;
    for (int r = wave; r < rows; r += nw) {
        const float4* xr = (const float4*)(src + (size_t)r * 1024 + lane * 16);
        float4 v[4]; float mx = 0.f;
#pragma unroll
        for (int i = 0; i < 4; ++i) { v[i] = xr[i]; mx = fmaxf(mx, fmaxf(fmaxf(fabsf(v[i].x), fabsf(v[i].y)), fmaxf(fabsf(v[i].z), fabsf(v[i].w)))); }
        mx = wave_max(mx);
        const float sc = fmaxf(mx, 1e-30f) * (1.f / 440.f), inv = 1.f / sc;
        uint4 o; o.x = pack4_fp8(v[0].x * inv, v[0].y * inv, v[0].z * inv, v[0].w * inv); o.y = pack4_fp8(v[1].x * inv, v[1].y * inv, v[1].z * inv, v[1].w * inv);
        o.z = pack4_fp8(v[2].x * inv, v[2].y * inv, v[2].z * inv, v[2].w * inv); o.w = pack4_fp8(v[3].x * inv, v[3].y * inv, v[3].z * inv, v[3].w * inv);
        *(uint4*)(dst + (size_t)r * 1024 + lane * 16) = o;
        if (lane == 0) scale[r] = sc;
    }
}
__device__ __forceinline__ void ph_rmsnorm2(int bid, int nblk, const float* __restrict__ x, const float* __restrict__ g, bf16* __restrict__ out, u8* __restrict__ h8, int rows) {
    const int tid_ = opq((int)threadIdx.x), wave = (bid * 512 + tid_) >> 6, nw = (nblk * 512) >> 6, lane = tid_ & 63;
    for (int r = wave; r < rows; r += nw) {
        const float4* xr = (const float4*)(x + (size_t)r * D + lane * 16);
        float4 v[4]; float ss = 0.f;
#pragma unroll
        for (int i = 0; i < 4; ++i) { v[i] = xr[i]; ss += v[i].x * v[i].x + v[i].y * v[i].y + v[i].z * v[i].z + v[i].w * v[i].w; }
        const float sc = rsqrtf(wave_sum(ss) * (1.f / D) + 1e-6f);
        uint4 q; unsigned qq[4]; uint2 ob[4];
#pragma unroll
        for (int i = 0; i < 4; ++i) { const float4 gg = ((const float4*)(g + lane * 16))[i];
            const float a = v[i].x * sc * gg.x, b = v[i].y * sc * gg.y, c = v[i].z * sc * gg.z, d = v[i].w * sc * gg.w;
            ob[i].x = pack2(a, b); ob[i].y = pack2(c, d); qq[i] = pack4_fp8(a * H8_SCALE, b * H8_SCALE, c * H8_SCALE, d * H8_SCALE); }
        q.x = qq[0]; q.y = qq[1]; q.z = qq[2]; q.w = qq[3];
        *(uint4*)(out + (size_t)r * D + lane * 16) = make_uint4(ob[0].x, ob[0].y, ob[1].x, ob[1].y);
        *(uint4*)(out + (size_t)r * D + lane * 16 + 8) = make_uint4(ob[2].x, ob[2].y, ob[3].x, ob[3].y);
        *(uint4*)(h8 + (size_t)r * D + lane * 16) = q;
    }
}

__device__ __forceinline__ void ph_peer2(unsigned char* shm, int bid, int nblk, const u8* __restrict__ H8, const float* X1, float* OUT, const u8* __restrict__ U8, const u8* __restrict__ V8,
                                         const float* __restrict__ USC, const float* __restrict__ VSC, const int* __restrict__ EID, const float* __restrict__ GATE, const float* __restrict__ gf) {
    const int wv = threadIdx.x >> 6, lane = threadIdx.x & 63, fr = lane & 15, fq = lane >> 4;
    float* zb = (float*)shm + wv * 128;
    const int wave = (bid * 512 + threadIdx.x) >> 6, nw = (nblk * 512) >> 6;
    for (int t = wave; t < T; t += nw) {
        uint4 hq[16];
#pragma unroll
        for (int s = 0; s < 16; ++s) hq[s] = *(const uint4*)(H8 + (size_t)t * 1024 + 64 * s + 16 * fq);
        const int e0 = EID[(size_t)t * 128 + lane], e1 = EID[(size_t)t * 128 + 64 + lane];
        const float g0 = GATE[(size_t)t * 128 + lane], g1 = GATE[(size_t)t * 128 + 64 + lane];
        const float us0 = USC[e0], us1 = USC[e1], vs0 = VSC[e0], vs1 = VSC[e1];
#pragma unroll 1
        for (int tile = 0; tile < 8; ++tile) {
            const int er = __shfl((tile < 4) ? e0 : e1, (tile & 3) * 16 + fr, 64);
            const u8* rowp = U8 + (size_t)er * 1024 + 16 * fq;
            uint4 a[16];
#pragma unroll
            for (int s = 0; s < 16; ++s) a[s] = *(const uint4*)(rowp + 64 * s);
            f32x4 acc = {0.f, 0.f, 0.f, 0.f};
#pragma unroll
            for (int s = 0; s < 16; ++s) {
                const long alo = (long)(((unsigned long long)a[s].y << 32) | a[s].x), ahi = (long)(((unsigned long long)a[s].w << 32) | a[s].z);
                const long blo = (long)(((unsigned long long)hq[s].y << 32) | hq[s].x), bhi = (long)(((unsigned long long)hq[s].w << 32) | hq[s].z);
                acc = __builtin_amdgcn_mfma_f32_16x16x32_fp8_fp8(alo, blo, acc, 0, 0, 0);
                acc = __builtin_amdgcn_mfma_f32_16x16x32_fp8_fp8(ahi, bhi, acc, 0, 0, 0);
            }
            if (fr == 0) { *(float4*)(zb + tile * 16 + 4 * fq) = make_float4(acc[0], acc[1], acc[2], acc[3]); }
        }
        __builtin_amdgcn_s_waitcnt(0); __builtin_amdgcn_wave_barrier();
        float cf0, cf1;
        { const float z0 = zb[lane] * us0 * (1.f / H8_SCALE), z1 = zb[64 + lane] * us1 * (1.f / H8_SCALE);
          cf0 = g0 * vs0 * 0.5f * z0 * (1.f + erff(z0 * 0.70710678118f)); cf1 = g1 * vs1 * 0.5f * z1 * (1.f + erff(z1 * 0.70710678118f)); }
        __builtin_amdgcn_wave_barrier();
        float acc[16];
#pragma unroll
        for (int i = 0; i < 16; ++i) acc[i] = 0.f;
#pragma unroll 1
        for (int k0 = 0; k0 < 128; k0 += 16) {
            uint4 r[16]; float cc[16];
#pragma unroll
            for (int j = 0; j < 16; ++j) {
                const int k = k0 + j;
                const int e = __builtin_amdgcn_readlane((k < 64) ? e0 : e1, k & 63);
                cc[j] = __int_as_float(__builtin_amdgcn_readlane(__float_as_int((k < 64) ? cf0 : cf1), k & 63));
                r[j] = *(const uint4*)(V8 + (size_t)e * 1024 + lane * 16);
            }
#pragma unroll
            for (int j = 0; j < 16; ++j) {
                const unsigned w[4] = {r[j].x, r[j].y, r[j].z, r[j].w};
#pragma unroll
                for (int q = 0; q < 4; ++q) {
                    const auto lo = __builtin_amdgcn_cvt_pk_f32_fp8((int)w[q], false), hi = __builtin_amdgcn_cvt_pk_f32_fp8((int)w[q], true);
                    acc[4 * q] += cc[j] * lo[0]; acc[4 * q + 1] += cc[j] * lo[1]; acc[4 * q + 2] += cc[j] * hi[0]; acc[4 * q + 3] += cc[j] * hi[1];
                }
            }
        }
        const float* xr = X1 + (size_t)t * D + lane * 16; float* orow = OUT + (size_t)t * D + lane * 16; float ss = 0.f;
#pragma unroll
        for (int i = 0; i < 4; ++i) { const float4 v = ((const float4*)xr)[i]; acc[4 * i] += v.x; acc[4 * i + 1] += v.y; acc[4 * i + 2] += v.z; acc[4 * i + 3] += v.w; }
#pragma unroll
        for (int i = 0; i < 16; ++i) ss += acc[i] * acc[i];
        const float sc = rsqrtf(wave_sum(ss) * (1.f / D) + 1e-6f);
#pragma unroll
        for (int i = 0; i < 4; ++i) { const float4 g = ((const float4*)(gf + lane * 16))[i];
            ((float4*)orow)[i] = make_float4(acc[4 * i] * sc * g.x, acc[4 * i + 1] * sc * g.y, acc[4 * i + 2] * sc * g.z, acc[4 * i + 3] * sc * g.w); }
    }
}

constexpr int TK_KPITCH = 136;
constexpr int TK_KEYS = 2 * 128 * TK_KPITCH * 2;
constexpr int TK_TAB = TK_KEYS, TK_XCH = TK_TAB + 64;
__device__ __forceinline__ void xmerge16(float (&run)[16], int xm) {
    float oth[16];
#pragma unroll
    for (int i = 0; i < 16; ++i) oth[i] = __shfl_xor(run[i], xm, 64);
    merge16_desc(run, oth);
}
__device__ __forceinline__ void cvt4_row(const float4 (&v)[4], int r, u8* __restrict__ dst, float* __restrict__ scale, int lane) {
    float ss = 0.f;
#pragma unroll
    for (int i = 0; i < 4; ++i) ss += v[i].x * v[i].x + v[i].y * v[i].y + v[i].z * v[i].z + v[i].w * v[i].w;
    ss = wave_sum(ss);
    const float sc = fmaxf(sqrtf(ss * (1.f / 1024.f)), 1e-30f) * 0.3352f, inv = 1.f / sc, lo_ = -8.f * sc, hi_ = 7.f * sc;
#pragma unroll
    for (int i = 0; i < 4; ++i) {
        const float f[4] = {v[i].x, v[i].y, v[i].z, v[i].w};
        unsigned w = 0u;
#pragma unroll
        for (int j = 0; j < 4; ++j) {
            const float b = fmaf(__builtin_amdgcn_fmed3f(f[j], lo_, hi_), inv, (j & 1) ? 12582912.f : 12582920.f);
            w |= (__float_as_uint(b) & 15u) << (4 * j); }
        ((unsigned short*)(dst + (size_t)r * 512))[lane + 64 * i] = (unsigned short)w;
    }
    if (lane == 0) scale[r] = sc;
}
__device__ __forceinline__ void ph_topk2(unsigned char* shm, int bid, int nblk, const bf16* __restrict__ Q, const bf16* __restrict__ keys, const float* __restrict__ SCL, unsigned short* __restrict__ E16, float* __restrict__ GATE,
                                         const float* __restrict__ Vsrc, u8* __restrict__ V4, float* __restrict__ VSC) {
    const int tid = threadIdx.x, lane = tid & 63, wv = tid >> 6, fr = lane & 15, fq = lane >> 4;
    bf16* KL = (bf16*)shm;
    unsigned char* tab = shm + TK_TAB;
    float* xch = (float*)(shm + TK_XCH) + wv * 512;
    const bool par = (nblk % 8) == 0;
    const int rank = par ? (bid >> 3) : bid, nrank = par ? (nblk >> 3) : nblk;
    if (tid == 0) {
#pragma unroll
        for (int n = 0; n < 50; ++n) tab[n] = (unsigned char)(CT.i[n] * 16 + CT.j[n]);
    }
    const int NW = nblk * 8, gw = bid * 8 + wv; int kq = 0;
    for (int h = par ? (bid & 7) : 0; h < 8; h += par ? 8 : 1) {
        __syncthreads();
        for (int i = tid; i < 2 * 128 * 16; i += 512) { const int row = i >> 4, ch = i & 15;
            *(uint4*)(KL + row * TK_KPITCH + ch * 8) = *(const uint4*)(keys + ((size_t)h * 256 + row) * 128 + ch * 8); }
        __syncthreads();
        for (int g = rank * 8 + wv; g < T / 16; g += nrank * 8) {
            const int t0 = g * 16;
            float tops[2][16];
#pragma unroll
            for (int p = 0; p < 2; ++p) {
                pg8::bf16x8 bq[4];
#pragma unroll
                for (int ks = 0; ks < 4; ++ks) bq[ks] = *(const pg8::bf16x8*)(Q + (size_t)(t0 + fr) * 2048 + h * 256 + p * 128 + ks * 32 + fq * 8);
                float sc[32];
#pragma unroll
                for (int mt = 0; mt < 8; ++mt) {
                    f32x4 acc = {0.f, 0.f, 0.f, 0.f};
#pragma unroll
                    for (int ks = 0; ks < 4; ++ks) acc = __builtin_amdgcn_mfma_f32_16x16x32_bf16(*(const pg8::bf16x8*)(KL + (p * 128 + mt * 16 + fr) * TK_KPITCH + ks * 32 + fq * 8), bq[ks], acc, 0, 0, 0);
#pragma unroll
                    for (int r = 0; r < 4; ++r) sc[mt * 4 + r] = __uint_as_float((__float_as_uint(acc[r]) & ~0x7Fu) | (unsigned)(mt * 16 + 4 * fq + r));
                }
                float run[16], grp[16];
#pragma unroll
                for (int i = 0; i < 16; ++i) { run[i] = sc[i]; grp[i] = sc[16 + i]; }
                sort16_desc(run); sort16_desc(grp); merge16_desc(run, grp);
                xmerge16(run, 16); xmerge16(run, 32);
#pragma unroll
                for (int i = 0; i < 16; ++i) tops[p][i] = run[i];
            }
            if (fq == 0) {
#pragma unroll
                for (int i = 0; i < 16; ++i) { xch[(fr * 2) * 16 + i] = tops[0][i]; xch[(fr * 2 + 1) * 16 + i] = tops[1][i]; }
            }
            asm volatile("s_waitcnt lgkmcnt(0)" ::: "memory"); __builtin_amdgcn_wave_barrier();
            float4 vr0[4], vr1[4];
            const int r0_ = gw + kq * NW, r1_ = gw + (kq + 1) * NW;
            if (r0_ < 16384) {
#pragma unroll
                for (int i = 0; i < 4; ++i) vr0[i] = ((const float4*)(Vsrc + (size_t)r0_ * 1024))[lane + 64 * i];
            }
            if (r1_ < 16384) {
#pragma unroll
                for (int i = 0; i < 4; ++i) vr1[i] = ((const float4*)(Vsrc + (size_t)r1_ * 1024))[lane + 64 * i];
            }
            const float* t1 = xch + (fr * 2) * 16; const float* t2 = t1 + 16;
            float run[16];
#pragma unroll
            for (int m = 0; m < 16; ++m) {
                const int n = fq * 13 + m;
                float v = -3.0e38f;
                if (m < 13 && n < 50) { const unsigned ij = tab[n];
                    const float a = __uint_as_float(__float_as_uint(t1[ij >> 4]) & ~0x7Fu), b = __uint_as_float(__float_as_uint(t2[ij & 15]) & ~0x7Fu);
                    v = __uint_as_float((__float_as_uint(a + b) & ~0xFFu) | ij); }
                run[m] = v;
            }
            sort13_desc(run);
            xmerge16(run, 16); xmerge16(run, 32);
            {
                float r4[4];
#pragma unroll
                for (int k = 0; k < 4; ++k) r4[k] = (fq == 0) ? run[k] : (fq == 1) ? run[4 + k] : (fq == 2) ? run[8 + k] : run[12 + k];
                const float mx = __uint_as_float(__float_as_uint(run[0]) & ~0xFFu), sct = SCL[t0 + fr];
                float e4[4], sum = 0.f;
#pragma unroll
                for (int k = 0; k < 4; ++k) { e4[k] = __expf((__uint_as_float(__float_as_uint(r4[k]) & ~0xFFu) - mx) * sct); sum += e4[k]; }
                sum += __shfl_xor(sum, 16, 64); sum += __shfl_xor(sum, 32, 64);
                const float inv = 1.f / sum;
                const size_t ob = (size_t)(t0 + fr) * 128 + h * 16 + 4 * fq;
                unsigned eo4[4];
#pragma unroll
                for (int k = 0; k < 4; ++k) { const unsigned ij = __float_as_uint(r4[k]) & 0xFFu; const unsigned e1 = __float_as_uint(t1[ij >> 4]) & 0x7Fu, e2 = __float_as_uint(t2[ij & 15]) & 0x7Fu;
                    eo4[k] = e1 * 128u + e2; }
                *(float4*)(GATE + ob) = make_float4(e4[0] * inv, e4[1] * inv, e4[2] * inv, e4[3] * inv);
                *(uint2*)(E16 + ob) = make_uint2(eo4[0] | (eo4[1] << 16), eo4[2] | (eo4[3] << 16));
            }
            __builtin_amdgcn_wave_barrier();
            if (r0_ < 16384) cvt4_row(vr0, r0_, V4, VSC, lane);
            if (r1_ < 16384) cvt4_row(vr1, r1_, V4, VSC, lane);
            kq += 2;
        }
    }
    for (int r = gw + kq * NW; r < 16384; r += NW) {
        float4 v[4];
#pragma unroll
        for (int i = 0; i < 4; ++i) v[i] = ((const float4*)(Vsrc + (size_t)r * 1024))[lane + 64 * i];
        cvt4_row(v, r, V4, VSC, lane);
    }
}

__device__ __forceinline__ void ph_peer_u(unsigned char* shm, int bid, int nblk, const u8* __restrict__ H8, const u8* __restrict__ U8, const float* __restrict__ USC, const float* __restrict__ VSC,
                                          const int* __restrict__ EID, const float* __restrict__ GATE, float* __restrict__ CF) {
    const int wv = threadIdx.x >> 6, lane = threadIdx.x & 63, fr = lane & 15, fq = lane >> 4;
    int* lst_e = (int*)shm + wv * 256; int* lst_s = lst_e + 128;
    const bool par = (nblk % 8) == 0;
    const int rank = par ? (bid >> 3) : bid, nrank = par ? (nblk >> 3) : nblk;
    for (int p = par ? (bid & 7) : 0; p < 8; p += par ? 8 : 1) {
        for (int t = rank * 8 + wv; t < T; t += nrank * 8) {
            const int e0 = EID[(size_t)t * 128 + lane], e1 = EID[(size_t)t * 128 + 64 + lane];
            const bool f0 = (e0 >> 11) == p, f1 = (e1 >> 11) == p;
            const unsigned long long m0 = __ballot(f0), m1 = __ballot(f1);
            const int c0 = __popcll(m0), cnt = c0 + __popcll(m1);
            if (cnt == 0) continue;
            const int below = __builtin_amdgcn_mbcnt_hi((unsigned)(m0 >> 32), __builtin_amdgcn_mbcnt_lo((unsigned)m0, 0));
            const int below1 = __builtin_amdgcn_mbcnt_hi((unsigned)(m1 >> 32), __builtin_amdgcn_mbcnt_lo((unsigned)m1, 0));
            if (f0) { lst_e[below] = e0; lst_s[below] = lane; }
            if (f1) { lst_e[c0 + below1] = e1; lst_s[c0 + below1] = 64 + lane; }
            uint4 hq[16];
#pragma unroll
            for (int s = 0; s < 16; ++s) hq[s] = *(const uint4*)(H8 + (size_t)t * 1024 + 64 * s + 16 * fq);
            __builtin_amdgcn_s_waitcnt(0); __builtin_amdgcn_wave_barrier();
            const int ntile = (cnt + 15) >> 4;
#pragma unroll 1
            for (int tile = 0; tile < ntile; ++tile) {
                const int j = tile * 16 + fr;
                const int er = lst_e[(j < cnt) ? j : 0];
                const u8* rowp = U8 + (size_t)er * 1024 + 16 * fq;
                uint4 a[16];
#pragma unroll
                for (int s = 0; s < 16; ++s) a[s] = *(const uint4*)(rowp + 64 * s);
                f32x4 acc = {0.f, 0.f, 0.f, 0.f};
#pragma unroll
                for (int s = 0; s < 16; ++s) {
                    const long alo = (long)(((unsigned long long)a[s].y << 32) | a[s].x), ahi = (long)(((unsigned long long)a[s].w << 32) | a[s].z);
                    const long blo = (long)(((unsigned long long)hq[s].y << 32) | hq[s].x), bhi = (long)(((unsigned long long)hq[s].w << 32) | hq[s].z);
                    acc = __builtin_amdgcn_mfma_f32_16x16x32_fp8_fp8(alo, blo, acc, 0, 0, 0);
                    acc = __builtin_amdgcn_mfma_f32_16x16x32_fp8_fp8(ahi, bhi, acc, 0, 0, 0);
                }
                const int jo = tile * 16 + 4 * fq + fr;
                if (fr < 4 && jo < cnt) {
                    const float d = (fr == 0) ? acc[0] : (fr == 1) ? acc[1] : (fr == 2) ? acc[2] : acc[3];
                    const int e = lst_e[jo], sl = lst_s[jo];
                    const float z = d * USC[e] * (1.f / H8_SCALE);
                    CF[(size_t)t * 128 + sl] = GATE[(size_t)t * 128 + sl] * VSC[e] * 0.5f * z * (1.f + erff(z * 0.70710678118f));
                }
            }
            __builtin_amdgcn_wave_barrier();
        }
    }
}

__device__ __forceinline__ void ph_peer_v(unsigned char* shm, int bid, int nblk, const float* X1, float* X2, const u8* __restrict__ V8, const int* __restrict__ EID, const float* __restrict__ CF, float* __restrict__ SS) {
    const int wv = threadIdx.x >> 6, lane = threadIdx.x & 63, tk = lane >> 3, pc = lane & 7;
    int* le = (int*)shm + wv * 2048;
    float* lc = (float*)(le + 1024);
    const bool par = (nblk % 8) == 0;
    const int rank = par ? (bid >> 3) : bid, nrank = par ? (nblk >> 3) : nblk;
    for (int p = par ? (bid & 7) : 0; p < 8; p += par ? 8 : 1) {
        for (int g = rank * 8 + wv; g < T / 8; g += nrank * 8) {
            const int t = g * 8 + tk;
            __builtin_amdgcn_wave_barrier();
#pragma unroll
            for (int i = 0; i < 4; ++i) { *(int4*)(le + tk * 128 + pc * 16 + 4 * i) = *(const int4*)(EID + (size_t)t * 128 + pc * 16 + 4 * i);
                                          *(float4*)(lc + tk * 128 + pc * 16 + 4 * i) = *(const float4*)(CF + (size_t)t * 128 + pc * 16 + 4 * i); }
            float acc[16];
            { const float* xr = X1 + (size_t)t * D + p * 128 + pc * 16;
#pragma unroll
              for (int i = 0; i < 4; ++i) { const float4 v = ((const float4*)xr)[i]; acc[4 * i] = v.x; acc[4 * i + 1] = v.y; acc[4 * i + 2] = v.z; acc[4 * i + 3] = v.w; } }
            __builtin_amdgcn_s_waitcnt(0); __builtin_amdgcn_wave_barrier();
            const u8* vb = V8 + p * 128 + pc * 16;
#pragma unroll 1
            for (int k0 = 0; k0 < 128; k0 += 16) {
                uint4 r[16]; float cc[16];
#pragma unroll
                for (int q = 0; q < 4; ++q) { const int4 e4 = *(const int4*)(le + tk * 128 + k0 + 4 * q); const float4 c4 = *(const float4*)(lc + tk * 128 + k0 + 4 * q);
                    r[4 * q] = *(const uint4*)(vb + (size_t)e4.x * 1024); r[4 * q + 1] = *(const uint4*)(vb + (size_t)e4.y * 1024); r[4 * q + 2] = *(const uint4*)(vb + (size_t)e4.z * 1024); r[4 * q + 3] = *(const uint4*)(vb + (size_t)e4.w * 1024);
                    cc[4 * q] = c4.x; cc[4 * q + 1] = c4.y; cc[4 * q + 2] = c4.z; cc[4 * q + 3] = c4.w; }
#pragma unroll
                for (int j = 0; j < 16; ++j) {
                    const unsigned w[4] = {r[j].x, r[j].y, r[j].z, r[j].w};
#pragma unroll
                    for (int q = 0; q < 4; ++q) {
                        const auto lo = __builtin_amdgcn_cvt_pk_f32_fp8((int)w[q], false), hi = __builtin_amdgcn_cvt_pk_f32_fp8((int)w[q], true);
                        acc[4 * q] += cc[j] * lo[0]; acc[4 * q + 1] += cc[j] * lo[1]; acc[4 * q + 2] += cc[j] * hi[0]; acc[4 * q + 3] += cc[j] * hi[1];
                    }
                }
            }
            float ss = 0.f;
#pragma unroll
            for (int i = 0; i < 16; ++i) ss += acc[i] * acc[i];
            { float* orow = X2 + (size_t)t * D + p * 128 + pc * 16;
#pragma unroll
              for (int i = 0; i < 4; ++i) ((float4*)orow)[i] = make_float4(acc[4 * i], acc[4 * i + 1], acc[4 * i + 2], acc[4 * i + 3]); }
            ss += __shfl_xor(ss, 1, 64); ss += __shfl_xor(ss, 2, 64); ss += __shfl_xor(ss, 4, 64);
            if (pc == 0) SS[(size_t)t * 8 + p] = ss;
        }
    }
}

__device__ __forceinline__ void ph_peer_f(int bid, int nblk, const bf16* __restrict__ X2, float* __restrict__ OUT, const float* __restrict__ SS, const float* __restrict__ gf) {
    const int tid_ = opq((int)threadIdx.x), wave = (bid * 512 + tid_) >> 6, nw = (nblk * 512) >> 6, lane = tid_ & 63;
    float4 g[4], ns0, ns1; uint2 nx[4];
#pragma unroll
    for (int i = 0; i < 4; ++i) g[i] = ((const float4*)gf)[lane + 64 * i];
    if (wave < T) {
        ns0 = *(const float4*)(SS + (size_t)wave * 8); ns1 = *(const float4*)(SS + (size_t)wave * 8 + 4);
#pragma unroll
        for (int i = 0; i < 4; ++i) nx[i] = ((const uint2*)(X2 + (size_t)wave * D))[lane + 64 * i];
    }
    for (int t = wave; t < T; t += nw) {
        float4 v[4]; const float4 s0 = ns0, s1 = ns1;
#pragma unroll
        for (int i = 0; i < 4; ++i) v[i] = make_float4(bflo(nx[i].x), bfhi(nx[i].x), bflo(nx[i].y), bfhi(nx[i].y));
        if (t + nw < T) {
            ns0 = *(const float4*)(SS + (size_t)(t + nw) * 8); ns1 = *(const float4*)(SS + (size_t)(t + nw) * 8 + 4);
#pragma unroll
            for (int i = 0; i < 4; ++i) nx[i] = ((const uint2*)(X2 + (size_t)(t + nw) * D))[lane + 64 * i];
        }
        const float sc = rsqrtf(((s0.x + s0.y) + (s0.z + s0.w) + (s1.x + s1.y) + (s1.z + s1.w)) * (1.f / D) + 1e-6f);
#pragma unroll
        for (int i = 0; i < 4; ++i) ((float4*)(OUT + (size_t)t * D))[lane + 64 * i] = make_float4(v[i].x * sc * g[i].x, v[i].y * sc * g[i].y, v[i].z * sc * g[i].z, v[i].w * sc * g[i].w);
    }
}

struct Part { int p0, pstep, rank, nrank; };
__device__ __forceinline__ long u4lo(const uint4& v) { return (long)(((unsigned long long)v.y << 32) | v.x); }
__device__ __forceinline__ long u4hi(const uint4& v) { return (long)(((unsigned long long)v.w << 32) | v.z); }
__device__ __forceinline__ int pu_compact(int e0, int e1, int p, int lane, int* lst) {
    const bool f0 = (e0 >> 11) == p, f1 = (e1 >> 11) == p;
    const unsigned long long m0 = __ballot(f0), m1 = __ballot(f1);
    const int c0 = __popcll(m0), cnt = c0 + __popcll(m1);
    const int b0 = __builtin_amdgcn_mbcnt_hi((unsigned)(m0 >> 32), __builtin_amdgcn_mbcnt_lo((unsigned)m0, 0));
    const int b1 = __builtin_amdgcn_mbcnt_hi((unsigned)(m1 >> 32), __builtin_amdgcn_mbcnt_lo((unsigned)m1, 0));
    __builtin_amdgcn_wave_barrier();
    if (f0) { lst[b0] = e0; lst[128 + b0] = lane; }
    if (f1) { lst[c0 + b1] = e1; lst[128 + c0 + b1] = 64 + lane; }
    asm volatile("s_waitcnt lgkmcnt(0)" ::: "memory"); __builtin_amdgcn_wave_barrier();
    return cnt;
}
struct PuScal { float us[2], vs[2], gt[2]; int sl[2]; };
__device__ __forceinline__ void pu_scalars(PuScal& S, int t, int cnt, const int* lst, int fr, int fq, const float* __restrict__ USC, const float* __restrict__ VSC, const float* __restrict__ GATE) {
#pragma unroll
    for (int rt = 0; rt < 2; ++rt) { const int jo = rt * 16 + 4 * fq + fr; S.us[rt] = 0.f; S.vs[rt] = 0.f; S.gt[rt] = 0.f; S.sl[rt] = 0;
        if (fr < 4 && jo < cnt) { const int e = lst[jo], sl = lst[128 + jo]; S.sl[rt] = sl; S.us[rt] = USC[e]; S.vs[rt] = VSC[e]; S.gt[rt] = GATE[(size_t)t * 128 + sl]; } }
}
template <int HALF> __device__ __forceinline__ void pu_rows(uint4 (&a)[8], const u8* __restrict__ U8, const int* lst, int cnt, int j0, int fr, int fq, int pad_row) {
    const int j = j0 + fr; const int er = (j < cnt) ? lst[j] : pad_row;
    const u8* r0 = U8 + (size_t)er * 1024 + 16 * fq + HALF * 512;
#pragma unroll
    for (int s = 0; s < 8; ++s) a[s] = *(const uint4*)(r0 + 64 * s);
}
template <int HALF> __device__ __forceinline__ void pu_mma(const uint4 (&a)[8], const unsigned char* hbuf, int fq, f32x4& acc) {
#pragma unroll
    for (int s = 0; s < 8; ++s) {
        const uint4 hv = *(const uint4*)(hbuf + HALF * 512 + 64 * s + 16 * fq);
        acc = __builtin_amdgcn_mfma_f32_16x16x32_fp8_fp8(u4lo(a[s]), u4lo(hv), acc, 0, 0, 0);
        acc = __builtin_amdgcn_mfma_f32_16x16x32_fp8_fp8(u4hi(a[s]), u4hi(hv), acc, 0, 0, 0);
    }
}
__device__ __forceinline__ float gelu_erf(float v) {
    const float av = fabsf(v), tt = __builtin_amdgcn_rcpf(av * 0.2316418882f + 1.0f);
    float q = tt * 0.5307027145f + (-0.7265760135f); q = q * tt + 0.7107068705f; q = q * tt + (-0.142248368f); q = q * tt + 0.127414796f; q = q * tt;
    const float e = __builtin_amdgcn_exp2f((v * v) * (-0.72134752044f));
    const float m = v * (q * e);
    return v < 0.f ? m : v - m;
}
__device__ __forceinline__ void pu_tile_mma(const uint4 (&aA)[8], const uint4 (&aB)[8], const unsigned char* hbuf, int fq, f32x4& acc) { pu_mma<0>(aA, hbuf, fq, acc); pu_mma<1>(aB, hbuf, fq, acc); }
__device__ __forceinline__ void ph_peer_u2(unsigned char* shm, const Part pt, const u8* __restrict__ H8, const u8* __restrict__ U8, const float* __restrict__ USC, const float* __restrict__ VSC,
                                           const int* __restrict__ EID, const float* __restrict__ GATE, float* __restrict__ CF) {
    const int wv = threadIdx.x >> 6;
    const int rank = pt.rank, nrank = pt.nrank, tstep = nrank * 8;
    for (int p = pt.p0; p < 8; p += pt.pstep) {
        int tn = rank * 8 + wv;
        if (tn >= T) continue;
        const int pad = p * 2048;
        int cb = 1, cnt = 0, t = 0;
        bool has_cur = false;
        uint4 hreg = make_uint4(0, 0, 0, 0);
        PuScal S;
        uint4 a0A[8], a0B[8], a1A[8], a1B[8];
        int ne0, ne1;
        { const int lane0 = threadIdx.x & 63; ne0 = EID[(size_t)tn * 128 + lane0]; ne1 = EID[(size_t)tn * 128 + 64 + lane0]; }
#pragma unroll 1
        for (;;) {
            const int lane = opq((int)threadIdx.x) & 63, fr = lane & 15, fq = lane >> 4;
            int* lstb = (int*)shm + (opq((int)threadIdx.x) >> 6) * 512;
            unsigned char* hbuf = shm + 16384 + (opq((int)threadIdx.x) >> 6) * 1024;
            int* lcur = lstb + cb * 256; int* lnxt = lstb + (cb ^ 1) * 256;
            if (has_cur) {
                __builtin_amdgcn_wave_barrier();
                *(uint4*)(hbuf + lane * 16) = hreg;
                asm volatile("s_waitcnt lgkmcnt(0)" ::: "memory"); __builtin_amdgcn_wave_barrier();
                f32x4 acc0 = {0.f, 0.f, 0.f, 0.f}, acc1 = {0.f, 0.f, 0.f, 0.f};
                pu_tile_mma(a0A, a0B, hbuf, fq, acc0);
                if (cnt > 16) pu_tile_mma(a1A, a1B, hbuf, fq, acc1);
                for (int tile = 2; tile * 16 < cnt; ++tile) {
                    pu_rows<0>(a1A, U8, lcur, cnt, tile * 16, fr, fq, pad); pu_rows<1>(a1B, U8, lcur, cnt, tile * 16, fr, fq, pad);
                    f32x4 acc = {0.f, 0.f, 0.f, 0.f}; pu_tile_mma(a1A, a1B, hbuf, fq, acc);
                    const int jo = tile * 16 + 4 * fq + fr;
                    if (fr < 4 && jo < cnt) { const float d = (fr == 0) ? acc[0] : (fr == 1) ? acc[1] : (fr == 2) ? acc[2] : acc[3];
                        const int e = lcur[jo], sl = lcur[128 + jo];
                        CF[(size_t)t * 128 + sl] = GATE[(size_t)t * 128 + sl] * VSC[e] * gelu_erf(d * USC[e] * (1.f / H8_SCALE)); }
                }
                if (fr < 4) {
                    const int jo = 4 * fq + fr;
                    if (jo < cnt) { const float d = (fr == 0) ? acc0[0] : (fr == 1) ? acc0[1] : (fr == 2) ? acc0[2] : acc0[3];
                        CF[(size_t)t * 128 + S.sl[0]] = S.gt[0] * S.vs[0] * gelu_erf(d * S.us[0] * (1.f / H8_SCALE)); }
                    if (16 + jo < cnt) { const float d = (fr == 0) ? acc1[0] : (fr == 1) ? acc1[1] : (fr == 2) ? acc1[2] : acc1[3];
                        CF[(size_t)t * 128 + S.sl[1]] = S.gt[1] * S.vs[1] * gelu_erf(d * S.us[1] * (1.f / H8_SCALE)); }
                }
            }
            if (tn >= T) break;
            const int ncnt = pu_compact(ne0, ne1, p, lane, lnxt);
            pu_rows<0>(a0A, U8, lnxt, ncnt, 0, fr, fq, pad); pu_rows<1>(a0B, U8, lnxt, ncnt, 0, fr, fq, pad);
            if (ncnt > 16) { pu_rows<0>(a1A, U8, lnxt, ncnt, 16, fr, fq, pad); pu_rows<1>(a1B, U8, lnxt, ncnt, 16, fr, fq, pad); }
            hreg = *(const uint4*)(H8 + (size_t)tn * 1024 + lane * 16);
            pu_scalars(S, tn, ncnt, lnxt, fr, fq, USC, VSC, GATE);
            if (tn + tstep < T) { ne0 = EID[(size_t)(tn + tstep) * 128 + lane]; ne1 = EID[(size_t)(tn + tstep) * 128 + 64 + lane]; }
            t = tn; tn += tstep; cnt = ncnt; cb ^= 1; has_cur = true;
        }
    }
}

__device__ __forceinline__ void pv_issue(uint4 (&r)[8], float (&cc)[8], const u8* vb, const int* le, const float* lc, int k0) {
#pragma unroll
    for (int q = 0; q < 2; ++q) { const int4 e4 = *(const int4*)(le + k0 + 4 * q); const float4 c4 = *(const float4*)(lc + k0 + 4 * q);
        r[4 * q] = *(const uint4*)(vb + (size_t)e4.x * 1024); r[4 * q + 1] = *(const uint4*)(vb + (size_t)e4.y * 1024); r[4 * q + 2] = *(const uint4*)(vb + (size_t)e4.z * 1024); r[4 * q + 3] = *(const uint4*)(vb + (size_t)e4.w * 1024);
        cc[4 * q] = c4.x; cc[4 * q + 1] = c4.y; cc[4 * q + 2] = c4.z; cc[4 * q + 3] = c4.w; }
}
__device__ __forceinline__ void pv_fma(float (&acc)[16], const uint4 (&r)[8], const float (&cc)[8]) {
#pragma unroll
    for (int j = 0; j < 8; ++j) {
        const unsigned w[4] = {r[j].x, r[j].y, r[j].z, r[j].w};
#pragma unroll
        for (int q = 0; q < 4; ++q) {
            const auto lo = __builtin_amdgcn_cvt_pk_f32_fp8((int)w[q], false), hi = __builtin_amdgcn_cvt_pk_f32_fp8((int)w[q], true);
            acc[4 * q] += cc[j] * lo[0]; acc[4 * q + 1] += cc[j] * lo[1]; acc[4 * q + 2] += cc[j] * hi[0]; acc[4 * q + 3] += cc[j] * hi[1];
        }
        if (j & 1) __builtin_amdgcn_sched_barrier(0);
    }
}
__device__ __forceinline__ void ph_peer_v2(unsigned char* shm, const Part pt, const float* X1, float* X2, const u8* __restrict__ V8, const int* __restrict__ EID, const float* __restrict__ CF, float* __restrict__ SS) {
    const int wv = threadIdx.x >> 6, lane = threadIdx.x & 63, tk = lane >> 3, pc = lane & 7;
    int* le = (int*)shm + wv * 2048 + tk * 128;
    float* lc = (float*)((int*)shm + wv * 2048 + 1024) + tk * 128;
    const int rank = pt.rank, nrank = pt.nrank, gstep = nrank * 8;
    for (int p = pt.p0; p < 8; p += pt.pstep) {
        int g = rank * 8 + wv;
        if (g >= T / 8) continue;
        int4 pe0, pe1, pe2, pe3; float4 pf0, pf1, pf2, pf3;
        { const int* er = EID + (size_t)(g * 8 + tk) * 128 + pc * 16; const float* cr = CF + (size_t)(g * 8 + tk) * 128 + pc * 16;
          pe0 = *(const int4*)(er); pe1 = *(const int4*)(er + 4); pe2 = *(const int4*)(er + 8); pe3 = *(const int4*)(er + 12);
          pf0 = *(const float4*)(cr); pf1 = *(const float4*)(cr + 4); pf2 = *(const float4*)(cr + 8); pf3 = *(const float4*)(cr + 12); }
        const u8* vb = V8 + p * 128 + pc * 16;
#pragma unroll 1
        for (; g < T / 8; g += gstep) {
            const int lane = opq((int)threadIdx.x) & 63, tk = lane >> 3, pc = lane & 7;
            int* le = (int*)shm + wv * 2048 + tk * 128; float* lc = (float*)((int*)shm + wv * 2048 + 1024) + tk * 128;
            const u8* vb = V8 + p * 128 + pc * 16;
            const int t = g * 8 + tk;
            __builtin_amdgcn_wave_barrier();
            *(int4*)(le + pc * 16) = pe0; *(int4*)(le + pc * 16 + 4) = pe1; *(int4*)(le + pc * 16 + 8) = pe2; *(int4*)(le + pc * 16 + 12) = pe3;
            *(float4*)(lc + pc * 16) = pf0; *(float4*)(lc + pc * 16 + 4) = pf1; *(float4*)(lc + pc * 16 + 8) = pf2; *(float4*)(lc + pc * 16 + 12) = pf3;
            asm volatile("s_waitcnt lgkmcnt(0)" ::: "memory"); __builtin_amdgcn_wave_barrier();
            float acc[16];
#pragma unroll
            for (int i = 0; i < 16; ++i) acc[i] = 0.f;
            if (g + gstep < T / 8) { const int* er = EID + (size_t)((g + gstep) * 8 + tk) * 128 + pc * 16; const float* cr = CF + (size_t)((g + gstep) * 8 + tk) * 128 + pc * 16;
                pe0 = *(const int4*)(er); pe1 = *(const int4*)(er + 4); pe2 = *(const int4*)(er + 8); pe3 = *(const int4*)(er + 12);
                pf0 = *(const float4*)(cr); pf1 = *(const float4*)(cr + 4); pf2 = *(const float4*)(cr + 8); pf3 = *(const float4*)(cr + 12); }
            uint4 rA[8], rB[8]; float cA[8], cB[8];
            pv_issue(rA, cA, vb, le, lc, 0);
#pragma unroll 1
            for (int k0 = 0; k0 < 128; k0 += 16) {
                pv_issue(rB, cB, vb, le, lc, k0 + 8);
                pv_fma(acc, rA, cA);
                if (k0 + 16 < 128) pv_issue(rA, cA, vb, le, lc, k0 + 16);
                pv_fma(acc, rB, cB);
            }
            { const float* xr = X1 + (size_t)t * D + p * 128 + pc * 16;
#pragma unroll
              for (int i = 0; i < 4; ++i) { const float4 v = ((const float4*)xr)[i]; acc[4 * i] += v.x; acc[4 * i + 1] += v.y; acc[4 * i + 2] += v.z; acc[4 * i + 3] += v.w; } }
            float ss = 0.f;
#pragma unroll
            for (int i = 0; i < 16; ++i) ss += acc[i] * acc[i];
            { float* orow = X2 + (size_t)t * D + p * 128 + pc * 16;
#pragma unroll
              for (int i = 0; i < 4; ++i) ((float4*)orow)[i] = make_float4(acc[4 * i], acc[4 * i + 1], acc[4 * i + 2], acc[4 * i + 3]); }
            ss += __shfl_xor(ss, 1, 64); ss += __shfl_xor(ss, 2, 64); ss += __shfl_xor(ss, 4, 64);
            if (pc == 0) SS[(size_t)t * 8 + p] = ss;
        }
    }
}

__device__ __forceinline__ void pw_issue(uint4 (&r)[8], const u8* ub, const int* le, int k0) {
#pragma unroll
    for (int q = 0; q < 2; ++q) { const int4 e4 = *(const int4*)(le + k0 + 4 * q);
        r[4 * q] = *(const uint4*)(ub + (size_t)e4.x * 1024); r[4 * q + 1] = *(const uint4*)(ub + (size_t)e4.y * 1024); r[4 * q + 2] = *(const uint4*)(ub + (size_t)e4.z * 1024); r[4 * q + 3] = *(const uint4*)(ub + (size_t)e4.w * 1024); }
}
__device__ __forceinline__ float pw_dot8(const uint4 (&r)[8], const float (&h)[16], int pc) {
    float d[8];
#pragma unroll
    for (int j = 0; j < 8; ++j) {
        const unsigned w[4] = {r[j].x, r[j].y, r[j].z, r[j].w};
        typedef float f2v __attribute__((ext_vector_type(2)));
        f2v s2 = {0.f, 0.f};
#pragma unroll
        for (int q = 0; q < 4; ++q) {
            const f2v lo = __builtin_amdgcn_cvt_pk_f32_fp8((int)w[q], false), hi = __builtin_amdgcn_cvt_pk_f32_fp8((int)w[q], true);
            const f2v ha = {h[4 * q], h[4 * q + 1]}, hb = {h[4 * q + 2], h[4 * q + 3]};
            s2 = __builtin_elementwise_fma(ha, lo, s2); s2 = __builtin_elementwise_fma(hb, hi, s2);
        }
        d[j] = s2[0] + s2[1];
        if (j & 1) __builtin_amdgcn_sched_barrier(0);
    }
    float e4[4], e2[2];
#pragma unroll
    for (int j = 0; j < 4; ++j) { const float snd = (pc & 4) ? d[j] : d[j + 4], kp = (pc & 4) ? d[j + 4] : d[j]; e4[j] = kp + __shfl_xor(snd, 4, 64); }
#pragma unroll
    for (int j = 0; j < 2; ++j) { const float snd = (pc & 2) ? e4[j] : e4[j + 2], kp = (pc & 2) ? e4[j + 2] : e4[j]; e2[j] = kp + __shfl_xor(snd, 2, 64); }
    { const float snd = (pc & 1) ? e2[0] : e2[1], kp = (pc & 1) ? e2[1] : e2[0]; return kp + __shfl_xor(snd, 1, 64); }
}
__device__ __forceinline__ void ph_peer_u3(unsigned char* shm, const Part pt, const u8* __restrict__ H8, const u8* __restrict__ U8, const int* __restrict__ EID, float* __restrict__ PART) {
    const int wv = threadIdx.x >> 6;
    const int rank = pt.rank, nrank = pt.nrank, gstep = nrank * 8;
    for (int p = pt.p0; p < 8; p += pt.pstep) {
        int g = rank * 8 + wv;
        if (g >= T / 8) continue;
        int4 pe0, pe1, pe2, pe3;
        { const int l0 = threadIdx.x & 63; const int* er = EID + (size_t)(g * 8 + (l0 >> 3)) * 128 + (l0 & 7) * 16;
          pe0 = *(const int4*)(er); pe1 = *(const int4*)(er + 4); pe2 = *(const int4*)(er + 8); pe3 = *(const int4*)(er + 12); }
#pragma unroll 1
        for (; g < T / 8; g += gstep) {
            const int lane = opq((int)threadIdx.x) & 63, tk = lane >> 3, pc = lane & 7;
            int* le = (int*)shm + wv * 1024 + tk * 128;
            const u8* ub = U8 + p * 128 + pc * 16;
            const int t = g * 8 + tk;
            __builtin_amdgcn_wave_barrier();
            *(int4*)(le + pc * 16) = pe0; *(int4*)(le + pc * 16 + 4) = pe1; *(int4*)(le + pc * 16 + 8) = pe2; *(int4*)(le + pc * 16 + 12) = pe3;
            asm volatile("s_waitcnt lgkmcnt(0)" ::: "memory"); __builtin_amdgcn_wave_barrier();
            float h[16];
            { const uint4 hq = *(const uint4*)(H8 + (size_t)t * 1024 + p * 128 + pc * 16); const unsigned w[4] = {hq.x, hq.y, hq.z, hq.w};
#pragma unroll
              for (int q = 0; q < 4; ++q) { const auto lo = __builtin_amdgcn_cvt_pk_f32_fp8((int)w[q], false), hi = __builtin_amdgcn_cvt_pk_f32_fp8((int)w[q], true);
                  h[4 * q] = lo[0] * (1.f / H8_SCALE); h[4 * q + 1] = lo[1] * (1.f / H8_SCALE); h[4 * q + 2] = hi[0] * (1.f / H8_SCALE); h[4 * q + 3] = hi[1] * (1.f / H8_SCALE); } }
            if (g + gstep < T / 8) { const int* er = EID + (size_t)((g + gstep) * 8 + tk) * 128 + pc * 16;
                pe0 = *(const int4*)(er); pe1 = *(const int4*)(er + 4); pe2 = *(const int4*)(er + 8); pe3 = *(const int4*)(er + 12); }
            float* prow = PART + ((size_t)p * T + t) * 128 + pc;
            uint4 rA[8], rB[8];
            pw_issue(rA, ub, le, 0);
#pragma unroll 1
            for (int k0 = 0; k0 < 128; k0 += 16) {
                pw_issue(rB, ub, le, k0 + 8);
                prow[k0] = pw_dot8(rA, h, pc);
                if (k0 + 16 < 128) pw_issue(rA, ub, le, k0 + 16);
                prow[k0 + 8] = pw_dot8(rB, h, pc);
            }
        }
    }
}
__device__ __forceinline__ void ph_peer_cf(int bid, int nblk, const float* __restrict__ PART, const float* __restrict__ USC, const float* __restrict__ VSC, const int* __restrict__ EID, const float* __restrict__ GATE, float* __restrict__ CF) {
    const int tid_ = opq((int)threadIdx.x);
    for (size_t i = (size_t)bid * 512 + tid_; i < (size_t)T * 128 / 4; i += (size_t)nblk * 512) {
        float4 s = ((const float4*)PART)[i];
#pragma unroll
        for (int p = 1; p < 8; ++p) { const float4 v = ((const float4*)(PART + (size_t)p * T * 128))[i]; s.x += v.x; s.y += v.y; s.z += v.z; s.w += v.w; }
        const int4 e = ((const int4*)EID)[i]; const float4 g = ((const float4*)GATE)[i];
        float4 o;
        o.x = g.x * VSC[e.x] * gelu_erf(s.x * USC[e.x]); o.y = g.y * VSC[e.y] * gelu_erf(s.y * USC[e.y]); o.z = g.z * VSC[e.z] * gelu_erf(s.z * USC[e.z]); o.w = g.w * VSC[e.w] * gelu_erf(s.w * USC[e.w]);
        ((float4*)CF)[i] = o;
    }
}

__device__ __forceinline__ unsigned fp4_code(float q) {
    const float a = fabsf(q);
    unsigned c = (a >= 0.25f) + (a >= 0.75f) + (a >= 1.25f) + (a >= 1.75f) + (a >= 2.5f) + (a >= 3.5f) + (a >= 5.0f);
    return c | ((q < 0.f) ? 8u : 0u);
}
__device__ __forceinline__ void ph_cvt_fp4(int bid, int nblk, const float* __restrict__ src, u8* __restrict__ dst, float* __restrict__ scale, int rows) {
    const int tid_ = opq((int)threadIdx.x), wave = (bid * 512 + tid_) >> 6, nw = (nblk * 512) >> 6, lane = tid_ & 63;
    for (int r = wave; r < rows; r += nw) {
        const float4* xr = (const float4*)(src + (size_t)r * 1024 + lane * 16);
        float4 v[4]; float mx = 0.f;
#pragma unroll
        for (int i = 0; i < 4; ++i) { v[i] = xr[i]; mx = fmaxf(mx, fmaxf(fmaxf(fabsf(v[i].x), fabsf(v[i].y)), fmaxf(fabsf(v[i].z), fabsf(v[i].w)))); }
        mx = wave_max(mx);
        const float sc = fmaxf(mx, 1e-30f) * (1.f / 6.f), inv = 1.f / sc;
        unsigned w0 = 0, w1 = 0;
#pragma unroll
        for (int i = 0; i < 2; ++i) { w0 |= fp4_code(v[i].x * inv) << (16 * i); w0 |= fp4_code(v[i].y * inv) << (16 * i + 4); w0 |= fp4_code(v[i].z * inv) << (16 * i + 8); w0 |= fp4_code(v[i].w * inv) << (16 * i + 12); }
#pragma unroll
        for (int i = 0; i < 2; ++i) { w1 |= fp4_code(v[2 + i].x * inv) << (16 * i); w1 |= fp4_code(v[2 + i].y * inv) << (16 * i + 4); w1 |= fp4_code(v[2 + i].z * inv) << (16 * i + 8); w1 |= fp4_code(v[2 + i].w * inv) << (16 * i + 12); }
        *(uint2*)(dst + (size_t)r * 512 + lane * 8) = make_uint2(w0, w1);
        if (lane == 0) scale[r] = sc;
    }
}
__device__ __forceinline__ void ph_peer_cf2(int bid, int nblk, const float* __restrict__ PART, const float* __restrict__ USC, const float* __restrict__ VSC, const int* __restrict__ EID, const float* __restrict__ GATE,
                                            unsigned short* __restrict__ E16, bf16* __restrict__ CFH) {
    const int tid_ = opq((int)threadIdx.x);
    for (size_t i = (size_t)bid * 512 + tid_; i < (size_t)T * 128 / 4; i += (size_t)nblk * 512) {
        float4 s = ((const float4*)PART)[i];
#pragma unroll
        for (int p = 1; p < 8; ++p) { const float4 v = ((const float4*)(PART + (size_t)p * T * 128))[i]; s.x += v.x; s.y += v.y; s.z += v.z; s.w += v.w; }
        const int4 e = ((const int4*)EID)[i]; const float4 g = ((const float4*)GATE)[i];
        const float ox = g.x * VSC[e.x] * gelu_erf(s.x * USC[e.x]), oy = g.y * VSC[e.y] * gelu_erf(s.y * USC[e.y]), oz = g.z * VSC[e.z] * gelu_erf(s.z * USC[e.z]), ow = g.w * VSC[e.w] * gelu_erf(s.w * USC[e.w]);
        ((uint2*)CFH)[i] = make_uint2(pack2(ox, oy), pack2(oz, ow));
        ((uint2*)E16)[i] = make_uint2((unsigned)e.x | ((unsigned)e.y << 16), (unsigned)e.z | ((unsigned)e.w << 16));
    }
}
__device__ __forceinline__ void pv4_issue(uint4 (&r)[4], float (&cc)[4], const u8* vb, const unsigned short* le, const bf16* lc, int k0) {
    const uint2 e8 = *(const uint2*)(le + k0), c8 = *(const uint2*)(lc + k0);
    const unsigned ew[2] = {e8.x, e8.y}, cw[2] = {c8.x, c8.y};
#pragma unroll
    for (int q = 0; q < 2; ++q) { r[2 * q] = *(const uint4*)(vb + (size_t)(ew[q] & 0xFFFFu) * 512); r[2 * q + 1] = *(const uint4*)(vb + (size_t)(ew[q] >> 16) * 512);
        cc[2 * q] = bflo(cw[q]); cc[2 * q + 1] = bfhi(cw[q]); }
}
__device__ __forceinline__ void pv4_fma(float (&acc)[32], const uint4 (&r)[4], const float (&cc)[4]) {
#pragma unroll
    for (int j = 0; j < 4; ++j) {
        const unsigned w[4] = {r[j].x, r[j].y, r[j].z, r[j].w};
#pragma unroll
        for (int q = 0; q < 4; ++q) {
            const auto b0 = __builtin_amdgcn_cvt_scalef32_pk_f32_fp4(w[q], 1.0f, 0), b1 = __builtin_amdgcn_cvt_scalef32_pk_f32_fp4(w[q], 1.0f, 1);
            const auto b2 = __builtin_amdgcn_cvt_scalef32_pk_f32_fp4(w[q], 1.0f, 2), b3 = __builtin_amdgcn_cvt_scalef32_pk_f32_fp4(w[q], 1.0f, 3);
            acc[8 * q] += cc[j] * b0[0]; acc[8 * q + 1] += cc[j] * b0[1]; acc[8 * q + 2] += cc[j] * b1[0]; acc[8 * q + 3] += cc[j] * b1[1];
            acc[8 * q + 4] += cc[j] * b2[0]; acc[8 * q + 5] += cc[j] * b2[1]; acc[8 * q + 6] += cc[j] * b3[0]; acc[8 * q + 7] += cc[j] * b3[1];
        }
        __builtin_amdgcn_sched_barrier(0);
    }
}
__device__ __forceinline__ void ph_peer_v5(unsigned char* shm, const Part pt, const float* X1, float* X2, const u8* __restrict__ V4, const unsigned short* __restrict__ E16, const bf16* __restrict__ CFH, float* __restrict__ SS) {
    const int wv = threadIdx.x >> 6;
    const int rank = pt.rank, nrank = pt.nrank, gstep = nrank * 8;
    for (int p = pt.p0; p < 4; p += pt.pstep) {
        int g = rank * 8 + wv;
        if (g >= T / 8) continue;
        uint4 pe0, pe1, pf0, pf1;
        { const int l0 = threadIdx.x & 63; const size_t o = (size_t)(g * 8 + (l0 >> 3)) * 128 + (l0 & 7) * 16;
          pe0 = *(const uint4*)(E16 + o); pe1 = *(const uint4*)(E16 + o + 8); pf0 = *(const uint4*)(CFH + o); pf1 = *(const uint4*)(CFH + o + 8); }
#pragma unroll 1
        for (; g < T / 8; g += gstep) {
            const int lane = opq((int)threadIdx.x) & 63, tk = lane >> 3, pc = lane & 7;
            unsigned short* le = (unsigned short*)(shm + wv * 4096) + tk * 128; bf16* lc = (bf16*)(shm + wv * 4096 + 2048) + tk * 128;
            const u8* vb = V4 + p * 128 + pc * 16;
            const int t = g * 8 + tk;
            __builtin_amdgcn_wave_barrier();
            *(uint4*)(le + pc * 16) = pe0; *(uint4*)(le + pc * 16 + 8) = pe1; *(uint4*)(lc + pc * 16) = pf0; *(uint4*)(lc + pc * 16 + 8) = pf1;
            asm volatile("s_waitcnt lgkmcnt(0)" ::: "memory"); __builtin_amdgcn_wave_barrier();
            float acc[32];
#pragma unroll
            for (int i = 0; i < 32; ++i) acc[i] = 0.f;
            if (g + gstep < T / 8) { const size_t o = (size_t)((g + gstep) * 8 + tk) * 128 + pc * 16;
                pe0 = *(const uint4*)(E16 + o); pe1 = *(const uint4*)(E16 + o + 8); pf0 = *(const uint4*)(CFH + o); pf1 = *(const uint4*)(CFH + o + 8); }
            uint4 rA[4], rB[4]; float cA[4], cB[4];
            pv4_issue(rA, cA, vb, le, lc, 0);
#pragma unroll 1
            for (int k0 = 0; k0 < 128; k0 += 8) {
                pv4_issue(rB, cB, vb, le, lc, k0 + 4);
                pv4_fma(acc, rA, cA);
                if (k0 + 8 < 128) pv4_issue(rA, cA, vb, le, lc, k0 + 8);
                pv4_fma(acc, rB, cB);
            }
            float ss = 0.f;
            { const float* xr = X1 + (size_t)t * D + p * 256 + pc * 32; float* orow = X2 + (size_t)t * D + p * 256 + pc * 32;
#pragma unroll
              for (int i = 0; i < 8; ++i) { const float4 v = ((const float4*)xr)[i]; const float a = acc[4 * i] + v.x, b = acc[4 * i + 1] + v.y, c = acc[4 * i + 2] + v.z, d = acc[4 * i + 3] + v.w;
                  ss += a * a + b * b + c * c + d * d; ((float4*)orow)[i] = make_float4(a, b, c, d); } }
            ss += __shfl_xor(ss, 1, 64); ss += __shfl_xor(ss, 2, 64); ss += __shfl_xor(ss, 4, 64);
            if (pc == 0) { SS[(size_t)t * 8 + p] = ss; SS[(size_t)t * 8 + 4 + p] = 0.f; }
        }
    }
}

__device__ __forceinline__ unsigned pack4_i8(float a, float b, float c, float d) {
    const int ia = (int)rintf(a), ib = (int)rintf(b), ic = (int)rintf(c), id = (int)rintf(d);
    return (unsigned)(ia & 0xFF) | ((unsigned)(ib & 0xFF) << 8) | ((unsigned)(ic & 0xFF) << 16) | ((unsigned)(id & 0xFF) << 24);
}
__device__ __forceinline__ void ph_cvt_i8(int bid, int nblk, const float* __restrict__ src, u8* __restrict__ dst, float* __restrict__ scale, int rows) {
    const int tid_ = opq((int)threadIdx.x), wave = (bid * 512 + tid_) >> 6, nw = (nblk * 512) >> 6, lane = tid_ & 63;
    float4 nx[4];
    if (wave < rows) {
#pragma unroll
        for (int i = 0; i < 4; ++i) nx[i] = ((const float4*)(src + (size_t)wave * 1024))[lane + 64 * i];
    }
    for (int r = wave; r < rows; r += nw) {
        float4 v[4]; float mx = 0.f;
#pragma unroll
        for (int i = 0; i < 4; ++i) v[i] = nx[i];
        if (r + nw < rows) {
#pragma unroll
            for (int i = 0; i < 4; ++i) nx[i] = ((const float4*)(src + (size_t)(r + nw) * 1024))[lane + 64 * i];
        }
#pragma unroll
        for (int i = 0; i < 4; ++i) mx = fmaxf(mx, fmaxf(fmaxf(fabsf(v[i].x), fabsf(v[i].y)), fmaxf(fabsf(v[i].z), fabsf(v[i].w))));
        mx = wave_max(mx);
        const float sc = fmaxf(mx, 1e-30f) * (1.f / 127.f), inv = 1.f / sc;
#pragma unroll
        for (int i = 0; i < 4; ++i) ((unsigned*)(dst + (size_t)r * 1024))[lane + 64 * i] = pack4_i8(v[i].x * inv, v[i].y * inv, v[i].z * inv, v[i].w * inv);
        if (lane == 0) scale[r] = sc;
    }
}
__device__ __forceinline__ void ph_rowstat(int bid, int nblk, const bf16* __restrict__ x, const float* __restrict__ g, u8* __restrict__ h8, float* __restrict__ hs, float* __restrict__ scl, int rows) {
    const int tid_ = opq((int)threadIdx.x), wave = (bid * 512 + tid_) >> 6, nw = (nblk * 512) >> 6, lane = tid_ & 63;
    float4 gg[4]; uint2 nx[4];
#pragma unroll
    for (int i = 0; i < 4; ++i) gg[i] = ((const float4*)g)[lane + 64 * i];
    if (wave < rows) {
#pragma unroll
        for (int i = 0; i < 4; ++i) nx[i] = ((const uint2*)(x + (size_t)wave * D))[lane + 64 * i];
    }
    for (int r = wave; r < rows; r += nw) {
        float4 v[4]; float ss = 0.f;
#pragma unroll
        for (int i = 0; i < 4; ++i) v[i] = make_float4(bflo(nx[i].x), bfhi(nx[i].x), bflo(nx[i].y), bfhi(nx[i].y));
        if (r + nw < rows) {
#pragma unroll
            for (int i = 0; i < 4; ++i) nx[i] = ((const uint2*)(x + (size_t)(r + nw) * D))[lane + 64 * i];
        }
#pragma unroll
        for (int i = 0; i < 4; ++i) ss += v[i].x * v[i].x + v[i].y * v[i].y + v[i].z * v[i].z + v[i].w * v[i].w;
        const float sc = rsqrtf(wave_sum(ss) * (1.f / D) + 1e-6f);
        float mx = 0.f;
#pragma unroll
        for (int i = 0; i < 4; ++i) {
            v[i].x *= sc * gg[i].x; v[i].y *= sc * gg[i].y; v[i].z *= sc * gg[i].z; v[i].w *= sc * gg[i].w;
            mx = fmaxf(mx, fmaxf(fmaxf(fabsf(v[i].x), fabsf(v[i].y)), fmaxf(fabsf(v[i].z), fabsf(v[i].w)))); }
        mx = wave_max(mx);
        const float hsc = fmaxf(mx, 1e-30f) * (1.f / 119.f), inv = 1.f / hsc;
#pragma unroll
        for (int i = 0; i < 4; ++i) ((unsigned*)(h8 + (size_t)r * D))[lane + 64 * i] = pack4_i8(v[i].x * inv, v[i].y * inv, v[i].z * inv, v[i].w * inv);
        if (lane == 0) { hs[r] = hsc; scl[r] = sc; }
    }
}
__device__ __forceinline__ float pw_dot8_i8(const uint4 (&r)[8], const uint4 hq, int pc) {
    int d[8];
#pragma unroll
    for (int j = 0; j < 8; ++j) {
        int s = __builtin_amdgcn_sdot4((int)r[j].x, (int)hq.x, 0, false);
        s = __builtin_amdgcn_sdot4((int)r[j].y, (int)hq.y, s, false); s = __builtin_amdgcn_sdot4((int)r[j].z, (int)hq.z, s, false); s = __builtin_amdgcn_sdot4((int)r[j].w, (int)hq.w, s, false);
        d[j] = s;
    }
    int e4[4], e2[2];
#pragma unroll
    for (int j = 0; j < 4; ++j) { const int snd = (pc & 4) ? d[j] : d[j + 4], kp = (pc & 4) ? d[j + 4] : d[j]; e4[j] = kp + __shfl_xor(snd, 4, 64); }
#pragma unroll
    for (int j = 0; j < 2; ++j) { const int snd = (pc & 2) ? e4[j] : e4[j + 2], kp = (pc & 2) ? e4[j + 2] : e4[j]; e2[j] = kp + __shfl_xor(snd, 2, 64); }
    { const int snd = (pc & 1) ? e2[0] : e2[1], kp = (pc & 1) ? e2[1] : e2[0]; return (float)(kp + __shfl_xor(snd, 1, 64)); }
}
__device__ __forceinline__ void ph_peer_u6(unsigned char* shm, const Part pt, const u8* __restrict__ H8, const float* __restrict__ HS, const u8* __restrict__ U8, const int* __restrict__ EID, float* __restrict__ PART) {
    const int wv = threadIdx.x >> 6;
    const int rank = pt.rank, nrank = pt.nrank, gstep = nrank * 8;
    for (int p = pt.p0; p < 8; p += pt.pstep) {
        int g = rank * 8 + wv;
        if (g >= T / 8) continue;
        int4 pe0, pe1, pe2, pe3;
        { const int l0 = threadIdx.x & 63; const int* er = EID + (size_t)(g * 8 + (l0 >> 3)) * 128 + (l0 & 7) * 16;
          pe0 = *(const int4*)(er); pe1 = *(const int4*)(er + 4); pe2 = *(const int4*)(er + 8); pe3 = *(const int4*)(er + 12); }
#pragma unroll 1
        for (; g < T / 8; g += gstep) {
            const int lane = opq((int)threadIdx.x) & 63, tk = lane >> 3, pc = lane & 7;
            int* le = (int*)shm + wv * 1024 + tk * 128;
            const u8* ub = U8 + p * 128 + pc * 16;
            const int t = g * 8 + tk;
            __builtin_amdgcn_wave_barrier();
            *(int4*)(le + pc * 16) = pe0; *(int4*)(le + pc * 16 + 4) = pe1; *(int4*)(le + pc * 16 + 8) = pe2; *(int4*)(le + pc * 16 + 12) = pe3;
            asm volatile("s_waitcnt lgkmcnt(0)" ::: "memory"); __builtin_amdgcn_wave_barrier();
            const uint4 hq = *(const uint4*)(H8 + (size_t)t * 1024 + p * 128 + pc * 16);
            const float hsc = HS[t];
            if (g + gstep < T / 8) { const int* er = EID + (size_t)((g + gstep) * 8 + tk) * 128 + pc * 16;
                pe0 = *(const int4*)(er); pe1 = *(const int4*)(er + 4); pe2 = *(const int4*)(er + 8); pe3 = *(const int4*)(er + 12); }
            float* prow = PART + ((size_t)p * T + t) * 128 + pc;
            uint4 rA[8], rB[8];
            pw_issue(rA, ub, le, 0);
#pragma unroll 1
            for (int k0 = 0; k0 < 128; k0 += 16) {
                pw_issue(rB, ub, le, k0 + 8);
                prow[k0] = pw_dot8_i8(rA, hq, pc) * hsc;
                if (k0 + 16 < 128) pw_issue(rA, ub, le, k0 + 16);
                prow[k0 + 8] = pw_dot8_i8(rB, hq, pc) * hsc;
            }
        }
    }
}

__device__ __forceinline__ void ph_peer_cf3(int bid, int nblk, const bf16* __restrict__ PART, const float* __restrict__ USC, const float* __restrict__ VSC, const unsigned short* __restrict__ E16, const float* __restrict__ GATE,
                                            unsigned* __restrict__ CFQ, float* __restrict__ CS, int npart) {
    const int tid_ = opq((int)threadIdx.x);
    for (size_t i = (size_t)bid * 512 + tid_; i < (size_t)T * 128 / 4; i += (size_t)nblk * 512) {
        float4 s = make_float4(0.f, 0.f, 0.f, 0.f);
#pragma unroll 1
        for (int p = 0; p < npart; ++p) { const uint2 v = ((const uint2*)(PART + (size_t)p * T * 128))[i]; s.x += bflo(v.x); s.y += bfhi(v.x); s.z += bflo(v.y); s.w += bfhi(v.y); }
        const uint2 e2 = ((const uint2*)E16)[i]; const float4 g = ((const float4*)GATE)[i];
        const unsigned ex = e2.x & 0xFFFFu, ey = e2.x >> 16, ez = e2.y & 0xFFFFu, ew = e2.y >> 16;
        const float ox = g.x * VSC[ex] * gelu_erf(s.x * USC[ex]), oy = g.y * VSC[ey] * gelu_erf(s.y * USC[ey]), oz = g.z * VSC[ez] * gelu_erf(s.z * USC[ez]), ow = g.w * VSC[ew] * gelu_erf(s.w * USC[ew]);
        float m = fmaxf(fmaxf(fabsf(ox), fabsf(oy)), fmaxf(fabsf(oz), fabsf(ow)));
#pragma unroll
        for (int o = 1; o < 32; o <<= 1) m = fmaxf(m, __shfl_xor(m, o, 64));
        const float cs = fmaxf(m, 1e-30f) * (1.f / 127.f), inv = 1.f / cs;
        CFQ[i] = pack4_i8(ox * inv, oy * inv, oz * inv, ow * inv);
        if ((i & 31) == 0) CS[i >> 5] = cs;
    }
}
__device__ __forceinline__ void pv6_issue(uint4 (&r)[8], uint2& cq, const u8* vb, const unsigned short* le, const unsigned* lq, int k0) {
    const uint4 e8 = *(const uint4*)(le + k0); cq = *(const uint2*)(lq + (k0 >> 2));
    const unsigned ew[4] = {e8.x, e8.y, e8.z, e8.w};
#pragma unroll
    for (int q = 0; q < 4; ++q) { r[2 * q] = *(const uint4*)(vb + (size_t)(ew[q] & 0xFFFFu) * 1024); r[2 * q + 1] = *(const uint4*)(vb + (size_t)(ew[q] >> 16) * 1024); }
}
__device__ __forceinline__ void pv6_quad(int (&acc)[16], const uint4& a, const uint4& b, const uint4& c, const uint4& d, unsigned cf4) {
    const unsigned aw[4] = {a.x, a.y, a.z, a.w}, bw[4] = {b.x, b.y, b.z, b.w}, cw[4] = {c.x, c.y, c.z, c.w}, dw[4] = {d.x, d.y, d.z, d.w};
#pragma unroll
    for (int q = 0; q < 4; ++q) {
        const unsigned t0 = __builtin_amdgcn_perm(bw[q], aw[q], 0x05010400u), t1 = __builtin_amdgcn_perm(bw[q], aw[q], 0x07030602u);
        const unsigned t2 = __builtin_amdgcn_perm(dw[q], cw[q], 0x05010400u), t3 = __builtin_amdgcn_perm(dw[q], cw[q], 0x07030602u);
        const unsigned c0 = __builtin_amdgcn_perm(t2, t0, 0x05040100u), c1 = __builtin_amdgcn_perm(t2, t0, 0x07060302u);
        const unsigned c2 = __builtin_amdgcn_perm(t3, t1, 0x05040100u), c3 = __builtin_amdgcn_perm(t3, t1, 0x07060302u);
        acc[4 * q] = __builtin_amdgcn_sdot4((int)c0, (int)cf4, acc[4 * q], false); acc[4 * q + 1] = __builtin_amdgcn_sdot4((int)c1, (int)cf4, acc[4 * q + 1], false);
        acc[4 * q + 2] = __builtin_amdgcn_sdot4((int)c2, (int)cf4, acc[4 * q + 2], false); acc[4 * q + 3] = __builtin_amdgcn_sdot4((int)c3, (int)cf4, acc[4 * q + 3], false);
    }
}
typedef int v4i_t __attribute__((ext_vector_type(4)));
__device__ __forceinline__ void pv7_quad(v4i_t (&acc)[4], const uint4& a, const uint4& b, const uint4& c, const uint4& d, unsigned cf4, const unsigned (&sel)[4]) {
    const uint4 rw[4] = {a, b, c, d};
#pragma unroll
    for (int s_ = 0; s_ < 4; ++s_) {
        const int ad = (int)__builtin_amdgcn_perm(cf4, 0u, sel[s_]);
        acc[0] = __builtin_amdgcn_mfma_i32_4x4x4i8(ad, (int)rw[s_].x, acc[0], 0, 0, 0);
        acc[1] = __builtin_amdgcn_mfma_i32_4x4x4i8(ad, (int)rw[s_].y, acc[1], 0, 0, 0);
        acc[2] = __builtin_amdgcn_mfma_i32_4x4x4i8(ad, (int)rw[s_].z, acc[2], 0, 0, 0);
        acc[3] = __builtin_amdgcn_mfma_i32_4x4x4i8(ad, (int)rw[s_].w, acc[3], 0, 0, 0);
    }
}
__device__ __forceinline__ void pv8_issue(uint4 (&r)[8], uint2& cq, const u8* vb, const unsigned short* le, const unsigned* lq, int k0) {
    const uint4 e8 = *(const uint4*)(le + k0); cq = *(const uint2*)(lq + (k0 >> 2));
    const unsigned ew[4] = {e8.x, e8.y, e8.z, e8.w};
#pragma unroll
    for (int q = 0; q < 4; ++q) { r[2 * q] = *(const uint4*)(vb + (size_t)(ew[q] & 0xFFFFu) * 512); r[2 * q + 1] = *(const uint4*)(vb + (size_t)(ew[q] >> 16) * 512); }
}
__device__ __forceinline__ void pv8_quad(v4i_t (&aL)[4], v4i_t (&aH)[4], const uint4& a, const uint4& b, const uint4& c, const uint4& d, unsigned cf4, const unsigned (&sel)[4]) {
    const uint4 rw[4] = {a, b, c, d};
#pragma unroll
    for (int s_ = 0; s_ < 4; ++s_) {
        const int ad = (int)__builtin_amdgcn_perm(cf4, 0u, sel[s_]);
        const unsigned w[4] = {rw[s_].x, rw[s_].y, rw[s_].z, rw[s_].w};
#pragma unroll
        for (int q = 0; q < 4; ++q) {
            aL[q] = __builtin_amdgcn_mfma_i32_4x4x4i8(ad, (int)(w[q] & 0x0F0F0F0Fu), aL[q], 0, 0, 0);
            aH[q] = __builtin_amdgcn_mfma_i32_4x4x4i8(ad, (int)w[q], aH[q], 0, 0, 0);
        }
    }
}
constexpr int PV8_NB = 3;
__device__ __forceinline__ void ph_peer_v8(unsigned char* shm, const Part pt, const bf16* X1, bf16* X2, const u8* __restrict__ V4, const unsigned short* __restrict__ E16, const unsigned* __restrict__ CFQ,
                                           const float* __restrict__ CS, float* __restrict__ SS) {
    const int wv = threadIdx.x >> 6;
    const int rank = pt.rank, nrank = pt.nrank, gstep = nrank * 8;
    for (int p = pt.p0; p < 4; p += pt.pstep) {
        int g = rank * 8 + wv;
        if (g >= T / 8) continue;
        uint4 pe0, pe1, pq0;
        { const int l0 = threadIdx.x & 63; const size_t o = (size_t)(g * 8 + (l0 >> 3)) * 128 + (l0 & 7) * 16;
          pe0 = *(const uint4*)(E16 + o); pe1 = *(const uint4*)(E16 + o + 8); pq0 = *(const uint4*)(CFQ + (o >> 2)); }
#pragma unroll 1
        for (; g < T / 8; g += gstep) {
            const int lane = opq((int)threadIdx.x) & 63, tk = lane >> 3, pc = lane & 7;
            unsigned short* le = (unsigned short*)(shm + wv * 3072) + tk * 128; unsigned* lq = (unsigned*)(shm + wv * 3072 + 2048) + tk * 32;
            const u8* vb = V4 + p * 128 + pc * 16;
            const int t = g * 8 + tk;
            __builtin_amdgcn_wave_barrier();
            *(uint4*)(le + pc * 16) = pe0; *(uint4*)(le + pc * 16 + 8) = pe1; *(uint4*)(lq + pc * 4) = pq0;
            asm volatile("s_waitcnt lgkmcnt(0)" ::: "memory"); __builtin_amdgcn_wave_barrier();
            const float cs = CS[t];
            const bf16* xrow = X1 + (size_t)t * D + p * 256 + pc * 32;
            const uint4 xv0 = *(const uint4*)xrow, xv1 = *(const uint4*)(xrow + 8), xv2 = *(const uint4*)(xrow + 16), xv3 = *(const uint4*)(xrow + 24);
            int csum = __builtin_amdgcn_sdot4((int)pq0.x, 0x01010101, 0, false);
            csum = __builtin_amdgcn_sdot4((int)pq0.y, 0x01010101, csum, false); csum = __builtin_amdgcn_sdot4((int)pq0.z, 0x01010101, csum, false); csum = __builtin_amdgcn_sdot4((int)pq0.w, 0x01010101, csum, false);
            csum += __shfl_xor(csum, 1, 64); csum += __shfl_xor(csum, 2, 64); csum += __shfl_xor(csum, 4, 64);
            v4i_t aL[4], aH[4];
#pragma unroll
            for (int i = 0; i < 4; ++i) { aL[i] = (v4i_t){0, 0, 0, 0}; aH[i] = (v4i_t){0, 0, 0, 0}; }
            unsigned sel[4];
#pragma unroll
            for (int i = 0; i < 4; ++i) sel[i] = 0x0C0C0C0Cu ^ ((0x0Cu ^ (4u + i)) << (8 * (lane & 3)));
            if (g + gstep < T / 8) { const size_t o = (size_t)((g + gstep) * 8 + tk) * 128 + pc * 16;
                pe0 = *(const uint4*)(E16 + o); pe1 = *(const uint4*)(E16 + o + 8); pq0 = *(const uint4*)(CFQ + (o >> 2)); }
            uint4 rr[PV8_NB][8]; uint2 qq[PV8_NB];
#pragma unroll
            for (int bt = 0; bt < PV8_NB - 1; ++bt) pv8_issue(rr[bt], qq[bt], vb, le, lq, bt * 8);
#pragma unroll
            for (int bt = 0; bt < 16; ++bt) {
                if (bt + PV8_NB - 1 < 16) pv8_issue(rr[(bt + PV8_NB - 1) % PV8_NB], qq[(bt + PV8_NB - 1) % PV8_NB], vb, le, lq, (bt + PV8_NB - 1) * 8);
                __builtin_amdgcn_sched_barrier(0);
                pv8_quad(aL, aH, rr[bt % PV8_NB][0], rr[bt % PV8_NB][1], rr[bt % PV8_NB][2], rr[bt % PV8_NB][3], qq[bt % PV8_NB].x, sel);
                pv8_quad(aL, aH, rr[bt % PV8_NB][4], rr[bt % PV8_NB][5], rr[bt % PV8_NB][6], rr[bt % PV8_NB][7], qq[bt % PV8_NB].y, sel);
                __builtin_amdgcn_sched_barrier(0);
            }
            float ss = 0.f;
            { bf16* orow = X2 + (size_t)t * D + p * 256 + pc * 32;
              const unsigned xw[16] = {xv0.x, xv0.y, xv0.z, xv0.w, xv1.x, xv1.y, xv1.z, xv1.w, xv2.x, xv2.y, xv2.z, xv2.w, xv3.x, xv3.y, xv3.z, xv3.w}; unsigned ow[16];
              const int off8 = 8 * csum;
#pragma unroll
              for (int dw = 0; dw < 16; ++dw) {
                  const int lo_ = aL[dw >> 2][dw & 3], raw_ = aH[dw >> 2][dw & 3];
                  const float a = (float)(lo_ - off8) * cs + bflo(xw[dw]), b = (float)((raw_ - lo_) >> 4) * cs + bfhi(xw[dw]); ss += a * a + b * b; ow[dw] = pack2(a, b); }
              *(uint4*)orow = make_uint4(ow[0], ow[1], ow[2], ow[3]); *(uint4*)(orow + 8) = make_uint4(ow[4], ow[5], ow[6], ow[7]);
              *(uint4*)(orow + 16) = make_uint4(ow[8], ow[9], ow[10], ow[11]); *(uint4*)(orow + 24) = make_uint4(ow[12], ow[13], ow[14], ow[15]); }
            ss += __shfl_xor(ss, 1, 64); ss += __shfl_xor(ss, 2, 64); ss += __shfl_xor(ss, 4, 64);
            if (pc == 0) SS[(size_t)t * 8 + p] = ss;
            if (pc == 1) SS[(size_t)t * 8 + 4 + p] = 0.f;
        }
    }
}
__device__ __forceinline__ void ph_peer_v6(unsigned char* shm, const Part pt, const bf16* X1, bf16* X2, const u8* __restrict__ V8, const unsigned short* __restrict__ E16, const unsigned* __restrict__ CFQ,
                                           const float* __restrict__ CS, float* __restrict__ SS) {
    const int wv = threadIdx.x >> 6;
    const int rank = pt.rank, nrank = pt.nrank, gstep = nrank * 8;
    for (int p = pt.p0; p < 8; p += pt.pstep) {
        int g = rank * 8 + wv;
        if (g >= T / 8) continue;
        uint4 pe0, pe1, pq0;
        { const int l0 = threadIdx.x & 63; const size_t o = (size_t)(g * 8 + (l0 >> 3)) * 128 + (l0 & 7) * 16;
          pe0 = *(const uint4*)(E16 + o); pe1 = *(const uint4*)(E16 + o + 8); pq0 = *(const uint4*)(CFQ + (o >> 2)); }
#pragma unroll 1
        for (; g < T / 8; g += gstep) {
            const int lane = opq((int)threadIdx.x) & 63, tk = lane >> 3, pc = lane & 7;
            unsigned short* le = (unsigned short*)(shm + wv * 3072) + tk * 128; unsigned* lq = (unsigned*)(shm + wv * 3072 + 2048) + tk * 32;
            const u8* vb = V8 + p * 128 + pc * 16;
            const int t = g * 8 + tk;
            __builtin_amdgcn_wave_barrier();
            *(uint4*)(le + pc * 16) = pe0; *(uint4*)(le + pc * 16 + 8) = pe1; *(uint4*)(lq + pc * 4) = pq0;
            asm volatile("s_waitcnt lgkmcnt(0)" ::: "memory"); __builtin_amdgcn_wave_barrier();
            const float cs = CS[t];
            const uint4 xv0 = *(const uint4*)(X1 + (size_t)t * D + p * 128 + pc * 16), xv1 = *(const uint4*)(X1 + (size_t)t * D + p * 128 + pc * 16 + 8);
            v4i_t acq[4];
#pragma unroll
            for (int i = 0; i < 4; ++i) acq[i] = (v4i_t){0, 0, 0, 0};
            unsigned sel[4];
#pragma unroll
            for (int i = 0; i < 4; ++i) sel[i] = 0x0C0C0C0Cu ^ ((0x0Cu ^ (4u + i)) << (8 * (lane & 3)));
            if (g + gstep < T / 8) { const size_t o = (size_t)((g + gstep) * 8 + tk) * 128 + pc * 16;
                pe0 = *(const uint4*)(E16 + o); pe1 = *(const uint4*)(E16 + o + 8); pq0 = *(const uint4*)(CFQ + (o >> 2)); }
            uint4 rA[8], rB[8]; uint2 qA, qB;
            pv6_issue(rA, qA, vb, le, lq, 0);
#pragma unroll 1
            for (int k0 = 0; k0 < 112; k0 += 16) {
                pv6_issue(rB, qB, vb, le, lq, k0 + 8);
                pv7_quad(acq, rA[0], rA[1], rA[2], rA[3], qA.x, sel); pv7_quad(acq, rA[4], rA[5], rA[6], rA[7], qA.y, sel);
                pv6_issue(rA, qA, vb, le, lq, k0 + 16);
                pv7_quad(acq, rB[0], rB[1], rB[2], rB[3], qB.x, sel); pv7_quad(acq, rB[4], rB[5], rB[6], rB[7], qB.y, sel);
            }
            pv6_issue(rB, qB, vb, le, lq, 120);
            pv7_quad(acq, rA[0], rA[1], rA[2], rA[3], qA.x, sel); pv7_quad(acq, rA[4], rA[5], rA[6], rA[7], qA.y, sel);
            pv7_quad(acq, rB[0], rB[1], rB[2], rB[3], qB.x, sel); pv7_quad(acq, rB[4], rB[5], rB[6], rB[7], qB.y, sel);
            float ss = 0.f;
            { bf16* orow = X2 + (size_t)t * D + p * 128 + pc * 16;
              const unsigned xw[8] = {xv0.x, xv0.y, xv0.z, xv0.w, xv1.x, xv1.y, xv1.z, xv1.w}; unsigned ow[8];
#pragma unroll
              for (int i = 0; i < 8; ++i) { const float a = (float)acq[i >> 1][(2 * i) & 3] * cs + bflo(xw[i]), b = (float)acq[i >> 1][(2 * i + 1) & 3] * cs + bfhi(xw[i]); ss += a * a + b * b; ow[i] = pack2(a, b); }
              *(uint4*)orow = make_uint4(ow[0], ow[1], ow[2], ow[3]); *(uint4*)(orow + 8) = make_uint4(ow[4], ow[5], ow[6], ow[7]); }
            ss += __shfl_xor(ss, 1, 64); ss += __shfl_xor(ss, 2, 64); ss += __shfl_xor(ss, 4, 64);
            if (pc == 0) SS[(size_t)t * 8 + p] = ss;
        }
    }
}

template <bool OFFS> __device__ __forceinline__ void ph_cvt_i4(int bid, int nblk, const float* __restrict__ src, u8* __restrict__ dst, float* __restrict__ scale, int rows) {
    const int tid_ = opq((int)threadIdx.x), wave = (bid * 512 + tid_) >> 6, nw = (nblk * 512) >> 6, lane = tid_ & 63;
    for (int r = wave; r < rows; r += nw) {
        const float4* xr = (const float4*)(src + (size_t)r * 1024 + lane * 16);
        float4 v[4]; float ss = 0.f;
#pragma unroll
        for (int i = 0; i < 4; ++i) { v[i] = xr[i]; ss += v[i].x * v[i].x + v[i].y * v[i].y + v[i].z * v[i].z + v[i].w * v[i].w; }
        ss = wave_sum(ss);
        const float sc = fmaxf(sqrtf(ss * (1.f / 1024.f)), 1e-30f) * 0.3352f, inv = 1.f / sc;
        unsigned w[2] = {0u, 0u};
#pragma unroll
        for (int i = 0; i < 4; ++i) {
            const float f[4] = {v[i].x, v[i].y, v[i].z, v[i].w};
#pragma unroll
            for (int j = 0; j < 4; ++j) { const int q0 = (int)fminf(fmaxf(rintf(f[j] * inv), -8.f), 7.f); const int q = (OFFS && !(j & 1)) ? (q0 + 8) : (q0 & 15); w[i >> 1] |= (unsigned)q << (4 * ((i & 1) * 4 + j)); }
        }
        *(uint2*)(dst + (size_t)r * 512 + lane * 8) = make_uint2(w[0], w[1]);
        if (lane == 0) scale[r] = sc;
    }
}
__device__ __forceinline__ void pw4_issue(uint4 (&r)[8], const u8* ub, const int* le, int k0) {
#pragma unroll
    for (int q = 0; q < 2; ++q) { const int4 e4 = *(const int4*)(le + k0 + 4 * q);
        r[4 * q] = *(const uint4*)(ub + (size_t)e4.x * 512); r[4 * q + 1] = *(const uint4*)(ub + (size_t)e4.y * 512); r[4 * q + 2] = *(const uint4*)(ub + (size_t)e4.z * 512); r[4 * q + 3] = *(const uint4*)(ub + (size_t)e4.w * 512); }
}
__device__ __forceinline__ float pw_dot8_i4(const uint4 (&r)[8], const unsigned (&he)[4], const unsigned (&ho)[4], int hsum8, int pc) {
    int d[8];
#pragma unroll
    for (int j = 0; j < 8; ++j) {
        const unsigned w[4] = {r[j].x, r[j].y, r[j].z, r[j].w};
        int s = -hsum8;
#pragma unroll
        for (int q = 0; q < 4; ++q) { s = __builtin_amdgcn_sdot4((int)(w[q] & 0x0F0F0F0Fu), (int)he[q], s, false); s = __builtin_amdgcn_sdot4((int)((w[q] >> 4) & 0x0F0F0F0Fu), (int)ho[q], s, false); }
        d[j] = s;
    }
    int e4[4], e2[2];
#pragma unroll
    for (int j = 0; j < 4; ++j) { const int snd = (pc & 4) ? d[j] : d[j + 4], kp = (pc & 4) ? d[j + 4] : d[j]; e4[j] = kp + __shfl_xor(snd, 4, 64); }
#pragma unroll
    for (int j = 0; j < 2; ++j) { const int snd = (pc & 2) ? e4[j] : e4[j + 2], kp = (pc & 2) ? e4[j + 2] : e4[j]; e2[j] = kp + __shfl_xor(snd, 2, 64); }
    { const int snd = (pc & 1) ? e2[0] : e2[1], kp = (pc & 1) ? e2[1] : e2[0]; return (float)(kp + __shfl_xor(snd, 1, 64)); }
}
__device__ __forceinline__ float pw_dot8_n4(const uint4 (&r)[8], const unsigned (&hA)[4], const unsigned (&hB)[4], int pc) {
    int d[8];
#pragma unroll
    for (int j = 0; j < 8; ++j) {
        const unsigned w[4] = {r[j].x, r[j].y, r[j].z, r[j].w};
        int hi = 0, lo = 0;
#pragma unroll
        for (int q = 0; q < 4; ++q) { hi = __builtin_amdgcn_sdot8((int)w[q], (int)hA[q], hi, false); lo = __builtin_amdgcn_sdot8((int)w[q], (int)hB[q], lo, false); }
        d[j] = hi * 16 + lo;
    }
    int e4[4], e2[2];
#pragma unroll
    for (int j = 0; j < 4; ++j) { const int snd = (pc & 4) ? d[j] : d[j + 4], kp = (pc & 4) ? d[j + 4] : d[j]; e4[j] = kp + __shfl_xor(snd, 4, 64); }
#pragma unroll
    for (int j = 0; j < 2; ++j) { const int snd = (pc & 2) ? e4[j] : e4[j + 2], kp = (pc & 2) ? e4[j + 2] : e4[j]; e2[j] = kp + __shfl_xor(snd, 2, 64); }
    { const int snd = (pc & 1) ? e2[0] : e2[1], kp = (pc & 1) ? e2[1] : e2[0]; return (float)(kp + __shfl_xor(snd, 1, 64)); }
}
__device__ __forceinline__ unsigned nib_compact4(unsigned x) { const unsigned y = (x | (x >> 4)) & 0x00FF00FFu; return (y | (y >> 8)) & 0xFFFFu; }
__device__ __forceinline__ void pw5_issue(uint4 (&r)[8], const u8* ub, const unsigned short* le, int k0) {
    const uint4 e8 = *(const uint4*)(le + k0);
    const unsigned ew[4] = {e8.x, e8.y, e8.z, e8.w};
#pragma unroll
    for (int q = 0; q < 4; ++q) { r[2 * q] = *(const uint4*)(ub + (size_t)(ew[q] & 0xFFFFu) * 512); r[2 * q + 1] = *(const uint4*)(ub + (size_t)(ew[q] >> 16) * 512); }
}
constexpr int PU7_NB = 3;
__device__ __forceinline__ void ph_peer_u7(unsigned char* shm, const Part pt, const u8* __restrict__ H8, const float* __restrict__ HS, const u8* __restrict__ U4, const unsigned short* __restrict__ E16, bf16* __restrict__ PART) {
    const int wv = threadIdx.x >> 6;
    const int rank = pt.rank, nrank = pt.nrank, gstep = nrank * 8;
    for (int p = pt.p0; p < 4; p += pt.pstep) {
        int g = rank * 8 + wv;
        if (g >= T / 8) continue;
        uint4 pe0, pe1;
        { const int l0 = threadIdx.x & 63; const unsigned short* er = E16 + (size_t)(g * 8 + (l0 >> 3)) * 128 + (l0 & 7) * 16;
          pe0 = *(const uint4*)(er); pe1 = *(const uint4*)(er + 8); }
#pragma unroll 1
        for (; g < T / 8; g += gstep) {
            const int lane = opq((int)threadIdx.x) & 63, tk = lane >> 3, pc = lane & 7;
            unsigned short* le = (unsigned short*)(shm + wv * 2048) + tk * 128;
            const u8* ub = U4 + p * 128 + pc * 16;
            const int t = g * 8 + tk;
            __builtin_amdgcn_wave_barrier();
            *(uint4*)(le + pc * 16) = pe0; *(uint4*)(le + pc * 16 + 8) = pe1;
            asm volatile("s_waitcnt lgkmcnt(0)" ::: "memory"); __builtin_amdgcn_wave_barrier();
            const uint4 ha = *(const uint4*)(H8 + (size_t)t * 1024 + p * 256 + pc * 32), hb = *(const uint4*)(H8 + (size_t)t * 1024 + p * 256 + pc * 32 + 16);
            const unsigned hw[8] = {ha.x, ha.y, ha.z, ha.w, hb.x, hb.y, hb.z, hb.w};
            unsigned hA[4], hB[4];
#pragma unroll
            for (int q = 0; q < 4; ++q) {
                unsigned pa[2], pb[2];
#pragma unroll
                for (int e = 0; e < 2; ++e) { const unsigned w = hw[2 * q + e];
                    const unsigned t8 = ((w & 0x7F7F7F7Fu) + 0x08080808u) ^ (w & 0x80808080u);
                    pa[e] = nib_compact4((t8 >> 4) & 0x0F0F0F0Fu); pb[e] = nib_compact4(w & 0x0F0F0F0Fu); }
                hA[q] = pa[0] | (pa[1] << 16); hB[q] = pb[0] | (pb[1] << 16);
            }
            const float hsc = HS[t];
            if (g + gstep < T / 8) { const unsigned short* er = E16 + (size_t)((g + gstep) * 8 + tk) * 128 + pc * 16;
                pe0 = *(const uint4*)(er); pe1 = *(const uint4*)(er + 8); }
            bf16* prow = PART + ((size_t)p * T + t) * 128 + pc;
            uint4 rr[PU7_NB][8];
#pragma unroll
            for (int bt = 0; bt < PU7_NB - 1; ++bt) pw5_issue(rr[bt], ub, le, bt * 8);
#pragma unroll
            for (int bt = 0; bt < 16; ++bt) {
                if (bt + PU7_NB - 1 < 16) pw5_issue(rr[(bt + PU7_NB - 1) % PU7_NB], ub, le, (bt + PU7_NB - 1) * 8);
                prow[bt * 8] = f2bf(pw_dot8_n4(rr[bt % PU7_NB], hA, hB, pc) * hsc);
            }
        }
    }
}

constexpr int C2_SLOT = 16384, C2_RING = 8, C2_SBUF = C2_RING * C2_SLOT;
__device__ __forceinline__ void chain2_dma(unsigned char* shm, int slot, const bf16* __restrict__ PHI, const bf16* __restrict__ PSI, size_t item, int w, int lane) {
    const bf16* src[2] = {PHI + item, PSI + item};
#pragma unroll
    for (int m = 0; m < 2; ++m)
#pragma unroll
        for (int i = 0; i < 2; ++i) {
            const int row = (w * 2 + i) * 8 + (lane >> 3), jj = (lane & 7) ^ (row & 7);
            __builtin_amdgcn_global_load_lds((const unsigned*)((const char*)src[m] + row * 128 + jj * 16),
                                             (PG8_LAS unsigned*)(shm + slot * C2_SLOT + m * 8192 + (w * 2 + i) * 1024), 16, 0, 0);
        }
}
__device__ __forceinline__ void ph_chain2(unsigned char* shm, int bh, bf16* __restrict__ PHI, const bf16* __restrict__ PSI) {
    const int b = bh >> 3, h = bh & 7, tid = threadIdx.x, lane = tid & 63, w = __builtin_amdgcn_readfirstlane((tid >> 6) & 3), fr = lane & 15, fq = lane >> 4;
    const size_t ib = ((size_t)(b * 64) * 8 + h) * 4096, istep = (size_t)8 * 4096;
#define CH_BAR() do { asm volatile("s_waitcnt lgkmcnt(0)" ::: "memory"); __builtin_amdgcn_s_barrier(); asm volatile("" ::: "memory"); } while (0)
    if (tid < 256) {
        pg8::bf16x8 sf[2];
#pragma unroll
        for (int j = 0; j < 8; ++j) { sf[0][j] = 0; sf[1][j] = 0; }
#pragma unroll
        for (int c = 0; c < 7; ++c) chain2_dma(shm, c, PHI, PSI, ib + (size_t)c * istep, w, lane);
#pragma unroll 1
        for (int ch = 0; ch < 64; ++ch) {
            asm volatile("s_waitcnt vmcnt(24)" ::: "memory");
            CH_BAR();
            chain2_dma(shm, (ch + 7) & 7, PHI, PSI, ib + (size_t)((ch + 7 < 64) ? ch + 7 : 63) * istep, w, lane);
            const unsigned char* sl = shm + (ch & 7) * C2_SLOT;
            f32x4 sa[4]; pg8::bf16x8 ap[4][2];
#pragma unroll
            for (int mt = 0; mt < 4; ++mt) {
                const int row = w * 16 + fr, sw = (((mt * 2 + (fq >> 1)) ^ (row & 7)) * 16) + (fq & 1) * 8;
                const uint2 ps = *(const uint2*)(sl + 8192 + row * 128 + sw);
                sa[mt][0] = bflo(ps.x); sa[mt][1] = bfhi(ps.x); sa[mt][2] = bflo(ps.y); sa[mt][3] = bfhi(ps.y);
#pragma unroll
                for (int ks = 0; ks < 2; ++ks) { const int ar = mt * 16 + fr; ap[mt][ks] = *(const pg8::bf16x8*)(sl + ar * 128 + (((ks * 4 + fq) ^ (ar & 7)) * 16)); }
            }
#pragma unroll
            for (int ks = 0; ks < 2; ++ks)
#pragma unroll
                for (int mt = 0; mt < 4; ++mt) sa[mt] = __builtin_amdgcn_mfma_f32_16x16x32_bf16(ap[mt][ks], sf[ks], sa[mt], 0, 0, 0);
            uint4 o0, o1;
            o0.x = pack2(sa[0][0], sa[0][1]); o0.y = pack2(sa[0][2], sa[0][3]); o0.z = pack2(sa[1][0], sa[1][1]); o0.w = pack2(sa[1][2], sa[1][3]);
            o1.x = pack2(sa[2][0], sa[2][1]); o1.y = pack2(sa[2][2], sa[2][3]); o1.z = pack2(sa[3][0], sa[3][1]); o1.w = pack2(sa[3][2], sa[3][3]);
            sf[0] = __builtin_bit_cast(pg8::bf16x8, o0); sf[1] = __builtin_bit_cast(pg8::bf16x8, o1);
            unsigned char* sb = shm + C2_SBUF + (ch & 1) * 8192 + w * 2048 + lane * 32;
            *(uint4*)sb = o0; *(uint4*)(sb + 16) = o1;
        }
        asm volatile("s_waitcnt vmcnt(0)" ::: "memory");
        CH_BAR();
    } else {
        CH_BAR();
#pragma unroll 1
        for (int ch = 1; ch < 64; ++ch) {
            CH_BAR();
            const unsigned char* sb = shm + C2_SBUF + ((ch - 1) & 1) * 8192 + w * 2048 + lane * 32;
            const uint4 a = *(const uint4*)sb, c = *(const uint4*)(sb + 16);
            bf16* dst = PHI + ib + (size_t)(ch - 1) * istep + w * 1024 + lane * 16;
            *(uint4*)dst = a; *(uint4*)(dst + 8) = c;
        }
        CH_BAR();
    }
#undef CH_BAR
    __syncthreads();
}

struct YoPre { uint4 s0, s1, a[2][2]; uint2 y0[2]; uint4 vv, gg; float bon; };
__device__ __forceinline__ void yout_load(YoPre& P, int it, const bf16* __restrict__ SPHI, const bf16* __restrict__ OMG, const bf16* __restrict__ Y0, const bf16* __restrict__ V, const bf16* __restrict__ G, const float* __restrict__ BONUS, int tid) {
    const int lane = tid & 63, wv = tid >> 6, vg = wv & 3, mh = wv >> 2, fr = lane & 15, fq = lane >> 4;
    const int ch = (it >> 3) & 63, h = it & 7, b = it >> 9;
    P.s0 = make_uint4(0, 0, 0, 0); P.s1 = make_uint4(0, 0, 0, 0);
    if (ch > 0) { const bf16* sp = SPHI + (size_t)(it - 8) * 4096 + vg * 1024 + lane * 16; P.s0 = *(const uint4*)sp; P.s1 = *(const uint4*)(sp + 8); }
#pragma unroll
    for (int q = 0; q < 2; ++q) { const int mt = mh * 2 + q;
        P.y0[q] = *(const uint2*)(Y0 + (size_t)it * 4096 + (vg * 16 + fr) * 64 + mt * 16 + 4 * fq);
#pragma unroll
        for (int ks = 0; ks < 2; ++ks) P.a[q][ks] = *(const uint4*)(OMG + (size_t)it * 4096 + (mt * 16 + fr) * 64 + ks * 32 + fq * 8); }
    const int et = tid >> 3, eq = tid & 7; const int t = b * SEQ + ch * 64 + et; const size_t o = (size_t)t * 512 + h * 64 + eq * 8;
    P.vv = *(const uint4*)(V + o); P.gg = *(const uint4*)(G + o); P.bon = BONUS[(size_t)t * 8 + h];
}
__device__ __forceinline__ void ph_yout(unsigned char* shm, int bid, int nblk, const bf16* __restrict__ SPHI, const bf16* __restrict__ OMG, const bf16* __restrict__ Y0, const bf16* __restrict__ V, const bf16* __restrict__ G,
                                        const float* __restrict__ BONUS, const float* __restrict__ gng, const float* __restrict__ gnb, bf16* __restrict__ O) {
    if (bid >= 2048) return;
    YoPre P, Q;
    yout_load(P, bid, SPHI, OMG, Y0, V, G, BONUS, threadIdx.x);
    if (bid + nblk < 2048) yout_load(Q, bid + nblk, SPHI, OMG, Y0, V, G, BONUS, threadIdx.x);
    int par = 0;
    for (int it = bid; it < 2048; it += nblk, par ^= 1) {
        const int tid = opq((int)threadIdx.x), lane = tid & 63, wv = tid >> 6, vg = wv & 3, mh = wv >> 2, fr = lane & 15, fq = lane >> 4;
        const int ch = (it >> 3) & 63, h = it & 7, b = it >> 9;
        bf16* yb = (bf16*)(shm + par * (64 * 72 * 2));
        const pg8::bf16x8 sf0 = __builtin_bit_cast(pg8::bf16x8, P.s0), sf1 = __builtin_bit_cast(pg8::bf16x8, P.s1);
#pragma unroll
        for (int q = 0; q < 2; ++q) { const int mt = mh * 2 + q;
            f32x4 ya; ya[0] = bflo(P.y0[q].x); ya[1] = bfhi(P.y0[q].x); ya[2] = bflo(P.y0[q].y); ya[3] = bfhi(P.y0[q].y);
            ya = __builtin_amdgcn_mfma_f32_16x16x32_bf16(__builtin_bit_cast(pg8::bf16x8, P.a[q][0]), sf0, ya, 0, 0, 0);
            ya = __builtin_amdgcn_mfma_f32_16x16x32_bf16(__builtin_bit_cast(pg8::bf16x8, P.a[q][1]), sf1, ya, 0, 0, 0);
#pragma unroll
            for (int r = 0; r < 4; ++r) yb[(mt * 16 + 4 * fq + r) * 72 + vg * 16 + fr] = f2bf(ya[r]); }
        const uint4 cv = P.vv, cg = P.gg; const float cbon = P.bon;
        P = Q;
        if (it + 2 * nblk < 2048) yout_load(Q, it + 2 * nblk, SPHI, OMG, Y0, V, G, BONUS, tid);
        __syncthreads();
        const int et = tid >> 3, eq = tid & 7; const int t = b * SEQ + ch * 64 + et;
        float y[8], s = 0.f;
        unpack8(*(const uint4*)(yb + et * 72 + eq * 8), y);
#pragma unroll
        for (int i = 0; i < 8; ++i) s += y[i];
        s += __shfl_xor(s, 1, 64); s += __shfl_xor(s, 2, 64); s += __shfl_xor(s, 4, 64);
        const float mean = s * (1.f / 64.f);
        float q = 0.f;
#pragma unroll
        for (int i = 0; i < 8; ++i) { y[i] -= mean; q += y[i] * y[i]; }
        q += __shfl_xor(q, 1, 64); q += __shfl_xor(q, 2, 64); q += __shfl_xor(q, 4, 64);
        const float rstd = rsqrtf(q * (1.f / 64.f) + 64e-5f);
        float v8[8], g8[8], o8[8]; unpack8(cv, v8); unpack8(cg, g8);
        const float4 w0 = *(const float4*)(gng + h * 64 + eq * 8), w1 = *(const float4*)(gng + h * 64 + eq * 8 + 4), b0 = *(const float4*)(gnb + h * 64 + eq * 8), b1 = *(const float4*)(gnb + h * 64 + eq * 8 + 4);
        const float gw[8] = {w0.x, w0.y, w0.z, w0.w, w1.x, w1.y, w1.z, w1.w}, gb[8] = {b0.x, b0.y, b0.z, b0.w, b1.x, b1.y, b1.z, b1.w};
#pragma unroll
        for (int i = 0; i < 8; ++i) o8[i] = (y[i] * rstd * gw[i] + gb[i] + cbon * v8[i]) * g8[i];
        *(uint4*)(O + (size_t)t * 512 + h * 64 + eq * 8) = pack8(o8);
    }
}

constexpr int LDS_BYTES = 150528 + 64;
constexpr int N_PHASES = 14;
constexpr size_t WS_BAR = 19 * MiB;
struct MP { const float* in[28]; float* out; unsigned char* ws; int ph_lo, ph_hi; };

__global__ void __launch_bounds__(512, 2) mega(MP p) {
    extern __shared__ __attribute__((aligned(16))) unsigned char lds[];
    const int bid = blockIdx.x, nblk = gridDim.x, tid = threadIdx.x;
    volatile LAS unsigned* st = (volatile LAS unsigned*)(lds + LDS_BYTES - 16);
    if (tid < 4) st[tid] = 0u;
    __syncthreads();
    const int lo = p.ph_lo, hi = p.ph_hi;
    XcdBarrier bar; bar.bar = (unsigned*)(p.ws + WS_BAR); bar.x = 0; bar.st = st;
    if (hi - lo > 1) bar = xcd_barrier_post((unsigned*)(p.ws + WS_BAR), st);
    unsigned rk_ = 0u;
    if (tid == 0 && hi - lo > 1) rk_ = xb_add((unsigned*)(p.ws + WS_BAR) + XCD_BAR_WORDS + 64 * bar.x, 1u);
#define IN(k) (lo <= (k) && (k) < hi)
    unsigned nbar = 0u;
#define SEAM(k) do { if (IN(k) && IN((k) + 1)) { xcd_barrier(bar, nbar); ++nbar; } } while (0)
#define SEAMN(k) do { if (IN(k) && IN((k) + 1)) { xcd_barrier<false>(bar, nbar); ++nbar; } } while (0)
    unsigned char* ws = p.ws; unsigned char* ob = (unsigned char*)p.out;
    const float* x = p.in[0];
    bf16 *WIN_T = (bf16*)(ws + WS_WIN_T), *PW_T = (bf16*)(ws + WS_PW_T), *WO_T = (bf16*)(ws + WS_WO_T), *WOUT_T = (bf16*)(ws + WS_WOUT_T), *WQ_T = (bf16*)(ws + WS_WQ_T), *KEYS = (bf16*)(ws + WS_KEYS);
    bf16 *XN = (bf16*)(ws + WS_XN), *PROJ = (bf16*)(ws + WS_PROJ), *YN = (bf16*)(ws + WS_YN), *G = (bf16*)(ws + WS_G), *M = (bf16*)(ws + WS_M);
    bf16 *Q = (bf16*)(ws + WS_Q);
    u8 *U8 = (u8*)(ws + WS_XN), *V8 = (u8*)(ws + WS_PROJ + 64 * MiB), *H8 = (u8*)(ws + WS_PROJ + 80 * MiB);
    bf16* XN2 = (bf16*)(ws + WS_M);
    float *USC = (float*)(ws + 19 * MiB + 512 * 1024), *VSC = USC + 16384, *HS = USC + 32768, *CF = (float*)(ws + WS_PROJ + 144 * MiB), *SS = (float*)(ws + WS_BONUS), *SCL = USC + 65536, *PARTB = (float*)(ws + WS_Q);
    float *BONUS = (float*)(ws + WS_BONUS), *GATE = (float*)(ws + WS_GATE); int* EID = (int*)(ws + WS_EID);
    bf16 *OMG = (bf16*)(ob), *Y0 = (bf16*)(ob + 16 * MiB), *V = (bf16*)(ob + 32 * MiB), *O = (bf16*)(ob + 48 * MiB);
    bf16 *PHI = (bf16*)(ws + WS_LD), *PSI = (bf16*)(ws + WS_LD + 16 * MiB);
    bf16* X1 = (bf16*)(ws + WS_PROJ + 96 * MiB);

    if (IN(0)) {
        ph_transpose_reg(bid, nblk, 0, p.in[2], WIN_T, 1024, DIN, DINP);
        ph_rmsnorm(bid, nblk, x, p.in[1], XN, T);
        __syncthreads();
    }
    if (tid == 0) st[2] = rk_;
    SEAMN(0);
    if (IN(1)) ph_gemm(lds, bid, nblk, XN, WIN_T, T, DINP, 1024, EpiGen<FStoreBf16>{FStoreBf16{PROJ, DINP}});
    SEAMN(1);
    if (IN(2)) {
        ChunkParams cp{PROJ, p.in[9], p.in[10], p.in[11], p.in[12], p.in[13], p.in[14], p.in[15], p.in[16], p.in[17], V, G, PHI, PSI, OMG, Y0, BONUS};
        ph_chunkprep(lds, bid, nblk, cp);
        __syncthreads();
    }
    SEAMN(2);
    if (IN(3)) {
        if (bid < 32) ph_chain2(lds, bid, PHI, PSI);
        else {
            const int ob_ = bid - 32, on_ = nblk - 32;
            int t0 = 0;
            t0 += ph_transpose(lds, ob_, on_, t0, p.in[7], PW_T, 512, 1024, 1024);
            t0 += ph_transpose(lds, ob_, on_, t0, p.in[20], WO_T, 512, 1024, 1024);
            t0 += ph_transpose(lds, ob_, on_, t0, p.in[21], WOUT_T, 1024, 1024, 1024);
            t0 += ph_transpose(lds, ob_, on_, t0, p.in[23], WQ_T, 1024, 2048, 2048, p.in[22]);
            ph_cvt(ob_, on_, p.in[24], KEYS, (size_t)(8 * 2 * 128 * 128 / 4));
            ph_cvt_i4<false>(ob_, on_, p.in[25], U8, USC, 16384);
            __syncthreads();
        }
    }
    SEAM(3);
    if (IN(4)) {
        ph_yout(lds, bid, nblk, PHI, OMG, Y0, V, G, BONUS, p.in[18], p.in[19], O);
        __syncthreads();
        {
            const int ob_ = bid, on_ = nblk;
            ph_conv(lds, ob_, on_, PROJ, p.in[3], p.in[4], p.in[5], p.in[6], YN);
            __syncthreads();
            __syncthreads();
        }
    }
    SEAM(4);
    if (IN(5)) ph_gemm2(lds, bid, nblk, YN, PW_T, O, WO_T, T, 1024, 512, 8, 16, EpiMix{M, PROJ, p.in[8]});
    SEAMN(5);
    if (IN(6)) ph_gemm(lds, bid, nblk, M, WOUT_T, T, 1024, 1024, EpiGen2<FResX12B>{FResX12B{x, X1}});
    SEAM(6);
    if (IN(7)) {
        ph_rowstat(bid, nblk, X1, p.in[22], H8, HS, SCL, T);
        __syncthreads();
        ph_gemm(lds, bid, nblk, X1, WQ_T, T, 2048, 1024, EpiGen<FStoreBf16>{FStoreBf16{Q, 2048}});
    }
    SEAM(7);
    if (IN(9)) ph_topk2(lds, bid, nblk, Q, KEYS, SCL, (unsigned short*)CF, GATE, p.in[26], V8, VSC);
    SEAM(9);
    Part part4;
    const bool census_ok = (hi - lo > 1) && st[-3] != 0u && bar.x < 8u;
    if (census_ok) {
        const unsigned n0 = st[-1], n1 = st[-2];
        part4.p0 = (int)(bar.x >> 1); part4.pstep = 4; part4.rank = (int)(((bar.x & 1u) ? n0 : 0u) + st[2]); part4.nrank = (int)(n0 + n1);
    } else if ((nblk % 4) == 0) { part4.p0 = bid & 3; part4.pstep = 4; part4.rank = bid >> 2; part4.nrank = nblk >> 2; }
    else { part4.p0 = 0; part4.pstep = 1; part4.rank = bid; part4.nrank = nblk; }
    if (IN(10)) ph_peer_u7(lds, part4, H8, HS, U8, (const unsigned short*)CF, (bf16*)PARTB);
    SEAM(10);
    if (IN(11)) ph_peer_cf3(bid, nblk, (const bf16*)PARTB, USC, VSC, (const unsigned short*)CF, GATE, (unsigned*)((unsigned short*)CF + (size_t)T * 128), HS + 16384, 4);
    SEAM(11);
    if (IN(12)) ph_peer_v8(lds, part4, X1, X1, V8, (const unsigned short*)CF, (const unsigned*)((const unsigned short*)CF + (size_t)T * 128), HS + 16384, SS);
    SEAM(12);
    if (IN(13)) ph_peer_f(bid, nblk, X1, p.out, SS, p.in[27]);
#undef IN
#undef SEAM
#undef SEAMN
}

#ifndef MK_PER_PHASE
#define MK_PER_PHASE 0
#endif
extern "C" void kernel_launch(void* const* d_in, const int* in_sizes, int n_in, void* d_out, int out_size, void* d_ws, size_t ws_size, hipStream_t stream) {
    static int grid = 0;
    if (grid == 0) {
        if (n_in != 28 || ws_size < WS_END) { fprintf(stderr, "kernel_launch: unexpected n_in %d / ws_size %zu\n", n_in, ws_size); grid = -1; return; }
        int dev = 0, cus = 0;
        if (hipGetDevice(&dev) != hipSuccess || hipDeviceGetAttribute(&cus, hipDeviceAttributeMultiprocessorCount, dev) != hipSuccess) { grid = -1; return; }
        if (hipFuncSetAttribute((const void*)mega, hipFuncAttributeMaxDynamicSharedMemorySize, LDS_BYTES) != hipSuccess) { fprintf(stderr, "kernel_launch: hipFuncSetAttribute failed\n"); grid = -1; return; }
        (void)hipGetLastError();
        grid = cus;
    }
    if (grid < 0) return;
    (void)hipMemsetAsync((unsigned char*)d_ws + WS_BAR, 0, XCD_BAR_WORDS * 4 + 16 * 256, stream);
    MP a{};
    for (int i = 0; i < 28; ++i) a.in[i] = (const float*)d_in[i];
    a.out = (float*)d_out; a.ws = (unsigned char*)d_ws;
#if MK_PER_PHASE
    for (int ph = 0; ph < N_PHASES; ++ph) { a.ph_lo = ph; a.ph_hi = ph + 1; hipLaunchKernelGGL(mega, dim3(grid), dim3(512), LDS_BYTES, stream, a); }
#else
    a.ph_lo = 0; a.ph_hi = N_PHASES;
    hipLaunchKernelGGL(mega, dim3(grid), dim3(512), LDS_BYTES, stream, a);
#endif
}
```
